# Optimizing an MI355X kernel written in HIP

```python
import math
import jax
import jax.numpy as jnp
from jax import lax
import numpy as np

D_MODEL = 2048
BATCH = 4
SEQ = 8192
DEPTH = 2

GRID_W = 64
CTX_LEN = 256
N_DIR = 2

ML_HEADS = 4
ML_DH = 256
ML_W = ML_HEADS * ML_DH
ML_CHUNK = 64
ML_NORM_EPS = 1e-6

RW_HEADS = 16
RW_DH = 64
RW_W = RW_HEADS * RW_DH
RW_DECAY_RANK = 64
RW_A_RANK = 64
RW_G_RANK = 128
RW_DECAY_OFFSET = 0.5
RW_NORM_EPS = 64e-5

S5_W = 1024
S5_GROUP = 16
S5_GROUPS = S5_W // S5_GROUP
S5_STATE = 64

N_BRANCH = 3

N_GROUPS = 4
EXPERTS_PER_GROUP = 4
N_EXPERTS = N_GROUPS * EXPERTS_PER_GROUP
TOP_K = 2
D_EXPERT = 1024

DEEPNORM_ALPHA = (2.0 * DEPTH) ** 0.25
DEEPNORM_BETA = (8.0 * DEPTH) ** -0.25
LN_EPS = 1e-5
N_MOD = 6

IN_WIDTHS = (ML_W, ML_W, ML_W, ML_W, N_DIR * ML_HEADS, N_DIR * ML_HEADS,
             RW_W, RW_W, RW_W, N_DIR * RW_DECAY_RANK, N_DIR * RW_A_RANK, RW_G_RANK,
             S5_W, N_BRANCH * D_MODEL)
D_IN = sum(IN_WIDTHS)
RW_IN_WIDTHS = (RW_W, RW_W, RW_W, N_DIR * RW_DECAY_RANK, N_DIR * RW_A_RANK, RW_G_RANK)
RW_IN_W = sum(RW_IN_WIDTHS)

kernel_name = 'hybrid_mlstm_rwkv7_s5_moe_deepnorm'


def layer_norm(x, eps=LN_EPS):
    xf = x.astype(jnp.float32)
    mu = jnp.mean(xf, axis=-1, keepdims=True)
    var = jnp.mean(jnp.square(xf - mu), axis=-1, keepdims=True)
    return (xf - mu) * lax.rsqrt(var + eps)


def modulate(x, shift, scale):
    return (layer_norm(x) * (1.0 + scale) + shift).astype(x.dtype)


def post_norm(z, gain, bias):
    return (layer_norm(z) * gain + bias).astype(z.dtype)


def head_norm(h, gain, bias, eps):
    y = layer_norm(h, eps)
    return y.reshape(h.shape[:-2] + (-1,)) * gain + bias


def split_cols(z, widths):
    return jnp.split(z, np.cumsum(widths)[:-1].tolist(), axis=-1)


def depthwise_conv3x3(z, w, b):
    ch = z.shape[-1]
    y = lax.conv_general_dilated(z, w[:, :, None, :].astype(z.dtype), window_strides=(1, 1), padding='SAME',
                                 dimension_numbers=('NHWC', 'HWIO', 'NHWC'), feature_group_count=ch)
    return y + b.astype(z.dtype)


def centred_shift(z):
    zp = jnp.pad(z, ((0, 0), (1, 1), (0, 0)))
    return 0.5 * (zp[:, :-2] + zp[:, 2:])


def dir_seq(c, x):
    fwd = jnp.concatenate([c[0], x[0]], axis=1)
    bwd = jnp.concatenate([jnp.flip(c[-1], 1), jnp.flip(x[-1], 1)], axis=1)
    return jnp.stack([fwd, bwd])


def dir_unsum(y, n_ctx):
    yc = y[0, :, :n_ctx] + jnp.flip(y[1, :, :n_ctx], 1)
    yx = y[0, :, n_ctx:] + jnp.flip(y[1, :, n_ctx:], 1)
    return yc, yx


def mlstm_chunkwise(q, k, v, ig, fg):
    P, B, T, H, dk = q.shape
    dv = v.shape[-1]
    L = ML_CHUNK
    n_chunks = T // L

    def to_chunks(a):
        a = a.astype(jnp.float32).reshape((P, B, n_chunks, L) + a.shape[3:])
        return jnp.swapaxes(jnp.moveaxis(a, 2, 0), 3, 4)

    xs = (to_chunks(q), to_chunks(k * dk ** -0.5), to_chunks(v), to_chunks(ig),
          to_chunks(jax.nn.log_sigmoid(fg.astype(jnp.float32))))
    tri = jnp.tril(jnp.ones((L, L), dtype=bool))

    def step(carry, inp):
        cmat, nvec, m = carry
        qj, kj, vj, li, lf = inp
        bcum = jnp.cumsum(lf, axis=-1)
        log_d = jnp.where(tri, bcum[..., :, None] - bcum[..., None, :] + li[..., None, :], -jnp.inf)
        inter = bcum + m[..., None]
        m_j = jnp.maximum(jnp.max(log_d, axis=-1), inter)
        scores = jnp.einsum('pbhjd,pbhsd->pbhjs', qj, kj) * jnp.exp(log_d - m_j[..., None])
        s_inter = jnp.exp(inter - m_j)
        num = (jnp.einsum('pbhjs,pbhsv->pbhjv', scores, vj)
               + s_inter[..., None] * jnp.einsum('pbhvd,pbhjd->pbhjv', cmat, qj))
        den = jnp.sum(scores, axis=-1) + s_inter * jnp.einsum('pbhd,pbhjd->pbhj', nvec, qj)
        h = num / jnp.maximum(jnp.abs(den), jnp.exp(-m_j))[..., None]
        b_last = bcum[..., -1]
        log_w = b_last[..., None] - bcum + li
        m_new = jnp.maximum(b_last + m, jnp.max(log_w, axis=-1))
        wts = jnp.exp(log_w - m_new[..., None])
        carry_decay = jnp.exp(b_last + m - m_new)
        cmat = carry_decay[..., None, None] * cmat + jnp.einsum('pbhs,pbhsv,pbhsd->pbhvd', wts, vj, kj)
        nvec = carry_decay[..., None] * nvec + jnp.einsum('pbhs,pbhsd->pbhd', wts, kj)
        return (cmat, nvec, m_new), h

    init = (jnp.zeros((P, B, H, dv, dk), jnp.float32), jnp.zeros((P, B, H, dk), jnp.float32),
            jnp.zeros((P, B, H), jnp.float32))
    _, h = lax.scan(step, init, xs)
    h = jnp.moveaxis(jnp.swapaxes(h, 3, 4), 0, 2)
    return h.reshape(P, B, T, H, dv)


def rwkv7_scan(r, w, k, v, kk, a):
    P, B, T, H, n = r.shape

    def to_time(z):
        return jnp.moveaxis(z.astype(jnp.float32), 2, 0)

    def step(s, inp):
        rt, wt, kt, vt, kkt, at = inp
        s_kk = jnp.einsum('pbhvk,pbhk->pbhv', s, kkt)
        s = s * wt[..., None, :] - s_kk[..., :, None] * (kkt * at)[..., None, :] + vt[..., :, None] * kt[..., None, :]
        return s, jnp.einsum('pbhvk,pbhk->pbhv', s, rt)

    s0 = jnp.zeros((P, B, H, n, n), jnp.float32)
    _, y = lax.scan(step, s0, tuple(to_time(z) for z in (r, w, k, v, kk, a)))
    return jnp.moveaxis(y, 0, 2)


def _diag_linear_combine(e1, e2):
    a1, b1 = e1
    a2, b2 = e2
    return a1 * a2, a2 * b1 + b2


def mlstm_branch(seg_c, seg_x, hw_c, hw_x, conv_w, conv_b, ig_b, fg_b, norm_g, norm_b):
    def heads(z):
        return z.reshape(z.shape[:-1] + (ML_HEADS, ML_DH))[None]

    prepped = []
    for (q, k, v, o, ig, fg), (rows, cols) in ((seg_c, hw_c), (seg_x, hw_x)):
        bsz, length, _ = q.shape
        qk = jnp.concatenate([q, k], axis=-1).reshape(bsz, rows, cols, 2 * ML_W)
        qk = jax.nn.silu(depthwise_conv3x3(qk, conv_w, conv_b)).reshape(bsz, length, 2 * ML_W)
        q, k = jnp.split(qk, 2, axis=-1)
        ig = jnp.moveaxis(ig.reshape(bsz, length, N_DIR, ML_HEADS) + ig_b, 2, 0)
        fg = jnp.moveaxis(fg.reshape(bsz, length, N_DIR, ML_HEADS) + fg_b, 2, 0)
        prepped.append((heads(q), heads(k), heads(v), ig, fg))
    (qc, kc, vc, ic, fc), (qx, kx, vx, ix, fx) = prepped
    h = mlstm_chunkwise(dir_seq(qc, qx), dir_seq(kc, kx), dir_seq(vc, vx), dir_seq(ic, ix), dir_seq(fc, fx))
    hc, hx = dir_unsum(h, qc.shape[2])
    oc, ox = seg_c[3], seg_x[3]
    yc = (jax.nn.sigmoid(oc) * head_norm(hc, norm_g, norm_b, ML_NORM_EPS)).astype(oc.dtype)
    yx = (jax.nn.sigmoid(ox) * head_norm(hx, norm_g, norm_b, ML_NORM_EPS)).astype(ox.dtype)
    return yc, yx


def rwkv7_branch(seg_c, seg_x, mu, w0, w_up, a0, a_up, g_up, k_k, k_a, r_k, norm_g, norm_b):
    def hd(z):
        return z.reshape(z.shape[:-1] + (RW_HEADS, RW_DH))

    prepped = []
    for seg in (seg_c, seg_x):
        z = jnp.concatenate(seg, axis=-1)
        z = z + mu * (centred_shift(z) - z)
        r, k, v, wd, ad, gd = split_cols(z, RW_IN_WIDTHS)
        bsz, length, _ = r.shape
        wd = wd.reshape(bsz, length, N_DIR, RW_DECAY_RANK)
        ad = ad.reshape(bsz, length, N_DIR, RW_A_RANK)
        w_pre = (w0 + jnp.einsum('bldr,drc->bldc', jnp.tanh(wd), w_up)).astype(jnp.float32)
        decay = jnp.exp(-jnp.exp(-jax.nn.softplus(-w_pre) - RW_DECAY_OFFSET))
        a = jax.nn.sigmoid(a0 + jnp.einsum('bldr,drc->bldc', ad, a_up))
        g = jax.nn.sigmoid(gd) @ g_up
        kk = hd(k * k_k).astype(jnp.float32)
        kk = kk / jnp.maximum(jnp.sqrt(jnp.sum(jnp.square(kk), axis=-1, keepdims=True)), 1e-12)
        k_dir = k[:, :, None, :] * (1.0 + (a - 1.0) * k_a)
        bonus = jnp.sum(hd(r[:, :, None, :] * k_dir * r_k.reshape(-1)), axis=(2, 4))
        bonus = bonus[..., None] * hd(v)
        prepped.append((hd(r)[None], jnp.moveaxis(hd(decay), 2, 0), jnp.moveaxis(hd(k_dir), 2, 0),
                        hd(v)[None], kk[None], jnp.moveaxis(hd(a), 2, 0), bonus, g))
    (rc, dc, kc, vc, kkc, ac, bc, gc), (rx, dx, kx, vx, kkx, ax, bx, gx) = prepped
    y = rwkv7_scan(dir_seq(rc, rx), dir_seq(dc, dx), dir_seq(kc, kx), dir_seq(vc, vx),
                   dir_seq(kkc, kkx), dir_seq(ac, ax))
    yc, yx = dir_unsum(y, rc.shape[2])

    def finish(yy, bonus, g):
        out = (head_norm(yy, norm_g, norm_b, RW_NORM_EPS) + bonus.reshape(bonus.shape[:-2] + (-1,))) * g
        return out.astype(g.dtype)

    return finish(yc, bc, gc), finish(yx, bx, gx)


def s5_branch(uc, ux, lam_re, lam_im, log_dt, b_re, b_im, c_re, c_im, d_skip):
    n_ctx = uc.shape[1]
    useq = dir_seq(uc[None], ux[None]).astype(jnp.float32)
    _, bsz, t_len, _ = useq.shape
    yc = d_skip * uc.astype(jnp.float32)
    yx = d_skip * ux.astype(jnp.float32)
    for d in range(N_DIR):
        lam = lax.complex(lam_re[d].astype(jnp.float32), lam_im[d].astype(jnp.float32))
        lam_bar = jnp.exp(lam * jnp.exp(log_dt[d].astype(jnp.float32))[:, None])
        b_bar = ((lam_bar - 1.0) / lam)[..., None] * lax.complex(b_re[d].astype(jnp.float32),
                                                                  b_im[d].astype(jnp.float32))
        u = useq[d].reshape(bsz, t_len, S5_GROUPS, S5_GROUP).astype(jnp.complex64)
        bu = jnp.einsum('gnc,btgc->btgn', b_bar, u)
        a_el = jnp.broadcast_to(lam_bar, (1, t_len) + lam_bar.shape)
        _, state = lax.associative_scan(_diag_linear_combine, (a_el, bu), axis=1)
        c_mat = lax.complex(c_re[d].astype(jnp.float32), c_im[d].astype(jnp.float32))
        y = jnp.real(jnp.einsum('gcn,btgn->btgc', c_mat, state)).reshape(bsz, t_len, S5_W)
        if d == 0:
            yc = yc + y[:, :n_ctx]
            yx = yx + y[:, n_ctx:]
        else:
            yc = yc + jnp.flip(y[:, :n_ctx], 1)
            yx = yx + jnp.flip(y[:, n_ctx:], 1)
    return jax.nn.gelu(yc).astype(uc.dtype), jax.nn.gelu(yx).astype(ux.dtype)


def token_mixer(uc, ux, need_ctx, w_in,
                ml_conv_w, ml_conv_b, ml_ig_b, ml_fg_b, ml_norm_g, ml_norm_b, ml_proj,
                rw_mu, rw_w0, rw_w_up, rw_a0, rw_a_up, rw_g_up, rw_k_k, rw_k_a, rw_r_k,
                rw_norm_g, rw_norm_b, rw_proj,
                s5_lam_re, s5_lam_im, s5_log_dt, s5_b_re, s5_b_im, s5_c_re, s5_c_im, s5_d,
                s5_w_val, s5_w_gate, w_out):
    hw_c = (1, uc.shape[1])
    hw_x = (ux.shape[1] // GRID_W, GRID_W)
    pc = split_cols(uc @ w_in, IN_WIDTHS)
    px = split_cols(ux @ w_in, IN_WIDTHS)
    ml_c, ml_x = mlstm_branch(pc[0:6], px[0:6], hw_c, hw_x, ml_conv_w, ml_conv_b, ml_ig_b, ml_fg_b,
                              ml_norm_g, ml_norm_b)
    rw_c, rw_x = rwkv7_branch(pc[6:12], px[6:12], rw_mu, rw_w0, rw_w_up, rw_a0, rw_a_up, rw_g_up,
                              rw_k_k, rw_k_a, rw_r_k, rw_norm_g, rw_norm_b)
    s5_c, s5_x = s5_branch(pc[12], px[12], s5_lam_re, s5_lam_im, s5_log_dt, s5_b_re, s5_b_im,
                           s5_c_re, s5_c_im, s5_d)

    def merge(ml, rw, s5, gate_pre):
        g = jax.nn.sigmoid(gate_pre).reshape(gate_pre.shape[:-1] + (N_BRANCH, D_MODEL))
        z = (g[..., 0, :] * (ml @ ml_proj) + g[..., 1, :] * (rw @ rw_proj)
             + g[..., 2, :] * ((s5 @ s5_w_val) * jax.nn.sigmoid(s5 @ s5_w_gate)))
        return z @ w_out

    out_x = merge(ml_x, rw_x, s5_x, px[13])
    out_c = merge(ml_c, rw_c, s5_c, pc[13]) if need_ctx else None
    return out_c, out_x


def moe_ffn(u, router_w, router_b, w_gate, w_up, w_down):
    n_tok = u.shape[0]
    affinity = jax.nn.sigmoid((u @ router_w).astype(jnp.float32))
    grouped = (affinity + router_b.astype(jnp.float32)).reshape(n_tok, N_GROUPS, EXPERTS_PER_GROUP)
    group_score = jnp.sum(lax.top_k(grouped, TOP_K)[0], axis=-1)
    best = jnp.argmax(group_score, axis=-1)
    keep = (best[:, None] == jnp.arange(N_GROUPS))[..., None]
    masked = jnp.where(keep, grouped, -jnp.inf).reshape(n_tok, N_EXPERTS)
    _, idx = lax.top_k(masked, TOP_K)
    wsel = jnp.take_along_axis(affinity, idx, axis=-1)
    wsel = wsel / jnp.sum(wsel, axis=-1, keepdims=True)
    gates = jnp.sum((idx[..., None] == jnp.arange(N_EXPERTS)).astype(jnp.float32) * wsel[..., None], axis=1)
    gates = gates.astype(u.dtype)
    out = jnp.zeros_like(u)
    for e in range(N_EXPERTS):
        h = jax.nn.silu(u @ w_gate[e]) * (u @ w_up[e])
        out = out + gates[:, e, None] * (h @ w_down[e])
    return out


def setup_inputs(seed: int = 0) -> dict:
    key = jax.random.key(seed)
    ks = iter(jax.random.split(key, 64))

    def nrm(shape, scale):
        return scale * jax.random.normal(next(ks), shape, jnp.float32)

    def unif(shape, lo, hi):
        return jax.random.uniform(next(ks), shape, jnp.float32, minval=lo, maxval=hi)

    L = DEPTH
    D = D_MODEL
    return {
        'x': nrm((BATCH, SEQ, D), 1.0),
        'c': nrm((BATCH, D), 1.0),
        'ctx': nrm((BATCH, CTX_LEN, D), 1.0),
        'c_ctx': nrm((D,), 1.0),
        'ada_w': nrm((L, D, N_MOD * D), D ** -0.5),
        'ada_b': nrm((L, N_MOD * D), 0.02),
        'w_in': nrm((L, D, D_IN), D ** -0.5),
        'ml_conv_w': nrm((L, 3, 3, 2 * ML_W), 1.0 / 3.0),
        'ml_conv_b': nrm((L, 2 * ML_W), 0.02),
        'ml_ig_b': nrm((L, N_DIR, ML_HEADS), 0.5),
        'ml_fg_b': jnp.linspace(3.0, 6.0, ML_HEADS) + nrm((L, N_DIR, ML_HEADS), 0.1),
        'ml_norm_g': 1.0 + nrm((L, ML_W), 0.02),
        'ml_norm_b': nrm((L, ML_W), 0.02),
        'ml_proj': nrm((L, ML_W, D), DEEPNORM_BETA * ML_W ** -0.5),
        'rw_mu': unif((L, RW_IN_W), 0.0, 1.0),
        'rw_w0': jnp.linspace(-6.0, -1.0, RW_W) + nrm((L, N_DIR, RW_W), 0.1),
        'rw_w_up': nrm((L, N_DIR, RW_DECAY_RANK, RW_W), 0.5 * RW_DECAY_RANK ** -0.5),
        'rw_a0': nrm((L, N_DIR, RW_W), 0.1),
        'rw_a_up': nrm((L, N_DIR, RW_A_RANK, RW_W), 0.5 * RW_A_RANK ** -0.5),
        'rw_g_up': nrm((L, RW_G_RANK, RW_W), RW_G_RANK ** -0.5),
        'rw_k_k': 0.85 + nrm((L, RW_W), 0.02),
        'rw_k_a': 1.0 + nrm((L, RW_W), 0.02),
        'rw_r_k': nrm((L, RW_HEADS, RW_DH), 0.1),
        'rw_norm_g': 1.0 + nrm((L, RW_W), 0.02),
        'rw_norm_b': nrm((L, RW_W), 0.02),
        'rw_proj': nrm((L, RW_W, D), DEEPNORM_BETA * RW_W ** -0.5),
        's5_lam_re': -0.5 + nrm((L, N_DIR, S5_GROUPS, S5_STATE), 0.01),
        's5_lam_im': math.pi * jnp.arange(S5_STATE, dtype=jnp.float32) + nrm((L, N_DIR, S5_GROUPS, S5_STATE), 0.01),
        's5_log_dt': unif((L, N_DIR, S5_GROUPS), math.log(1e-3), math.log(1e-1)),
        's5_b_re': nrm((L, N_DIR, S5_GROUPS, S5_STATE, S5_GROUP), (2.0 * S5_GROUP) ** -0.5),
        's5_b_im': nrm((L, N_DIR, S5_GROUPS, S5_STATE, S5_GROUP), (2.0 * S5_GROUP) ** -0.5),
        's5_c_re': nrm((L, N_DIR, S5_GROUPS, S5_GROUP, S5_STATE), 1.0),
        's5_c_im': nrm((L, N_DIR, S5_GROUPS, S5_GROUP, S5_STATE), 1.0),
        's5_d': nrm((L, S5_W), 0.5),
        's5_w_val': nrm((L, S5_W, D), DEEPNORM_BETA * S5_W ** -0.5),
        's5_w_gate': nrm((L, S5_W, D), S5_W ** -0.5),
        'w_out': nrm((L, D, D), DEEPNORM_BETA * D ** -0.5),
        'ln1_g': 1.0 + nrm((L, D), 0.02),
        'ln1_b': nrm((L, D), 0.02),
        'ln2_g': 1.0 + nrm((L, D), 0.02),
        'ln2_b': nrm((L, D), 0.02),
        'router_w': nrm((D, N_EXPERTS), D ** -0.5),
        'router_b': nrm((N_EXPERTS,), 0.01),
        'exp_w_gate': nrm((L, N_EXPERTS, D, D_EXPERT), D ** -0.5),
        'exp_w_up': nrm((L, N_EXPERTS, D, D_EXPERT), D ** -0.5),
        'exp_w_down': nrm((L, N_EXPERTS, D_EXPERT, D), DEEPNORM_BETA * D_EXPERT ** -0.5),
    }


def reference(x, c, ctx, c_ctx, ada_w, ada_b, w_in, ml_conv_w, ml_conv_b, ml_ig_b, ml_fg_b, ml_norm_g,
              ml_norm_b, ml_proj, rw_mu, rw_w0, rw_w_up, rw_a0, rw_a_up, rw_g_up, rw_k_k, rw_k_a, rw_r_k,
              rw_norm_g, rw_norm_b, rw_proj, s5_lam_re, s5_lam_im, s5_log_dt, s5_b_re, s5_b_im, s5_c_re,
              s5_c_im, s5_d, s5_w_val, s5_w_gate, w_out, ln1_g, ln1_b, ln2_g, ln2_b, router_w, router_b,
              exp_w_gate, exp_w_up, exp_w_down):
    silu_c = jax.nn.silu(c)[:, None, :]
    silu_cc = jax.nn.silu(c_ctx)[None, None, :]
    xc = ctx
    for i in range(DEPTH):
        need_ctx = i < DEPTH - 1
        mx = jnp.split(silu_c @ ada_w[i] + ada_b[i], N_MOD, axis=-1)
        mc = jnp.split(silu_cc @ ada_w[i] + ada_b[i], N_MOD, axis=-1)
        mix_c, mix_x = token_mixer(
            modulate(xc, mc[0], mc[1]), modulate(x, mx[0], mx[1]), need_ctx, w_in[i],
            ml_conv_w[i], ml_conv_b[i], ml_ig_b[i], ml_fg_b[i], ml_norm_g[i], ml_norm_b[i], ml_proj[i],
            rw_mu[i], rw_w0[i], rw_w_up[i], rw_a0[i], rw_a_up[i], rw_g_up[i], rw_k_k[i], rw_k_a[i], rw_r_k[i],
            rw_norm_g[i], rw_norm_b[i], rw_proj[i],
            s5_lam_re[i], s5_lam_im[i], s5_log_dt[i], s5_b_re[i], s5_b_im[i], s5_c_re[i], s5_c_im[i], s5_d[i],
            s5_w_val[i], s5_w_gate[i], w_out[i])
        x = post_norm(DEEPNORM_ALPHA * x + mx[2] * mix_x, ln1_g[i], ln1_b[i])
        tokens = [modulate(x, mx[3], mx[4]).reshape(-1, D_MODEL)]
        if need_ctx:
            xc = post_norm(DEEPNORM_ALPHA * xc + mc[2] * mix_c, ln1_g[i], ln1_b[i])
            tokens.append(modulate(xc, mc[3], mc[4]).reshape(-1, D_MODEL))
        ffn = moe_ffn(jnp.concatenate(tokens, axis=0), router_w, router_b, exp_w_gate[i], exp_w_up[i],
                      exp_w_down[i])
        n_lat = x.shape[0] * x.shape[1]
        x = post_norm(DEEPNORM_ALPHA * x + mx[5] * ffn[:n_lat].reshape(x.shape), ln2_g[i], ln2_b[i])
        if need_ctx:
            xc = post_norm(DEEPNORM_ALPHA * xc + mc[5] * ffn[n_lat:].reshape(xc.shape), ln2_g[i], ln2_b[i])
    return x
```

```cpp
#include <hip/hip_runtime.h>
#include <stdint.h>
#include <stdio.h>

#define LAS __attribute__((address_space(3)))
typedef unsigned short bf16_t;
typedef short bf16x8 __attribute__((ext_vector_type(8)));
typedef float f32x4 __attribute__((ext_vector_type(4)));
typedef float f32x2 __attribute__((ext_vector_type(2)));
typedef unsigned u32x4 __attribute__((ext_vector_type(4)));
typedef unsigned u32x2 __attribute__((ext_vector_type(2)));

constexpr int D = 2048, NB = 4, SEQ = 8192, CTXL = 256, TB = SEQ + CTXL, R = NB * TB;
constexpr int NCH = TB / 64;
constexpr int PW = 8704;
constexpr int PC_Q = 0, PC_K = 1024, PC_V = 2048, PC_O = 3072, PC_IG = 4096, PC_FG = 4104, PC_RR = 4112, PC_RK = 5136, PC_RV = 6160,
              PC_WD = 7184, PC_AD = 7312, PC_GD = 7440, PC_S5 = 7568, PC_END = 8592;
constexpr int NTHR = 512, NWAVE = 8;
constexpr int LDS_BYTES = 163840;
constexpr float ALPHA = 1.4142135623730951f;
constexpr float LN_EPS = 1e-5f;

enum { I_X = 0, I_C, I_CTX, I_CCTX, I_ADAW, I_ADAB, I_WIN, I_MLCW, I_MLCB, I_MLIGB, I_MLFGB, I_MLNG, I_MLNB, I_MLPROJ, I_RWMU, I_RWW0, I_RWWUP, I_RWA0, I_RWAUP,
       I_RWGUP, I_RWKK, I_RWKA, I_RWRK, I_RWNG, I_RWNB, I_RWPROJ, I_S5LRE, I_S5LIM, I_S5LDT, I_S5BRE, I_S5BIM, I_S5CRE, I_S5CIM, I_S5D, I_S5WV, I_S5WG, I_WOUT,
       I_LN1G, I_LN1B, I_LN2G, I_LN2B, I_ROUTW, I_ROUTB, I_EWG, I_EWU, I_EWD, N_IN };

constexpr size_t al256(size_t x) { return (x + 255) & ~(size_t)255; }
constexpr size_t WS_CTL = 0, CTL_BYTES = 65536;
constexpr size_t WS_MODS = WS_CTL + CTL_BYTES;
constexpr size_t WS_ROUTE = al256(WS_MODS + 2 * 5 * 12288 * 4);
constexpr size_t WS_BONUS = al256(WS_ROUTE + (size_t)R * 8 * 4);
constexpr size_t WS_S5KC = al256(WS_BONUS + (size_t)2 * R * 16 * 4);
constexpr size_t WS_S5E = al256(WS_S5KC + (size_t)64 * 128 * 256 * 2);
constexpr size_t WS_S5F = al256(WS_S5E + (size_t)64 * 256 * 1024 * 2);
constexpr size_t WS_S5X = al256(WS_S5F + (size_t)64 * 1024 * 256 * 2);
constexpr size_t WS_GUPT = al256(WS_S5X + (size_t)64 * 528 * 256 * 4);
constexpr size_t WS_WIN = al256(WS_GUPT + (size_t)1024 * 128 * 2);
constexpr size_t WS_WG = al256(WS_WIN + (size_t)PW * D * 2);
constexpr size_t WS_WML = al256(WS_WG + (size_t)6144 * D * 2);
constexpr size_t WS_WOUT = al256(WS_WML + (size_t)4 * 2048 * 1024 * 2);
constexpr size_t WS_EGU = al256(WS_WOUT + (size_t)2048 * 2048 * 2);
constexpr size_t WS_EDN = al256(WS_EGU + (size_t)16 * 2048 * 2048 * 2);
constexpr size_t WS_P = al256(WS_EDN + (size_t)16 * 2048 * 1024 * 2);
constexpr size_t WS_U = al256(WS_P + (size_t)R * PW * 2);
constexpr size_t WS_QK = al256(WS_U + (size_t)R * D * 2);
constexpr size_t WS_SC = al256(WS_QK + (size_t)R * D * 2);
constexpr size_t SC_BYTES = (size_t)71680 * 2048 * 2;
constexpr size_t WS_XC = al256(WS_SC + SC_BYTES);
constexpr size_t WS_END = al256(WS_XC + (size_t)NB * CTXL * D * 4);
constexpr size_t WS_X1 = WS_P;
constexpr size_t WS_T1 = WS_P;
constexpr size_t WS_T2 = WS_P + (size_t)R * D * 2;
constexpr size_t WS_MIX = WS_P + (size_t)R * D * 4;
constexpr size_t WS_Z = WS_MIX + (size_t)R * D * 2;
static_assert(WS_Z + (size_t)R * D * 2 <= WS_U, "P-region aliases overflow");
static_assert(WS_END <= 1633652928ull, "workspace too large");

constexpr int CW_BAR = 0;
constexpr int CW_ECNT = 4096;

__device__ __forceinline__ float bf2f(bf16_t b) { return __uint_as_float(((unsigned)b) << 16); }
typedef __bf16 bf16x2_t __attribute__((ext_vector_type(2)));
__device__ __forceinline__ unsigned pk_bf16(float lo, float hi) { const f32x2 v = {lo, hi}; const bf16x2_t r = __builtin_convertvector(v, bf16x2_t); unsigned u; __builtin_memcpy(&u, &r, 4); return u; }
constexpr bool F8 = true;
constexpr int OPB = F8 ? 1 : 2;
constexpr float W8_SCALE = 64.0f;
typedef int v8i __attribute__((ext_vector_type(8)));
typedef int v4i __attribute__((ext_vector_type(4)));
__device__ __forceinline__ float clamp8(float x) { return fminf(fmaxf(x, -448.0f), 448.0f); }
__device__ __forceinline__ unsigned pk4_fp8(float a, float b, float c, float d) { int w = 0; w = __builtin_amdgcn_cvt_pk_fp8_f32(clamp8(a), clamp8(b), w, false); w = __builtin_amdgcn_cvt_pk_fp8_f32(clamp8(c), clamp8(d), w, true); return (unsigned)w; }
__device__ __forceinline__ bf16_t f2bf(float f) { return (bf16_t)(pk_bf16(f, 0.f) & 0xffffu); }
__device__ __forceinline__ float sigmoidf_(float x) { return __builtin_amdgcn_rcpf(1.0f + __expf(-x)); }
__device__ __forceinline__ float tanhf_(float x) { return 1.0f - 2.0f * __builtin_amdgcn_rcpf(1.0f + __expf(2.0f * x)); }
__device__ __forceinline__ void unpack8(const u32x4 p, float (&o)[8]) { const unsigned w[4] = {p.x, p.y, p.z, p.w};
#pragma unroll
    for (int e = 0; e < 4; ++e) { o[2 * e] = __uint_as_float(w[e] << 16); o[2 * e + 1] = __uint_as_float(w[e] & 0xffff0000u); } }
__device__ __forceinline__ void st_op4(void* base, size_t ei, float a, float b, float c, float d) {
    if (F8) *(unsigned*)((char*)base + ei) = pk4_fp8(a, b, c, d);
    else { u32x2 w; w.x = pk_bf16(a, b); w.y = pk_bf16(c, d); *(u32x2*)((char*)base + ei * 2) = w; } }
__device__ __forceinline__ void st_op8(void* base, size_t ei, const float (&v)[8]) {
    if (F8) { u32x2 w; w.x = pk4_fp8(v[0], v[1], v[2], v[3]); w.y = pk4_fp8(v[4], v[5], v[6], v[7]); *(u32x2*)((char*)base + ei) = w; }
    else { u32x4 w; w.x = pk_bf16(v[0], v[1]); w.y = pk_bf16(v[2], v[3]); w.z = pk_bf16(v[4], v[5]); w.w = pk_bf16(v[6], v[7]); *(u32x4*)((char*)base + ei * 2) = w; } }
__device__ __forceinline__ void st_op1(void* base, size_t ei, float a) {
    if (F8) ((unsigned char*)base)[ei] = (unsigned char)(pk4_fp8(a, 0.f, 0.f, 0.f) & 0xffu);
    else ((bf16_t*)base)[ei] = f2bf(a); }
__device__ __forceinline__ float siluf_(float x) { return x * sigmoidf_(x); }
template <int M> __device__ __forceinline__ float shx(float v) { return __int_as_float(__builtin_amdgcn_ds_swizzle(__float_as_int(v), 0x1f | (M << 10))); }
__device__ __forceinline__ float shx32(float v, int lane) { return __int_as_float(__builtin_amdgcn_ds_bpermute((lane ^ 32) << 2, __float_as_int(v))); }
__device__ __forceinline__ float shup(float v, int o, int lane) { return __int_as_float(__builtin_amdgcn_ds_bpermute((lane - o) << 2, __float_as_int(v))); }
__device__ __forceinline__ float rdlane(float v, int l) { return __int_as_float(__builtin_amdgcn_readlane(__float_as_int(v), l)); }
__device__ __forceinline__ float wave_sum(float v, int lane) {
    v += shx32(v, lane); v += shx<16>(v); v += shx<8>(v); v += shx<4>(v); v += shx<2>(v); v += shx<1>(v);
    return v;
}

#define XB_TMO      128
#define XB_XCNT(j)  (256  + 64 * (j))
#define XB_XSUB(j)  (1280 + 64 * (j))
#define XB_XGEN(j)  (2304 + 64 * (j))
#define XB_TOP      3328
#define XB_TOPGEN   3392
#define XCD_BAR_WORDS 3456
#define XB_SPIN_CAP (1u << 18)
__device__ __forceinline__ unsigned xb_ld(unsigned* p)              { return __hip_atomic_load(p, __ATOMIC_RELAXED, __HIP_MEMORY_SCOPE_AGENT); }
__device__ __forceinline__ unsigned xb_add(unsigned* p, unsigned v) { return __hip_atomic_fetch_add(p, v, __ATOMIC_RELAXED, __HIP_MEMORY_SCOPE_AGENT); }
__device__ __forceinline__ unsigned xb_xcc_id() { return (unsigned)__builtin_amdgcn_s_getreg((3 << 11) | 20) & 0xFu; }
#define XB_SPIN(cond, bar) do { unsigned _sp = 0; while (cond) { __builtin_amdgcn_s_sleep(1); \
    if ((++_sp & 255u) == 0u) { if (xb_ld(&(bar)[XB_TMO])) break; if (_sp > XB_SPIN_CAP) { atomicAdd(&(bar)[XB_TMO], 1u); break; } } } } while (0)
struct XcdBarrier { unsigned* bar; unsigned x; volatile LAS unsigned* st; };
__device__ __forceinline__ XcdBarrier xcd_barrier_post(unsigned* bar, volatile LAS unsigned* st) {
    XcdBarrier b; b.bar = bar; b.x = xb_xcc_id(); b.st = st;
    if (threadIdx.x == 0) (void)xb_add(&bar[XB_XCNT(b.x)], 1u);
    return b;
}
__device__ __forceinline__ void xcd_barrier_complete(unsigned* bar, unsigned x, unsigned& nloc, unsigned& nx) {
    const unsigned G = gridDim.x * gridDim.y * gridDim.z;
    unsigned sum, cnt, mine, sp = 0u;
    for (;;) {
        sum = 0u; cnt = 0u; mine = 0u;
#pragma unroll
        for (unsigned j = 0; j < 16; ++j) { const unsigned c = xb_ld(&bar[XB_XCNT(j)]); sum += c; cnt += (c > 0u) ? 1u : 0u; mine = (j == x) ? c : mine; }
        if (sum == G) break;
        __builtin_amdgcn_s_sleep(1);
        if ((++sp & 255u) == 0u) { if (xb_ld(&bar[XB_TMO])) break; if (sp > XB_SPIN_CAP) { atomicAdd(&bar[XB_TMO], 1u); break; } }
    }
    nloc = mine > 0u ? mine : 1u; nx = cnt > 0u ? cnt : 1u;
}
__device__ __forceinline__ void xcd_barrier(const XcdBarrier& b) {
    asm volatile("s_waitcnt vmcnt(0)" ::: "memory");
    __syncthreads();
    if (threadIdx.x == 0) {
        unsigned* bar = b.bar;
        __builtin_amdgcn_s_waitcnt(0);
        unsigned nloc = b.st[0], nx = b.st[1];
        if (nloc == 0u) { xcd_barrier_complete(bar, b.x, nloc, nx); b.st[0] = nloc; b.st[1] = nx; }
        const unsigned old = xb_add(&bar[XB_XSUB(b.x)], 1u);
        const unsigned gen = old / nloc;
        if (old + 1u == (gen + 1u) * nloc) {
            __builtin_amdgcn_fence(__ATOMIC_RELEASE, "agent");
            asm volatile("s_waitcnt vmcnt(0)" ::: "memory");
            const unsigned og = xb_add(&bar[XB_TOP], 1u);
            const unsigned tg = og / nx;
            if (og + 1u == (tg + 1u) * nx) xb_add(&bar[XB_TOPGEN], 1u);
            else XB_SPIN(xb_ld(&bar[XB_TOPGEN]) == tg, bar);
            __builtin_amdgcn_fence(__ATOMIC_ACQUIRE, "agent");
            xb_add(&bar[XB_XGEN(b.x)], 1u);
            asm volatile("s_waitcnt vmcnt(0)" ::: "memory");
        } else {
            XB_SPIN(xb_ld(&bar[XB_XGEN(b.x)]) == gen, bar);
            __builtin_amdgcn_fence(__ATOMIC_ACQUIRE, "agent");
            asm volatile("s_waitcnt vmcnt(0)" ::: "memory");
        }
    }
    __syncthreads();
}

struct Args { const float* in[N_IN]; float* out; unsigned char* ws; int ph_lo, ph_hi; };
struct Frame {
    const float* const* in; float* out; unsigned char* ws; LAS unsigned char* lds;
    int wave, G, bid;
};
__device__ __forceinline__ int ltid_(int wave) { int l; asm volatile("v_mbcnt_lo_u32_b32 %0, -1, 0\n\tv_mbcnt_hi_u32_b32 %0, -1, %0" : "=v"(l)); return wave * 64 + l; }
#define ltid() ltid_(F.wave)

__device__ __forceinline__ const float* xin_row(const Frame& F, int layer, int r) {
    const int b = r / TB, s = r - b * TB;
    if (s < CTXL) return (layer == 0 ? F.in[I_CTX] : (const float*)(F.ws + WS_XC)) + ((size_t)b * CTXL + s) * D;
    return (layer == 0 ? F.in[I_X] : (const float*)F.out) + ((size_t)b * SEQ + (s - CTXL)) * D;
}
__device__ __forceinline__ float* xout_row(const Frame& F, int r) {
    const int b = r / TB, s = r - b * TB;
    if (s < CTXL) return (float*)(F.ws + WS_XC) + ((size_t)b * CTXL + s) * D;
    return F.out + ((size_t)b * SEQ + (s - CTXL)) * D;
}

__device__ __forceinline__ void phase_mods(const Frame& F) {
    const int tid = ltid(), lane = tid & 63; (void)lane;
    LAS float* sc = (LAS float*)F.lds;
    LAS float* red = (LAS float*)(F.lds + 5 * 2048 * 4);
    float* mods = (float*)(F.ws + WS_MODS);
    for (int i = tid; i < 5 * 2048; i += NTHR) { const int r = i >> 11, k = i & 2047; const float v = r < 4 ? F.in[I_C][r * 2048 + k] : F.in[I_CCTX][k]; sc[i] = siluf_(v); }
    __syncthreads();
    for (int it = F.bid; it < 2 * 96; it += F.G) {
        const int l = it / 96, cg = it - l * 96, c4 = (tid & 31) * 4, ks = tid >> 5;
        const float* w = F.in[I_ADAW] + (size_t)l * 2048 * 12288 + cg * 128 + c4;
        f32x4 a0 = (f32x4){0.f, 0.f, 0.f, 0.f}, a1 = a0, a2 = a0, a3 = a0, a4 = a0;
#pragma unroll 8
        for (int k = ks; k < 2048; k += 16) { const f32x4 wv = *(const f32x4*)(w + (size_t)k * 12288); a0 += sc[k] * wv; a1 += sc[2048 + k] * wv; a2 += sc[4096 + k] * wv; a3 += sc[6144 + k] * wv; a4 += sc[8192 + k] * wv; }
        *(LAS f32x4*)(red + (ks * 5 + 0) * 128 + c4) = a0; *(LAS f32x4*)(red + (ks * 5 + 1) * 128 + c4) = a1; *(LAS f32x4*)(red + (ks * 5 + 2) * 128 + c4) = a2;
        *(LAS f32x4*)(red + (ks * 5 + 3) * 128 + c4) = a3; *(LAS f32x4*)(red + (ks * 5 + 4) * 128 + c4) = a4;
        __syncthreads();
        for (int i = tid; i < 5 * 128; i += NTHR) { const int r = i >> 7, cc = i & 127; float s = 0.f;
#pragma unroll
            for (int s16 = 0; s16 < 16; ++s16) s += red[(s16 * 5 + r) * 128 + cc];
            mods[((size_t)l * 5 + r) * 12288 + cg * 128 + cc] = s + F.in[I_ADAB][l * 12288 + cg * 128 + cc]; }
        __syncthreads();
    }
}

__device__ __forceinline__ void phase_ln1(const Frame& F, int layer) {
    const int tid = ltid(), lane = tid & 63; (void)lane;
    const float* mods = (const float*)(F.ws + WS_MODS) + (size_t)layer * 5 * 12288;
    bf16_t* U = (bf16_t*)(F.ws + WS_U);
    const int stride = F.G * NWAVE; f32x4 xq[8];
    { const float* x = xin_row(F, layer, F.bid * NWAVE + F.wave);
#pragma unroll
      for (int i = 0; i < 8; ++i) xq[i] = *(const f32x4*)(x + (i * 64 + lane) * 4); }
    for (int r = F.bid * NWAVE + F.wave; r < R; r += stride) {
        const int b = r / TB, s = r - b * TB; const float* md = mods + (size_t)(s < CTXL ? 4 : b) * 12288;
        f32x4 v[8]; float sum = 0.f;
#pragma unroll
        for (int i = 0; i < 8; ++i) { v[i] = xq[i]; sum += (v[i][0] + v[i][1]) + (v[i][2] + v[i][3]); }
        { const float* xn = xin_row(F, layer, r + stride < R ? r + stride : r);
#pragma unroll
          for (int i = 0; i < 8; ++i) xq[i] = *(const f32x4*)(xn + (i * 64 + lane) * 4); }
        const float mean = wave_sum(sum, lane) * (1.0f / D); float q = 0.f;
#pragma unroll
        for (int i = 0; i < 8; ++i) { v[i] -= mean; q += (v[i][0] * v[i][0] + v[i][1] * v[i][1]) + (v[i][2] * v[i][2] + v[i][3] * v[i][3]); }
        const float rstd = rsqrtf(wave_sum(q, lane) * (1.0f / D) + LN_EPS);
#pragma unroll
        for (int i = 0; i < 8; ++i) { const int e = (i * 64 + lane) * 4; const f32x4 sh = *(const f32x4*)(md + e), scl = *(const f32x4*)(md + 2048 + e);
            const f32x4 u = v[i] * rstd * (scl + 1.0f) + sh; st_op4(U, (size_t)r * D + e, u[0], u[1], u[2], u[3]); }
    }
}

namespace pg8 {
constexpr int BM = 256, BK = 64, HALF = 128, HTB = HALF * BK * 2, STAGE_BYTES = 8 * HTB, NXCD = 8, WGM = 8;
__host__ __device__ __forceinline__ int lds_byte(int r, int c) { const int st = (r >> 4) * 2 + (c >> 5), rr = r & 15, cc = c & 31, ob = rr * 64 + cc * 2; return st * 1024 + (ob ^ (((ob >> 9) & 1) << 5)); }
__host__ __device__ __forceinline__ void stage_rc(int b, int& Rr, int& C) { const int st = b / 1024, sb = b % 1024, swz = sb ^ (((sb >> 9) & 1) << 5); Rr = (st >> 1) * 16 + swz / 64; C = (st & 1) * 32 + (swz % 64) / 2; }
__host__ __device__ __forceinline__ int perm32(int rho) { const int n = rho >> 4, i = rho & 15; return 8 * (i >> 2) + 4 * n + (i & 3); }
struct Unit { int pm, pn; };
struct Gemm { const bf16_t* A; const bf16_t* Bt; int lda, ldb, K; };
struct StaticOrder {
    int nM, nN, nwg, G, c, skipctx;
    __device__ void init(int M, int N, int G_, int c_, int skipctx_ = 0) { nM = M / BM; nN = N / BM; nwg = nM * nN; G = G_; c = c_; skipctx = skipctx_; }
    __device__ bool next(int i, Unit& u) const {
        const long L = (long)i * G + c; if (L >= nwg) return false;
        int wgid = (int)L; { const int q = nwg / NXCD, r = nwg % NXCD, xcd = wgid % NXCD, off = wgid / NXCD; wgid = (xcd < r ? xcd * (q + 1) : r * (q + 1) + (xcd - r) * q) + off; }
        const int nig = WGM * nN, gid = wgid / nig, fm = gid * WGM, gsz = (nM - fm) < WGM ? (nM - fm) : WGM;
        u.pm = fm + ((wgid % nig) % gsz); u.pn = (wgid % nig) / gsz;
        if (skipctx) u.pm += (u.pm >> 5) + 1;
        return true;
    }
};
struct GroupedOrder {
    const LAS int* ts; int nN, G, c;
    __device__ bool next(int i, Unit& u) const {
        const int L = i * G + c; const int tot = __builtin_amdgcn_readfirstlane(ts[16]) * nN; if (L >= tot) return false;
        const int pm = L / nN, pl = L - pm * nN; int e = 0;
#pragma unroll 1
        for (int j = 1; j < 16; ++j) e += (pm >= ts[j]) ? 1 : 0;
        u.pm = __builtin_amdgcn_readfirstlane(pm); u.pn = __builtin_amdgcn_readfirstlane(e * nN + pl); return true;
    }
};
__device__ __forceinline__ unsigned cvt_pk_bf16(float lo, float hi) { return pk_bf16(lo, hi); }
__device__ __forceinline__ float fsig(float x) { return __builtin_amdgcn_rcpf(1.0f + __expf(-x)); }
template <int MODE, bool O8> struct Epi {
    static constexpr bool PERM = true; static constexpr float ASC = F8 ? 1.0f / W8_SCALE : 1.0f;
    void* O; const bf16_t* X; const bf16_t* Zin; int ldc; int pn_mod;
    __device__ __forceinline__ void put8(size_t ei, const float (&h)[8]) const {
        if (O8) st_op8(O, ei, h);
        else { u32x4 w; w.x = cvt_pk_bf16(h[0], h[1]); w.y = cvt_pk_bf16(h[2], h[3]); w.z = cvt_pk_bf16(h[4], h[5]); w.w = cvt_pk_bf16(h[6], h[7]); *(u32x4*)((bf16_t*)O + ei) = w; } }
    __device__ __forceinline__ void operator()(const f32x4 (&acc)[2][2][4][2], const Unit& u, int wr, int wc, int fr, int fq) const {
        const int row0 = u.pm * BM + wr * 64 + fr; const int pnl = u.pn % pn_mod;
        if (MODE == 4 || MODE == 5 || MODE == 6) {
            const int col0 = pnl * HALF + wc * 32 + 8 * fq;
#pragma unroll
            for (int ai = 0; ai < 2; ++ai)
#pragma unroll
                for (int m = 0; m < 4; ++m) { const size_t ei = (size_t)(row0 + ai * HALF + m * 16) * ldc + col0;
                    const f32x4 g0 = acc[ai][0][m][0], g1 = acc[ai][0][m][1], u0 = acc[ai][1][m][0], u1 = acc[ai][1][m][1]; float h[8];
                    float xa[8], xb[8]; if (MODE == 6) { unpack8(*(const u32x4*)(X + ei), xa); unpack8(*(const u32x4*)(Zin + ei), xb); }
#pragma unroll
                    for (int j = 0; j < 4; ++j) { const float ga = g0[j] * ASC, gb = g1[j] * ASC;
                        if (MODE == 4) { h[j] = ga * fsig(ga) * (u0[j] * ASC); h[4 + j] = gb * fsig(gb) * (u1[j] * ASC); }
                        else if (MODE == 5) { h[j] = ga * fsig(u0[j] * ASC); h[4 + j] = gb * fsig(u1[j] * ASC); }
                        else { h[j] = fsig(ga) * xa[j] + fsig(u0[j] * ASC) * xb[j]; h[4 + j] = fsig(gb) * xa[4 + j] + fsig(u1[j] * ASC) * xb[4 + j]; } }
                    put8(ei, h); }
        } else {
            const int col0 = pnl * BM + wc * 32 + 8 * fq;
#pragma unroll
            for (int ai = 0; ai < 2; ++ai)
#pragma unroll
              for (int mh = 0; mh < 2; ++mh) {
                u32x4 xw[2][2], zw[2][2];
                if (MODE == 1 || MODE == 2) {
#pragma unroll
                    for (int m2 = 0; m2 < 2; ++m2)
#pragma unroll
                        for (int bj = 0; bj < 2; ++bj) { const size_t ro = (size_t)(row0 + ai * HALF + (mh * 2 + m2) * 16) * ldc + col0 + bj * HALF;
                            xw[m2][bj] = *(const u32x4*)(X + ro); if (MODE == 2) zw[m2][bj] = *(const u32x4*)(Zin + ro); }
                }
#pragma unroll
                for (int m2 = 0; m2 < 2; ++m2) { const int m = mh * 2 + m2; const size_t ro = (size_t)(row0 + ai * HALF + m * 16) * ldc + col0;
#pragma unroll
                    for (int bj = 0; bj < 2; ++bj) { const f32x4 v0 = acc[ai][bj][m][0], v1 = acc[ai][bj][m][1]; float h[8];
#pragma unroll
                        for (int j = 0; j < 4; ++j) { h[j] = v0[j] * ASC; h[4 + j] = v1[j] * ASC; }
                        if (MODE == 1 || MODE == 2) { float x8[8]; unpack8(xw[m2][bj], x8);
#pragma unroll
                            for (int j = 0; j < 8; ++j) h[j] = fsig(h[j]) * x8[j];
                            if (MODE == 2) { float z8[8]; unpack8(zw[m2][bj], z8);
#pragma unroll
                                for (int j = 0; j < 8; ++j) h[j] += z8[j]; } }
                        put8(ro + bj * HALF, h); } }
              }
        }
    }
};

template <class EpiT, class Sched>
__device__ __forceinline__ void gemm_phase(LAS unsigned char* lds, const Gemm g, const Sched& S, const EpiT& E, int wave_id) {
    const int tid = ltid_(wave_id), wid = __builtin_amdgcn_readfirstlane(tid >> 6), lane = tid & 63, wr = wid >> 2, wc = wid & 3, fr = lane & 15, fq = lane >> 4;
    const int K = g.K, nt = K / BK;
    unsigned voffA[2], voffB[2];
#pragma unroll
    for (int i = 0; i < 2; ++i) { int Rr, C; stage_rc(tid * 16 + i * 8192, Rr, C); const int Rb = EpiT::PERM ? ((Rr & ~31) + perm32(Rr & 31)) : Rr;
        voffA[i] = (unsigned)(Rr * g.lda + C) * 2u; voffB[i] = (unsigned)(Rb * g.ldb + C) * 2u; }
    const size_t kstep = (size_t)(BK * 2);
    const size_t hstepA = (size_t)HALF * g.lda * 2, hstepB = (size_t)HALF * g.ldb * 2;
    const size_t tstepA = 2 * hstepA, tstepB = 2 * hstepB;
    const unsigned ldsw = (unsigned)wid * 1024u;
    const int aoff = lds_byte(wr * 64 + fr, fq * 8), boff = lds_byte(wc * 32 + fr, fq * 8);
#define PG8_SA(b, h) (((b) * 2 + (h)) * HTB)
#define PG8_SB(b, h) ((4 + (b) * 2 + (h)) * HTB)
#define PG8_STAGE(bufoff, gbase, voff) do { _Pragma("unroll") for (int _i = 0; _i < 2; ++_i) \
        __builtin_amdgcn_global_load_lds((const unsigned*)((const char*)(gbase) + (voff)[_i]), (LAS unsigned*)(lds + (bufoff) + ldsw + _i * 8192), 16, 0, 0); } while (0)
#define PG8_LD8(dst, addr) do { const v4i lo_ = *(const LAS v4i*)(addr), hi_ = *(const LAS v4i*)((addr) + 1024); dst = __builtin_shufflevector(lo_, hi_, 0, 1, 2, 3, 4, 5, 6, 7); } while (0)
#define PG8_LDA(dst, b, h) do { _Pragma("unroll") for (int m = 0; m < 4; ++m) PG8_LD8(dst[m], lds + PG8_SA(b, h) + aoff + m * 2048); } while (0)
#define PG8_LDB(dst, b, h) do { _Pragma("unroll") for (int n = 0; n < 2; ++n) PG8_LD8(dst[n], lds + PG8_SB(b, h) + boff + n * 2048); } while (0)
#define PG8_HALF(v, k) __builtin_bit_cast(bf16x8, __builtin_shufflevector(v, v, 4 * (k), 4 * (k) + 1, 4 * (k) + 2, 4 * (k) + 3))
#define PG8_MMA(ai, bj, At, Bt) do { __builtin_amdgcn_s_setprio(1); _Pragma("unroll") for (int m = 0; m < 4; ++m) _Pragma("unroll") for (int n = 0; n < 2; ++n) { \
        if (F8) asm volatile("v_mfma_f32_16x16x128_f8f6f4 %0, %1, %2, %0" : "+v"(acc[ai][bj][m][n]) : "v"(Bt[n]), "v"(At[m]));     \
        else { acc[ai][bj][m][n] = __builtin_amdgcn_mfma_f32_16x16x32_bf16(PG8_HALF(Bt[n], 0), PG8_HALF(At[m], 0), acc[ai][bj][m][n], 0, 0, 0); \
               acc[ai][bj][m][n] = __builtin_amdgcn_mfma_f32_16x16x32_bf16(PG8_HALF(Bt[n], 1), PG8_HALF(At[m], 1), acc[ai][bj][m][n], 0, 0, 0); } } \
        __builtin_amdgcn_s_setprio(0); } while (0)
#define PG8_WAIT_V(n) asm volatile("s_waitcnt vmcnt(" #n ")" ::: "memory")
#define PG8_WAIT_L(n) asm volatile("s_waitcnt lgkmcnt(" #n ")" ::: "memory")
#define PG8_BAR __builtin_amdgcn_s_barrier()
#define PG8_SCHED __builtin_amdgcn_sched_barrier(0)
    Unit cur, nxt; int ui = 0;
    if (!S.next(0, cur)) return;
    f32x4 acc[2][2][4][2];
#pragma unroll
    for (int a = 0; a < 2; ++a)
#pragma unroll
        for (int b = 0; b < 2; ++b)
#pragma unroll
            for (int m = 0; m < 4; ++m)
#pragma unroll
                for (int n = 0; n < 2; ++n) acc[a][b][m][n] = (f32x4){0.f, 0.f, 0.f, 0.f};
    v8i At[4], B0[2], B1[2];
    const char* cA = (const char*)g.A + (size_t)cur.pm * tstepA; const char* cB = (const char*)g.Bt + (size_t)cur.pn * tstepB;
    PG8_STAGE(PG8_SB(0, 0), cB, voffB); PG8_STAGE(PG8_SA(0, 0), cA, voffA); PG8_STAGE(PG8_SB(0, 1), cB + hstepB, voffB); PG8_STAGE(PG8_SA(0, 1), cA + hstepA, voffA);
    if (wr == 1) PG8_BAR;
    PG8_WAIT_V(4); PG8_BAR;
    PG8_STAGE(PG8_SB(1, 0), cB + kstep, voffB); PG8_STAGE(PG8_SA(1, 0), cA + kstep, voffA); PG8_STAGE(PG8_SB(1, 1), cB + hstepB + kstep, voffB);
    PG8_WAIT_V(6); PG8_BAR;
    for (;;) {
        const bool has_next = S.next(ui + 1, nxt);
        const char* nA = has_next ? (const char*)g.A + (size_t)nxt.pm * tstepA : cA; const char* nB = has_next ? (const char*)g.Bt + (size_t)nxt.pn * tstepB : cB;
        for (int t = 0; t < nt; t += 2) {
            const bool last = (t == nt - 2);
            const char* a1 = cA + (size_t)(t + 1) * kstep;
            const char* a2 = last ? nA : cA + (size_t)(t + 2) * kstep; const char* b2 = last ? nB : cB + (size_t)(t + 2) * kstep;
            const char* a3 = a2 + kstep; const char* b3 = b2 + kstep;
            PG8_LDB(B0, 0, 0); PG8_SCHED; PG8_LDA(At, 0, 0); PG8_STAGE(PG8_SA(1, 1), a1 + hstepA, voffA);
            PG8_WAIT_L(8); PG8_BAR; PG8_WAIT_L(0); PG8_MMA(0, 0, At, B0); PG8_BAR; PG8_SCHED;
            PG8_LDB(B1, 0, 1); PG8_STAGE(PG8_SB(0, 0), b2, voffB);
            PG8_BAR; PG8_WAIT_L(0); PG8_MMA(0, 1, At, B1); PG8_BAR;
            PG8_LDA(At, 0, 1); PG8_STAGE(PG8_SA(0, 0), a2, voffA);
            PG8_BAR; PG8_WAIT_L(0); PG8_MMA(1, 0, At, B0); PG8_BAR; PG8_SCHED;
            PG8_STAGE(PG8_SB(0, 1), b2 + hstepB, voffB);
            PG8_WAIT_V(6); PG8_BAR; PG8_MMA(1, 1, At, B1); PG8_BAR;
            PG8_LDB(B0, 1, 0); PG8_SCHED; PG8_LDA(At, 1, 0); PG8_STAGE(PG8_SA(0, 1), a2 + hstepA, voffA);
            PG8_WAIT_L(8); PG8_BAR; PG8_WAIT_L(0); PG8_MMA(0, 0, At, B0); PG8_BAR; PG8_SCHED;
            PG8_LDB(B1, 1, 1); PG8_STAGE(PG8_SB(1, 0), b3, voffB);
            PG8_BAR; PG8_WAIT_L(0); PG8_MMA(0, 1, At, B1); PG8_BAR;
            PG8_LDA(At, 1, 1); PG8_STAGE(PG8_SA(1, 0), a3, voffA);
            PG8_BAR; PG8_WAIT_L(0); PG8_MMA(1, 0, At, B0); PG8_BAR; PG8_SCHED;
            PG8_STAGE(PG8_SB(1, 1), b3 + hstepB, voffB);
            PG8_WAIT_V(6); PG8_BAR; PG8_MMA(1, 1, At, B1); PG8_BAR;
        }
        if (F8) { __builtin_amdgcn_sched_barrier(0); asm volatile("s_nop 15\n\ts_nop 15" ::: "memory"); __builtin_amdgcn_sched_barrier(0); }
        E(acc, cur, wr, wc, fr, fq);
        if (!has_next) break;
#pragma unroll
        for (int a = 0; a < 2; ++a)
#pragma unroll
            for (int b = 0; b < 2; ++b)
#pragma unroll
                for (int m = 0; m < 4; ++m)
#pragma unroll
                    for (int n = 0; n < 2; ++n) acc[a][b][m][n] = (f32x4){0.f, 0.f, 0.f, 0.f};
        cur = nxt; cA = nA; cB = nB; ++ui;
    }
    PG8_WAIT_V(0);
    if (wr == 0) PG8_BAR;
    PG8_BAR;
#undef PG8_SA
#undef PG8_SB
#undef PG8_STAGE
#undef PG8_LDA
#undef PG8_LD8
#undef PG8_HALF
#undef PG8_LDB
#undef PG8_MMA
#undef PG8_WAIT_V
#undef PG8_WAIT_L
#undef PG8_BAR
#undef PG8_SCHED
}
}

template <int MODE, bool O8>
__device__ __forceinline__ void dense_gemm(const Frame& F, const void* A, const void* Bt, int M, int N, int K, void* O, const bf16_t* X, const bf16_t* Zin, int ldc, int skipctx = 0, int rot = 0) {
    pg8::Gemm g{(const bf16_t*)A, (const bf16_t*)Bt, K * OPB / 2, K * OPB / 2, K * OPB / 2}; pg8::StaticOrder S; S.init(skipctx ? NB * SEQ : M, N, F.G, (F.bid + rot) % F.G, skipctx);
    pg8::Epi<MODE, O8> E{O, X, Zin, ldc, 1 << 30};
    pg8::gemm_phase<pg8::Epi<MODE, O8>, pg8::StaticOrder>(F.lds, g, S, E, F.wave);
}

struct TJob { const float* src; bf16_t* dst; size_t src_bstride; int src_pitch, K, Nvalid, Npad, dst_pitch, blk, blk_stride, row_off, nbatch, dst_brow; bool f8; };
constexpr int N_TJOBS = 13;
__device__ __forceinline__ TJob get_tjob(const Frame& F, int layer, int j) {
    TJob t; t.src_bstride = 0; t.blk = 1 << 30; t.blk_stride = 0; t.row_off = 0; t.nbatch = 1; t.dst_brow = 0; t.f8 = F8 && (j != 10);
    unsigned char* ws = F.ws;
    switch (j) {
    case 0: t.src = F.in[I_WIN] + (size_t)layer * 2048 * 14736; t.src_pitch = 14736; t.K = 2048; t.Nvalid = PC_END; t.Npad = PW; t.dst = (bf16_t*)(ws + WS_WIN); t.dst_pitch = 2048; break;
    case 1: t.src = F.in[I_WIN] + (size_t)layer * 2048 * 14736 + PC_END; t.src_pitch = 14736; t.K = 2048; t.Nvalid = 2048; t.Npad = 2048; t.dst = (bf16_t*)(ws + WS_WG); t.dst_pitch = 2048; t.blk = 128; t.blk_stride = 256; t.row_off = 0; break;
    case 11: t.src = F.in[I_WIN] + (size_t)layer * 2048 * 14736 + PC_END + 2048; t.src_pitch = 14736; t.K = 2048; t.Nvalid = 2048; t.Npad = 2048; t.dst = (bf16_t*)(ws + WS_WG); t.dst_pitch = 2048; t.blk = 128; t.blk_stride = 256; t.row_off = 128; break;
    case 12: t.src = F.in[I_WIN] + (size_t)layer * 2048 * 14736 + PC_END + 4096; t.src_pitch = 14736; t.K = 2048; t.Nvalid = 2048; t.Npad = 2048; t.dst = (bf16_t*)(ws + WS_WG + (size_t)4096 * 2048 * OPB); t.dst_pitch = 2048; break;
    case 2: t.src = F.in[I_MLPROJ] + (size_t)layer * 1024 * 2048; t.src_pitch = 2048; t.K = 1024; t.Nvalid = 2048; t.Npad = 2048; t.dst = (bf16_t*)(ws + WS_WML); t.dst_pitch = 1024; break;
    case 3: t.src = F.in[I_RWPROJ] + (size_t)layer * 1024 * 2048; t.src_pitch = 2048; t.K = 1024; t.Nvalid = 2048; t.Npad = 2048; t.dst = (bf16_t*)(ws + WS_WML + (size_t)1 * 2048 * 1024 * OPB); t.dst_pitch = 1024; break;
    case 4: t.src = F.in[I_S5WV] + (size_t)layer * 1024 * 2048; t.src_pitch = 2048; t.K = 1024; t.Nvalid = 2048; t.Npad = 2048; t.dst = (bf16_t*)(ws + WS_WML + (size_t)2 * 2048 * 1024 * OPB); t.dst_pitch = 1024; t.blk = 128; t.blk_stride = 256; t.row_off = 0; break;
    case 5: t.src = F.in[I_S5WG] + (size_t)layer * 1024 * 2048; t.src_pitch = 2048; t.K = 1024; t.Nvalid = 2048; t.Npad = 2048; t.dst = (bf16_t*)(ws + WS_WML + (size_t)2 * 2048 * 1024 * OPB); t.dst_pitch = 1024; t.blk = 128; t.blk_stride = 256; t.row_off = 128; break;
    case 6: t.src = F.in[I_WOUT] + (size_t)layer * 2048 * 2048; t.src_pitch = 2048; t.K = 2048; t.Nvalid = 2048; t.Npad = 2048; t.dst = (bf16_t*)(ws + WS_WOUT); t.dst_pitch = 2048; break;
    case 7: t.src = F.in[I_EWG] + (size_t)layer * 16 * 2048 * 1024; t.src_bstride = (size_t)2048 * 1024; t.src_pitch = 1024; t.K = 2048; t.Nvalid = 1024; t.Npad = 1024; t.dst = (bf16_t*)(ws + WS_EGU); t.dst_pitch = 2048;
            t.blk = 128; t.blk_stride = 256; t.row_off = 0; t.nbatch = 16; t.dst_brow = 2048; break;
    case 8: t.src = F.in[I_EWU] + (size_t)layer * 16 * 2048 * 1024; t.src_bstride = (size_t)2048 * 1024; t.src_pitch = 1024; t.K = 2048; t.Nvalid = 1024; t.Npad = 1024; t.dst = (bf16_t*)(ws + WS_EGU); t.dst_pitch = 2048;
            t.blk = 128; t.blk_stride = 256; t.row_off = 128; t.nbatch = 16; t.dst_brow = 2048; break;
    case 9: t.src = F.in[I_EWD] + (size_t)layer * 16 * 1024 * 2048; t.src_bstride = (size_t)1024 * 2048; t.src_pitch = 2048; t.K = 1024; t.Nvalid = 2048; t.Npad = 2048; t.dst = (bf16_t*)(ws + WS_EDN); t.dst_pitch = 1024;
            t.nbatch = 16; t.dst_brow = 2048; break;
    default: t.src = F.in[I_RWGUP] + (size_t)layer * 128 * 1024; t.src_pitch = 1024; t.K = 128; t.Nvalid = 1024; t.Npad = 1024; t.dst = (bf16_t*)(ws + WS_GUPT); t.dst_pitch = 128; break;
    }
    return t;
}
__device__ __forceinline__ int tjob_tiles(const TJob& t) { return t.nbatch * (t.Npad / 64) * (t.K / (t.f8 ? 128 : 64)); }
__device__ __forceinline__ void transpose_tile(LAS float* T, int lane, const TJob& t, int tile) {
    const int nkt = t.K / 64, nnt = t.Npad / 64;
    const int b = tile / (nnt * nkt), rem = tile - b * nnt * nkt, ktile = rem / nnt, ntile = rem - ktile * nnt;
    const int n0 = ntile * 64, k0 = ktile * 64;
    const float* src = t.src + (size_t)b * t.src_bstride;
    f32x4 v[16];
#pragma unroll
    for (int p = 0; p < 16; ++p) { const int kk = p * 4 + (lane >> 4), nn = (lane & 15) * 4;
        v[p] = (f32x4){0.f, 0.f, 0.f, 0.f};
        if (n0 + nn < t.Nvalid) v[p] = *(const f32x4*)(src + (size_t)(k0 + kk) * t.src_pitch + n0 + nn); }
#pragma unroll
    for (int p = 0; p < 16; ++p) { const int kk = p * 4 + (lane >> 4), nn = (lane & 15) * 4; T[kk * 65 + nn] = v[p][0]; T[kk * 65 + nn + 1] = v[p][1]; T[kk * 65 + nn + 2] = v[p][2]; T[kk * 65 + nn + 3] = v[p][3]; }
    asm volatile("s_waitcnt lgkmcnt(0)" ::: "memory"); __builtin_amdgcn_wave_barrier();
#pragma unroll
    for (int ps = 0; ps < 8; ++ps) { const int n = ps * 8 + (lane >> 3), kq = (lane & 7) * 8; float x[8];
#pragma unroll
        for (int j = 0; j < 8; ++j) x[j] = T[(kq + j) * 65 + n];
        const int ng = n0 + n; const int drow = b * t.dst_brow + (ng / t.blk) * t.blk_stride + (ng % t.blk) + t.row_off;
        if (t.f8) { u32x2 w; w.x = pk4_fp8(x[0] * W8_SCALE, x[1] * W8_SCALE, x[2] * W8_SCALE, x[3] * W8_SCALE); w.y = pk4_fp8(x[4] * W8_SCALE, x[5] * W8_SCALE, x[6] * W8_SCALE, x[7] * W8_SCALE);
            *(u32x2*)((char*)t.dst + (size_t)drow * t.dst_pitch + k0 + kq) = w; }
        else { u32x4 w; w.x = pk_bf16(x[0], x[1]); w.y = pk_bf16(x[2], x[3]); w.z = pk_bf16(x[4], x[5]); w.w = pk_bf16(x[6], x[7]);
            *(u32x4*)(t.dst + (size_t)drow * t.dst_pitch + k0 + kq) = w; } }
    asm volatile("s_waitcnt lgkmcnt(0)" ::: "memory"); __builtin_amdgcn_wave_barrier();
}
__device__ __forceinline__ void transpose_tile8(LAS unsigned* T8, int lane, const TJob& t, int tile) {
    const int nkt = t.K / 128, nnt = t.Npad / 64;
    const int b = tile / (nnt * nkt), rem = tile - b * nnt * nkt, ktile = rem / nnt, ntile = rem - ktile * nnt;
    const int n0 = ntile * 64, k0 = ktile * 128;
    const float* src = t.src + (size_t)b * t.src_bstride;
    const int nn = (lane & 15) * 4, kq = lane >> 4;
    f32x4 v[32];
#pragma unroll
    for (int p = 0; p < 32; ++p) { const int kk = (p >> 2) * 16 + kq * 4 + (p & 3);
        v[p] = (f32x4){0.f, 0.f, 0.f, 0.f};
        if (n0 + nn < t.Nvalid) v[p] = *(const f32x4*)(src + (size_t)(k0 + kk) * t.src_pitch + n0 + nn); }
#pragma unroll
    for (int g = 0; g < 8; ++g)
#pragma unroll
        for (int j = 0; j < 4; ++j)
            T8[(nn + j) * 36 + g * 4 + kq] = pk4_fp8(v[4 * g][j] * W8_SCALE, v[4 * g + 1][j] * W8_SCALE, v[4 * g + 2][j] * W8_SCALE, v[4 * g + 3][j] * W8_SCALE);
    asm volatile("s_waitcnt lgkmcnt(0)" ::: "memory"); __builtin_amdgcn_wave_barrier();
#pragma unroll
    for (int ps = 0; ps < 8; ++ps) { const int n = ps * 8 + (lane >> 3), pc = lane & 7;
        const u32x4 w = *(const LAS u32x4*)(T8 + n * 36 + pc * 4);
        const int ng = n0 + n; const int drow = b * t.dst_brow + (ng / t.blk) * t.blk_stride + (ng % t.blk) + t.row_off;
        *(u32x4*)((char*)t.dst + (size_t)drow * t.dst_pitch + k0 + pc * 16) = w; }
    asm volatile("s_waitcnt lgkmcnt(0)" ::: "memory"); __builtin_amdgcn_wave_barrier();
}
__device__ __forceinline__ void phase_wprep(const Frame& F, int layer) {
    const int tid = ltid(), lane = tid & 63; (void)lane;
    LAS float* T = (LAS float*)F.lds + F.wave * (64 * 65);
    const int gw = F.bid * NWAVE + F.wave, nw = F.G * NWAVE;
    int base = 0;
#pragma unroll
    for (int j = 0; j < N_TJOBS; ++j) {
        const TJob t = get_tjob(F, layer, j); const int nt = tjob_tiles(t);
        const int first = (gw - (base % nw) + nw) % nw;
        for (int tile = first; tile < nt; tile += nw) { if (t.f8) transpose_tile8((LAS unsigned*)T, lane, t, tile); else transpose_tile(T, lane, t, tile); }
        base += nt;
    }
    __syncthreads();
}

__device__ __forceinline__ void phase_post1_route(const Frame& F, int layer, bool use_mix) {
    const int tid = ltid(), lane = tid & 63; (void)lane;
    const float* mods = (const float*)(F.ws + WS_MODS) + (size_t)layer * 5 * 12288;
    const bf16_t* MIX = (const bf16_t*)(F.ws + WS_MIX);
    bf16_t* X1 = (bf16_t*)(F.ws + WS_X1);
    unsigned* route = (unsigned*)(F.ws + WS_ROUTE);
    unsigned* ecnt = (unsigned*)(F.ws + WS_CTL) + CW_ECNT + layer * 64;
    const float* g1 = F.in[I_LN1G] + layer * D; const float* b1 = F.in[I_LN1B] + layer * D;
    LAS float* RW = (LAS float*)F.lds;
    LAS unsigned* lcnt = (LAS unsigned*)(F.lds + 131072 + 256);
    if (tid < 32) lcnt[tid] = 0u;
    for (int i4 = tid; i4 < 2048 * 16 / 4; i4 += NTHR) { const int k = i4 >> 2, qd = i4 & 3; const int ii = k >> 8, ln = (k >> 2) & 63, c = k & 3;
        *(LAS f32x4*)(RW + ((((qd * 8 + ii) * 4 + c) * 64 + ln) * 4)) = *(const f32x4*)(F.in[I_ROUTW] + (size_t)k * 16 + qd * 4); }
    __syncthreads();
    const int stride = F.G * NWAVE;
    f32x4 xq[8]; u32x2 mq[8];
    const int nrows = layer == 1 ? NB * SEQ : R;
#define ROW_OF(qi) (layer == 1 ? (qi) + ((qi) >> 13) * CTXL + CTXL : (qi))
    { const int r = ROW_OF(F.bid * NWAVE + F.wave); const float* x = xin_row(F, layer, r);
#pragma unroll
      for (int i = 0; i < 8; ++i) { const int e = (i * 64 + lane) * 4; xq[i] = *(const f32x4*)(x + e); mq[i] = *(const u32x2*)(MIX + (size_t)r * D + e); } }
    for (int qi = F.bid * NWAVE + F.wave; qi < nrows; qi += stride) { const int r = ROW_OF(qi);
        const int b = r / TB, s = r - b * TB; const float* md = mods + (size_t)(s < CTXL ? 4 : b) * 12288;
        f32x4 v[8]; float sum = 0.f;
#pragma unroll
        for (int i = 0; i < 8; ++i) { const int e = (i * 64 + lane) * 4; v[i] = xq[i] * ALPHA;
            if (use_mix) { const u32x2 m = mq[i]; const f32x4 g = *(const f32x4*)(md + 2 * 2048 + e);
                v[i][0] += g[0] * __uint_as_float(m.x << 16); v[i][1] += g[1] * __uint_as_float(m.x & 0xffff0000u); v[i][2] += g[2] * __uint_as_float(m.y << 16); v[i][3] += g[3] * __uint_as_float(m.y & 0xffff0000u); }
            sum += (v[i][0] + v[i][1]) + (v[i][2] + v[i][3]); }
        { const int rn = ROW_OF(qi + stride < nrows ? qi + stride : qi); const float* xn = xin_row(F, layer, rn);
#pragma unroll
          for (int i = 0; i < 8; ++i) { const int e = (i * 64 + lane) * 4; xq[i] = *(const f32x4*)(xn + e); mq[i] = *(const u32x2*)(MIX + (size_t)rn * D + e); } }
        float mean = wave_sum(sum, lane) * (1.0f / D); float q = 0.f;
#pragma unroll
        for (int i = 0; i < 8; ++i) { v[i] -= mean; q += (v[i][0] * v[i][0] + v[i][1] * v[i][1]) + (v[i][2] * v[i][2] + v[i][3] * v[i][3]); }
        float rstd = rsqrtf(wave_sum(q, lane) * (1.0f / D) + LN_EPS);
        sum = 0.f;
#pragma unroll
        for (int i = 0; i < 8; ++i) { const int e = (i * 64 + lane) * 4; const f32x4 gg = *(const f32x4*)(g1 + e), bb = *(const f32x4*)(b1 + e);
            v[i] = v[i] * rstd * gg + bb; { u32x2 w; w.x = pk_bf16(v[i][0], v[i][1]); w.y = pk_bf16(v[i][2], v[i][3]); *(u32x2*)(X1 + (size_t)r * D + e) = w; } sum += (v[i][0] + v[i][1]) + (v[i][2] + v[i][3]); }
        mean = wave_sum(sum, lane) * (1.0f / D); q = 0.f;
#pragma unroll
        for (int i = 0; i < 8; ++i) { v[i] -= mean; q += (v[i][0] * v[i][0] + v[i][1] * v[i][1]) + (v[i][2] * v[i][2] + v[i][3] * v[i][3]); }
        rstd = rsqrtf(wave_sum(q, lane) * (1.0f / D) + LN_EPS);
        float lg[16];
#pragma unroll
        for (int e = 0; e < 16; ++e) lg[e] = 0.f;
#pragma unroll
        for (int i = 0; i < 8; ++i) { const int e0 = (i * 64 + lane) * 4; const f32x4 sh = *(const f32x4*)(md + 3 * 2048 + e0), scl = *(const f32x4*)(md + 4 * 2048 + e0);
            const f32x4 u = v[i] * rstd * (scl + 1.0f) + sh;
#pragma unroll
            for (int j = 0; j < 4; ++j) {
#pragma unroll
                for (int qd = 0; qd < 4; ++qd) { const f32x4 w = *(const LAS f32x4*)(RW + ((((qd * 8 + i) * 4 + j) * 64 + lane) * 4)); lg[qd * 4 + 0] += u[j] * w[0]; lg[qd * 4 + 1] += u[j] * w[1]; lg[qd * 4 + 2] += u[j] * w[2]; lg[qd * 4 + 3] += u[j] * w[3]; } }
            __builtin_amdgcn_sched_barrier(0); }
#pragma unroll
        for (int e = 0; e < 16; ++e) lg[e] = wave_sum(lg[e], lane);
        float aff[16], gsc[16];
#pragma unroll
        for (int e = 0; e < 16; ++e) { aff[e] = __builtin_amdgcn_rcpf(1.0f + __expf(-lg[e])); gsc[e] = aff[e] + F.in[I_ROUTB][e]; }
        int best = 0; float bestv = -1e30f;
#pragma unroll
        for (int gI = 0; gI < 4; ++gI) { float m1 = -1e30f, m2 = -1e30f;
#pragma unroll
            for (int j = 0; j < 4; ++j) { const float t = gsc[gI * 4 + j]; if (t > m1) { m2 = m1; m1 = t; } else if (t > m2) m2 = t; }
            const float sc = m1 + m2; if (sc > bestv) { bestv = sc; best = gI; } }
        int i0 = 0, i1 = 0; { float m1 = -1e30f, m2 = -1e30f;
#pragma unroll
            for (int gI = 0; gI < 4; ++gI) if (gI == best) {
#pragma unroll
                for (int j = 0; j < 4; ++j) { const float t = gsc[gI * 4 + j]; if (t > m1) { m2 = m1; i1 = i0; m1 = t; i0 = gI * 4 + j; } else if (t > m2) { m2 = t; i1 = gI * 4 + j; } } } }
        float a0 = 0.f, a1 = 0.f;
#pragma unroll
        for (int e = 0; e < 16; ++e) { a0 = (e == i0) ? aff[e] : a0; a1 = (e == i1) ? aff[e] : a1; }
        const float inv = 1.0f / (a0 + a1);
        if (lane == 0) {
            const unsigned s0 = __hip_atomic_fetch_add(lcnt + i0, 1u, __ATOMIC_RELAXED, __HIP_MEMORY_SCOPE_WORKGROUP), s1 = __hip_atomic_fetch_add(lcnt + i1, 1u, __ATOMIC_RELAXED, __HIP_MEMORY_SCOPE_WORKGROUP);
            u32x4 w0; w0.x = (unsigned)i0; w0.y = (unsigned)i1; w0.z = __float_as_uint(a0 * inv); w0.w = __float_as_uint(a1 * inv);
            *(u32x4*)(route + (size_t)r * 8) = w0; u32x2 w1; w1.x = s0; w1.y = s1; *(u32x2*)(route + (size_t)r * 8 + 4) = w1;
        }
    }
    __syncthreads();
    if (tid < 16) lcnt[16 + tid] = atomicAdd(ecnt + tid, lcnt[tid]);
    __syncthreads();
    for (int qi = F.bid * NWAVE + F.wave; qi < nrows; qi += stride) { const int r = ROW_OF(qi);
        if (lane == 0) { const u32x2 e01 = *(const u32x2*)(route + (size_t)r * 8); u32x2 sl = *(const u32x2*)(route + (size_t)r * 8 + 4);
            sl.x += lcnt[16 + e01.x]; sl.y += lcnt[16 + e01.y]; *(u32x2*)(route + (size_t)r * 8 + 4) = sl; } }
}
__device__ __forceinline__ void load_tile_starts(const Frame& F, int tid, int layer, LAS int* ts) {
    if (tid == 0) { const unsigned* ecnt = (const unsigned*)(F.ws + WS_CTL) + CW_ECNT + layer * 64; int a = 0;
        for (int e = 0; e < 16; ++e) { ts[e] = a; a += (int)((__hip_atomic_load(ecnt + e, __ATOMIC_RELAXED, __HIP_MEMORY_SCOPE_AGENT) + 255u) >> 8); } ts[16] = a; }
    __syncthreads();
}
__device__ __forceinline__ void phase_gather(const Frame& F, int layer) {
    const int tid = ltid(), lane = tid & 63; (void)lane;
    LAS int* ts = (LAS int*)(F.lds + LDS_BYTES - 512);
    const float* mods = (const float*)(F.ws + WS_MODS) + (size_t)layer * 5 * 12288;
    LAS float* ML = (LAS float*)F.lds;
    for (int i = tid; i < 5 * 2 * 512; i += NTHR) { const int mr = i >> 10, v = (i >> 9) & 1, c4 = i & 511; *(LAS f32x4*)(ML + (mr * 2 + v) * 2048 + c4 * 4) = *(const f32x4*)(mods + (size_t)mr * 12288 + (3 + v) * 2048 + c4 * 4); }
    load_tile_starts(F, tid, layer, ts);
    const bf16_t* X1 = (const bf16_t*)(F.ws + WS_X1);
    const unsigned* route = (const unsigned*)(F.ws + WS_ROUTE);
    bf16_t* UG = (bf16_t*)(F.ws + WS_SC);
    const int stride = F.G * NWAVE;
    u32x2 xw[8]; u32x4 rr; u32x2 sl;
    const int nrows = layer == 1 ? NB * SEQ : R;
    { const int r = ROW_OF(F.bid * NWAVE + F.wave);
#pragma unroll
      for (int i = 0; i < 8; ++i) xw[i] = *(const u32x2*)(X1 + (size_t)r * D + (i * 64 + lane) * 4);
      rr = *(const u32x4*)(route + (size_t)r * 8); sl = *(const u32x2*)(route + (size_t)r * 8 + 4); }
    for (int qi = F.bid * NWAVE + F.wave; qi < nrows; qi += stride) { const int r = ROW_OF(qi);
        const int b = r / TB, s = r - b * TB; const LAS float* md = ML + (s < CTXL ? 4 : b) * 4096;
        f32x4 v[8]; float sum = 0.f;
#pragma unroll
        for (int i = 0; i < 8; ++i) { const u32x2 w = xw[i]; v[i][0] = __uint_as_float(w.x << 16); v[i][1] = __uint_as_float(w.x & 0xffff0000u); v[i][2] = __uint_as_float(w.y << 16); v[i][3] = __uint_as_float(w.y & 0xffff0000u); sum += (v[i][0] + v[i][1]) + (v[i][2] + v[i][3]); }
        const u32x4 rc = rr; const u32x2 sc_ = sl;
        { const int rn = ROW_OF(qi + stride < nrows ? qi + stride : qi);
#pragma unroll
          for (int i = 0; i < 8; ++i) xw[i] = *(const u32x2*)(X1 + (size_t)rn * D + (i * 64 + lane) * 4);
          rr = *(const u32x4*)(route + (size_t)rn * 8); sl = *(const u32x2*)(route + (size_t)rn * 8 + 4); }
        const float mean = wave_sum(sum, lane) * (1.0f / D); float q = 0.f;
#pragma unroll
        for (int i = 0; i < 8; ++i) { v[i] -= mean; q += (v[i][0] * v[i][0] + v[i][1] * v[i][1]) + (v[i][2] * v[i][2] + v[i][3] * v[i][3]); }
        const float rstd = rsqrtf(wave_sum(q, lane) * (1.0f / D) + LN_EPS);
        const size_t row0 = (size_t)ts[rc.x] * 256 + sc_.x, row1 = (size_t)ts[rc.y] * 256 + sc_.y;
#pragma unroll
        for (int i = 0; i < 8; ++i) { const int e = (i * 64 + lane) * 4; const f32x4 sh = *(const LAS f32x4*)(md + e), scl = *(const LAS f32x4*)(md + 2048 + e);
            const f32x4 u = v[i] * rstd * (scl + 1.0f) + sh;
            st_op4(UG, row0 * D + e, u[0], u[1], u[2], u[3]); st_op4(UG, row1 * D + e, u[0], u[1], u[2], u[3]); }
    }
}
__device__ __forceinline__ void phase_moe_gemm(const Frame& F, int layer, int which) {
    const int tid = ltid(), lane = tid & 63; (void)lane;
    LAS int* ts = (LAS int*)(F.lds + pg8::STAGE_BYTES);
    load_tile_starts(F, tid, layer, ts);
    if (which == 0) {
        pg8::Gemm g{(const bf16_t*)(F.ws + WS_SC), (const bf16_t*)(F.ws + WS_EGU), 2048 * OPB / 2, 2048 * OPB / 2, 2048 * OPB / 2};
        pg8::GroupedOrder S{ts, 8, F.G, F.bid}; pg8::Epi<4, true> E{(void*)(F.ws + WS_U), nullptr, nullptr, 1024, 8};
        pg8::gemm_phase<pg8::Epi<4, true>, pg8::GroupedOrder>(F.lds, g, S, E, F.wave);
    } else {
        pg8::Gemm g{(const bf16_t*)(F.ws + WS_U), (const bf16_t*)(F.ws + WS_EDN), 1024 * OPB / 2, 1024 * OPB / 2, 1024 * OPB / 2};
        pg8::GroupedOrder S{ts, 8, F.G, F.bid}; pg8::Epi<0, false> E{(void*)(F.ws + WS_SC), nullptr, nullptr, 2048, 8};
        pg8::gemm_phase<pg8::Epi<0, false>, pg8::GroupedOrder>(F.lds, g, S, E, F.wave);
    }
}
__device__ __forceinline__ void phase_post2_moe(const Frame& F, int layer, bool use_ffn) {
    const int tid = ltid(), lane = tid & 63; (void)lane;
    LAS int* ts = (LAS int*)(F.lds + LDS_BYTES - 512);
    const float* mods = (const float*)(F.ws + WS_MODS) + (size_t)layer * 5 * 12288;
    LAS float* GL5 = (LAS float*)F.lds;
    LAS float* G2L = GL5 + 5 * 2048; LAS float* NXL = G2L + 2 * 2048;
    for (int i = tid; i < 5 * 512; i += NTHR) { const int mr = i >> 9, c4 = i & 511; *(LAS f32x4*)(GL5 + mr * 2048 + c4 * 4) = *(const f32x4*)(mods + (size_t)mr * 12288 + 5 * 2048 + c4 * 4); }
    for (int i = tid; i < 2 * 512; i += NTHR) { const int v = i >> 9, c4 = i & 511; *(LAS f32x4*)(G2L + v * 2048 + c4 * 4) = *(const f32x4*)((v == 0 ? F.in[I_LN2G] : F.in[I_LN2B]) + layer * D + c4 * 4); }
    if (layer == 0) for (int i = tid; i < 5 * 2 * 512; i += NTHR) { const int mr = i >> 10, v = (i >> 9) & 1, c4 = i & 511; *(LAS f32x4*)(NXL + (mr * 2 + v) * 2048 + c4 * 4) = *(const f32x4*)(mods + (size_t)5 * 12288 + (size_t)mr * 12288 + v * 2048 + c4 * 4); }
    load_tile_starts(F, tid, layer, ts);
    const bf16_t* X1 = (const bf16_t*)(F.ws + WS_X1);
    const unsigned* route = (const unsigned*)(F.ws + WS_ROUTE);
    const bf16_t* Y = (const bf16_t*)(F.ws + WS_SC);
    const float* g2 = F.in[I_LN2G] + layer * D; const float* b2 = F.in[I_LN2B] + layer * D;
    const int stride = F.G * NWAVE;
    u32x2 xw[8], y0w[8], y1w[8]; u32x4 rrN; u32x2 slN; float w0c, w1c;
    const int nrows = layer == 1 ? NB * SEQ : R;
    { const int r = ROW_OF(F.bid * NWAVE + F.wave); const u32x4 rr = *(const u32x4*)(route + (size_t)r * 8); const u32x2 sl = *(const u32x2*)(route + (size_t)r * 8 + 4);
      const size_t row0 = (size_t)ts[rr.x] * 256 + sl.x, row1 = (size_t)ts[rr.y] * 256 + sl.y; w0c = __uint_as_float(rr.z); w1c = __uint_as_float(rr.w);
#pragma unroll
      for (int i = 0; i < 8; ++i) { const int e = (i * 64 + lane) * 4; xw[i] = *(const u32x2*)(X1 + (size_t)r * D + e); y0w[i] = *(const u32x2*)(Y + row0 * D + e); y1w[i] = *(const u32x2*)(Y + row1 * D + e); }
      const int q0 = F.bid * NWAVE + F.wave; const int rn = ROW_OF(q0 + stride < nrows ? q0 + stride : q0); rrN = *(const u32x4*)(route + (size_t)rn * 8); slN = *(const u32x2*)(route + (size_t)rn * 8 + 4); }
    for (int qi = F.bid * NWAVE + F.wave; qi < nrows; qi += stride) { const int r = ROW_OF(qi);
        const int b = r / TB, s = r - b * TB; const int mr = s < CTXL ? 4 : b;
        const float w0 = w0c, w1 = w1c;
        f32x4 v[8]; float sum = 0.f;
#pragma unroll
        for (int i = 0; i < 8; ++i) { const int e = (i * 64 + lane) * 4; { const u32x2 w = xw[i]; v[i][0] = __uint_as_float(w.x << 16); v[i][1] = __uint_as_float(w.x & 0xffff0000u); v[i][2] = __uint_as_float(w.y << 16); v[i][3] = __uint_as_float(w.y & 0xffff0000u); v[i] *= ALPHA; }
            if (use_ffn) { const u32x2 y0 = y0w[i], y1 = y1w[i]; const f32x4 g = *(const LAS f32x4*)(GL5 + mr * 2048 + e);
                v[i][0] += g[0] * (w0 * __uint_as_float(y0.x << 16) + w1 * __uint_as_float(y1.x << 16));
                v[i][1] += g[1] * (w0 * __uint_as_float(y0.x & 0xffff0000u) + w1 * __uint_as_float(y1.x & 0xffff0000u));
                v[i][2] += g[2] * (w0 * __uint_as_float(y0.y << 16) + w1 * __uint_as_float(y1.y << 16));
                v[i][3] += g[3] * (w0 * __uint_as_float(y0.y & 0xffff0000u) + w1 * __uint_as_float(y1.y & 0xffff0000u)); }
            sum += (v[i][0] + v[i][1]) + (v[i][2] + v[i][3]); }
        {
            const int rn = ROW_OF(qi + stride < nrows ? qi + stride : qi); const int rn2 = ROW_OF(qi + 2 * stride < nrows ? qi + 2 * stride : qi);
            const size_t row0 = (size_t)ts[rrN.x] * 256 + slN.x, row1 = (size_t)ts[rrN.y] * 256 + slN.y; w0c = __uint_as_float(rrN.z); w1c = __uint_as_float(rrN.w);
#pragma unroll
            for (int i = 0; i < 8; ++i) { const int e = (i * 64 + lane) * 4; xw[i] = *(const u32x2*)(X1 + (size_t)rn * D + e); y0w[i] = *(const u32x2*)(Y + row0 * D + e); y1w[i] = *(const u32x2*)(Y + row1 * D + e); }
            rrN = *(const u32x4*)(route + (size_t)rn2 * 8); slN = *(const u32x2*)(route + (size_t)rn2 * 8 + 4); }
        const float mean = wave_sum(sum, lane) * (1.0f / D); float q = 0.f;
#pragma unroll
        for (int i = 0; i < 8; ++i) { v[i] -= mean; q += (v[i][0] * v[i][0] + v[i][1] * v[i][1]) + (v[i][2] * v[i][2] + v[i][3] * v[i][3]); }
        const float rstd = rsqrtf(wave_sum(q, lane) * (1.0f / D) + LN_EPS);
        float* o = xout_row(F, r); float sum2 = 0.f;
#pragma unroll
        for (int i = 0; i < 8; ++i) { const int e = (i * 64 + lane) * 4; const f32x4 gg = *(const LAS f32x4*)(G2L + e), bb = *(const LAS f32x4*)(G2L + 2048 + e);
            v[i] = v[i] * rstd * gg + bb; *(f32x4*)(o + e) = v[i]; sum2 += (v[i][0] + v[i][1]) + (v[i][2] + v[i][3]); }
        if (layer == 0) {
            const LAS float* mdn = NXL + mr * 4096; void* U = (void*)(F.ws + WS_U);
            const float mean2 = wave_sum(sum2, lane) * (1.0f / D); float q2 = 0.f;
#pragma unroll
            for (int i = 0; i < 8; ++i) { v[i] -= mean2; q2 += (v[i][0] * v[i][0] + v[i][1] * v[i][1]) + (v[i][2] * v[i][2] + v[i][3] * v[i][3]); }
            const float rstd2 = rsqrtf(wave_sum(q2, lane) * (1.0f / D) + LN_EPS);
#pragma unroll
            for (int i = 0; i < 8; ++i) { const int e = (i * 64 + lane) * 4; const f32x4 sh = *(const LAS f32x4*)(mdn + e), scl = *(const LAS f32x4*)(mdn + 2048 + e);
                const f32x4 u = v[i] * rstd2 * (scl + 1.0f) + sh; st_op4(U, (size_t)r * D + e, u[0], u[1], u[2], u[3]); }
        }
    }
}


__device__ __forceinline__ bf16x8 pack_8(const f32x4 a, const f32x4 b) { u32x4 w; w.x = pk_bf16(a[0], a[1]); w.y = pk_bf16(a[2], a[3]); w.z = pk_bf16(b[0], b[1]); w.w = pk_bf16(b[2], b[3]); bf16x8 r; __builtin_memcpy(&r, &w, 16); return r; }
__device__ __forceinline__ bf16x8 lds_2x8(const LAS bf16_t* p0, const LAS bf16_t* p1) { const u32x2 a = *(const LAS u32x2*)p0, b = *(const LAS u32x2*)p1; u32x4 w; w.x = a.x; w.y = a.y; w.z = b.x; w.w = b.y; bf16x8 r; __builtin_memcpy(&r, &w, 16); return r; }
__device__ __forceinline__ int nat_chunk(int d, int j) { return d == 0 ? j : (j < 4 ? 3 - j : 135 - j); }
__device__ __forceinline__ bf16x8 ldsA(const LAS bf16_t* p) { return *(const LAS bf16x8*)p; }
#define MFMA16(a, b, c) __builtin_amdgcn_mfma_f32_16x16x32_bf16((a), (b), (c), 0, 0, 0)
constexpr size_t SC_RWF = 0, SC_RWB = (size_t)R * 1024 * 2, SC_S5 = 2 * SC_RWB, SC_ML = SC_S5 + (size_t)R * 1024 * OPB, SC_RWO = F8 ? SC_ML + (size_t)R * 1024 * OPB : SC_RWF;
static_assert(SC_RWO + (size_t)R * 1024 * OPB <= SC_BYTES, "SC region overflow");

__device__ __forceinline__ void conv_item(const Frame& F, int tid, int layer, int it) {
    const bf16_t* P = (const bf16_t*)(F.ws + WS_P); bf16_t* QK = (bf16_t*)(F.ws + WS_QK);
    int b, rowbase[3], jmin, jmax; bool rv[3];
    if (it < 512) { b = it >> 7; const int i = it & 127; jmin = 0; jmax = 63;
        _Pragma("unroll") for (int a = 0; a < 3; ++a) { const int ii = i + a - 1; rv[a] = (ii >= 0 && ii < 128); rowbase[a] = b * TB + CTXL + ii * 64; } }
    else { const int q = it - 512; b = q >> 2; const int seg = q & 3; jmin = seg == 0 ? 0 : -1; jmax = seg == 3 ? 63 : 64;
        rv[0] = false; rv[2] = false; rv[1] = true; rowbase[0] = rowbase[2] = rowbase[1] = b * TB + seg * 64; }
    const int c0 = tid * 4;
    const float* cw = F.in[I_MLCW] + (size_t)layer * 9 * 2048; const float* cb = F.in[I_MLCB] + layer * 2048;
    f32x4 w[3][3];
#pragma unroll
    for (int a = 0; a < 3; ++a)
#pragma unroll
        for (int bb = 0; bb < 3; ++bb) w[a][bb] = *(const f32x4*)(cw + (a * 3 + bb) * 2048 + c0);
    const f32x4 bias = *(const f32x4*)(cb + c0);
    const float osc = c0 >= 1024 ? 0.0625f : 1.0f;
    f32x4 win[3][3];
#pragma unroll
    for (int a = 0; a < 3; ++a) { win[a][0] = (f32x4){0.f, 0.f, 0.f, 0.f}; win[a][1] = win[a][0]; win[a][2] = win[a][0]; }
    auto ldcol = [&](int a, int jj) -> f32x4 {
        const bool ok = rv[a] && jj >= jmin && jj <= jmax; const int rr = ok ? rowbase[a] + jj : rowbase[1];
        const u32x2 p = *(const u32x2*)(P + (size_t)rr * PW + c0); const float mk = ok ? 1.0f : 0.0f; f32x4 r;
        r[0] = mk * __uint_as_float(p.x << 16); r[1] = mk * __uint_as_float(p.x & 0xffff0000u); r[2] = mk * __uint_as_float(p.y << 16); r[3] = mk * __uint_as_float(p.y & 0xffff0000u);
        return r; };
#pragma unroll
    for (int a = 0; a < 3; ++a) { win[a][1] = ldcol(a, -1); win[a][2] = ldcol(a, 0); }
    for (int j0 = 0; j0 < 64; j0 += 8) {
        f32x4 nw[3][8];
#pragma unroll
        for (int u = 0; u < 8; ++u)
#pragma unroll
            for (int a = 0; a < 3; ++a) nw[a][u] = ldcol(a, j0 + u + 1);
#pragma unroll
        for (int u = 0; u < 8; ++u) {
            f32x4 acc = bias;
#pragma unroll
            for (int a = 0; a < 3; ++a) { win[a][0] = win[a][1]; win[a][1] = win[a][2]; win[a][2] = nw[a][u];
                acc += win[a][0] * w[a][0] + win[a][1] * w[a][1] + win[a][2] * w[a][2]; }
            u32x2 o; o.x = pk_bf16(siluf_(acc[0]) * osc, siluf_(acc[1]) * osc); o.y = pk_bf16(siluf_(acc[2]) * osc, siluf_(acc[3]) * osc);
            *(u32x2*)(QK + (size_t)(rowbase[1] + j0 + u) * 2048 + c0) = o;
        }
    }
}

__device__ __forceinline__ void fsincos(float a, float* s, float* c) { const float k = rintf(a * 0.15915494309189535f); const float r = fmaf(-k, 6.2831854820251465f, a) + k * 1.7484555e-7f; *s = __sinf(r); *c = __cosf(r); }
__device__ __forceinline__ void s5_tables_item(const Frame& F, int tid, int layer, int g) {
    LAS float* pwr = (LAS float*)F.lds;
    LAS float* pwi = pwr + 2 * 65 * 64;
    LAS float* bbr = pwi + 2 * 65 * 64;
    LAS float* bbi = bbr + 2 * 64 * 16;
    LAS float* ccr = bbi + 2 * 64 * 16;
    LAS float* cci = ccr + 2 * 16 * 64;
    LAS float* k0b = cci + 2 * 16 * 64;
    bf16_t* KC = (bf16_t*)(F.ws + WS_S5KC) + (size_t)g * 128 * 256;
    bf16_t* EC = (bf16_t*)(F.ws + WS_S5E) + (size_t)g * 256 * 1024;
    bf16_t* FC = (bf16_t*)(F.ws + WS_S5F) + (size_t)g * 1024 * 256;
    {
        const int dn = tid & 127, d = dn >> 6, n = dn & 63, tg = tid >> 7;
        const size_t li = (((size_t)layer * 2 + d) * 64 + g) * 64 + n;
        const float lre = F.in[I_S5LRE][li], lim = F.in[I_S5LIM][li], dt = expf(F.in[I_S5LDT][((size_t)layer * 2 + d) * 64 + g]);
        const float zr = lre * dt, zi = lim * dt;
        for (int tau = tg; tau <= 64; tau += 4) { const float mag = expf(zr * (float)tau); float sn, cs; fsincos(zi * (float)tau, &sn, &cs);
            pwr[(d * 65 + tau) * 64 + n] = mag * cs; pwi[(d * 65 + tau) * 64 + n] = mag * sn; }
        if (tg == 0) {
            const float mag = expf(zr); float sn, cs; fsincos(zi, &sn, &cs);
            const float nr = mag * cs - 1.0f, ni = mag * sn, den = 1.0f / (lre * lre + lim * lim);
            const float cr = (nr * lre + ni * lim) * den, ci = (ni * lre - nr * lim) * den;
            const float* br = F.in[I_S5BRE] + li * 16; const float* bi = F.in[I_S5BIM] + li * 16;
            for (int c = 0; c < 16; ++c) { bbr[(d * 64 + n) * 16 + c] = cr * br[c] - ci * bi[c]; bbi[(d * 64 + n) * 16 + c] = cr * bi[c] + ci * br[c]; }
        }
        for (int i = tid; i < 2 * 16 * 64; i += NTHR) { const int dd = i >> 10, rem = i & 1023;
            const size_t ci_ = (((size_t)layer * 2 + dd) * 64 + g) * 1024 + rem; ccr[i] = F.in[I_S5CRE][ci_]; cci[i] = F.in[I_S5CIM][ci_]; }
    }
    __syncthreads();
    {
        const int d = tid >> 8, co = (tid >> 4) & 15, ci = tid & 15;
        for (int half = 0; half < 2; ++half) {
            float acc[32];
#pragma unroll
            for (int t = 0; t < 32; ++t) acc[t] = 0.f;
            for (int n = 0; n < 64; ++n) {
                const float c_r = ccr[(d * 16 + co) * 64 + n], c_i = cci[(d * 16 + co) * 64 + n], b_r = bbr[(d * 64 + n) * 16 + ci], b_i = bbi[(d * 64 + n) * 16 + ci];
                const float gr = c_r * b_r - c_i * b_i, gi = c_r * b_i + c_i * b_r;
#pragma unroll
                for (int t = 0; t < 32; ++t) acc[t] += gr * pwr[(d * 65 + half * 32 + t) * 64 + n] - gi * pwi[(d * 65 + half * 32 + t) * 64 + n];
            }
            if (half == 0) {
                if (d == 1) k0b[tid & 255] = acc[0];
                __syncthreads();
                if (d == 0) acc[0] += k0b[tid & 255] + (co == ci ? F.in[I_S5D][layer * 1024 + g * 16 + co] : 0.f);
            }
#pragma unroll
            for (int t = 0; t < 32; ++t) { const int tau = half * 32 + t; if (d == 1 && tau == 0) continue; const int delta = d == 0 ? tau : -tau; KC[(size_t)(delta + 63) * 256 + co * 16 + ci] = f2bf(acc[t]); }
        }
        if (d == 1) KC[(size_t)127 * 256 + (tid & 255)] = 0;
    }
    for (int u = tid; u < 2 * 64 * 64 * 2; u += NTHR) {
        const int ch = u & 1, sp = (u >> 1) & 63, n = (u >> 7) & 63, d = u >> 13;
        const int tau = d == 0 ? 63 - sp : sp; const float pr = pwr[(d * 65 + tau) * 64 + n], pi = pwi[(d * 65 + tau) * 64 + n];
        float er[8], ei[8];
#pragma unroll
        for (int e = 0; e < 8; ++e) { const float b_r = bbr[(d * 64 + n) * 16 + ch * 8 + e], b_i = bbi[(d * 64 + n) * 16 + ch * 8 + e]; er[e] = pr * b_r - pi * b_i; ei[e] = pr * b_i + pi * b_r; }
        u32x4 wr_, wi_; wr_.x = pk_bf16(er[0], er[1]); wr_.y = pk_bf16(er[2], er[3]); wr_.z = pk_bf16(er[4], er[5]); wr_.w = pk_bf16(er[6], er[7]);
        wi_.x = pk_bf16(ei[0], ei[1]); wi_.y = pk_bf16(ei[2], ei[3]); wi_.z = pk_bf16(ei[4], ei[5]); wi_.w = pk_bf16(ei[6], ei[7]);
        *(u32x4*)(EC + (size_t)(d * 128 + n) * 1024 + sp * 16 + ch * 8) = wr_;
        *(u32x4*)(EC + (size_t)(d * 128 + 64 + n) * 1024 + sp * 16 + ch * 8) = wi_;
    }
    for (int u = tid; u < 1024 * 32; u += NTHR) {
        const int n8 = u & 7, part = (u >> 3) & 1, d = (u >> 4) & 1, co = (u >> 5) & 15, tp = u >> 9;
        const int tau = d == 0 ? tp + 1 : 64 - tp; float f[8];
#pragma unroll
        for (int e = 0; e < 8; ++e) { const int n = n8 * 8 + e; const float c_r = ccr[(d * 16 + co) * 64 + n], c_i = cci[(d * 16 + co) * 64 + n], pr = pwr[(d * 65 + tau) * 64 + n], pi = pwi[(d * 65 + tau) * 64 + n];
            f[e] = part == 0 ? (c_r * pr - c_i * pi) : -(c_r * pi + c_i * pr); }
        u32x4 w; w.x = pk_bf16(f[0], f[1]); w.y = pk_bf16(f[2], f[3]); w.z = pk_bf16(f[4], f[5]); w.w = pk_bf16(f[6], f[7]);
        *(u32x4*)(FC + (size_t)(tp * 16 + co) * 256 + d * 128 + part * 64 + n8 * 8) = w;
    }
    __syncthreads();
}

__device__ __forceinline__ void s5a_wave_item(const Frame& F, int lane, int wi) {
    const int rh = wi & 1, w2 = wi >> 1, g = w2 / 9, cq = w2 - g * 9, l15 = lane & 15, q = lane >> 4;
    const bf16_t* P = (const bf16_t*)(F.ws + WS_P); const bf16_t* EC = (const bf16_t*)(F.ws + WS_S5E) + (size_t)g * 256 * 1024 + (size_t)rh * 128 * 1024;
    float* XL = (float*)(F.ws + WS_S5X);
    const bf16_t* ub[4]; int colv[4];
#pragma unroll
    for (int c = 0; c < 4; ++c) { const int ct = (cq * 4 + c) < 33 ? cq * 4 + c : 32; const int col = ct * 16 + l15, b = col / NCH, jn = col - b * NCH; colv[c] = col;
        ub[c] = P + (size_t)(b * TB + jn * 64 + (q >> 1)) * PW + PC_S5 + g * 16 + (q & 1) * 8; }
    const unsigned eoff = (unsigned)(l15 * 1024 + q * 8) * 2u;
    f32x4 acc[4][8];
#pragma unroll
    for (int c = 0; c < 4; ++c)
#pragma unroll
        for (int x = 0; x < 8; ++x) acc[c][x] = (f32x4){0.f, 0.f, 0.f, 0.f};
    for (int ks = 0; ks < 32; ks += 2) {
        bf16x8 Bf[2][4], Af[2][8];
#pragma unroll
        for (int u = 0; u < 2; ++u) {
#pragma unroll
            for (int c = 0; c < 4; ++c) Bf[u][c] = *(const bf16x8*)(ub[c] + (size_t)((ks + u) * 2) * PW);
            unsigned eo = eoff; asm volatile("" : "+v"(eo));
#pragma unroll
            for (int x = 0; x < 8; ++x) Af[u][x] = *(const bf16x8*)((const char*)(EC + (size_t)(x * 16) * 1024 + (ks + u) * 32) + eo); }
#pragma unroll
        for (int u = 0; u < 2; ++u)
#pragma unroll
            for (int x = 0; x < 8; ++x)
#pragma unroll
                for (int c = 0; c < 4; ++c) acc[c][x] = MFMA16(Af[u][x], Bf[u][c], acc[c][x]);
    }
#pragma unroll
    for (int c = 0; c < 4; ++c) if (cq * 4 + c < 33) {
#pragma unroll
        for (int x = 0; x < 8; ++x) *(f32x4*)(XL + ((size_t)g * 528 + colv[c]) * 256 + rh * 128 + x * 16 + q * 4) = acc[c][x]; }
}

__device__ __forceinline__ void s5b_item(const Frame& F, int tid, int layer, int it) {
    const int idx = it * NTHR + tid, n = idx & 63, g = (idx >> 6) & 63, b = (idx >> 12) & 3, d = idx >> 14;
    const size_t li = (((size_t)layer * 2 + d) * 64 + g) * 64 + n;
    const float dt = expf(F.in[I_S5LDT][((size_t)layer * 2 + d) * 64 + g]);
    const float zr = F.in[I_S5LRE][li] * dt * 64.0f, zi = F.in[I_S5LIM][li] * dt * 64.0f;
    const float mag = expf(zr); float sn, cs; fsincos(zi, &sn, &cs); const float ar = mag * cs, ai = mag * sn;
    float* XL = (float*)(F.ws + WS_S5X);
    float cr = 0.f, ci = 0.f;
    for (int j0 = 0; j0 < NCH; j0 += 12) {
        float xr[12], xi[12];
#pragma unroll
        for (int u = 0; u < 12; ++u) { const int col = b * NCH + nat_chunk(d, j0 + u); const float* p = XL + ((size_t)g * 528 + col) * 256 + d * 128 + n; xr[u] = p[0]; xi[u] = p[64]; }
#pragma unroll
        for (int u = 0; u < 12; ++u) { const int col = b * NCH + nat_chunk(d, j0 + u); float* p = XL + ((size_t)g * 528 + col) * 256 + d * 128 + n;
            p[0] = cr; p[64] = ci; const float nr = ar * cr - ai * ci + xr[u], ni = ar * ci + ai * cr + xi[u]; cr = nr; ci = ni; }
    }
}

__device__ __forceinline__ float gelu_tanh(float x) { const float u = 0.7978845608028654f * (x + 0.044715f * x * x * x); const float e = __expf(2.0f * u); const float th = 1.0f - 2.0f / (e + 1.0f); return 0.5f * x * (1.0f + th); }
__device__ __forceinline__ void s5c_block_item(const Frame& F, int tid, int it) {
    const int g = it >> 2, part = it & 3, lane = tid & 63, l15 = lane & 15, q = lane >> 4;
    const int wave = __builtin_amdgcn_readfirstlane(tid >> 6);
    LAS bf16_t* KL = (LAS bf16_t*)F.lds;
    LAS bf16_t* UL = KL + 127 * 264;
    { const bf16_t* KC = (const bf16_t*)(F.ws + WS_S5KC) + (size_t)g * 128 * 256;
      for (int i = tid; i < 127 * 32; i += NTHR) { const int r = i >> 5, sgm = i & 31, co = sgm >> 1, hf = sgm & 1;
          *(LAS u32x4*)(KL + r * 264 + hf * 128 + co * 8) = *(const u32x4*)(KC + (size_t)r * 256 + sgm * 8); } }
    const bf16_t* P = (const bf16_t*)(F.ws + WS_P);
    const bf16_t* FC = (const bf16_t*)(F.ws + WS_S5F) + (size_t)g * 1024 * 256; const float* XC = (const float*)(F.ws + WS_S5X);
    void* OUT = (void*)(F.ws + WS_SC + SC_S5);
    const int c0 = part == 0 ? 0 : 9 + (part - 1) * 8, nct = part == 0 ? 9 : 8;
    for (int cp = 0; cp < (nct + 1) / 2; ++cp) {
        const int ctA = c0 + 2 * cp; const bool vB = (2 * cp + 1) < nct; const int ctB = vB ? ctA + 1 : ctA;
        __syncthreads();
        { const int grp = tid >> 8; const int ct = grp == 0 ? ctA : ctB;
#pragma unroll
          for (int i = 0; i < 8; ++i) { const int id = (tid & 255) + i * 256, s = id >> 5, rem = id & 31, cl = rem >> 1, hf = rem & 1;
              const int colg = ct * 16 + cl, bb = colg / NCH, jj = colg - bb * NCH;
              *(LAS u32x4*)(UL + grp * 16384 + s * 256 + hf * 128 + cl * 8) = *(const u32x4*)(P + (size_t)(bb * TB + jj * 64 + s) * PW + PC_S5 + g * 16 + hf * 8); } }
        __syncthreads();
        const int colA = ctA * 16 + l15, bA = colA / NCH, jA = colA - bA * NCH, colB = ctB * 16 + l15, bB = colB / NCH, jB = colB - bB * NCH;
        const LAS bf16_t* kcl = KL + (63 - (q >> 1)) * 264 + (q & 1) * 128 + l15 * 8;
        const LAS bf16_t* ul = UL + (q >> 1) * 256 + (q & 1) * 128 + l15 * 8;
        f32x4 acc[2][8];
#pragma unroll
        for (int c = 0; c < 2; ++c)
#pragma unroll
            for (int x = 0; x < 8; ++x) acc[c][x] = (f32x4){0.f, 0.f, 0.f, 0.f};
        for (int kb = 0; kb < 4; ++kb) {
#pragma unroll
            for (int i = 0; i < 8; ++i) { const int ks = kb * 8 + i; const bf16x8 b0 = ldsA(ul + ks * 512), b1 = ldsA(ul + 16384 + ks * 512);
#pragma unroll
                for (int x = 0; x < 8; ++x) { const bf16x8 af = ldsA(kcl + (wave * 8 + x - 2 * ks) * 264); acc[0][x] = MFMA16(af, b0, acc[0][x]); acc[1][x] = MFMA16(af, b1, acc[1][x]); }
                if (i & 1) __builtin_amdgcn_sched_barrier(0); }
        }
        {
            bf16x8 Xa[8], Xb[8];
#pragma unroll
            for (int ks = 0; ks < 8; ++ks) { const float* xp = XC + ((size_t)g * 528 + colA) * 256 + ks * 32 + q * 8; Xa[ks] = pack_8(*(const f32x4*)xp, *(const f32x4*)(xp + 4));
                const float* xq = XC + ((size_t)g * 528 + colB) * 256 + ks * 32 + q * 8; Xb[ks] = pack_8(*(const f32x4*)xq, *(const f32x4*)(xq + 4)); }
            const unsigned foff = (unsigned)(l15 * 256 + q * 8) * 2u; const bf16_t* fu = FC + (size_t)(wave * 128) * 256;
#pragma unroll
            for (int ks = 0; ks < 8; ++ks) { bf16x8 Af[8]; unsigned fo = foff; asm volatile("" : "+v"(fo));
#pragma unroll
                for (int x = 0; x < 8; ++x) Af[x] = *(const bf16x8*)((const char*)(fu + (size_t)(x * 16) * 256 + ks * 32) + fo);
#pragma unroll
                for (int x = 0; x < 8; ++x) { acc[0][x] = MFMA16(Af[x], Xa[ks], acc[0][x]); acc[1][x] = MFMA16(Af[x], Xb[ks], acc[1][x]); }
                __builtin_amdgcn_sched_barrier(0); }
        }
#pragma unroll
        for (int x = 0; x < 8; ++x) { const int tp = wave * 8 + x;
            { const size_t row = (size_t)bA * TB + jA * 64 + tp; st_op4(OUT, row * 1024 + g * 16 + q * 4, gelu_tanh(acc[0][x][0]), gelu_tanh(acc[0][x][1]), gelu_tanh(acc[0][x][2]), gelu_tanh(acc[0][x][3])); }
            if (vB) { const size_t row = (size_t)bB * TB + jB * 64 + tp; st_op4(OUT, row * 1024 + g * 16 + q * 4, gelu_tanh(acc[1][x][0]), gelu_tanh(acc[1][x][1]), gelu_tanh(acc[1][x][2]), gelu_tanh(acc[1][x][3])); } }
    }
    __syncthreads();
}

__device__ __forceinline__ float logsigmoidf_(float x) { return fminf(x, 0.f) - __logf(1.0f + __expf(-fabsf(x))); }
__device__ __forceinline__ void mlstm_item(const Frame& F, int tid, int layer, int item) {
    const int vs = item & 3, h = (item >> 2) & 3, b = (item >> 4) & 3, d = item >> 6;
    const int lane = tid & 63, wave = __builtin_amdgcn_readfirstlane(tid >> 6), l15 = lane & 15, q = lane >> 4;
    const int y = wave & 3, p = wave >> 2;
    LAS bf16_t* Qs = (LAS bf16_t*)F.lds;
    LAS bf16_t* Ks = Qs + 64 * 264;
    LAS bf16_t* Kt = Ks + 64 * 264;
    LAS bf16_t* Vt = Kt + 256 * 72;
    LAS bf16_t* Vw = Vt + 64 * 72;
    LAS bf16_t* St = Vw + 64 * 72;
    LAS float* PX = (LAS float*)(St + 64 * 72);
    LAS float* fl = PX + 4 * 4 * 64 * 4;
    LAS float* gsc = fl;
    LAS float* rsum = fl + 384;
    LAS float* qn = fl + 512;
    LAS float* nvec = fl + 576;
    LAS float* wtsl = fl + 832;
    const bf16_t* P = (const bf16_t*)(F.ws + WS_P); const bf16_t* QK = (const bf16_t*)(F.ws + WS_QK);
    bf16_t* HO = (bf16_t*)(F.ws + WS_P);
    if (tid < 256) nvec[tid] = 0.f;
    f32x4 Cst[8];
#pragma unroll
    for (int x = 0; x < 8; ++x) Cst[x] = (f32x4){0.f, 0.f, 0.f, 0.f};
    float m_prev = 0.f;
    u32x4 pq[4], pk[4], pv; float pgi = 0.f, pgf = 0.f;
#define ML_LOAD(jj) do { const int rb_ = b * TB + nat_chunk(d, (jj)) * 64; int tl = tid; asm volatile("" : "+v"(tl));   \
        _Pragma("unroll") for (int i = 0; i < 4; ++i) { const int id = tl + i * NTHR; { const int t = id >> 5, seg = id & 31; const size_t row = (size_t)(rb_ + (d == 0 ? t : 63 - t)); pq[i] = *(const u32x4*)(QK + row * 2048 + h * 256 + seg * 8); } \
            { const int t = id & 63, seg = id >> 6; const size_t row = (size_t)(rb_ + (d == 0 ? t : 63 - t)); pk[i] = *(const u32x4*)(QK + row * 2048 + 1024 + h * 256 + seg * 8); } } \
        { const int t = tl & 63, seg = tl >> 6; const size_t row = (size_t)(rb_ + (d == 0 ? t : 63 - t)); pv = *(const u32x4*)(P + row * PW + PC_V + h * 256 + vs * 64 + seg * 8); } \
        if (wave == 7) { const size_t row = (size_t)(rb_ + (d == 0 ? lane : 63 - lane)); pgi = bf2f(P[row * PW + PC_IG + d * 4 + h]); pgf = bf2f(P[row * PW + PC_FG + d * 4 + h]); } } while (0)
#define ML_STAGE(jj) do { int tl = tid; asm volatile("" : "+v"(tl)); \
        _Pragma("unroll") for (int i = 0; i < 4; ++i) { const int id = tl + i * NTHR; { const int t = id >> 5, seg = id & 31; *(LAS u32x4*)(Qs + t * 264 + seg * 8) = pq[i]; } \
            { const int t = id & 63, seg = id >> 6; *(LAS u32x4*)(Ks + t * 264 + seg * 8) = pk[i]; const unsigned kw[4] = {pk[i].x, pk[i].y, pk[i].z, pk[i].w}; \
              _Pragma("unroll") for (int e = 0; e < 4; ++e) { Kt[(seg * 8 + 2 * e) * 72 + t] = (bf16_t)(kw[e] & 0xffffu); Kt[(seg * 8 + 2 * e + 1) * 72 + t] = (bf16_t)(kw[e] >> 16); } } } \
        { const int t = tl & 63, seg = tl >> 6; const unsigned vw_[4] = {pv.x, pv.y, pv.z, pv.w}; \
            _Pragma("unroll") for (int e = 0; e < 4; ++e) { Vt[(seg * 8 + 2 * e) * 72 + t] = (bf16_t)(vw_[e] & 0xffffu); Vt[(seg * 8 + 2 * e + 1) * 72 + t] = (bf16_t)(vw_[e] >> 16); } } \
        if (wave == 7) { const float igb = F.in[I_MLIGB][layer * 8 + d * 4 + h], fgb = F.in[I_MLFGB][layer * 8 + d * 4 + h];     \
            float bc = logsigmoidf_(pgf + fgb); \
            _Pragma("unroll") for (int o = 1; o < 64; o <<= 1) { const float t = shup(bc, o, lane); if (lane >= o) bc += t; } \
            const float g_ = (pgi + igb) - bc; float pm = g_; \
            _Pragma("unroll") for (int o = 1; o < 64; o <<= 1) { const float t = shup(pm, o, lane); if (lane >= o) pm = fmaxf(pm, t); } \
            LAS float* gs_ = gsc + ((jj) & 1) * 192; gs_[lane] = g_; gs_[64 + lane] = pm; gs_[128 + lane] = bc; } } while (0)
    ML_LOAD(0);
    __syncthreads();
    ML_STAGE(0);
    ML_LOAD(1);
    __syncthreads();
    for (int j = 0; j < NCH; ++j) {
        const int rb = b * TB + nat_chunk(d, j) * 64;
        const LAS float* gg = gsc + (j & 1) * 192; const LAS float* pmx = gg + 64; const LAS float* bcm = gg + 128;
        const float a63 = fmaxf(m_prev, pmx[63]), decay = __expf(m_prev - a63), m_new = bcm[63] + a63;
        { const int tr = wave >> 1; float rp[4] = {0.f, 0.f, 0.f, 0.f};
#pragma unroll
          for (int u = 0; u < 2; ++u) { const int tc = (wave & 1) * 2 + u; f32x4 acc = (f32x4){0.f, 0.f, 0.f, 0.f};
              if (tc <= tr) {
#pragma unroll
                  for (int ks = 0; ks < 8; ++ks) acc = MFMA16(ldsA(Qs + (tr * 16 + l15) * 264 + ks * 32 + q * 8), ldsA(Ks + (tc * 16 + l15) * 264 + ks * 32 + q * 8), acc);
              }
              const int s = tc * 16 + l15; const float gs = gg[s];
#pragma unroll
              for (int i = 0; i < 4; ++i) { const int jr = tr * 16 + q * 4 + i; const float v = (s <= jr) ? acc[i] * __expf(gs - fmaxf(pmx[jr], m_prev)) : 0.f; St[jr * 72 + s] = f2bf(v); rp[i] += v; } }
#pragma unroll
          for (int i = 0; i < 4; ++i) { float s_ = rp[i]; s_ += shx<1>(s_); s_ += shx<2>(s_); s_ += shx<4>(s_); s_ += shx<8>(s_); if (l15 == 0) rsum[(wave & 1) * 64 + tr * 16 + q * 4 + i] = s_; } }
#pragma unroll
        for (int i = 0; i < 8; ++i) { const int id = tid + i * NTHR, dv = id >> 6, s = id & 63; Vw[dv * 72 + s] = f2bf(bf2f(Vt[dv * 72 + s]) * __expf(gg[s] - a63)); }
        if (tid < 64) wtsl[tid] = __expf(gg[tid] - a63);
        { const int row = tid >> 3, part = tid & 7; float qv = 0.f;
#pragma unroll
          for (int e8 = 0; e8 < 4; ++e8) { float x8[8]; unpack8(*(const LAS u32x4*)(Qs + row * 264 + part * 32 + e8 * 8), x8); const f32x4 n0 = *(const LAS f32x4*)(nvec + part * 32 + e8 * 8), n1 = *(const LAS f32x4*)(nvec + part * 32 + e8 * 8 + 4);
              qv += (x8[0] * n0[0] + x8[1] * n0[1]) + (x8[2] * n0[2] + x8[3] * n0[3]) + (x8[4] * n1[0] + x8[5] * n1[1]) + (x8[6] * n1[2] + x8[7] * n1[3]); }
          qv += shx<1>(qv); qv += shx<2>(qv); qv += shx<4>(qv);
          if (part == 0) qn[row] = qv; }
        __syncthreads();
        f32x4 acc[4], PXs[4];
#pragma unroll
        for (int rt = 0; rt < 4; ++rt) PXs[rt] = (f32x4){0.f, 0.f, 0.f, 0.f};
        { bf16x8 Cb[4];
#pragma unroll
          for (int kk = 0; kk < 4; ++kk) Cb[kk] = pack_8(Cst[2 * kk], Cst[2 * kk + 1]);
#pragma unroll
          for (int rt = 0; rt < 4; ++rt) { acc[rt] = (f32x4){0.f, 0.f, 0.f, 0.f};
#pragma unroll
              for (int kk = 0; kk < 4; ++kk) { const LAS bf16_t* qp = Qs + (rt * 16 + l15) * 264 + (p * 8 + 2 * kk) * 16 + q * 4; acc[rt] = MFMA16(lds_2x8(qp, qp + 16), Cb[kk], acc[rt]); } } }
        if (p == 1) {
#pragma unroll
            for (int rt = 0; rt < 4; ++rt) *(LAS f32x4*)(PX + ((y * 4 + rt) * 64 + lane) * 4) = acc[rt];
        } else {
#pragma unroll
            for (int rt = 0; rt < 4; ++rt) { f32x4 a2 = (f32x4){0.f, 0.f, 0.f, 0.f};
#pragma unroll
                for (int ks = 0; ks < 2; ++ks) a2 = MFMA16(ldsA(St + (rt * 16 + l15) * 72 + ks * 32 + q * 8), ldsA(Vt + (y * 16 + l15) * 72 + ks * 32 + q * 8), a2);
                PXs[rt] = a2; }
        }
        { const bf16x8 vw0 = ldsA(Vw + (y * 16 + l15) * 72 + q * 8), vw1 = ldsA(Vw + (y * 16 + l15) * 72 + 32 + q * 8);
          bf16x8 wq0, wq1; { const f32x4 a0 = *(const LAS f32x4*)(wtsl + q * 8), a1 = *(const LAS f32x4*)(wtsl + q * 8 + 4), b0 = *(const LAS f32x4*)(wtsl + 32 + q * 8), b1 = *(const LAS f32x4*)(wtsl + 32 + q * 8 + 4);
              const f32x4 zz = (f32x4){0.f, 0.f, 0.f, 0.f}; wq0 = l15 == 0 ? pack_8(a0, a1) : pack_8(zz, zz); wq1 = l15 == 0 ? pack_8(b0, b1) : pack_8(zz, zz); }
#pragma unroll
          for (int x = 0; x < 8; ++x) { Cst[x] *= decay; const LAS bf16_t* kp = Kt + ((p * 8 + x) * 16 + l15) * 72 + q * 8; const bf16x8 k0 = ldsA(kp), k1 = ldsA(kp + 32);
              Cst[x] = MFMA16(k0, vw0, Cst[x]); Cst[x] = MFMA16(k1, vw1, Cst[x]);
              if (x == 2 * y || x == 2 * y + 1) { const int dkb = (p * 8 + x) * 16 + q * 4; f32x4 nn = (f32x4){0.f, 0.f, 0.f, 0.f};
                  if (l15 == 0) { nn = *(const LAS f32x4*)(nvec + dkb); nn *= decay; }
                  nn = MFMA16(k0, wq0, nn); nn = MFMA16(k1, wq1, nn);
                  if (l15 == 0) *(LAS f32x4*)(nvec + dkb) = nn; } } }
        __syncthreads();
        if (p == 0) {
#pragma unroll
            for (int rt = 0; rt < 4; ++rt) { const f32x4 px = *(const LAS f32x4*)(PX + ((y * 4 + rt) * 64 + lane) * 4);
#pragma unroll
                for (int i = 0; i < 4; ++i) { const int t = rt * 16 + q * 4 + i; const float a_ = fmaxf(pmx[t], m_prev), si = __expf(m_prev - a_);
                    const float hd = fmaxf(fabsf(rsum[t] + rsum[64 + t] + si * qn[t]), __expf(-(bcm[t] + a_)));
                    const float num = (acc[rt][i] + px[i]) * si + PXs[rt][i];
                    const size_t row = (size_t)(rb + (d == 0 ? t : 63 - t));
                    HO[row * PW + d * 1024 + h * 256 + vs * 64 + y * 16 + l15] = f2bf(num * __builtin_amdgcn_rcpf(hd)); } }
        }
        if (j + 1 < NCH) { ML_STAGE(j + 1); if (j + 2 < NCH) ML_LOAD(j + 2); }
        m_prev = m_new;
        __syncthreads();
    }
#undef ML_LOAD
#undef ML_STAGE
}

__device__ __forceinline__ void ml_finish_rows(const Frame& F, int lane, int layer) {
    const bf16_t* P = (const bf16_t*)(F.ws + WS_P); bf16_t* ML = (bf16_t*)(F.ws + WS_SC + SC_ML);
    const float* ng = F.in[I_MLNG] + layer * 1024; const float* nb = F.in[I_MLNB] + layer * 1024;
    const int c0 = lane * 16, stride = F.G * NWAVE;
    for (int r0 = F.bid * NWAVE + F.wave; r0 < R; r0 += 4 * stride) {
        u32x4 ha[4][2], hb[4][2], ho[4][2];
#pragma unroll
        for (int u = 0; u < 4; ++u) { const int r = r0 + u * stride < R ? r0 + u * stride : r0; const bf16_t* pr = P + (size_t)r * PW;
#pragma unroll
            for (int hh = 0; hh < 2; ++hh) { ha[u][hh] = *(const u32x4*)(pr + c0 + hh * 8); hb[u][hh] = *(const u32x4*)(pr + 1024 + c0 + hh * 8); ho[u][hh] = *(const u32x4*)(pr + PC_O + c0 + hh * 8); } }
#pragma unroll
        for (int u = 0; u < 4; ++u) { const int r = r0 + u * stride; if (r < R) {
            float v[16], o[16];
#pragma unroll
            for (int hh = 0; hh < 2; ++hh) { float a8[8], b8[8], o8[8]; unpack8(ha[u][hh], a8); unpack8(hb[u][hh], b8); unpack8(ho[u][hh], o8);
#pragma unroll
                for (int e2 = 0; e2 < 8; ++e2) { v[hh * 8 + e2] = a8[e2] + b8[e2]; o[hh * 8 + e2] = o8[e2]; } }
            float s = 0.f;
#pragma unroll
            for (int e2 = 0; e2 < 16; ++e2) s += v[e2];
            s += shx<1>(s); s += shx<2>(s); s += shx<4>(s); s += shx<8>(s);
            const float mean = s * (1.0f / 256.0f); float qq = 0.f;
#pragma unroll
            for (int e2 = 0; e2 < 16; ++e2) { v[e2] -= mean; qq += v[e2] * v[e2]; }
            qq += shx<1>(qq); qq += shx<2>(qq); qq += shx<4>(qq); qq += shx<8>(qq);
            const float rstd = rsqrtf(qq * (1.0f / 256.0f) + 1e-6f);
            float y8[8];
#pragma unroll
            for (int hh = 0; hh < 2; ++hh) {
#pragma unroll
                for (int e2 = 0; e2 < 8; ++e2) { const int ee = hh * 8 + e2; y8[e2] = (v[ee] * rstd * ng[c0 + ee] + nb[c0 + ee]) * sigmoidf_(o[ee]); }
                st_op8(ML, (size_t)r * 1024 + c0 + hh * 8, y8); } } }
    }
}


__device__ __forceinline__ void tshift8(const bf16_t* P, size_t row, int srow, int col, const float* mu, float (&o)[8]) {
    float z[8], zp[8], zn[8];
    const bool hp = (srow != 0 && srow != CTXL), hn = (srow != CTXL - 1 && srow != TB - 1);
    const u32x4 wz = *(const u32x4*)(P + row * PW + col), wp = *(const u32x4*)(P + (hp ? row - 1 : row) * PW + col), wn = *(const u32x4*)(P + (hn ? row + 1 : row) * PW + col);
    const f32x4 m0 = *(const f32x4*)mu, m1 = *(const f32x4*)(mu + 4);
    unpack8(wz, z); unpack8(wp, zp); unpack8(wn, zn);
    const float fp = hp ? 0.5f : 0.f, fn = hn ? 0.5f : 0.f;
#pragma unroll
    for (int e = 0; e < 8; ++e) { const float m = e < 4 ? m0[e & 3] : m1[e & 3]; o[e] = z[e] + m * (fp * zp[e] + fn * zn[e] - z[e]); }
}
__device__ __forceinline__ void rwkv_item(const Frame& F, int tid, int layer, int item) {
    const int h = item & 15, b = (item >> 4) & 3, d = item >> 6;
    const int lane = tid & 63, wave = __builtin_amdgcn_readfirstlane(tid >> 6), l15 = lane & 15, q = lane >> 4;
    LAS float* r_ = (LAS float*)F.lds;
    LAS float* w_ = r_ + 4096, *kd_ = w_ + 4096, *kk_ = kd_ + 4096, *bb_ = kk_ + 4096, *v_ = bb_ + 4096;
    LAS bf16_t* TW = (LAS bf16_t*)(v_ + 4096);
    LAS bf16_t* TA = TW + 64 * 72;
    LAS bf16_t* WU = TA + 64 * 72;
    LAS bf16_t* AU = WU + 64 * 72;
    LAS float* yout = (LAS float*)TW;
    const bf16_t* P = (const bf16_t*)(F.ws + WS_P);
    bf16_t* YO = (bf16_t*)(F.ws + WS_SC + (d == 0 ? SC_RWF : SC_RWB));
    float* BON = (float*)(F.ws + WS_BONUS) + (size_t)d * R * 16;
    const float* mu = F.in[I_RWMU] + layer * 3456;
    {
        const int rr = tid >> 3, c0 = (tid & 7) * 8;
        const float* wu = F.in[I_RWWUP] + (((size_t)layer * 2 + d) * 64 + rr) * 1024 + h * 64 + c0; const float* au = F.in[I_RWAUP] + (((size_t)layer * 2 + d) * 64 + rr) * 1024 + h * 64 + c0;
#pragma unroll
        for (int e = 0; e < 8; ++e) { WU[(c0 + e) * 72 + rr] = f2bf(wu[e]); AU[(c0 + e) * 72 + rr] = f2bf(au[e]); }
    }
    const int t_ = tid >> 3, c0 = (tid & 7) * 8;
    float mur[8], muk[8], muv[8], muw[8], mua[8], kkc[8], kac[8], rkc[8];
#pragma unroll
    for (int e = 0; e < 8; ++e) { mur[e] = mu[h * 64 + c0 + e]; muk[e] = mu[1024 + h * 64 + c0 + e]; muv[e] = mu[2048 + h * 64 + c0 + e]; muw[e] = mu[3072 + d * 64 + c0 + e]; mua[e] = mu[3200 + d * 64 + c0 + e];
        kkc[e] = F.in[I_RWKK][layer * 1024 + h * 64 + c0 + e]; kac[e] = F.in[I_RWKA][layer * 1024 + h * 64 + c0 + e]; rkc[e] = F.in[I_RWRK][layer * 1024 + h * 64 + c0 + e]; }
    float S[8];
#pragma unroll
    for (int e = 0; e < 8; ++e) S[e] = 0.f;
    const int vrow = tid >> 3, cg = tid & 7;
    __syncthreads();
    for (int j = 0; j < NCH; ++j) {
        const int jn = nat_chunk(d, j); const int srow = jn * 64 + (d == 0 ? t_ : 63 - t_); const size_t row = (size_t)b * TB + srow;
        float rs[8], ks[8], vs[8], tmp[8];
        tshift8(P, row, srow, PC_RR + h * 64 + c0, mur, rs); tshift8(P, row, srow, PC_RK + h * 64 + c0, muk, ks); tshift8(P, row, srow, PC_RV + h * 64 + c0, muv, vs);
        tshift8(P, row, srow, PC_WD + d * 64 + c0, muw, tmp);
#pragma unroll
        for (int e = 0; e < 8; ++e) TW[t_ * 72 + c0 + e] = f2bf(tanhf_(tmp[e]));
        tshift8(P, row, srow, PC_AD + d * 64 + c0, mua, tmp);
#pragma unroll
        for (int e = 0; e < 8; ++e) TA[t_ * 72 + c0 + e] = f2bf(tmp[e]);
        float kkv[8], ss = 0.f;
#pragma unroll
        for (int e = 0; e < 8; ++e) { r_[t_ * 64 + c0 + e] = rs[e]; v_[t_ * 64 + c0 + e] = vs[e]; kkv[e] = ks[e] * kkc[e]; ss += kkv[e] * kkv[e]; }
        ss += shx<1>(ss); ss += shx<2>(ss); ss += shx<4>(ss);
        const float inv = 1.0f / fmaxf(sqrtf(ss), 1e-12f);
        __syncthreads();
        {
            const int tr = wave >> 1;
#pragma unroll
            for (int u = 0; u < 2; ++u) { const int tc = (wave & 1) * 2 + u; f32x4 aw = (f32x4){0.f, 0.f, 0.f, 0.f}, aa = aw;
#pragma unroll
                for (int kq = 0; kq < 2; ++kq) { aw = MFMA16(ldsA(TW + (tr * 16 + l15) * 72 + kq * 32 + q * 8), ldsA(WU + (tc * 16 + l15) * 72 + kq * 32 + q * 8), aw);
                    aa = MFMA16(ldsA(TA + (tr * 16 + l15) * 72 + kq * 32 + q * 8), ldsA(AU + (tc * 16 + l15) * 72 + kq * 32 + q * 8), aa); }
                const int c = tc * 16 + l15; const float w0 = F.in[I_RWW0][((size_t)layer * 2 + d) * 1024 + h * 64 + c], a0 = F.in[I_RWA0][((size_t)layer * 2 + d) * 1024 + h * 64 + c];
#pragma unroll
                for (int i = 0; i < 4; ++i) { const int t = tr * 16 + q * 4 + i; w_[t * 64 + c] = __expf(-0.6065306597126334f * sigmoidf_(w0 + aw[i])); bb_[t * 64 + c] = sigmoidf_(a0 + aa[i]); } }
        }
        __syncthreads();
        { float bon = 0.f;
#pragma unroll
          for (int e = 0; e < 8; ++e) { const float a = bb_[t_ * 64 + c0 + e]; const float kdv = ks[e] * (1.0f + (a - 1.0f) * kac[e]); const float kkn = kkv[e] * inv;
              kd_[t_ * 64 + c0 + e] = kdv; kk_[t_ * 64 + c0 + e] = kkn; bb_[t_ * 64 + c0 + e] = kkn * a; bon += rs[e] * kdv * rkc[e]; }
          bon += shx<1>(bon); bon += shx<2>(bon); bon += shx<4>(bon);
          if ((tid & 7) == 0) BON[row * 16 + h] = bon; }
        __syncthreads();
        for (int t = 0; t < 64; ++t) {
            const LAS f32x4* pk = (const LAS f32x4*)(kk_ + t * 64 + cg * 8); const LAS f32x4* pw = (const LAS f32x4*)(w_ + t * 64 + cg * 8);
            const LAS f32x4* pb = (const LAS f32x4*)(bb_ + t * 64 + cg * 8); const LAS f32x4* pd = (const LAS f32x4*)(kd_ + t * 64 + cg * 8); const LAS f32x4* pr = (const LAS f32x4*)(r_ + t * 64 + cg * 8);
            const f32x4 k0 = pk[0], k1 = pk[1], w0 = pw[0], w1 = pw[1], b0 = pb[0], b1 = pb[1], d0 = pd[0], d1 = pd[1], r0 = pr[0], r1 = pr[1];
            const float vv = v_[t * 64 + vrow];
            float skk = (S[0] * k0[0] + S[1] * k0[1]) + (S[2] * k0[2] + S[3] * k0[3]) + (S[4] * k1[0] + S[5] * k1[1]) + (S[6] * k1[2] + S[7] * k1[3]);
            skk += shx<1>(skk); skk += shx<2>(skk); skk += shx<4>(skk);
#pragma unroll
            for (int e = 0; e < 4; ++e) { S[e] = S[e] * w0[e] - skk * b0[e] + vv * d0[e]; S[4 + e] = S[4 + e] * w1[e] - skk * b1[e] + vv * d1[e]; }
            float y = (S[0] * r0[0] + S[1] * r0[1]) + (S[2] * r0[2] + S[3] * r0[3]) + (S[4] * r1[0] + S[5] * r1[1]) + (S[6] * r1[2] + S[7] * r1[3]);
            y += shx<1>(y); y += shx<2>(y); y += shx<4>(y);
            if (cg == 0) yout[t * 64 + vrow] = y;
        }
        __syncthreads();
        { float yv[8];
#pragma unroll
          for (int e = 0; e < 8; ++e) yv[e] = yout[t_ * 64 + c0 + e];
          u32x4 w; w.x = pk_bf16(yv[0], yv[1]); w.y = pk_bf16(yv[2], yv[3]); w.z = pk_bf16(yv[4], yv[5]); w.w = pk_bf16(yv[6], yv[7]);
          *(u32x4*)(YO + row * 1024 + h * 64 + c0) = w; }
        __syncthreads();
    }
}

#define MFMAF32(a, b, c) __builtin_amdgcn_mfma_f32_16x16x4f32((a), (b), (c), 0, 0, 0)
__device__ __forceinline__ f32x4 mm16(const f32x4 P, const f32x4 Y) {
    f32x4 acc = (f32x4){0.f, 0.f, 0.f, 0.f};
#pragma unroll
    for (int i = 0; i < 4; ++i) acc = MFMAF32(P[i], Y[i], acc);
    return acc;
}
__device__ __forceinline__ bf16x8 pack_lo4(const f32x4 x) { u32x4 w; w.x = pk_bf16(x[0], x[1]); w.y = pk_bf16(x[2], x[3]); w.z = 0u; w.w = 0u; bf16x8 r; __builtin_memcpy(&r, &w, 16); return r; }
__device__ __forceinline__ bf16x8 pack_hi4(const f32x4 x) { u32x4 w; w.x = 0u; w.y = 0u; w.z = pk_bf16(x[0], x[1]); w.w = pk_bf16(x[2], x[3]); bf16x8 r; __builtin_memcpy(&r, &w, 16); return r; }
#define WAVE_SYNC() do { asm volatile("s_waitcnt lgkmcnt(0)" ::: "memory"); __builtin_amdgcn_wave_barrier(); } while (0)
constexpr int RWC_WREG = 15360;
constexpr int RWC_R0 = 0, RWC_R1 = 2304, RWC_R2 = 4608, RWC_R3 = 6912, RWC_BK = 9216, RWC_V = 13312, RWC_NN = RWC_R1, RWC_TM = RWC_R1 + 1024, RWC_GL = RWC_R1 + 1536;
__device__ __forceinline__ void rwkvc_item(const Frame& F, int tid, int layer, int item) {
    const int h = item & 15, b = (item >> 4) & 3, d = item >> 6;
    const int lane = tid & 63, wave = __builtin_amdgcn_readfirstlane(tid >> 6), l15 = lane & 15, q = lane >> 4;
    LAS bf16_t* WU = (LAS bf16_t*)F.lds;
    LAS bf16_t* AU = WU + 64 * 72;
    LAS unsigned char* wreg0 = F.lds + 2 * 64 * 72 * 2;
    LAS unsigned char* wb = wreg0 + wave * RWC_WREG;
    LAS float* MUL = (LAS float*)(wreg0 + 8 * RWC_WREG);
    const bf16_t* P = (const bf16_t*)(F.ws + WS_P);
    bf16_t* YO = (bf16_t*)(F.ws + WS_SC + (d == 0 ? SC_RWF : SC_RWB));
    float* BON = (float*)(F.ws + WS_BONUS) + (size_t)d * R * 16;
    const float* mu = F.in[I_RWMU] + layer * 3456;
    if (tid < 320) { const int a = tid >> 6, c = tid & 63; const int off = a == 0 ? h * 64 : a == 1 ? 1024 + h * 64 : a == 2 ? 2048 + h * 64 : a == 3 ? 3072 + d * 64 : 3200 + d * 64; MUL[tid] = mu[off + c]; }
    {   const int rr = tid >> 3, c0 = (tid & 7) * 8;
        const float* wu = F.in[I_RWWUP] + (((size_t)layer * 2 + d) * 64 + rr) * 1024 + h * 64 + c0; const float* au = F.in[I_RWAUP] + (((size_t)layer * 2 + d) * 64 + rr) * 1024 + h * 64 + c0;
#pragma unroll
        for (int e = 0; e < 8; ++e) { WU[(c0 + e) * 72 + rr] = f2bf(wu[e]); AU[(c0 + e) * 72 + rr] = f2bf(au[e]); } }
    float kkc[4], kac[4], rkc[4], w0c[4], a0c[4];
#pragma unroll
    for (int ct = 0; ct < 4; ++ct) { const int c = h * 64 + ct * 16 + l15; kkc[ct] = F.in[I_RWKK][layer * 1024 + c]; kac[ct] = F.in[I_RWKA][layer * 1024 + c]; rkc[ct] = F.in[I_RWRK][layer * 1024 + c];
        w0c[ct] = F.in[I_RWW0][((size_t)layer * 2 + d) * 1024 + c]; a0c[ct] = F.in[I_RWA0][((size_t)layer * 2 + d) * 1024 + c]; }
    f32x4 Sacc[4];
#pragma unroll
    for (int x = 0; x < 4; ++x) Sacc[x] = (f32x4){0.f, 0.f, 0.f, 0.f};
    __syncthreads();
    for (int rnd = 0; rnd < NCH * 4 / 8; ++rnd) {
        {
            const int ch = rnd * 8 + wave, j64 = ch >> 2, jn = nat_chunk(d, j64), o0 = (ch & 3) * 16;
            LAS bf16_t* R0 = (LAS bf16_t*)(wb + RWC_R0); LAS bf16_t* R1 = (LAS bf16_t*)(wb + RWC_R1); LAS bf16_t* R2 = (LAS bf16_t*)(wb + RWC_R2); LAS bf16_t* R3 = (LAS bf16_t*)(wb + RWC_R3);
            LAS bf16_t* TAp = (LAS bf16_t*)(wb + RWC_BK); LAS bf16_t* BKT = (LAS bf16_t*)(wb + RWC_BK); LAS bf16_t* VF = (LAS bf16_t*)(wb + RWC_V);
            {
                const int t = lane >> 2, cq = (lane & 3) * 16; const int o = o0 + t; const int srow = jn * 64 + (d == 0 ? o : 63 - o); const size_t row = (size_t)b * TB + srow;
                const bool hp = (srow != 0 && srow != CTXL), hn = (srow != CTXL - 1 && srow != TB - 1); const float fp = hp ? 0.5f : 0.f, fn = hn ? 0.5f : 0.f;
                const bf16_t* pz = P + row * PW; const bf16_t* pp = P + (hp ? row - 1 : row) * PW; const bf16_t* pn = P + (hn ? row + 1 : row) * PW;
                const int colA[5] = {PC_RR + h * 64, PC_RK + h * 64, PC_RV + h * 64, PC_WD + d * 64, PC_AD + d * 64};
                u32x4 wz[5][2], wp[5][2], wn[5][2];
#pragma unroll
                for (int a = 0; a < 5; ++a)
#pragma unroll
                    for (int hh = 0; hh < 2; ++hh) { const int c = colA[a] + cq + hh * 8; wz[a][hh] = *(const u32x4*)(pz + c); wp[a][hh] = *(const u32x4*)(pp + c); wn[a][hh] = *(const u32x4*)(pn + c); }
                LAS bf16_t* dst[5] = {R0, R1, R2, R3, TAp};
#pragma unroll
                for (int a = 0; a < 5; ++a)
#pragma unroll
                    for (int hh = 0; hh < 2; ++hh) { const int cc = cq + hh * 8; float z[8], zp[8], zn[8], x8[8];
                        unpack8(wz[a][hh], z); unpack8(wp[a][hh], zp); unpack8(wn[a][hh], zn);
                        const f32x4 m0 = *(const LAS f32x4*)(MUL + a * 64 + cc), m1 = *(const LAS f32x4*)(MUL + a * 64 + cc + 4);
#pragma unroll
                        for (int e = 0; e < 8; ++e) { const float m = e < 4 ? m0[e & 3] : m1[e & 3]; x8[e] = z[e] + m * (fp * zp[e] + fn * zn[e] - z[e]); if (a == 3) x8[e] = tanhf_(x8[e]); }
                        u32x4 w; w.x = pk_bf16(x8[0], x8[1]); w.y = pk_bf16(x8[2], x8[3]); w.z = pk_bf16(x8[4], x8[5]); w.w = pk_bf16(x8[6], x8[7]); *(LAS u32x4*)(dst[a] + t * 72 + cc) = w; }
            }
            WAVE_SYNC();
            f32x4 lw[4], av[4];
            {   const bf16x8 tw0 = ldsA(R3 + l15 * 72 + q * 8), tw1 = ldsA(R3 + l15 * 72 + 32 + q * 8), ta0 = ldsA(TAp + l15 * 72 + q * 8), ta1 = ldsA(TAp + l15 * 72 + 32 + q * 8);
#pragma unroll
                for (int ct = 0; ct < 4; ++ct) { f32x4 aw = (f32x4){0.f, 0.f, 0.f, 0.f}, aa = aw;
                    aw = MFMA16(tw0, ldsA(WU + (ct * 16 + l15) * 72 + q * 8), aw); aw = MFMA16(tw1, ldsA(WU + (ct * 16 + l15) * 72 + 32 + q * 8), aw);
                    aa = MFMA16(ta0, ldsA(AU + (ct * 16 + l15) * 72 + q * 8), aa); aa = MFMA16(ta1, ldsA(AU + (ct * 16 + l15) * 72 + 32 + q * 8), aa);
#pragma unroll
                    for (int i = 0; i < 4; ++i) { lw[ct][i] = -0.6065306597126334f * sigmoidf_(w0c[ct] + aw[i]); av[ct][i] = sigmoidf_(a0c[ct] + aa[i]); } } }
            WAVE_SYNC();
            float ssq[4] = {0.f, 0.f, 0.f, 0.f};
#pragma unroll
            for (int ct = 0; ct < 4; ++ct)
#pragma unroll
                for (int i = 0; i < 4; ++i) { const float kk = bf2f(R1[(q * 4 + i) * 72 + ct * 16 + l15]) * kkc[ct]; ssq[i] += kk * kk; }
            float inv[4];
#pragma unroll
            for (int i = 0; i < 4; ++i) { float s = ssq[i]; s += shx<1>(s); s += shx<2>(s); s += shx<4>(s); s += shx<8>(s); inv[i] = 1.0f / fmaxf(sqrtf(s), 1e-12f); }
            float bon[4] = {0.f, 0.f, 0.f, 0.f};
            bf16x8 Apk[4];
            float glv[4];
#pragma unroll
            for (int ct = 0; ct < 4; ++ct) {
                f32x4 lg; lg[0] = lw[ct][0]; lg[1] = lg[0] + lw[ct][1]; lg[2] = lg[1] + lw[ct][2]; lg[3] = lg[2] + lw[ct][3];
                const float tot = lg[3];
                float x1 = tot; { const float t1 = shup(x1, 16, lane); if (q >= 1) x1 += t1; }
                float x2 = x1;  { const float t2 = shup(x1, 32, lane); if (q >= 2) x2 += t2; }
                const float excl = x2 - tot;
                const float lgL = __int_as_float(__builtin_amdgcn_ds_bpermute((48 + l15) << 2, __float_as_int(x2)));
                f32x4 At, Bh, Kh, vv; const float eex = __expf(excl), egL = __expf(lgL); float egprev = eex;
#pragma unroll
                for (int i = 0; i < 4; ++i) { const int idx = (q * 4 + i) * 72 + ct * 16 + l15; const float lgt = excl + lg[i];
                    const float rs = bf2f(R0[idx]), ks = bf2f(R1[idx]), vs = bf2f(R2[idx]); const float a = av[ct][i];
                    const float kkn = ks * kkc[ct] * inv[i], kd = ks * (1.0f + (a - 1.0f) * kac[ct]), beta = -kkn * a;
                    bon[i] += rs * kd * rkc[ct];
                    const float eg = __expf(lgt), egm = (i == 0) ? eex : egprev, ig = __builtin_amdgcn_rcpf(eg), gl = egL * ig; egprev = eg;
                    At[i] = kkn * egm; R0[idx] = f2bf(At[i]); R3[idx] = f2bf(rs * eg); R1[idx] = f2bf(beta * ig); R2[idx] = f2bf(kd * ig);
                    Bh[i] = beta * gl; Kh[i] = kd * gl; vv[i] = vs; }
                Apk[ct] = pack_lo4(At);
                { u32x2 w; w.x = pk_bf16(Bh[0], Bh[1]); w.y = pk_bf16(Bh[2], Bh[3]); *(LAS u32x2*)(BKT + (ct * 16 + l15) * 32 + q * 4) = w;
                  w.x = pk_bf16(Kh[0], Kh[1]); w.y = pk_bf16(Kh[2], Kh[3]); *(LAS u32x2*)(BKT + (ct * 16 + l15) * 32 + 16 + q * 4) = w;
                  w.x = pk_bf16(vv[0], vv[1]); w.y = pk_bf16(vv[2], vv[3]); *(LAS u32x2*)(VF + (ct * 64 + lane) * 4) = w; }
                glv[ct] = egL;
            }
#pragma unroll
            for (int i = 0; i < 4; ++i) { float s = bon[i]; s += shx<1>(s); s += shx<2>(s); s += shx<4>(s); s += shx<8>(s);
                if (l15 == 0) { const int o = o0 + q * 4 + i; const int srow = jn * 64 + (d == 0 ? o : 63 - o); BON[((size_t)b * TB + srow) * 16 + h] = s; } }
            WAVE_SYNC();
            f32x4 Mab = (f32x4){0.f, 0.f, 0.f, 0.f}, MabT = Mab, Mak = Mab, Nrb = Mab, Nrk = Mab;
#pragma unroll
            for (int kq = 0; kq < 2; ++kq) { const bf16x8 fa = ldsA(R0 + l15 * 72 + kq * 32 + q * 8), fr = ldsA(R3 + l15 * 72 + kq * 32 + q * 8), fb = ldsA(R1 + l15 * 72 + kq * 32 + q * 8), fk = ldsA(R2 + l15 * 72 + kq * 32 + q * 8);
                Mab = MFMA16(fa, fb, Mab); MabT = MFMA16(fb, fa, MabT); Mak = MFMA16(fa, fk, Mak); Nrb = MFMA16(fr, fb, Nrb); Nrk = MFMA16(fr, fk, Nrk); }
#pragma unroll
            for (int i = 0; i < 4; ++i) { const int rr_ = q * 4 + i; if (!(l15 < rr_)) { Mab[i] = 0.f; Mak[i] = 0.f; } if (!(rr_ < l15)) MabT[i] = 0.f; if (!(l15 <= rr_)) { Nrb[i] = 0.f; Nrk[i] = 0.f; } }
            f32x4 TT;
            {   f32x4 eye;
#pragma unroll
                for (int i = 0; i < 4; ++i) eye[i] = (q * 4 + i == l15) ? 1.0f : 0.0f;
                const f32x4 M2 = mm16(MabT, Mab), N2 = mm16(Mab, MabT);
                const f32x4 M4 = mm16(N2, M2), N4 = mm16(M2, N2);
                const f32x4 N8 = mm16(M4, N4);
                const f32x4 W1 = mm16(M4 + eye, N8 + eye);
                const f32x4 W2 = mm16(M2 + eye, W1);
                TT = mm16(Mab + eye, W2); }
            WAVE_SYNC();
            {   const bf16x8 Tp = pack_lo4(TT);
                LAS bf16_t* AH = R0; LAS bf16_t* NN = (LAS bf16_t*)(wb + RWC_NN); LAS bf16_t* TMm = (LAS bf16_t*)(wb + RWC_TM);
#pragma unroll
                for (int ct = 0; ct < 4; ++ct) { f32x4 ah = (f32x4){0.f, 0.f, 0.f, 0.f}; ah = MFMA16(Tp, Apk[ct], ah);
#pragma unroll
                    for (int i = 0; i < 4; ++i) AH[(q * 4 + i) * 72 + ct * 16 + l15] = f2bf(ah[i]); }
                f32x4 tm = (f32x4){0.f, 0.f, 0.f, 0.f}; tm = MFMA16(Tp, pack_lo4(Mak), tm);
#pragma unroll
                for (int i = 0; i < 4; ++i) { const int t = q * 4 + i; NN[t * 32 + l15] = f2bf(Nrb[i]); NN[t * 32 + 16 + l15] = f2bf(Nrk[i]); TMm[t * 16 + l15] = f2bf(tm[i]); }
                if (q == 0) {
#pragma unroll
                    for (int ct = 0; ct < 4; ++ct) ((LAS float*)(wb + RWC_GL))[ct * 16 + l15] = glv[ct]; } }
        }
        __syncthreads();
        if (wave < 4) {
            for (int c = 0; c < 8; ++c) {
                const LAS unsigned char* sb = wreg0 + c * RWC_WREG;
                const LAS bf16_t* AH = (const LAS bf16_t*)(sb + RWC_R0); const LAS bf16_t* RT = (const LAS bf16_t*)(sb + RWC_R3); const LAS bf16_t* BKT = (const LAS bf16_t*)(sb + RWC_BK);
                const LAS bf16_t* VF = (const LAS bf16_t*)(sb + RWC_V); const LAS bf16_t* NN = (const LAS bf16_t*)(sb + RWC_NN); const LAS bf16_t* TMm = (const LAS bf16_t*)(sb + RWC_TM); const LAS float* GL = (const LAS float*)(sb + RWC_GL);
                const bf16x8 Sb0 = pack_8(Sacc[0], Sacc[1]), Sb1 = pack_8(Sacc[2], Sacc[3]);
                const u32x2 vw = *(const LAS u32x2*)(VF + (wave * 64 + lane) * 4);
                bf16x8 V0; { u32x4 w; w.x = 0u; w.y = 0u; w.z = vw.x; w.w = vw.y; __builtin_memcpy(&V0, &w, 16); }
                bf16x8 TMf; { const u32x2 tq = *(const LAS u32x2*)(TMm + l15 * 16 + q * 4); u32x4 w; w.x = 0u; w.y = 0u; w.z = tq.x; w.w = tq.y; __builtin_memcpy(&TMf, &w, 16); }
                f32x4 U = (f32x4){0.f, 0.f, 0.f, 0.f};
                U = MFMA16(lds_2x8(AH + l15 * 72 + q * 4, AH + l15 * 72 + 16 + q * 4), Sb0, U);
                U = MFMA16(lds_2x8(AH + l15 * 72 + 32 + q * 4, AH + l15 * 72 + 48 + q * 4), Sb1, U);
                U = MFMA16(TMf, V0, U);
                bf16x8 UV; { u32x4 w; w.x = pk_bf16(U[0], U[1]); w.y = pk_bf16(U[2], U[3]); w.z = vw.x; w.w = vw.y; __builtin_memcpy(&UV, &w, 16); }
                f32x4 Y = (f32x4){0.f, 0.f, 0.f, 0.f};
                Y = MFMA16(lds_2x8(RT + l15 * 72 + q * 4, RT + l15 * 72 + 16 + q * 4), Sb0, Y);
                Y = MFMA16(lds_2x8(RT + l15 * 72 + 32 + q * 4, RT + l15 * 72 + 48 + q * 4), Sb1, Y);
                Y = MFMA16(lds_2x8(NN + l15 * 32 + q * 4, NN + l15 * 32 + 16 + q * 4), UV, Y);
#pragma unroll
                for (int x = 0; x < 4; ++x) { const f32x4 gl = *(const LAS f32x4*)(GL + x * 16 + q * 4); Sacc[x] *= gl;
                    Sacc[x] = MFMA16(lds_2x8(BKT + (x * 16 + l15) * 32 + q * 4, BKT + (x * 16 + l15) * 32 + 16 + q * 4), UV, Sacc[x]); }
                const int ch = rnd * 8 + c, j64 = ch >> 2, jn = nat_chunk(d, j64), o0 = (ch & 3) * 16;
#pragma unroll
                for (int i = 0; i < 4; ++i) { const int o = o0 + q * 4 + i; const int srow = jn * 64 + (d == 0 ? o : 63 - o);
                    YO[((size_t)b * TB + srow) * 1024 + h * 64 + wave * 16 + l15] = f2bf(Y[i]); }
            }
        }
        __syncthreads();
    }
}

__device__ __forceinline__ void rw_finish_item(const Frame& F, int tid, int layer, int it) {
    const int lane = tid & 63, wave = __builtin_amdgcn_readfirstlane(tid >> 6), l15 = lane & 15, q = lane >> 4;
    LAS bf16_t* GA = (LAS bf16_t*)F.lds;
    LAS float* mean_ = (LAS float*)(GA + 64 * 136);
    LAS float* rstd_ = mean_ + 1024, *bon_ = rstd_ + 1024;
    const bf16_t* P = (const bf16_t*)(F.ws + WS_P);
    bf16_t* YF = (bf16_t*)(F.ws + WS_SC + SC_RWF); const bf16_t* YB = (const bf16_t*)(F.ws + WS_SC + SC_RWB); void* RWO = (void*)(F.ws + WS_SC + SC_RWO);
    const float* BON = (const float*)(F.ws + WS_BONUS); const bf16_t* GUPT = (const bf16_t*)(F.ws + WS_GUPT);
    const float* mu = F.in[I_RWMU] + layer * 3456;
    const int hf = it & 1, it2 = it >> 1;
    const int b = it2 / NCH, jn = it2 - b * NCH; const size_t rb = (size_t)b * TB + jn * 64 + hf * 32; const int sb = jn * 64 + hf * 32;
    if (tid < 256) { const int t = tid >> 3, c0 = (tid & 7) * 16;
#pragma unroll
      for (int hh = 0; hh < 2; ++hh) { float m8[8], g8[8];
#pragma unroll
          for (int e = 0; e < 8; ++e) m8[e] = mu[3328 + c0 + hh * 8 + e];
          tshift8(P, rb + t, sb + t, PC_GD + c0 + hh * 8, m8, g8);
#pragma unroll
          for (int e = 0; e < 8; ++e) GA[t * 136 + c0 + hh * 8 + e] = f2bf(sigmoidf_(g8[e])); } }
    { const int p = tid, t = p >> 4, hd = p & 15; const size_t row = rb + t; float v[64]; float s = 0.f;
#pragma unroll
        for (int c8 = 0; c8 < 8; ++c8) { float a[8], bq[8]; unpack8(*(const u32x4*)(YF + row * 1024 + hd * 64 + c8 * 8), a); unpack8(*(const u32x4*)(YB + row * 1024 + hd * 64 + c8 * 8), bq);
#pragma unroll
            for (int e = 0; e < 8; ++e) { v[c8 * 8 + e] = a[e] + bq[e]; s += v[c8 * 8 + e]; } }
        const float mean = s * (1.0f / 64.0f); float qq = 0.f;
#pragma unroll
        for (int e = 0; e < 64; ++e) { const float dlt = v[e] - mean; qq += dlt * dlt; }
        mean_[t * 16 + hd] = mean; rstd_[t * 16 + hd] = rsqrtf(qq * (1.0f / 64.0f) + 64e-5f);
        bon_[t * 16 + hd] = BON[row * 16 + hd] + BON[((size_t)R + row) * 16 + hd]; }
    __syncthreads();
    const float* ng = F.in[I_RWNG] + layer * 1024; const float* nb = F.in[I_RWNB] + layer * 1024;
    for (int cc = 0; cc < 8; ++cc) { const int ct = wave * 8 + cc; const int c0 = ct * 16 + q * 4, hd = c0 >> 6;
        bf16x8 afr[4];
#pragma unroll
        for (int kq = 0; kq < 4; ++kq) afr[kq] = *(const bf16x8*)(GUPT + (size_t)(ct * 16 + l15) * 128 + kq * 32 + q * 8);
        const f32x4 muv = *(const f32x4*)(mu + 2048 + c0), ngc = *(const f32x4*)(ng + c0), nbc = *(const f32x4*)(nb + c0);
        u32x2 wf[2], wbk[2], wz[2], wp[2], wn[2]; float fpv[2], fnv[2];
#pragma unroll
        for (int rt = 0; rt < 2; ++rt) { const int t = rt * 16 + l15; const size_t row = rb + t; const int srow = sb + t;
            const bool hp = (srow != 0 && srow != CTXL), hn = (srow != CTXL - 1 && srow != TB - 1); fpv[rt] = hp ? 0.5f : 0.f; fnv[rt] = hn ? 0.5f : 0.f;
            wf[rt] = *(const u32x2*)(YF + row * 1024 + c0); wbk[rt] = *(const u32x2*)(YB + row * 1024 + c0);
            wz[rt] = *(const u32x2*)(P + row * PW + PC_RV + c0); wp[rt] = *(const u32x2*)(P + (hp ? row - 1 : row) * PW + PC_RV + c0); wn[rt] = *(const u32x2*)(P + (hn ? row + 1 : row) * PW + PC_RV + c0); }
#pragma unroll
        for (int rt = 0; rt < 2; ++rt) { f32x4 acc = (f32x4){0.f, 0.f, 0.f, 0.f};
#pragma unroll
            for (int kq = 0; kq < 4; ++kq) acc = MFMA16(afr[kq], ldsA(GA + (rt * 16 + l15) * 136 + kq * 32 + q * 8), acc);
            const int t = rt * 16 + l15; const size_t row = rb + t;
            const float fp = fpv[rt], fn = fnv[rt]; const float mean = mean_[t * 16 + hd], rstd = rstd_[t * 16 + hd], bon = bon_[t * 16 + hd];
            float o4[4];
#pragma unroll
            for (int i = 0; i < 4; ++i) { const unsigned sf = 16u;
                const unsigned uf = (i < 2 ? wf[rt].x : wf[rt].y), ub_ = (i < 2 ? wbk[rt].x : wbk[rt].y), uz = (i < 2 ? wz[rt].x : wz[rt].y), up = (i < 2 ? wp[rt].x : wp[rt].y), un = (i < 2 ? wn[rt].x : wn[rt].y);
                const float yf_ = (i & 1) ? __uint_as_float(uf & 0xffff0000u) : __uint_as_float(uf << sf), yb_ = (i & 1) ? __uint_as_float(ub_ & 0xffff0000u) : __uint_as_float(ub_ << sf);
                const float vz = (i & 1) ? __uint_as_float(uz & 0xffff0000u) : __uint_as_float(uz << sf), vp = (i & 1) ? __uint_as_float(up & 0xffff0000u) : __uint_as_float(up << sf), vn = (i & 1) ? __uint_as_float(un & 0xffff0000u) : __uint_as_float(un << sf);
                const float yn = (yf_ + yb_ - mean) * rstd * ngc[i] + nbc[i];
                const float vsft = vz + muv[i] * (fp * vp + fn * vn - vz);
                o4[i] = (yn + bon * vsft) * acc[i]; }
            st_op4(RWO, row * 1024 + c0, o4[0], o4[1], o4[2], o4[3]); }
    }
    __syncthreads();
}

__device__ __forceinline__ void phase_prep(const Frame& F, int layer) {
    const int tid = ltid();
    for (int it = F.bid; it < 64; it += F.G) s5_tables_item(F, tid, layer, it);
}
__device__ __forceinline__ void phase_gin(const Frame& F) {
    dense_gemm<0, false>(F, F.ws + WS_U, F.ws + WS_WIN, R, PW, 2048, F.ws + WS_P, nullptr, nullptr, PW);
}
__device__ __forceinline__ void phase_conv_s5a(const Frame& F, int layer) {
    const int tid = ltid(), lane = tid & 63;
    for (int it = F.bid; it < 528 + 144; it += F.G) { if (it < 528) conv_item(F, tid, layer, it); else s5a_wave_item(F, lane, (it - 528) * 8 + F.wave); }
}
__device__ __forceinline__ void phase_scan(const Frame& F, int layer) {
    const int tid = ltid();
    if (F.bid < 128) rwkvc_item(F, tid, layer, F.bid);
    else { if (F.bid < 192) { s5b_item(F, tid, layer, F.bid - 128); __syncthreads(); } mlstm_item(F, tid, layer, F.bid - 128); }
}
__device__ __forceinline__ void phase_fin(const Frame& F, int layer) {
    const int tid = ltid(), lane = tid & 63;
    for (int it = F.bid; it < 1056; it += F.G) rw_finish_item(F, tid, layer, it);
    for (int it = F.bid; it < 256; it += F.G) s5c_block_item(F, tid, it);
    ml_finish_rows(F, lane, layer);
}

#ifndef MK_ABL
#define MK_ABL 0
#endif
constexpr int NPH_LAYER = 19;
constexpr int NPH = 2 * NPH_LAYER;
__global__ void __launch_bounds__(NTHR, 2) mega_fwd(Args args) {
    extern __shared__ __attribute__((aligned(16))) unsigned char lds_raw[];
    Frame F; F.in = args.in; F.out = args.out; F.ws = args.ws; F.lds = (LAS unsigned char*)lds_raw;
    F.wave = __builtin_amdgcn_readfirstlane(threadIdx.x >> 6); F.G = gridDim.x; F.bid = blockIdx.x;
    volatile LAS unsigned* xbw = (volatile LAS unsigned*)(F.lds + LDS_BYTES - 16);
    if (threadIdx.x == 0) { xbw[0] = 0u; xbw[1] = 0u; xbw[2] = 0u; xbw[3] = 0u; }
    __syncthreads();
    const int lo = args.ph_lo, hi = args.ph_hi;
    const bool one_launch = (hi - lo) > 1;
    XcdBarrier bar; bar.bar = (unsigned*)(F.ws + WS_CTL) + CW_BAR; bar.x = 0; bar.st = xbw;
    if (one_launch) bar = xcd_barrier_post((unsigned*)(F.ws + WS_CTL) + CW_BAR, xbw);
#define IN(k) (lo <= (k) && (k) < hi)
#define SEAM(k) do { if (IN(k) && IN((k) + 1)) xcd_barrier(bar); } while (0)
#define TILE_SEAM() do { asm volatile("s_waitcnt vmcnt(0)" ::: "memory"); __syncthreads(); } while (0)
    bf16_t* const T1 = (bf16_t*)(F.ws + WS_T1); bf16_t* const T2 = (bf16_t*)(F.ws + WS_T2); bf16_t* const T1b = (bf16_t*)(F.ws + WS_SC + SC_RWF);     bf16_t* const Z = (bf16_t*)(F.ws + WS_Z); bf16_t* const MIX = (bf16_t*)(F.ws + WS_MIX);
    unsigned char* const Zop = F8 ? F.ws + WS_QK : F.ws + WS_Z;
    const unsigned char* const U = F.ws + WS_U; const unsigned char* const WG = F.ws + WS_WG; const unsigned char* const WML = F.ws + WS_WML;
    const unsigned char* const ML = F.ws + WS_SC + SC_ML; const unsigned char* const RWo = F.ws + WS_SC + SC_RWO; const unsigned char* const S5o = F.ws + WS_SC + SC_S5;
    for (int layer = 0; layer < 2; ++layer) {
        const int pb = layer * NPH_LAYER;
        const int rA = 0, rB = layer == 0 ? 32 : 0, rC = layer == 0 ? 64 : 0;
        if (IN(pb + 0)) { phase_prep(F, layer); if (layer == 0) phase_mods(F); phase_wprep(F, layer); }
        SEAM(pb + 0);
        if (IN(pb + 1)) { if (layer == 0) phase_ln1(F, layer); }
        if (layer == 0) SEAM(pb + 1);
        if (IN(pb + 2)) { phase_gin(F); }
        SEAM(pb + 2);
        if (IN(pb + 3)) { phase_conv_s5a(F, layer); }
        SEAM(pb + 3);
        if (IN(pb + 4)) { phase_scan(F, layer); }
        SEAM(pb + 4);
        if (IN(pb + 5)) { phase_fin(F, layer); }
        SEAM(pb + 5);
        if (IN(pb + 6)) { dense_gemm<0, false>(F, ML, WML, R, 2048, 1024, T1, nullptr, nullptr, 2048, layer == 1, rA); }
        TILE_SEAM();
        if (IN(pb + 8)) { dense_gemm<0, false>(F, RWo, WML + (size_t)1 * 2048 * 1024 * OPB, R, 2048, 1024, T1b, nullptr, nullptr, 2048, layer == 1, rB); }
        SEAM(pb + 8);
        if (IN(pb + 9)) { dense_gemm<6, false>(F, U, WG, R, 4096, 2048, Z, T1, T1b, 2048, layer == 1); }
        TILE_SEAM();
        if (IN(pb + 10)) { dense_gemm<5, false>(F, S5o, WML + (size_t)2 * 2048 * 1024 * OPB, R, 4096, 1024, T2, nullptr, nullptr, 2048, layer == 1, 2 * rC); }
        SEAM(pb + 10);
        if (IN(pb + 12)) { dense_gemm<2, true>(F, U, WG + (size_t)4096 * 2048 * OPB, R, 2048, 2048, Zop, T2, Z, 2048, layer == 1, rC); }
        SEAM(pb + 12);
        if (IN(pb + 13)) { dense_gemm<0, false>(F, Zop, F.ws + WS_WOUT, R, 2048, 2048, MIX, nullptr, nullptr, 2048, layer == 1); }
        SEAM(pb + 13);
        if (IN(pb + 14)) { phase_post1_route(F, layer, true); }
        SEAM(pb + 14);
        if (IN(pb + 15)) { phase_gather(F, layer); }
        SEAM(pb + 15);
        if (IN(pb + 16)) { phase_moe_gemm(F, layer, 0); }
        SEAM(pb + 16);
        if (IN(pb + 17)) { phase_moe_gemm(F, layer, 1); }
        SEAM(pb + 17);
        if (IN(pb + 18)) { phase_post2_moe(F, layer, true); }
        SEAM(pb + 18);
    }
#undef IN
#undef SEAM
#undef TILE_SEAM
}

#ifndef MK_ONE_LAUNCH
#define MK_ONE_LAUNCH 1
#endif
extern "C" void kernel_launch(void* const* d_in, const int* in_sizes, int n_in, void* d_out, int out_size, void* d_ws, size_t ws_size, hipStream_t stream) {
    static int grid = 0;
    if (grid == 0) {
        if (n_in != N_IN || ws_size < WS_END) { fprintf(stderr, "kernel_launch: unexpected n_in %d / ws_size %zu (need %zu)\n", n_in, ws_size, (size_t)WS_END); grid = -1; return; }
        int dev = 0, cus = 0, per_cu = 0;
        if (hipGetDevice(&dev) != hipSuccess || hipDeviceGetAttribute(&cus, hipDeviceAttributeMultiprocessorCount, dev) != hipSuccess) { grid = -1; return; }
        if (hipFuncSetAttribute((const void*)mega_fwd, hipFuncAttributeMaxDynamicSharedMemorySize, LDS_BYTES) != hipSuccess) { fprintf(stderr, "kernel_launch: hipFuncSetAttribute failed\n"); grid = -1; return; }
        if (hipOccupancyMaxActiveBlocksPerMultiprocessor(&per_cu, (const void*)mega_fwd, NTHR, LDS_BYTES) != hipSuccess || per_cu < 1) { fprintf(stderr, "kernel_launch: occupancy query says %d\n", per_cu); }
        (void)hipGetLastError();
        grid = 256;
        if (cus != 256) fprintf(stderr, "kernel_launch: %d CUs, this kernel is laid out for 256\n", cus);
    }
    if (grid < 0) return;
    (void)hipMemsetAsync((char*)d_ws + WS_CTL, 0, CTL_BYTES, stream);
    Args a{};
    for (int i = 0; i < N_IN; ++i) a.in[i] = (const float*)d_in[i];
    a.out = (float*)d_out; a.ws = (unsigned char*)d_ws;
#if MK_ONE_LAUNCH
    a.ph_lo = 0; a.ph_hi = NPH;
    hipLaunchKernelGGL(mega_fwd, dim3(grid), dim3(NTHR), LDS_BYTES, stream, a);
#else
    for (int p = 0; p < NPH; ++p) { a.ph_lo = p; a.ph_hi = p + 1; hipLaunchKernelGGL(mega_fwd, dim3(grid), dim3(NTHR), LDS_BYTES, stream, a); }
#endif
}
```

```cpp
#include <hip/hip_runtime.h>
#include <stdint.h>
#include <stdio.h>

#define LAS __attribute__((address_space(3)))
typedef unsigned short bf16_t;
typedef short bf16x8 __attribute__((ext_vector_type(8)));
typedef float f32x4 __attribute__((ext_vector_type(4)));
typedef float f32x2 __attribute__((ext_vector_type(2)));
typedef unsigned u32x4 __attribute__((ext_vector_type(4)));
typedef unsigned u32x2 __attribute__((ext_vector_type(2)));

constexpr int D = 2048, NB = 4, SEQ = 8192, CTXL = 256, TB = SEQ + CTXL, R = NB * TB;
constexpr int NCH = TB / 64;
constexpr int PW = 8704;
constexpr int PC_Q = 0, PC_K = 1024, PC_V = 2048, PC_O = 3072, PC_IG = 4096, PC_FG = 4104, PC_RR = 4112, PC_RK = 5136, PC_RV = 6160,
              PC_WD = 7184, PC_AD = 7312, PC_GD = 7440, PC_S5 = 7568, PC_END = 8592;
constexpr int NTHR = 512, NWAVE = 8;
constexpr int LDS_BYTES = 163840;
constexpr float ALPHA = 1.4142135623730951f;
constexpr float LN_EPS = 1e-5f;

enum { I_X = 0, I_C, I_CTX, I_CCTX, I_ADAW, I_ADAB, I_WIN, I_MLCW, I_MLCB, I_MLIGB, I_MLFGB, I_MLNG, I_MLNB, I_MLPROJ, I_RWMU, I_RWW0, I_RWWUP, I_RWA0, I_RWAUP,
       I_RWGUP, I_RWKK, I_RWKA, I_RWRK, I_RWNG, I_RWNB, I_RWPROJ, I_S5LRE, I_S5LIM, I_S5LDT, I_S5BRE, I_S5BIM, I_S5CRE, I_S5CIM, I_S5D, I_S5WV, I_S5WG, I_WOUT,
       I_LN1G, I_LN1B, I_LN2G, I_LN2B, I_ROUTW, I_ROUTB, I_EWG, I_EWU, I_EWD, N_IN };

constexpr size_t al256(size_t x) { return (x + 255) & ~(size_t)255; }
constexpr size_t WS_CTL = 0, CTL_BYTES = 65536;
constexpr size_t WS_MODS = WS_CTL + CTL_BYTES;
constexpr size_t WS_ROUTE = al256(WS_MODS + 2 * 5 * 12288 * 4);
constexpr size_t WS_BONUS = al256(WS_ROUTE + (size_t)R * 8 * 4);
constexpr size_t WS_S5KC = al256(WS_BONUS + (size_t)2 * R * 16 * 4);
constexpr size_t WS_S5E = al256(WS_S5KC + (size_t)64 * 128 * 256 * 2);
constexpr size_t WS_S5F = al256(WS_S5E + (size_t)64 * 256 * 1024 * 2);
constexpr size_t WS_S5X = al256(WS_S5F + (size_t)64 * 1024 * 256 * 2);
constexpr size_t WS_GUPT = al256(WS_S5X + (size_t)64 * 528 * 256 * 4);
constexpr size_t WS_WIN = al256(WS_GUPT + (size_t)1024 * 128 * 2);
constexpr size_t WS_WG = al256(WS_WIN + (size_t)PW * D * 2);
constexpr size_t WS_WML = al256(WS_WG + (size_t)6144 * D * 2);
constexpr size_t WS_WOUT = al256(WS_WML + (size_t)4 * 2048 * 1024 * 2);
constexpr size_t WS_EGU = al256(WS_WOUT + (size_t)2048 * 2048 * 2);
constexpr size_t WS_EDN = al256(WS_EGU + (size_t)16 * 2048 * 2048 * 2);
constexpr size_t WS_P = al256(WS_EDN + (size_t)16 * 2048 * 1024 * 2);
constexpr size_t WS_U = al256(WS_P + (size_t)R * PW * 2);
constexpr size_t WS_QK = al256(WS_U + (size_t)R * D * 2);
constexpr size_t WS_SC = al256(WS_QK + (size_t)R * D * 2);
constexpr size_t SC_BYTES = (size_t)71680 * 2048 * 2;
constexpr size_t WS_XC = al256(WS_SC + SC_BYTES);
constexpr size_t WS_END = al256(WS_XC + (size_t)NB * CTXL * D * 4);
constexpr size_t WS_X1 = WS_P;
constexpr size_t WS_T1 = WS_P;
constexpr size_t WS_T2 = WS_P + (size_t)R * D * 2;
constexpr size_t WS_MIX = WS_P + (size_t)R * D * 4;
constexpr size_t WS_Z = WS_MIX + (size_t)R * D * 2;
static_assert(WS_Z + (size_t)R * D * 2 <= WS_U, "P-region aliases overflow");
static_assert(WS_END <= 1633652928ull, "workspace too large");

constexpr int CW_BAR = 0;
constexpr int CW_ECNT = 4096;

__device__ __forceinline__ float bf2f(bf16_t b) { return __uint_as_float(((unsigned)b) << 16); }
typedef __bf16 bf16x2_t __attribute__((ext_vector_type(2)));
__device__ __forceinline__ unsigned pk_bf16(float lo, float hi) { const f32x2 v = {lo, hi}; const bf16x2_t r = __builtin_convertvector(v, bf16x2_t); unsigned u; __builtin_memcpy(&u, &r, 4); return u; }
constexpr bool F8 = true;
constexpr int OPB = F8 ? 1 : 2;
constexpr float W8_SCALE = 64.0f;
typedef int v8i __attribute__((ext_vector_type(8)));
typedef int v4i __attribute__((ext_vector_type(4)));
__device__ __forceinline__ float clamp8(float x) { return fminf(fmaxf(x, -448.0f), 448.0f); }
__device__ __forceinline__ unsigned pk4_fp8(float a, float b, float c, float d) { int w = 0; w = __builtin_amdgcn_cvt_pk_fp8_f32(clamp8(a), clamp8(b), w, false); w = __builtin_amdgcn_cvt_pk_fp8_f32(clamp8(c), clamp8(d), w, true); return (unsigned)w; }
__device__ __forceinline__ bf16_t f2bf(float f) { return (bf16_t)(pk_bf16(f, 0.f) & 0xffffu); }
__device__ __forceinline__ float sigmoidf_(float x) { return __builtin_amdgcn_rcpf(1.0f + __expf(-x)); }
__device__ __forceinline__ float tanhf_(float x) { return 1.0f - 2.0f * __builtin_amdgcn_rcpf(1.0f + __expf(2.0f * x)); }
__device__ __forceinline__ void unpack8(const u32x4 p, float (&o)[8]) { const unsigned w[4] = {p.x, p.y, p.z, p.w};
#pragma unroll
    for (int e = 0; e < 4; ++e) { o[2 * e] = __uint_as_float(w[e] << 16); o[2 * e + 1] = __uint_as_float(w[e] & 0xffff0000u); } }
__device__ __forceinline__ void st_op4(void* base, size_t ei, float a, float b, float c, float d) {
    if (F8) *(unsigned*)((char*)base + ei) = pk4_fp8(a, b, c, d);
    else { u32x2 w; w.x = pk_bf16(a, b); w.y = pk_bf16(c, d); *(u32x2*)((char*)base + ei * 2) = w; } }
__device__ __forceinline__ void st_op8(void* base, size_t ei, const float (&v)[8]) {
    if (F8) { u32x2 w; w.x = pk4_fp8(v[0], v[1], v[2], v[3]); w.y = pk4_fp8(v[4], v[5], v[6], v[7]); *(u32x2*)((char*)base + ei) = w; }
    else { u32x4 w; w.x = pk_bf16(v[0], v[1]); w.y = pk_bf16(v[2], v[3]); w.z = pk_bf16(v[4], v[5]); w.w = pk_bf16(v[6], v[7]); *(u32x4*)((char*)base + ei * 2) = w; } }
__device__ __forceinline__ void st_op1(void* base, size_t ei, float a) {
    if (F8) ((unsigned char*)base)[ei] = (unsigned char)(pk4_fp8(a, 0.f, 0.f, 0.f) & 0xffu);
    else ((bf16_t*)base)[ei] = f2bf(a); }
__device__ __forceinline__ float siluf_(float x) { return x * sigmoidf_(x); }
template <int M> __device__ __forceinline__ float shx(float v) { return __int_as_float(__builtin_amdgcn_ds_swizzle(__float_as_int(v), 0x1f | (M << 10))); }
__device__ __forceinline__ float shx32(float v, int lane) { return __int_as_float(__builtin_amdgcn_ds_bpermute((lane ^ 32) << 2, __float_as_int(v))); }
__device__ __forceinline__ float shup(float v, int o, int lane) { return __int_as_float(__builtin_amdgcn_ds_bpermute((lane - o) << 2, __float_as_int(v))); }
__device__ __forceinline__ float rdlane(float v, int l) { return __int_as_float(__builtin_amdgcn_readlane(__float_as_int(v), l)); }
__device__ __forceinline__ float wave_sum(float v, int lane) {
    v += shx32(v, lane); v += shx<16>(v); v += shx<8>(v); v += shx<4>(v); v += shx<2>(v); v += shx<1>(v);
    return v;
}

#define XB_TMO      128
#define XB_XCNT(j)  (256  + 64 * (j))
#define XB_XSUB(j)  (1280 + 64 * (j))
#define XB_XGEN(j)  (2304 + 64 * (j))
#define XB_TOP      3328
#define XB_TOPGEN   3392
#define XCD_BAR_WORDS 3456
#define XB_SPIN_CAP (1u << 18)
__device__ __forceinline__ unsigned xb_ld(unsigned* p)              { return __hip_atomic_load(p, __ATOMIC_RELAXED, __HIP_MEMORY_SCOPE_AGENT); }
__device__ __forceinline__ unsigned xb_add(unsigned* p, unsigned v) { return __hip_atomic_fetch_add(p, v, __ATOMIC_RELAXED, __HIP_MEMORY_SCOPE_AGENT); }
__device__ __forceinline__ unsigned xb_xcc_id() { return (unsigned)__builtin_amdgcn_s_getreg((3 << 11) | 20) & 0xFu; }
#define XB_SPIN(cond, bar) do { unsigned _sp = 0; while (cond) { __builtin_amdgcn_s_sleep(1); \
    if ((++_sp & 255u) == 0u) { if (xb_ld(&(bar)[XB_TMO])) break; if (_sp > XB_SPIN_CAP) { atomicAdd(&(bar)[XB_TMO], 1u); break; } } } } while (0)
struct XcdBarrier { unsigned* bar; unsigned x; volatile LAS unsigned* st; };
__device__ __forceinline__ XcdBarrier xcd_barrier_post(unsigned* bar, volatile LAS unsigned* st) {
    XcdBarrier b; b.bar = bar; b.x = xb_xcc_id(); b.st = st;
    if (threadIdx.x == 0) (void)xb_add(&bar[XB_XCNT(b.x)], 1u);
    return b;
}
__device__ __forceinline__ void xcd_barrier_complete(unsigned* bar, unsigned x, unsigned& nloc, unsigned& nx) {
    const unsigned G = gridDim.x * gridDim.y * gridDim.z;
    unsigned sum, cnt, mine, sp = 0u;
    for (;;) {
        sum = 0u; cnt = 0u; mine = 0u;
#pragma unroll
        for (unsigned j = 0; j < 16; ++j) { const unsigned c = xb_ld(&bar[XB_XCNT(j)]); sum += c; cnt += (c > 0u) ? 1u : 0u; mine = (j == x) ? c : mine; }
        if (sum == G) break;
        __builtin_amdgcn_s_sleep(1);
        if ((++sp & 255u) == 0u) { if (xb_ld(&bar[XB_TMO])) break; if (sp > XB_SPIN_CAP) { atomicAdd(&bar[XB_TMO], 1u); break; } }
    }
    nloc = mine > 0u ? mine : 1u; nx = cnt > 0u ? cnt : 1u;
}
__device__ __forceinline__ void xcd_barrier(const XcdBarrier& b) {
    asm volatile("s_waitcnt vmcnt(0)" ::: "memory");
    __syncthreads();
    if (threadIdx.x == 0) {
        unsigned* bar = b.bar;
        __builtin_amdgcn_s_waitcnt(0);
        unsigned nloc = b.st[0], nx = b.st[1];
        if (nloc == 0u) { xcd_barrier_complete(bar, b.x, nloc, nx); b.st[0] = nloc; b.st[1] = nx; }
        const unsigned old = xb_add(&bar[XB_XSUB(b.x)], 1u);
        const unsigned gen = old / nloc;
        if (old + 1u == (gen + 1u) * nloc) {
            __builtin_amdgcn_fence(__ATOMIC_RELEASE, "agent");
            asm volatile("s_waitcnt vmcnt(0)" ::: "memory");
            const unsigned og = xb_add(&bar[XB_TOP], 1u);
            const unsigned tg = og / nx;
            if (og + 1u == (tg + 1u) * nx) xb_add(&bar[XB_TOPGEN], 1u);
            else XB_SPIN(xb_ld(&bar[XB_TOPGEN]) == tg, bar);
            __builtin_amdgcn_fence(__ATOMIC_ACQUIRE, "agent");
            xb_add(&bar[XB_XGEN(b.x)], 1u);
            asm volatile("s_waitcnt vmcnt(0)" ::: "memory");
        } else {
            XB_SPIN(xb_ld(&bar[XB_XGEN(b.x)]) == gen, bar);
            __builtin_amdgcn_fence(__ATOMIC_ACQUIRE, "agent");
            asm volatile("s_waitcnt vmcnt(0)" ::: "memory");
        }
    }
    __syncthreads();
}

struct Args { const float* in[N_IN]; float* out; unsigned char* ws; int ph_lo, ph_hi; };
struct Frame {
    const float* const* in; float* out; unsigned char* ws; LAS unsigned char* lds;
    int wave, G, bid;
};
__device__ __forceinline__ int ltid_(int wave) { int l; asm volatile("v_mbcnt_lo_u32_b32 %0, -1, 0\n\tv_mbcnt_hi_u32_b32 %0, -1, %0" : "=v"(l)); return wave * 64 + l; }
#define ltid() ltid_(F.wave)

__device__ __forceinline__ const float* xin_row(const Frame& F, int layer, int r) {
    const int b = r / TB, s = r - b * TB;
    if (s < CTXL) return (layer == 0 ? F.in[I_CTX] : (const float*)(F.ws + WS_XC)) + ((size_t)b * CTXL + s) * D;
    return (layer == 0 ? F.in[I_X] : (const float*)F.out) + ((size_t)b * SEQ + (s - CTXL)) * D;
}
__device__ __forceinline__ float* xout_row(const Frame& F, int r) {
    const int b = r / TB, s = r - b * TB;
    if (s < CTXL) return (float*)(F.ws + WS_XC) + ((size_t)b * CTXL + s) * D;
    return F.out + ((size_t)b * SEQ + (s - CTXL)) * D;
}

__device__ __forceinline__ void phase_mods(const Frame& F) {
    const int tid = ltid(), lane = tid & 63; (void)lane;
    LAS float* sc = (LAS float*)F.lds;
    LAS float* red = (LAS float*)(F.lds + 5 * 2048 * 4);
    float* mods = (float*)(F.ws + WS_MODS);
    for (int i = tid; i < 5 * 2048; i += NTHR) { const int r = i >> 11, k = i & 2047; const float v = r < 4 ? F.in[I_C][r * 2048 + k] : F.in[I_CCTX][k]; sc[i] = siluf_(v); }
    __syncthreads();
    for (int it = F.bid; it < 2 * 96; it += F.G) {
        const int l = it / 96, cg = it - l * 96, c4 = (tid & 31) * 4, ks = tid >> 5;
        const float* w = F.in[I_ADAW] + (size_t)l * 2048 * 12288 + cg * 128 + c4;
        f32x4 a0 = (f32x4){0.f, 0.f, 0.f, 0.f}, a1 = a0, a2 = a0, a3 = a0, a4 = a0;
#pragma unroll 8
        for (int k = ks; k < 2048; k += 16) { const f32x4 wv = *(const f32x4*)(w + (size_t)k * 12288); a0 += sc[k] * wv; a1 += sc[2048 + k] * wv; a2 += sc[4096 + k] * wv; a3 += sc[6144 + k] * wv; a4 += sc[8192 + k] * wv; }
        *(LAS f32x4*)(red + (ks * 5 + 0) * 128 + c4) = a0; *(LAS f32x4*)(red + (ks * 5 + 1) * 128 + c4) = a1; *(LAS f32x4*)(red + (ks * 5 + 2) * 128 + c4) = a2;
        *(LAS f32x4*)(red + (ks * 5 + 3) * 128 + c4) = a3; *(LAS f32x4*)(red + (ks * 5 + 4) * 128 + c4) = a4;
        __syncthreads();
        for (int i = tid; i < 5 * 128; i += NTHR) { const int r = i >> 7, cc = i & 127; float s = 0.f;
#pragma unroll
            for (int s16 = 0; s16 < 16; ++s16) s += red[(s16 * 5 + r) * 128 + cc];
            mods[((size_t)l * 5 + r) * 12288 + cg * 128 + cc] = s + F.in[I_ADAB][l * 12288 + cg * 128 + cc]; }
        __syncthreads();
    }
}

__device__ __forceinline__ void phase_ln1(const Frame& F, int layer) {
    const int tid = ltid(), lane = tid & 63; (void)lane;
    const float* mods = (const float*)(F.ws + WS_MODS) + (size_t)layer * 5 * 12288;
    bf16_t* U = (bf16_t*)(F.ws + WS_U);
    const int stride = F.G * NWAVE; f32x4 xq[8];
    { const float* x = xin_row(F, layer, F.bid * NWAVE + F.wave);
#pragma unroll
      for (int i = 0; i < 8; ++i) xq[i] = *(const f32x4*)(x + (i * 64 + lane) * 4); }
    for (int r = F.bid * NWAVE + F.wave; r < R; r += stride) {
        const int b = r / TB, s = r - b * TB; const float* md = mods + (size_t)(s < CTXL ? 4 : b) * 12288;
        f32x4 v[8]; float sum = 0.f;
#pragma unroll
        for (int i = 0; i < 8; ++i) { v[i] = xq[i]; sum += (v[i][0] + v[i][1]) + (v[i][2] + v[i][3]); }
        { const float* xn = xin_row(F, layer, r + stride < R ? r + stride : r);
#pragma unroll
          for (int i = 0; i < 8; ++i) xq[i] = *(const f32x4*)(xn + (i * 64 + lane) * 4); }
        const float mean = wave_sum(sum, lane) * (1.0f / D); float q = 0.f;
#pragma unroll
        for (int i = 0; i < 8; ++i) { v[i] -= mean; q += (v[i][0] * v[i][0] + v[i][1] * v[i][1]) + (v[i][2] * v[i][2] + v[i][3] * v[i][3]); }
        const float rstd = rsqrtf(wave_sum(q, lane) * (1.0f / D) + LN_EPS);
#pragma unroll
        for (int i = 0; i < 8; ++i) { const int e = (i * 64 + lane) * 4; const f32x4 sh = *(const f32x4*)(md + e), scl = *(const f32x4*)(md + 2048 + e);
            const f32x4 u = v[i] * rstd * (scl + 1.0f) + sh; st_op4(U, (size_t)r * D + e, u[0], u[1], u[2], u[3]); }
    }
}

namespace pg8 {
constexpr int BM = 256, BK = 64, HALF = 128, HTB = HALF * BK * 2, STAGE_BYTES = 8 * HTB, NXCD = 8, WGM = 8;
__host__ __device__ __forceinline__ int lds_byte(int r, int c) { const int st = (r >> 4) * 2 + (c >> 5), rr = r & 15, cc = c & 31, ob = rr * 64 + cc * 2; return st * 1024 + (ob ^ (((ob >> 9) & 1) << 5)); }
__host__ __device__ __forceinline__ void stage_rc(int b, int& Rr, int& C) { const int st = b / 1024, sb = b % 1024, swz = sb ^ (((sb >> 9) & 1) << 5); Rr = (st >> 1) * 16 + swz / 64; C = (st & 1) * 32 + (swz % 64) / 2; }
__host__ __device__ __forceinline__ int perm32(int rho) { const int n = rho >> 4, i = rho & 15; return 8 * (i >> 2) + 4 * n + (i & 3); }
struct Unit { int pm, pn; };
struct Gemm { const bf16_t* A; const bf16_t* Bt; int lda, ldb, K; };
struct StaticOrder {
    int nM, nN, nwg, G, c, skipctx;
    __device__ void init(int M, int N, int G_, int c_, int skipctx_ = 0) { nM = M / BM; nN = N / BM; nwg = nM * nN; G = G_; c = c_; skipctx = skipctx_; }
    __device__ bool next(int i, Unit& u) const {
        const long L = (long)i * G + c; if (L >= nwg) return false;
        int wgid = (int)L; { const int q = nwg / NXCD, r = nwg % NXCD, xcd = wgid % NXCD, off = wgid / NXCD; wgid = (xcd < r ? xcd * (q + 1) : r * (q + 1) + (xcd - r) * q) + off; }
        const int nig = WGM * nN, gid = wgid / nig, fm = gid * WGM, gsz = (nM - fm) < WGM ? (nM - fm) : WGM;
        u.pm = fm + ((wgid % nig) % gsz); u.pn = (wgid % nig) / gsz;
        if (skipctx) u.pm += (u.pm >> 5) + 1;
        return true;
    }
};
struct GroupedOrder {
    const LAS int* ts; int nN, G, c;
    __device__ bool next(int i, Unit& u) const {
        const int L = i * G + c; const int tot = __builtin_amdgcn_readfirstlane(ts[16]) * nN; if (L >= tot) return false;
        const int pm = L / nN, pl = L - pm * nN; int e = 0;
#pragma unroll 1
        for (int j = 1; j < 16; ++j) e += (pm >= ts[j]) ? 1 : 0;
        u.pm = __builtin_amdgcn_readfirstlane(pm); u.pn = __builtin_amdgcn_readfirstlane(e * nN + pl); return true;
    }
};
__device__ __forceinline__ unsigned cvt_pk_bf16(float lo, float hi) { return pk_bf16(lo, hi); }
__device__ __forceinline__ float fsig(float x) { return __builtin_amdgcn_rcpf(1.0f + __expf(-x)); }
template <int MODE, bool O8> struct Epi {
    static constexpr bool PERM = true; static constexpr float ASC = F8 ? 1.0f / W8_SCALE : 1.0f;
    void* O; const bf16_t* X; const bf16_t* Zin; int ldc; int pn_mod;
    __device__ __forceinline__ void put8(size_t ei, const float (&h)[8]) const {
        if (O8) st_op8(O, ei, h);
        else { u32x4 w; w.x = cvt_pk_bf16(h[0], h[1]); w.y = cvt_pk_bf16(h[2], h[3]); w.z = cvt_pk_bf16(h[4], h[5]); w.w = cvt_pk_bf16(h[6], h[7]); *(u32x4*)((bf16_t*)O + ei) = w; } }
    __device__ __forceinline__ void operator()(const f32x4 (&acc)[2][2][4][2], const Unit& u, int wr, int wc, int fr, int fq) const {
        const int row0 = u.pm * BM + wr * 64 + fr; const int pnl = u.pn % pn_mod;
        if (MODE == 4 || MODE == 5 || MODE == 6) {
            const int col0 = pnl * HALF + wc * 32 + 8 * fq;
            u32x4 xw6[2][4], zw6[2][4];
            if (MODE == 6) {
#pragma unroll
                for (int ai = 0; ai < 2; ++ai)
#pragma unroll
                    for (int m = 0; m < 4; ++m) { const size_t ei = (size_t)(row0 + ai * HALF + m * 16) * ldc + col0; xw6[ai][m] = *(const u32x4*)(X + ei); zw6[ai][m] = *(const u32x4*)(Zin + ei); }
            }
#pragma unroll
            for (int ai = 0; ai < 2; ++ai)
#pragma unroll
                for (int m = 0; m < 4; ++m) { const size_t ei = (size_t)(row0 + ai * HALF + m * 16) * ldc + col0;
                    const f32x4 g0 = acc[ai][0][m][0], g1 = acc[ai][0][m][1], u0 = acc[ai][1][m][0], u1 = acc[ai][1][m][1]; float h[8];
                    float xa[8], xb[8]; if (MODE == 6) { unpack8(xw6[ai][m], xa); unpack8(zw6[ai][m], xb); }
#pragma unroll
                    for (int j = 0; j < 4; ++j) { const float ga = g0[j] * ASC, gb = g1[j] * ASC;
                        if (MODE == 4) { h[j] = ga * fsig(ga) * (u0[j] * ASC); h[4 + j] = gb * fsig(gb) * (u1[j] * ASC); }
                        else if (MODE == 5) { h[j] = ga * fsig(u0[j] * ASC); h[4 + j] = gb * fsig(u1[j] * ASC); }
                        else { h[j] = fsig(ga) * xa[j] + fsig(u0[j] * ASC) * xb[j]; h[4 + j] = fsig(gb) * xa[4 + j] + fsig(u1[j] * ASC) * xb[4 + j]; } }
                    put8(ei, h); }
        } else {
            const int col0 = pnl * BM + wc * 32 + 8 * fq;
#pragma unroll
            for (int ai = 0; ai < 2; ++ai)
#pragma unroll
              for (int mh = 0; mh < 2; ++mh) {
                u32x4 xw[2][2], zw[2][2];
                if (MODE == 1 || MODE == 2) {
#pragma unroll
                    for (int m2 = 0; m2 < 2; ++m2)
#pragma unroll
                        for (int bj = 0; bj < 2; ++bj) { const size_t ro = (size_t)(row0 + ai * HALF + (mh * 2 + m2) * 16) * ldc + col0 + bj * HALF;
                            xw[m2][bj] = *(const u32x4*)(X + ro); if (MODE == 2) zw[m2][bj] = *(const u32x4*)(Zin + ro); }
                }
#pragma unroll
                for (int m2 = 0; m2 < 2; ++m2) { const int m = mh * 2 + m2; const size_t ro = (size_t)(row0 + ai * HALF + m * 16) * ldc + col0;
#pragma unroll
                    for (int bj = 0; bj < 2; ++bj) { const f32x4 v0 = acc[ai][bj][m][0], v1 = acc[ai][bj][m][1]; float h[8];
#pragma unroll
                        for (int j = 0; j < 4; ++j) { h[j] = v0[j] * ASC; h[4 + j] = v1[j] * ASC; }
                        if (MODE == 1 || MODE == 2) { float x8[8]; unpack8(xw[m2][bj], x8);
#pragma unroll
                            for (int j = 0; j < 8; ++j) h[j] = fsig(h[j]) * x8[j];
                            if (MODE == 2) { float z8[8]; unpack8(zw[m2][bj], z8);
#pragma unroll
                                for (int j = 0; j < 8; ++j) h[j] += z8[j]; } }
                        put8(ro + bj * HALF, h); } }
              }
        }
    }
};

template <class EpiT, class Sched>
__device__ __forceinline__ void gemm_phase(LAS unsigned char* lds, const Gemm g, const Sched& S, const EpiT& E, int wave_id) {
    const int tid = ltid_(wave_id), wid = __builtin_amdgcn_readfirstlane(tid >> 6), lane = tid & 63, wr = wid >> 2, wc = wid & 3, fr = lane & 15, fq = lane >> 4;
    const int K = g.K, nt = K / BK;
    unsigned voffA[2], voffB[2];
#pragma unroll
    for (int i = 0; i < 2; ++i) { int Rr, C; stage_rc(tid * 16 + i * 8192, Rr, C); const int Rb = EpiT::PERM ? ((Rr & ~31) + perm32(Rr & 31)) : Rr;
        voffA[i] = (unsigned)(Rr * g.lda + C) * 2u; voffB[i] = (unsigned)(Rb * g.ldb + C) * 2u; }
    const size_t kstep = (size_t)(BK * 2);
    const size_t hstepA = (size_t)HALF * g.lda * 2, hstepB = (size_t)HALF * g.ldb * 2;
    const size_t tstepA = 2 * hstepA, tstepB = 2 * hstepB;
    const unsigned ldsw = (unsigned)wid * 1024u;
    const int aoff = lds_byte(wr * 64 + fr, fq * 8), boff = lds_byte(wc * 32 + fr, fq * 8);
#define PG8_SA(b, h) (((b) * 2 + (h)) * HTB)
#define PG8_SB(b, h) ((4 + (b) * 2 + (h)) * HTB)
#define PG8_STAGE(bufoff, gbase, voff) do { _Pragma("unroll") for (int _i = 0; _i < 2; ++_i) \
        __builtin_amdgcn_global_load_lds((const unsigned*)((const char*)(gbase) + (voff)[_i]), (LAS unsigned*)(lds + (bufoff) + ldsw + _i * 8192), 16, 0, 0); } while (0)
#define PG8_LD8(dst, addr) do { const v4i lo_ = *(const LAS v4i*)(addr), hi_ = *(const LAS v4i*)((addr) + 1024); dst = __builtin_shufflevector(lo_, hi_, 0, 1, 2, 3, 4, 5, 6, 7); } while (0)
#define PG8_LDA(dst, b, h) do { _Pragma("unroll") for (int m = 0; m < 4; ++m) PG8_LD8(dst[m], lds + PG8_SA(b, h) + aoff + m * 2048); } while (0)
#define PG8_LDB(dst, b, h) do { _Pragma("unroll") for (int n = 0; n < 2; ++n) PG8_LD8(dst[n], lds + PG8_SB(b, h) + boff + n * 2048); } while (0)
#define PG8_HALF(v, k) __builtin_bit_cast(bf16x8, __builtin_shufflevector(v, v, 4 * (k), 4 * (k) + 1, 4 * (k) + 2, 4 * (k) + 3))
#define PG8_MMA(ai, bj, At, Bt) do { __builtin_amdgcn_s_setprio(1); _Pragma("unroll") for (int m = 0; m < 4; ++m) _Pragma("unroll") for (int n = 0; n < 2; ++n) { \
        if (F8) asm volatile("v_mfma_f32_16x16x128_f8f6f4 %0, %1, %2, %0" : "+v"(acc[ai][bj][m][n]) : "v"(Bt[n]), "v"(At[m]));     \
        else { acc[ai][bj][m][n] = __builtin_amdgcn_mfma_f32_16x16x32_bf16(PG8_HALF(Bt[n], 0), PG8_HALF(At[m], 0), acc[ai][bj][m][n], 0, 0, 0); \
               acc[ai][bj][m][n] = __builtin_amdgcn_mfma_f32_16x16x32_bf16(PG8_HALF(Bt[n], 1), PG8_HALF(At[m], 1), acc[ai][bj][m][n], 0, 0, 0); } } \
        __builtin_amdgcn_s_setprio(0); } while (0)
#define PG8_WAIT_V(n) asm volatile("s_waitcnt vmcnt(" #n ")" ::: "memory")
#define PG8_WAIT_L(n) asm volatile("s_waitcnt lgkmcnt(" #n ")" ::: "memory")
#define PG8_BAR __builtin_amdgcn_s_barrier()
#define PG8_SCHED __builtin_amdgcn_sched_barrier(0)
    Unit cur, nxt; int ui = 0;
    if (!S.next(0, cur)) return;
    f32x4 acc[2][2][4][2];
#pragma unroll
    for (int a = 0; a < 2; ++a)
#pragma unroll
        for (int b = 0; b < 2; ++b)
#pragma unroll
            for (int m = 0; m < 4; ++m)
#pragma unroll
                for (int n = 0; n < 2; ++n) acc[a][b][m][n] = (f32x4){0.f, 0.f, 0.f, 0.f};
    v8i At[4], B0[2], B1[2];
    const char* cA = (const char*)g.A + (size_t)cur.pm * tstepA; const char* cB = (const char*)g.Bt + (size_t)cur.pn * tstepB;
    PG8_STAGE(PG8_SB(0, 0), cB, voffB); PG8_STAGE(PG8_SA(0, 0), cA, voffA); PG8_STAGE(PG8_SB(0, 1), cB + hstepB, voffB); PG8_STAGE(PG8_SA(0, 1), cA + hstepA, voffA);
    if (wr == 1) PG8_BAR;
    PG8_WAIT_V(4); PG8_BAR;
    PG8_STAGE(PG8_SB(1, 0), cB + kstep, voffB); PG8_STAGE(PG8_SA(1, 0), cA + kstep, voffA); PG8_STAGE(PG8_SB(1, 1), cB + hstepB + kstep, voffB);
    PG8_WAIT_V(6); PG8_BAR;
    for (;;) {
        const bool has_next = S.next(ui + 1, nxt);
        const char* nA = has_next ? (const char*)g.A + (size_t)nxt.pm * tstepA : cA; const char* nB = has_next ? (const char*)g.Bt + (size_t)nxt.pn * tstepB : cB;
        for (int t = 0; t < nt; t += 2) {
            const bool last = (t == nt - 2);
            const char* a1 = cA + (size_t)(t + 1) * kstep;
            const char* a2 = last ? nA : cA + (size_t)(t + 2) * kstep; const char* b2 = last ? nB : cB + (size_t)(t + 2) * kstep;
            const char* a3 = a2 + kstep; const char* b3 = b2 + kstep;
            PG8_LDB(B0, 0, 0); PG8_SCHED; PG8_LDA(At, 0, 0); PG8_STAGE(PG8_SA(1, 1), a1 + hstepA, voffA);
            PG8_WAIT_L(8); PG8_BAR; PG8_WAIT_L(0); PG8_MMA(0, 0, At, B0); PG8_BAR; PG8_SCHED;
            PG8_LDB(B1, 0, 1); PG8_STAGE(PG8_SB(0, 0), b2, voffB);
            PG8_BAR; PG8_WAIT_L(0); PG8_MMA(0, 1, At, B1); PG8_BAR;
            PG8_LDA(At, 0, 1); PG8_STAGE(PG8_SA(0, 0), a2, voffA);
            PG8_BAR; PG8_WAIT_L(0); PG8_MMA(1, 0, At, B0); PG8_BAR; PG8_SCHED;
            PG8_STAGE(PG8_SB(0, 1), b2 + hstepB, voffB);
            PG8_WAIT_V(6); PG8_BAR; PG8_MMA(1, 1, At, B1); PG8_BAR;
            PG8_LDB(B0, 1, 0); PG8_SCHED; PG8_LDA(At, 1, 0); PG8_STAGE(PG8_SA(0, 1), a2 + hstepA, voffA);
            PG8_WAIT_L(8); PG8_BAR; PG8_WAIT_L(0); PG8_MMA(0, 0, At, B0); PG8_BAR; PG8_SCHED;
            PG8_LDB(B1, 1, 1); PG8_STAGE(PG8_SB(1, 0), b3, voffB);
            PG8_BAR; PG8_WAIT_L(0); PG8_MMA(0, 1, At, B1); PG8_BAR;
            PG8_LDA(At, 1, 1); PG8_STAGE(PG8_SA(1, 0), a3, voffA);
            PG8_BAR; PG8_WAIT_L(0); PG8_MMA(1, 0, At, B0); PG8_BAR; PG8_SCHED;
            PG8_STAGE(PG8_SB(1, 1), b3 + hstepB, voffB);
            PG8_WAIT_V(6); PG8_BAR; PG8_MMA(1, 1, At, B1); PG8_BAR;
        }
        if (F8) { __builtin_amdgcn_sched_barrier(0); asm volatile("s_nop 15\n\ts_nop 15" ::: "memory"); __builtin_amdgcn_sched_barrier(0); }
        E(acc, cur, wr, wc, fr, fq);
        if (!has_next) break;
#pragma unroll
        for (int a = 0; a < 2; ++a)
#pragma unroll
            for (int b = 0; b < 2; ++b)
#pragma unroll
                for (int m = 0; m < 4; ++m)
#pragma unroll
                    for (int n = 0; n < 2; ++n) acc[a][b][m][n] = (f32x4){0.f, 0.f, 0.f, 0.f};
        cur = nxt; cA = nA; cB = nB; ++ui;
    }
    PG8_WAIT_V(0);
    if (wr == 0) PG8_BAR;
    PG8_BAR;
#undef PG8_SA
#undef PG8_SB
#undef PG8_STAGE
#undef PG8_LDA
#undef PG8_LD8
#undef PG8_HALF
#undef PG8_LDB
#undef PG8_MMA
#undef PG8_WAIT_V
#undef PG8_WAIT_L
#undef PG8_BAR
#undef PG8_SCHED
}
}

template <int MODE, bool O8>
__device__ __forceinline__ void dense_gemm(const Frame& F, const void* A, const void* Bt, int M, int N, int K, void* O, const bf16_t* X, const bf16_t* Zin, int ldc, int skipctx = 0, int rot = 0) {
    pg8::Gemm g{(const bf16_t*)A, (const bf16_t*)Bt, K * OPB / 2, K * OPB / 2, K * OPB / 2}; pg8::StaticOrder S; S.init(skipctx ? NB * SEQ : M, N, F.G, (F.bid + rot) % F.G, skipctx);
    pg8::Epi<MODE, O8> E{O, X, Zin, ldc, 1 << 30};
    pg8::gemm_phase<pg8::Epi<MODE, O8>, pg8::StaticOrder>(F.lds, g, S, E, F.wave);
}

struct TJob { const float* src; bf16_t* dst; size_t src_bstride; int src_pitch, K, Nvalid, Npad, dst_pitch, blk, blk_stride, row_off, nbatch, dst_brow; bool f8; };
constexpr int N_TJOBS = 13;
__device__ __forceinline__ TJob get_tjob(const Frame& F, int layer, int j) {
    TJob t; t.src_bstride = 0; t.blk = 1 << 30; t.blk_stride = 0; t.row_off = 0; t.nbatch = 1; t.dst_brow = 0; t.f8 = F8 && (j != 10);
    unsigned char* ws = F.ws;
    switch (j) {
    case 0: t.src = F.in[I_WIN] + (size_t)layer * 2048 * 14736; t.src_pitch = 14736; t.K = 2048; t.Nvalid = PC_END; t.Npad = PW; t.dst = (bf16_t*)(ws + WS_WIN); t.dst_pitch = 2048; break;
    case 1: t.src = F.in[I_WIN] + (size_t)layer * 2048 * 14736 + PC_END; t.src_pitch = 14736; t.K = 2048; t.Nvalid = 2048; t.Npad = 2048; t.dst = (bf16_t*)(ws + WS_WG); t.dst_pitch = 2048; t.blk = 128; t.blk_stride = 256; t.row_off = 0; break;
    case 11: t.src = F.in[I_WIN] + (size_t)layer * 2048 * 14736 + PC_END + 2048; t.src_pitch = 14736; t.K = 2048; t.Nvalid = 2048; t.Npad = 2048; t.dst = (bf16_t*)(ws + WS_WG); t.dst_pitch = 2048; t.blk = 128; t.blk_stride = 256; t.row_off = 128; break;
    case 12: t.src = F.in[I_WIN] + (size_t)layer * 2048 * 14736 + PC_END + 4096; t.src_pitch = 14736; t.K = 2048; t.Nvalid = 2048; t.Npad = 2048; t.dst = (bf16_t*)(ws + WS_WG + (size_t)4096 * 2048 * OPB); t.dst_pitch = 2048; break;
    case 2: t.src = F.in[I_MLPROJ] + (size_t)layer * 1024 * 2048; t.src_pitch = 2048; t.K = 1024; t.Nvalid = 2048; t.Npad = 2048; t.dst = (bf16_t*)(ws + WS_WML); t.dst_pitch = 1024; break;
    case 3: t.src = F.in[I_RWPROJ] + (size_t)layer * 1024 * 2048; t.src_pitch = 2048; t.K = 1024; t.Nvalid = 2048; t.Npad = 2048; t.dst = (bf16_t*)(ws + WS_WML + (size_t)1 * 2048 * 1024 * OPB); t.dst_pitch = 1024; break;
    case 4: t.src = F.in[I_S5WV] + (size_t)layer * 1024 * 2048; t.src_pitch = 2048; t.K = 1024; t.Nvalid = 2048; t.Npad = 2048; t.dst = (bf16_t*)(ws + WS_WML + (size_t)2 * 2048 * 1024 * OPB); t.dst_pitch = 1024; t.blk = 128; t.blk_stride = 256; t.row_off = 0; break;
    case 5: t.src = F.in[I_S5WG] + (size_t)layer * 1024 * 2048; t.src_pitch = 2048; t.K = 1024; t.Nvalid = 2048; t.Npad = 2048; t.dst = (bf16_t*)(ws + WS_WML + (size_t)2 * 2048 * 1024 * OPB); t.dst_pitch = 1024; t.blk = 128; t.blk_stride = 256; t.row_off = 128; break;
    case 6: t.src = F.in[I_WOUT] + (size_t)layer * 2048 * 2048; t.src_pitch = 2048; t.K = 2048; t.Nvalid = 2048; t.Npad = 2048; t.dst = (bf16_t*)(ws + WS_WOUT); t.dst_pitch = 2048; break;
    case 7: t.src = F.in[I_EWG] + (size_t)layer * 16 * 2048 * 1024; t.src_bstride = (size_t)2048 * 1024; t.src_pitch = 1024; t.K = 2048; t.Nvalid = 1024; t.Npad = 1024; t.dst = (bf16_t*)(ws + WS_EGU); t.dst_pitch = 2048;
            t.blk = 128; t.blk_stride = 256; t.row_off = 0; t.nbatch = 16; t.dst_brow = 2048; break;
    case 8: t.src = F.in[I_EWU] + (size_t)layer * 16 * 2048 * 1024; t.src_bstride = (size_t)2048 * 1024; t.src_pitch = 1024; t.K = 2048; t.Nvalid = 1024; t.Npad = 1024; t.dst = (bf16_t*)(ws + WS_EGU); t.dst_pitch = 2048;
            t.blk = 128; t.blk_stride = 256; t.row_off = 128; t.nbatch = 16; t.dst_brow = 2048; break;
    case 9: t.src = F.in[I_EWD] + (size_t)layer * 16 * 1024 * 2048; t.src_bstride = (size_t)1024 * 2048; t.src_pitch = 2048; t.K = 1024; t.Nvalid = 2048; t.Npad = 2048; t.dst = (bf16_t*)(ws + WS_EDN); t.dst_pitch = 1024;
            t.nbatch = 16; t.dst_brow = 2048; break;
    default: t.src = F.in[I_RWGUP] + (size_t)layer * 128 * 1024; t.src_pitch = 1024; t.K = 128; t.Nvalid = 1024; t.Npad = 1024; t.dst = (bf16_t*)(ws + WS_GUPT); t.dst_pitch = 128; break;
    }
    return t;
}
__device__ __forceinline__ int tjob_tiles(const TJob& t) { return t.nbatch * (t.Npad / 64) * (t.K / (t.f8 ? 128 : 64)); }
__device__ __forceinline__ void transpose_tile(LAS float* T, int lane, const TJob& t, int tile) {
    const int nkt = t.K / 64, nnt = t.Npad / 64;
    const int b = tile / (nnt * nkt), rem = tile - b * nnt * nkt, ktile = rem / nnt, ntile = rem - ktile * nnt;
    const int n0 = ntile * 64, k0 = ktile * 64;
    const float* src = t.src + (size_t)b * t.src_bstride;
    f32x4 v[16];
#pragma unroll
    for (int p = 0; p < 16; ++p) { const int kk = p * 4 + (lane >> 4), nn = (lane & 15) * 4;
        v[p] = (f32x4){0.f, 0.f, 0.f, 0.f};
        if (n0 + nn < t.Nvalid) v[p] = *(const f32x4*)(src + (size_t)(k0 + kk) * t.src_pitch + n0 + nn); }
#pragma unroll
    for (int p = 0; p < 16; ++p) { const int kk = p * 4 + (lane >> 4), nn = (lane & 15) * 4; T[kk * 65 + nn] = v[p][0]; T[kk * 65 + nn + 1] = v[p][1]; T[kk * 65 + nn + 2] = v[p][2]; T[kk * 65 + nn + 3] = v[p][3]; }
    asm volatile("s_waitcnt lgkmcnt(0)" ::: "memory"); __builtin_amdgcn_wave_barrier();
#pragma unroll
    for (int ps = 0; ps < 8; ++ps) { const int n = ps * 8 + (lane >> 3), kq = (lane & 7) * 8; float x[8];
#pragma unroll
        for (int j = 0; j < 8; ++j) x[j] = T[(kq + j) * 65 + n];
        const int ng = n0 + n; const int drow = b * t.dst_brow + (ng / t.blk) * t.blk_stride + (ng % t.blk) + t.row_off;
        if (t.f8) { u32x2 w; w.x = pk4_fp8(x[0] * W8_SCALE, x[1] * W8_SCALE, x[2] * W8_SCALE, x[3] * W8_SCALE); w.y = pk4_fp8(x[4] * W8_SCALE, x[5] * W8_SCALE, x[6] * W8_SCALE, x[7] * W8_SCALE);
            *(u32x2*)((char*)t.dst + (size_t)drow * t.dst_pitch + k0 + kq) = w; }
        else { u32x4 w; w.x = pk_bf16(x[0], x[1]); w.y = pk_bf16(x[2], x[3]); w.z = pk_bf16(x[4], x[5]); w.w = pk_bf16(x[6], x[7]);
            *(u32x4*)(t.dst + (size_t)drow * t.dst_pitch + k0 + kq) = w; } }
    asm volatile("s_waitcnt lgkmcnt(0)" ::: "memory"); __builtin_amdgcn_wave_barrier();
}
__device__ __forceinline__ void transpose_tile8(LAS unsigned* T8, int lane, const TJob& t, int tile) {
    const int nkt = t.K / 128, nnt = t.Npad / 64;
    const int b = tile / (nnt * nkt), rem = tile - b * nnt * nkt, ktile = rem / nnt, ntile = rem - ktile * nnt;
    const int n0 = ntile * 64, k0 = ktile * 128;
    const float* src = t.src + (size_t)b * t.src_bstride;
    const int nn = (lane & 15) * 4, kq = lane >> 4;
    f32x4 v[32];
#pragma unroll
    for (int p = 0; p < 32; ++p) { const int kk = (p >> 2) * 16 + kq * 4 + (p & 3);
        v[p] = (f32x4){0.f, 0.f, 0.f, 0.f};
        if (n0 + nn < t.Nvalid) v[p] = *(const f32x4*)(src + (size_t)(k0 + kk) * t.src_pitch + n0 + nn); }
#pragma unroll
    for (int g = 0; g < 8; ++g)
#pragma unroll
        for (int j = 0; j < 4; ++j)
            T8[(nn + j) * 36 + g * 4 + kq] = pk4_fp8(v[4 * g][j] * W8_SCALE, v[4 * g + 1][j] * W8_SCALE, v[4 * g + 2][j] * W8_SCALE, v[4 * g + 3][j] * W8_SCALE);
    asm volatile("s_waitcnt lgkmcnt(0)" ::: "memory"); __builtin_amdgcn_wave_barrier();
#pragma unroll
    for (int ps = 0; ps < 8; ++ps) { const int n = ps * 8 + (lane >> 3), pc = lane & 7;
        const u32x4 w = *(const LAS u32x4*)(T8 + n * 36 + pc * 4);
        const int ng = n0 + n; const int drow = b * t.dst_brow + (ng / t.blk) * t.blk_stride + (ng % t.blk) + t.row_off;
        *(u32x4*)((char*)t.dst + (size_t)drow * t.dst_pitch + k0 + pc * 16) = w; }
    asm volatile("s_waitcnt lgkmcnt(0)" ::: "memory"); __builtin_amdgcn_wave_barrier();
}
__device__ __forceinline__ void phase_wprep(const Frame& F, int layer) {
    const int tid = ltid(), lane = tid & 63; (void)lane;
    LAS float* T = (LAS float*)F.lds + F.wave * (64 * 65);
    const int gw = F.bid * NWAVE + F.wave, nw = F.G * NWAVE;
    int base = 0;
#pragma unroll
    for (int j = 0; j < N_TJOBS; ++j) {
        const TJob t = get_tjob(F, layer, j); const int nt = tjob_tiles(t);
        const int first = (gw - (base % nw) + nw) % nw;
        for (int tile = first; tile < nt; tile += nw) { if (t.f8) transpose_tile8((LAS unsigned*)T, lane, t, tile); else transpose_tile(T, lane, t, tile); }
        base += nt;
    }
    __syncthreads();
}

__device__ __forceinline__ void phase_post1_route(const Frame& F, int layer, bool use_mix) {
    const int tid = ltid(), lane = tid & 63; (void)lane;
    const float* mods = (const float*)(F.ws + WS_MODS) + (size_t)layer * 5 * 12288;
    const bf16_t* MIX = (const bf16_t*)(F.ws + WS_MIX);
    bf16_t* X1 = (bf16_t*)(F.ws + WS_X1);
    unsigned* route = (unsigned*)(F.ws + WS_ROUTE);
    unsigned* ecnt = (unsigned*)(F.ws + WS_CTL) + CW_ECNT + layer * 64;
    const float* g1 = F.in[I_LN1G] + layer * D; const float* b1 = F.in[I_LN1B] + layer * D;
    LAS float* RW = (LAS float*)F.lds;
    LAS unsigned* lcnt = (LAS unsigned*)(F.lds + 131072 + 256);
    if (tid < 32) lcnt[tid] = 0u;
    for (int i4 = tid; i4 < 2048 * 16 / 4; i4 += NTHR) { const int k = i4 >> 2, qd = i4 & 3; const int ii = k >> 8, ln = (k >> 2) & 63, c = k & 3;
        *(LAS f32x4*)(RW + ((((qd * 8 + ii) * 4 + c) * 64 + ln) * 4)) = *(const f32x4*)(F.in[I_ROUTW] + (size_t)k * 16 + qd * 4); }
    __syncthreads();
    const int stride = F.G * NWAVE;
    f32x4 xq[8]; u32x2 mq[8];
    const int nrows = layer == 1 ? NB * SEQ : R;
#define ROW_OF(qi) (layer == 1 ? (qi) + ((qi) >> 13) * CTXL + CTXL : (qi))
    { const int r = ROW_OF(F.bid * NWAVE + F.wave); const float* x = xin_row(F, layer, r);
#pragma unroll
      for (int i = 0; i < 8; ++i) { const int e = (i * 64 + lane) * 4; xq[i] = *(const f32x4*)(x + e); mq[i] = *(const u32x2*)(MIX + (size_t)r * D + e); } }
    for (int qi = F.bid * NWAVE + F.wave; qi < nrows; qi += stride) { const int r = ROW_OF(qi);
        const int b = r / TB, s = r - b * TB; const float* md = mods + (size_t)(s < CTXL ? 4 : b) * 12288;
        f32x4 v[8]; float sum = 0.f;
#pragma unroll
        for (int i = 0; i < 8; ++i) { const int e = (i * 64 + lane) * 4; v[i] = xq[i] * ALPHA;
            if (use_mix) { const u32x2 m = mq[i]; const f32x4 g = *(const f32x4*)(md + 2 * 2048 + e);
                v[i][0] += g[0] * __uint_as_float(m.x << 16); v[i][1] += g[1] * __uint_as_float(m.x & 0xffff0000u); v[i][2] += g[2] * __uint_as_float(m.y << 16); v[i][3] += g[3] * __uint_as_float(m.y & 0xffff0000u); }
            sum += (v[i][0] + v[i][1]) + (v[i][2] + v[i][3]); }
        { const int rn = ROW_OF(qi + stride < nrows ? qi + stride : qi); const float* xn = xin_row(F, layer, rn);
#pragma unroll
          for (int i = 0; i < 8; ++i) { const int e = (i * 64 + lane) * 4; xq[i] = *(const f32x4*)(xn + e); mq[i] = *(const u32x2*)(MIX + (size_t)rn * D + e); } }
        float mean = wave_sum(sum, lane) * (1.0f / D); float q = 0.f;
#pragma unroll
        for (int i = 0; i < 8; ++i) { v[i] -= mean; q += (v[i][0] * v[i][0] + v[i][1] * v[i][1]) + (v[i][2] * v[i][2] + v[i][3] * v[i][3]); }
        float rstd = rsqrtf(wave_sum(q, lane) * (1.0f / D) + LN_EPS);
        sum = 0.f;
#pragma unroll
        for (int i = 0; i < 8; ++i) { const int e = (i * 64 + lane) * 4; const f32x4 gg = *(const f32x4*)(g1 + e), bb = *(const f32x4*)(b1 + e);
            v[i] = v[i] * rstd * gg + bb; { u32x2 w; w.x = pk_bf16(v[i][0], v[i][1]); w.y = pk_bf16(v[i][2], v[i][3]); *(u32x2*)(X1 + (size_t)r * D + e) = w; } sum += (v[i][0] + v[i][1]) + (v[i][2] + v[i][3]); }
        mean = wave_sum(sum, lane) * (1.0f / D); q = 0.f;
#pragma unroll
        for (int i = 0; i < 8; ++i) { v[i] -= mean; q += (v[i][0] * v[i][0] + v[i][1] * v[i][1]) + (v[i][2] * v[i][2] + v[i][3] * v[i][3]); }
        rstd = rsqrtf(wave_sum(q, lane) * (1.0f / D) + LN_EPS);
        float lg[16];
#pragma unroll
        for (int e = 0; e < 16; ++e) lg[e] = 0.f;
#pragma unroll
        for (int i = 0; i < 8; ++i) { const int e0 = (i * 64 + lane) * 4; const f32x4 sh = *(const f32x4*)(md + 3 * 2048 + e0), scl = *(const f32x4*)(md + 4 * 2048 + e0);
            const f32x4 u = v[i] * rstd * (scl + 1.0f) + sh;
#pragma unroll
            for (int j = 0; j < 4; ++j) {
#pragma unroll
                for (int qd = 0; qd < 4; ++qd) { const f32x4 w = *(const LAS f32x4*)(RW + ((((qd * 8 + i) * 4 + j) * 64 + lane) * 4)); lg[qd * 4 + 0] += u[j] * w[0]; lg[qd * 4 + 1] += u[j] * w[1]; lg[qd * 4 + 2] += u[j] * w[2]; lg[qd * 4 + 3] += u[j] * w[3]; } }
            __builtin_amdgcn_sched_barrier(0); }
#pragma unroll
        for (int e = 0; e < 16; ++e) lg[e] = wave_sum(lg[e], lane);
        float aff[16], gsc[16];
#pragma unroll
        for (int e = 0; e < 16; ++e) { aff[e] = __builtin_amdgcn_rcpf(1.0f + __expf(-lg[e])); gsc[e] = aff[e] + F.in[I_ROUTB][e]; }
        int best = 0; float bestv = -1e30f;
#pragma unroll
        for (int gI = 0; gI < 4; ++gI) { float m1 = -1e30f, m2 = -1e30f;
#pragma unroll
            for (int j = 0; j < 4; ++j) { const float t = gsc[gI * 4 + j]; if (t > m1) { m2 = m1; m1 = t; } else if (t > m2) m2 = t; }
            const float sc = m1 + m2; if (sc > bestv) { bestv = sc; best = gI; } }
        int i0 = 0, i1 = 0; { float m1 = -1e30f, m2 = -1e30f;
#pragma unroll
            for (int gI = 0; gI < 4; ++gI) if (gI == best) {
#pragma unroll
                for (int j = 0; j < 4; ++j) { const float t = gsc[gI * 4 + j]; if (t > m1) { m2 = m1; i1 = i0; m1 = t; i0 = gI * 4 + j; } else if (t > m2) { m2 = t; i1 = gI * 4 + j; } } } }
        float a0 = 0.f, a1 = 0.f;
#pragma unroll
        for (int e = 0; e < 16; ++e) { a0 = (e == i0) ? aff[e] : a0; a1 = (e == i1) ? aff[e] : a1; }
        const float inv = 1.0f / (a0 + a1);
        if (lane == 0) {
            const unsigned s0 = __hip_atomic_fetch_add(lcnt + i0, 1u, __ATOMIC_RELAXED, __HIP_MEMORY_SCOPE_WORKGROUP), s1 = __hip_atomic_fetch_add(lcnt + i1, 1u, __ATOMIC_RELAXED, __HIP_MEMORY_SCOPE_WORKGROUP);
            u32x4 w0; w0.x = (unsigned)i0; w0.y = (unsigned)i1; w0.z = __float_as_uint(a0 * inv); w0.w = __float_as_uint(a1 * inv);
            *(u32x4*)(route + (size_t)r * 8) = w0; u32x2 w1; w1.x = s0; w1.y = s1; *(u32x2*)(route + (size_t)r * 8 + 4) = w1;
        }
    }
    __syncthreads();
    if (tid < 16) lcnt[16 + tid] = atomicAdd(ecnt + tid, lcnt[tid]);
    __syncthreads();
    for (int qi = F.bid * NWAVE + F.wave; qi < nrows; qi += stride) { const int r = ROW_OF(qi);
        if (lane == 0) { const u32x2 e01 = *(const u32x2*)(route + (size_t)r * 8); u32x2 sl = *(const u32x2*)(route + (size_t)r * 8 + 4);
            sl.x += lcnt[16 + e01.x]; sl.y += lcnt[16 + e01.y]; *(u32x2*)(route + (size_t)r * 8 + 4) = sl; } }
}
__device__ __forceinline__ void load_tile_starts(const Frame& F, int tid, int layer, LAS int* ts) {
    if (tid == 0) { const unsigned* ecnt = (const unsigned*)(F.ws + WS_CTL) + CW_ECNT + layer * 64; int a = 0;
        for (int e = 0; e < 16; ++e) { ts[e] = a; a += (int)((__hip_atomic_load(ecnt + e, __ATOMIC_RELAXED, __HIP_MEMORY_SCOPE_AGENT) + 255u) >> 8); } ts[16] = a; }
    __syncthreads();
}
__device__ __forceinline__ void phase_gather(const Frame& F, int layer) {
    const int tid = ltid(), lane = tid & 63; (void)lane;
    LAS int* ts = (LAS int*)(F.lds + LDS_BYTES - 512);
    const float* mods = (const float*)(F.ws + WS_MODS) + (size_t)layer * 5 * 12288;
    LAS float* ML = (LAS float*)F.lds;
    for (int i = tid; i < 5 * 2 * 512; i += NTHR) { const int mr = i >> 10, v = (i >> 9) & 1, c4 = i & 511; *(LAS f32x4*)(ML + (mr * 2 + v) * 2048 + c4 * 4) = *(const f32x4*)(mods + (size_t)mr * 12288 + (3 + v) * 2048 + c4 * 4); }
    load_tile_starts(F, tid, layer, ts);
    const bf16_t* X1 = (const bf16_t*)(F.ws + WS_X1);
    const unsigned* route = (const unsigned*)(F.ws + WS_ROUTE);
    bf16_t* UG = (bf16_t*)(F.ws + WS_SC);
    const int stride = F.G * NWAVE;
    u32x2 xw[8]; u32x4 rr; u32x2 sl;
    const int nrows = layer == 1 ? NB * SEQ : R;
    { const int r = ROW_OF(F.bid * NWAVE + F.wave);
#pragma unroll
      for (int i = 0; i < 8; ++i) xw[i] = *(const u32x2*)(X1 + (size_t)r * D + (i * 64 + lane) * 4);
      rr = *(const u32x4*)(route + (size_t)r * 8); sl = *(const u32x2*)(route + (size_t)r * 8 + 4); }
    for (int qi = F.bid * NWAVE + F.wave; qi < nrows; qi += stride) { const int r = ROW_OF(qi);
        const int b = r / TB, s = r - b * TB; const LAS float* md = ML + (s < CTXL ? 4 : b) * 4096;
        f32x4 v[8]; float sum = 0.f;
#pragma unroll
        for (int i = 0; i < 8; ++i) { const u32x2 w = xw[i]; v[i][0] = __uint_as_float(w.x << 16); v[i][1] = __uint_as_float(w.x & 0xffff0000u); v[i][2] = __uint_as_float(w.y << 16); v[i][3] = __uint_as_float(w.y & 0xffff0000u); sum += (v[i][0] + v[i][1]) + (v[i][2] + v[i][3]); }
        const u32x4 rc = rr; const u32x2 sc_ = sl;
        { const int rn = ROW_OF(qi + stride < nrows ? qi + stride : qi);
#pragma unroll
          for (int i = 0; i < 8; ++i) xw[i] = *(const u32x2*)(X1 + (size_t)rn * D + (i * 64 + lane) * 4);
          rr = *(const u32x4*)(route + (size_t)rn * 8); sl = *(const u32x2*)(route + (size_t)rn * 8 + 4); }
        const float mean = wave_sum(sum, lane) * (1.0f / D); float q = 0.f;
#pragma unroll
        for (int i = 0; i < 8; ++i) { v[i] -= mean; q += (v[i][0] * v[i][0] + v[i][1] * v[i][1]) + (v[i][2] * v[i][2] + v[i][3] * v[i][3]); }
        const float rstd = rsqrtf(wave_sum(q, lane) * (1.0f / D) + LN_EPS);
        const size_t row0 = (size_t)ts[rc.x] * 256 + sc_.x, row1 = (size_t)ts[rc.y] * 256 + sc_.y;
#pragma unroll
        for (int i = 0; i < 8; ++i) { const int e = (i * 64 + lane) * 4; const f32x4 sh = *(const LAS f32x4*)(md + e), scl = *(const LAS f32x4*)(md + 2048 + e);
            const f32x4 u = v[i] * rstd * (scl + 1.0f) + sh;
            st_op4(UG, row0 * D + e, u[0], u[1], u[2], u[3]); st_op4(UG, row1 * D + e, u[0], u[1], u[2], u[3]); }
    }
}
__device__ __forceinline__ void phase_moe_gemm(const Frame& F, int layer, int which) {
    const int tid = ltid(), lane = tid & 63; (void)lane;
    LAS int* ts = (LAS int*)(F.lds + pg8::STAGE_BYTES);
    load_tile_starts(F, tid, layer, ts);
    if (which == 0) {
        pg8::Gemm g{(const bf16_t*)(F.ws + WS_SC), (const bf16_t*)(F.ws + WS_EGU), 2048 * OPB / 2, 2048 * OPB / 2, 2048 * OPB / 2};
        pg8::GroupedOrder S{ts, 8, F.G, F.bid}; pg8::Epi<4, true> E{(void*)(F.ws + WS_U), nullptr, nullptr, 1024, 8};
        pg8::gemm_phase<pg8::Epi<4, true>, pg8::GroupedOrder>(F.lds, g, S, E, F.wave);
    } else {
        pg8::Gemm g{(const bf16_t*)(F.ws + WS_U), (const bf16_t*)(F.ws + WS_EDN), 1024 * OPB / 2, 1024 * OPB / 2, 1024 * OPB / 2};
        pg8::GroupedOrder S{ts, 8, F.G, F.bid}; pg8::Epi<0, false> E{(void*)(F.ws + WS_SC), nullptr, nullptr, 2048, 8};
        pg8::gemm_phase<pg8::Epi<0, false>, pg8::GroupedOrder>(F.lds, g, S, E, F.wave);
    }
}
__device__ __forceinline__ void phase_post2_moe(const Frame& F, int layer, bool use_ffn) {
    const int tid = ltid(), lane = tid & 63; (void)lane;
    LAS int* ts = (LAS int*)(F.lds + LDS_BYTES - 512);
    const float* mods = (const float*)(F.ws + WS_MODS) + (size_t)layer * 5 * 12288;
    LAS float* GL5 = (LAS float*)F.lds;
    LAS float* G2L = GL5 + 5 * 2048; LAS float* NXL = G2L + 2 * 2048;
    for (int i = tid; i < 5 * 512; i += NTHR) { const int mr = i >> 9, c4 = i & 511; *(LAS f32x4*)(GL5 + mr * 2048 + c4 * 4) = *(const f32x4*)(mods + (size_t)mr * 12288 + 5 * 2048 + c4 * 4); }
    for (int i = tid; i < 2 * 512; i += NTHR) { const int v = i >> 9, c4 = i & 511; *(LAS f32x4*)(G2L + v * 2048 + c4 * 4) = *(const f32x4*)((v == 0 ? F.in[I_LN2G] : F.in[I_LN2B]) + layer * D + c4 * 4); }
    if (layer == 0) for (int i = tid; i < 5 * 2 * 512; i += NTHR) { const int mr = i >> 10, v = (i >> 9) & 1, c4 = i & 511; *(LAS f32x4*)(NXL + (mr * 2 + v) * 2048 + c4 * 4) = *(const f32x4*)(mods + (size_t)5 * 12288 + (size_t)mr * 12288 + v * 2048 + c4 * 4); }
    load_tile_starts(F, tid, layer, ts);
    const bf16_t* X1 = (const bf16_t*)(F.ws + WS_X1);
    const unsigned* route = (const unsigned*)(F.ws + WS_ROUTE);
    const bf16_t* Y = (const bf16_t*)(F.ws + WS_SC);
    const float* g2 = F.in[I_LN2G] + layer * D; const float* b2 = F.in[I_LN2B] + layer * D;
    const int stride = F.G * NWAVE;
    u32x2 xw[8], y0w[8], y1w[8]; u32x4 rrN; u32x2 slN; float w0c, w1c;
    const int nrows = layer == 1 ? NB * SEQ : R;
    { const int r = ROW_OF(F.bid * NWAVE + F.wave); const u32x4 rr = *(const u32x4*)(route + (size_t)r * 8); const u32x2 sl = *(const u32x2*)(route + (size_t)r * 8 + 4);
      const size_t row0 = (size_t)ts[rr.x] * 256 + sl.x, row1 = (size_t)ts[rr.y] * 256 + sl.y; w0c = __uint_as_float(rr.z); w1c = __uint_as_float(rr.w);
#pragma unroll
      for (int i = 0; i < 8; ++i) { const int e = (i * 64 + lane) * 4; xw[i] = *(const u32x2*)(X1 + (size_t)r * D + e); y0w[i] = *(const u32x2*)(Y + row0 * D + e); y1w[i] = *(const u32x2*)(Y + row1 * D + e); }
      const int q0 = F.bid * NWAVE + F.wave; const int rn = ROW_OF(q0 + stride < nrows ? q0 + stride : q0); rrN = *(const u32x4*)(route + (size_t)rn * 8); slN = *(const u32x2*)(route + (size_t)rn * 8 + 4); }
    for (int qi = F.bid * NWAVE + F.wave; qi < nrows; qi += stride) { const int r = ROW_OF(qi);
        const int b = r / TB, s = r - b * TB; const int mr = s < CTXL ? 4 : b;
        const float w0 = w0c, w1 = w1c;
        f32x4 v[8]; float sum = 0.f;
#pragma unroll
        for (int i = 0; i < 8; ++i) { const int e = (i * 64 + lane) * 4; { const u32x2 w = xw[i]; v[i][0] = __uint_as_float(w.x << 16); v[i][1] = __uint_as_float(w.x & 0xffff0000u); v[i][2] = __uint_as_float(w.y << 16); v[i][3] = __uint_as_float(w.y & 0xffff0000u); v[i] *= ALPHA; }
            if (use_ffn) { const u32x2 y0 = y0w[i], y1 = y1w[i]; const f32x4 g = *(const LAS f32x4*)(GL5 + mr * 2048 + e);
                v[i][0] += g[0] * (w0 * __uint_as_float(y0.x << 16) + w1 * __uint_as_float(y1.x << 16));
                v[i][1] += g[1] * (w0 * __uint_as_float(y0.x & 0xffff0000u) + w1 * __uint_as_float(y1.x & 0xffff0000u));
                v[i][2] += g[2] * (w0 * __uint_as_float(y0.y << 16) + w1 * __uint_as_float(y1.y << 16));
                v[i][3] += g[3] * (w0 * __uint_as_float(y0.y & 0xffff0000u) + w1 * __uint_as_float(y1.y & 0xffff0000u)); }
            sum += (v[i][0] + v[i][1]) + (v[i][2] + v[i][3]); }
        {
            const int rn = ROW_OF(qi + stride < nrows ? qi + stride : qi); const int rn2 = ROW_OF(qi + 2 * stride < nrows ? qi + 2 * stride : qi);
            const size_t row0 = (size_t)ts[rrN.x] * 256 + slN.x, row1 = (size_t)ts[rrN.y] * 256 + slN.y; w0c = __uint_as_float(rrN.z); w1c = __uint_as_float(rrN.w);
#pragma unroll
            for (int i = 0; i < 8; ++i) { const int e = (i * 64 + lane) * 4; xw[i] = *(const u32x2*)(X1 + (size_t)rn * D + e); y0w[i] = *(const u32x2*)(Y + row0 * D + e); y1w[i] = *(const u32x2*)(Y + row1 * D + e); }
            rrN = *(const u32x4*)(route + (size_t)rn2 * 8); slN = *(const u32x2*)(route + (size_t)rn2 * 8 + 4); }
        const float mean = wave_sum(sum, lane) * (1.0f / D); float q = 0.f;
#pragma unroll
        for (int i = 0; i < 8; ++i) { v[i] -= mean; q += (v[i][0] * v[i][0] + v[i][1] * v[i][1]) + (v[i][2] * v[i][2] + v[i][3] * v[i][3]); }
        const float rstd = rsqrtf(wave_sum(q, lane) * (1.0f / D) + LN_EPS);
        float* o = xout_row(F, r); float sum2 = 0.f;
#pragma unroll
        for (int i = 0; i < 8; ++i) { const int e = (i * 64 + lane) * 4; const f32x4 gg = *(const LAS f32x4*)(G2L + e), bb = *(const LAS f32x4*)(G2L + 2048 + e);
            v[i] = v[i] * rstd * gg + bb; *(f32x4*)(o + e) = v[i]; sum2 += (v[i][0] + v[i][1]) + (v[i][2] + v[i][3]); }
        if (layer == 0) {
            const LAS float* mdn = NXL + mr * 4096; void* U = (void*)(F.ws + WS_U);
            const float mean2 = wave_sum(sum2, lane) * (1.0f / D); float q2 = 0.f;
#pragma unroll
            for (int i = 0; i < 8; ++i) { v[i] -= mean2; q2 += (v[i][0] * v[i][0] + v[i][1] * v[i][1]) + (v[i][2] * v[i][2] + v[i][3] * v[i][3]); }
            const float rstd2 = rsqrtf(wave_sum(q2, lane) * (1.0f / D) + LN_EPS);
#pragma unroll
            for (int i = 0; i < 8; ++i) { const int e = (i * 64 + lane) * 4; const f32x4 sh = *(const LAS f32x4*)(mdn + e), scl = *(const LAS f32x4*)(mdn + 2048 + e);
                const f32x4 u = v[i] * rstd2 * (scl + 1.0f) + sh; st_op4(U, (size_t)r * D + e, u[0], u[1], u[2], u[3]); }
        }
    }
}


__device__ __forceinline__ bf16x8 pack_8(const f32x4 a, const f32x4 b) { u32x4 w; w.x = pk_bf16(a[0], a[1]); w.y = pk_bf16(a[2], a[3]); w.z = pk_bf16(b[0], b[1]); w.w = pk_bf16(b[2], b[3]); bf16x8 r; __builtin_memcpy(&r, &w, 16); return r; }
__device__ __forceinline__ bf16x8 lds_2x8(const LAS bf16_t* p0, const LAS bf16_t* p1) { const u32x2 a = *(const LAS u32x2*)p0, b = *(const LAS u32x2*)p1; u32x4 w; w.x = a.x; w.y = a.y; w.z = b.x; w.w = b.y; bf16x8 r; __builtin_memcpy(&r, &w, 16); return r; }
__device__ __forceinline__ int nat_chunk(int d, int j) { return d == 0 ? j : (j < 4 ? 3 - j : 135 - j); }
__device__ __forceinline__ bf16x8 ldsA(const LAS bf16_t* p) { return *(const LAS bf16x8*)p; }
#define MFMA16(a, b, c) __builtin_amdgcn_mfma_f32_16x16x32_bf16((a), (b), (c), 0, 0, 0)
constexpr size_t SC_RWF = 0, SC_RWB = (size_t)R * 1024 * 2, SC_S5 = 2 * SC_RWB, SC_ML = SC_S5 + (size_t)R * 1024 * OPB, SC_RWO = F8 ? SC_ML + (size_t)R * 1024 * OPB : SC_RWF;
static_assert(SC_RWO + (size_t)R * 1024 * OPB <= SC_BYTES, "SC region overflow");

__device__ __forceinline__ void conv_item(const Frame& F, int tid, int layer, int it) {
    const bf16_t* P = (const bf16_t*)(F.ws + WS_P); bf16_t* QK = (bf16_t*)(F.ws + WS_QK);
    int b, rowbase[3], jmin, jmax; bool rv[3];
    if (it < 512) { b = it >> 7; const int i = it & 127; jmin = 0; jmax = 63;
        _Pragma("unroll") for (int a = 0; a < 3; ++a) { const int ii = i + a - 1; rv[a] = (ii >= 0 && ii < 128); rowbase[a] = b * TB + CTXL + ii * 64; } }
    else { const int q = it - 512; b = q >> 2; const int seg = q & 3; jmin = seg == 0 ? 0 : -1; jmax = seg == 3 ? 63 : 64;
        rv[0] = false; rv[2] = false; rv[1] = true; rowbase[0] = rowbase[2] = rowbase[1] = b * TB + seg * 64; }
    const int c0 = tid * 4;
    const float* cw = F.in[I_MLCW] + (size_t)layer * 9 * 2048; const float* cb = F.in[I_MLCB] + layer * 2048;
    f32x4 w[3][3];
#pragma unroll
    for (int a = 0; a < 3; ++a)
#pragma unroll
        for (int bb = 0; bb < 3; ++bb) w[a][bb] = *(const f32x4*)(cw + (a * 3 + bb) * 2048 + c0);
    const f32x4 bias = *(const f32x4*)(cb + c0);
    const float osc = c0 >= 1024 ? 0.0625f : 1.0f;
    f32x4 win[3][3];
#pragma unroll
    for (int a = 0; a < 3; ++a) { win[a][0] = (f32x4){0.f, 0.f, 0.f, 0.f}; win[a][1] = win[a][0]; win[a][2] = win[a][0]; }
    auto ldcol = [&](int a, int jj) -> f32x4 {
        const bool ok = rv[a] && jj >= jmin && jj <= jmax; const int rr = ok ? rowbase[a] + jj : rowbase[1];
        const u32x2 p = *(const u32x2*)(P + (size_t)rr * PW + c0); const float mk = ok ? 1.0f : 0.0f; f32x4 r;
        r[0] = mk * __uint_as_float(p.x << 16); r[1] = mk * __uint_as_float(p.x & 0xffff0000u); r[2] = mk * __uint_as_float(p.y << 16); r[3] = mk * __uint_as_float(p.y & 0xffff0000u);
        return r; };
#pragma unroll
    for (int a = 0; a < 3; ++a) { win[a][1] = ldcol(a, -1); win[a][2] = ldcol(a, 0); }
    for (int j0 = 0; j0 < 64; j0 += 8) {
        f32x4 nw[3][8];
#pragma unroll
        for (int u = 0; u < 8; ++u)
#pragma unroll
            for (int a = 0; a < 3; ++a) nw[a][u] = ldcol(a, j0 + u + 1);
#pragma unroll
        for (int u = 0; u < 8; ++u) {
            f32x4 acc = bias;
#pragma unroll
            for (int a = 0; a < 3; ++a) { win[a][0] = win[a][1]; win[a][1] = win[a][2]; win[a][2] = nw[a][u];
                acc += win[a][0] * w[a][0] + win[a][1] * w[a][1] + win[a][2] * w[a][2]; }
            u32x2 o; o.x = pk_bf16(siluf_(acc[0]) * osc, siluf_(acc[1]) * osc); o.y = pk_bf16(siluf_(acc[2]) * osc, siluf_(acc[3]) * osc);
            *(u32x2*)(QK + (size_t)(rowbase[1] + j0 + u) * 2048 + c0) = o;
        }
    }
}

__device__ __forceinline__ void fsincos(float a, float* s, float* c) { const float k = rintf(a * 0.15915494309189535f); const float r = fmaf(-k, 6.2831854820251465f, a) + k * 1.7484555e-7f; *s = __sinf(r); *c = __cosf(r); }
__device__ __forceinline__ void s5_tables_item(const Frame& F, int tid, int layer, int g) {
    LAS float* pwr = (LAS float*)F.lds;
    LAS float* pwi = pwr + 2 * 65 * 64;
    LAS float* bbr = pwi + 2 * 65 * 64;
    LAS float* bbi = bbr + 2 * 64 * 16;
    LAS float* ccr = bbi + 2 * 64 * 16;
    LAS float* cci = ccr + 2 * 16 * 64;
    LAS float* k0b = cci + 2 * 16 * 64;
    bf16_t* KC = (bf16_t*)(F.ws + WS_S5KC) + (size_t)g * 128 * 256;
    bf16_t* EC = (bf16_t*)(F.ws + WS_S5E) + (size_t)g * 256 * 1024;
    bf16_t* FC = (bf16_t*)(F.ws + WS_S5F) + (size_t)g * 1024 * 256;
    {
        const int dn = tid & 127, d = dn >> 6, n = dn & 63, tg = tid >> 7;
        const size_t li = (((size_t)layer * 2 + d) * 64 + g) * 64 + n;
        const float lre = F.in[I_S5LRE][li], lim = F.in[I_S5LIM][li], dt = expf(F.in[I_S5LDT][((size_t)layer * 2 + d) * 64 + g]);
        const float zr = lre * dt, zi = lim * dt;
        for (int tau = tg; tau <= 64; tau += 4) { const float mag = expf(zr * (float)tau); float sn, cs; fsincos(zi * (float)tau, &sn, &cs);
            pwr[(d * 65 + tau) * 64 + n] = mag * cs; pwi[(d * 65 + tau) * 64 + n] = mag * sn; }
        if (tg == 0) {
            const float mag = expf(zr); float sn, cs; fsincos(zi, &sn, &cs);
            const float nr = mag * cs - 1.0f, ni = mag * sn, den = 1.0f / (lre * lre + lim * lim);
            const float cr = (nr * lre + ni * lim) * den, ci = (ni * lre - nr * lim) * den;
            const float* br = F.in[I_S5BRE] + li * 16; const float* bi = F.in[I_S5BIM] + li * 16;
            for (int c = 0; c < 16; ++c) { bbr[(d * 64 + n) * 16 + c] = cr * br[c] - ci * bi[c]; bbi[(d * 64 + n) * 16 + c] = cr * bi[c] + ci * br[c]; }
        }
        for (int i = tid; i < 2 * 16 * 64; i += NTHR) { const int dd = i >> 10, rem = i & 1023;
            const size_t ci_ = (((size_t)layer * 2 + dd) * 64 + g) * 1024 + rem; ccr[i] = F.in[I_S5CRE][ci_]; cci[i] = F.in[I_S5CIM][ci_]; }
    }
    __syncthreads();
    {
        const int d = tid >> 8, co = (tid >> 4) & 15, ci = tid & 15;
        for (int half = 0; half < 2; ++half) {
            float acc[32];
#pragma unroll
            for (int t = 0; t < 32; ++t) acc[t] = 0.f;
            for (int n = 0; n < 64; ++n) {
                const float c_r = ccr[(d * 16 + co) * 64 + n], c_i = cci[(d * 16 + co) * 64 + n], b_r = bbr[(d * 64 + n) * 16 + ci], b_i = bbi[(d * 64 + n) * 16 + ci];
                const float gr = c_r * b_r - c_i * b_i, gi = c_r * b_i + c_i * b_r;
#pragma unroll
                for (int t = 0; t < 32; ++t) acc[t] += gr * pwr[(d * 65 + half * 32 + t) * 64 + n] - gi * pwi[(d * 65 + half * 32 + t) * 64 + n];
            }
            if (half == 0) {
                if (d == 1) k0b[tid & 255] = acc[0];
                __syncthreads();
                if (d == 0) acc[0] += k0b[tid & 255] + (co == ci ? F.in[I_S5D][layer * 1024 + g * 16 + co] : 0.f);
            }
#pragma unroll
            for (int t = 0; t < 32; ++t) { const int tau = half * 32 + t; if (d == 1 && tau == 0) continue; const int delta = d == 0 ? tau : -tau; KC[(size_t)(delta + 63) * 256 + co * 16 + ci] = f2bf(acc[t]); }
        }
        if (d == 1) KC[(size_t)127 * 256 + (tid & 255)] = 0;
    }
    for (int u = tid; u < 2 * 64 * 64 * 2; u += NTHR) {
        const int ch = u & 1, sp = (u >> 1) & 63, n = (u >> 7) & 63, d = u >> 13;
        const int tau = d == 0 ? 63 - sp : sp; const float pr = pwr[(d * 65 + tau) * 64 + n], pi = pwi[(d * 65 + tau) * 64 + n];
        float er[8], ei[8];
#pragma unroll
        for (int e = 0; e < 8; ++e) { const float b_r = bbr[(d * 64 + n) * 16 + ch * 8 + e], b_i = bbi[(d * 64 + n) * 16 + ch * 8 + e]; er[e] = pr * b_r - pi * b_i; ei[e] = pr * b_i + pi * b_r; }
        u32x4 wr_, wi_; wr_.x = pk_bf16(er[0], er[1]); wr_.y = pk_bf16(er[2], er[3]); wr_.z = pk_bf16(er[4], er[5]); wr_.w = pk_bf16(er[6], er[7]);
        wi_.x = pk_bf16(ei[0], ei[1]); wi_.y = pk_bf16(ei[2], ei[3]); wi_.z = pk_bf16(ei[4], ei[5]); wi_.w = pk_bf16(ei[6], ei[7]);
        *(u32x4*)(EC + (size_t)(d * 128 + n) * 1024 + sp * 16 + ch * 8) = wr_;
        *(u32x4*)(EC + (size_t)(d * 128 + 64 + n) * 1024 + sp * 16 + ch * 8) = wi_;
    }
    for (int u = tid; u < 1024 * 32; u += NTHR) {
        const int n8 = u & 7, part = (u >> 3) & 1, d = (u >> 4) & 1, co = (u >> 5) & 15, tp = u >> 9;
        const int tau = d == 0 ? tp + 1 : 64 - tp; float f[8];
#pragma unroll
        for (int e = 0; e < 8; ++e) { const int n = n8 * 8 + e; const float c_r = ccr[(d * 16 + co) * 64 + n], c_i = cci[(d * 16 + co) * 64 + n], pr = pwr[(d * 65 + tau) * 64 + n], pi = pwi[(d * 65 + tau) * 64 + n];
            f[e] = part == 0 ? (c_r * pr - c_i * pi) : -(c_r * pi + c_i * pr); }
        u32x4 w; w.x = pk_bf16(f[0], f[1]); w.y = pk_bf16(f[2], f[3]); w.z = pk_bf16(f[4], f[5]); w.w = pk_bf16(f[6], f[7]);
        *(u32x4*)(FC + (size_t)(tp * 16 + co) * 256 + d * 128 + part * 64 + n8 * 8) = w;
    }
    __syncthreads();
}

__device__ __forceinline__ void s5a_wave_item(const Frame& F, int lane, int wi) {
    const int rh = wi & 1, w2 = wi >> 1, g = w2 / 9, cq = w2 - g * 9, l15 = lane & 15, q = lane >> 4;
    const bf16_t* P = (const bf16_t*)(F.ws + WS_P); const bf16_t* EC = (const bf16_t*)(F.ws + WS_S5E) + (size_t)g * 256 * 1024 + (size_t)rh * 128 * 1024;
    float* XL = (float*)(F.ws + WS_S5X);
    const bf16_t* ub[4]; int colv[4];
#pragma unroll
    for (int c = 0; c < 4; ++c) { const int ct = (cq * 4 + c) < 33 ? cq * 4 + c : 32; const int col = ct * 16 + l15, b = col / NCH, jn = col - b * NCH; colv[c] = col;
        ub[c] = P + (size_t)(b * TB + jn * 64 + (q >> 1)) * PW + PC_S5 + g * 16 + (q & 1) * 8; }
    const unsigned eoff = (unsigned)(l15 * 1024 + q * 8) * 2u;
    f32x4 acc[4][8];
#pragma unroll
    for (int c = 0; c < 4; ++c)
#pragma unroll
        for (int x = 0; x < 8; ++x) acc[c][x] = (f32x4){0.f, 0.f, 0.f, 0.f};
    for (int ks = 0; ks < 32; ks += 2) {
        bf16x8 Bf[2][4], Af[2][8];
#pragma unroll
        for (int u = 0; u < 2; ++u) {
#pragma unroll
            for (int c = 0; c < 4; ++c) Bf[u][c] = *(const bf16x8*)(ub[c] + (size_t)((ks + u) * 2) * PW);
            unsigned eo = eoff; asm volatile("" : "+v"(eo));
#pragma unroll
            for (int x = 0; x < 8; ++x) Af[u][x] = *(const bf16x8*)((const char*)(EC + (size_t)(x * 16) * 1024 + (ks + u) * 32) + eo); }
#pragma unroll
        for (int u = 0; u < 2; ++u)
#pragma unroll
            for (int x = 0; x < 8; ++x)
#pragma unroll
                for (int c = 0; c < 4; ++c) acc[c][x] = MFMA16(Af[u][x], Bf[u][c], acc[c][x]);
    }
#pragma unroll
    for (int c = 0; c < 4; ++c) if (cq * 4 + c < 33) {
#pragma unroll
        for (int x = 0; x < 8; ++x) *(f32x4*)(XL + ((size_t)g * 528 + colv[c]) * 256 + rh * 128 + x * 16 + q * 4) = acc[c][x]; }
}

__device__ __forceinline__ void s5b_item(const Frame& F, int tid, int layer, int it) {
    const int idx = it * NTHR + tid, n = idx & 63, g = (idx >> 6) & 63, b = (idx >> 12) & 3, d = idx >> 14;
    const size_t li = (((size_t)layer * 2 + d) * 64 + g) * 64 + n;
    const float dt = expf(F.in[I_S5LDT][((size_t)layer * 2 + d) * 64 + g]);
    const float zr = F.in[I_S5LRE][li] * dt * 64.0f, zi = F.in[I_S5LIM][li] * dt * 64.0f;
    const float mag = expf(zr); float sn, cs; fsincos(zi, &sn, &cs); const float ar = mag * cs, ai = mag * sn;
    float* XL = (float*)(F.ws + WS_S5X);
    float cr = 0.f, ci = 0.f;
    for (int j0 = 0; j0 < NCH; j0 += 12) {
        float xr[12], xi[12];
#pragma unroll
        for (int u = 0; u < 12; ++u) { const int col = b * NCH + nat_chunk(d, j0 + u); const float* p = XL + ((size_t)g * 528 + col) * 256 + d * 128 + n; xr[u] = p[0]; xi[u] = p[64]; }
#pragma unroll
        for (int u = 0; u < 12; ++u) { const int col = b * NCH + nat_chunk(d, j0 + u); float* p = XL + ((size_t)g * 528 + col) * 256 + d * 128 + n;
            p[0] = cr; p[64] = ci; const float nr = ar * cr - ai * ci + xr[u], ni = ar * ci + ai * cr + xi[u]; cr = nr; ci = ni; }
    }
}

__device__ __forceinline__ float gelu_tanh(float x) { const float u = 0.7978845608028654f * (x + 0.044715f * x * x * x); const float e = __expf(2.0f * u); const float th = 1.0f - 2.0f / (e + 1.0f); return 0.5f * x * (1.0f + th); }
__device__ __forceinline__ void s5c_block_item(const Frame& F, int tid, int it) {
    const int g = it >> 2, part = it & 3, lane = tid & 63, l15 = lane & 15, q = lane >> 4;
    const int wave = __builtin_amdgcn_readfirstlane(tid >> 6);
    LAS bf16_t* KL = (LAS bf16_t*)F.lds;
    LAS bf16_t* UL = KL + 127 * 264;
    { const bf16_t* KC = (const bf16_t*)(F.ws + WS_S5KC) + (size_t)g * 128 * 256;
      for (int i = tid; i < 127 * 32; i += NTHR) { const int r = i >> 5, sgm = i & 31, co = sgm >> 1, hf = sgm & 1;
          *(LAS u32x4*)(KL + r * 264 + hf * 128 + co * 8) = *(const u32x4*)(KC + (size_t)r * 256 + sgm * 8); } }
    const bf16_t* P = (const bf16_t*)(F.ws + WS_P);
    const bf16_t* FC = (const bf16_t*)(F.ws + WS_S5F) + (size_t)g * 1024 * 256; const float* XC = (const float*)(F.ws + WS_S5X);
    void* OUT = (void*)(F.ws + WS_SC + SC_S5);
    const int c0 = part == 0 ? 0 : 9 + (part - 1) * 8, nct = part == 0 ? 9 : 8;
    for (int cp = 0; cp < (nct + 1) / 2; ++cp) {
        const int ctA = c0 + 2 * cp; const bool vB = (2 * cp + 1) < nct; const int ctB = vB ? ctA + 1 : ctA;
        __syncthreads();
        { const int grp = tid >> 8; const int ct = grp == 0 ? ctA : ctB;
#pragma unroll
          for (int i = 0; i < 8; ++i) { const int id = (tid & 255) + i * 256, s = id >> 5, rem = id & 31, cl = rem >> 1, hf = rem & 1;
              const int colg = ct * 16 + cl, bb = colg / NCH, jj = colg - bb * NCH;
              *(LAS u32x4*)(UL + grp * 16384 + s * 256 + hf * 128 + cl * 8) = *(const u32x4*)(P + (size_t)(bb * TB + jj * 64 + s) * PW + PC_S5 + g * 16 + hf * 8); } }
        __syncthreads();
        const int colA = ctA * 16 + l15, bA = colA / NCH, jA = colA - bA * NCH, colB = ctB * 16 + l15, bB = colB / NCH, jB = colB - bB * NCH;
        const LAS bf16_t* kcl = KL + (63 - (q >> 1)) * 264 + (q & 1) * 128 + l15 * 8;
        const LAS bf16_t* ul = UL + (q >> 1) * 256 + (q & 1) * 128 + l15 * 8;
        f32x4 acc[2][8];
#pragma unroll
        for (int c = 0; c < 2; ++c)
#pragma unroll
            for (int x = 0; x < 8; ++x) acc[c][x] = (f32x4){0.f, 0.f, 0.f, 0.f};
        for (int kb = 0; kb < 4; ++kb) {
#pragma unroll
            for (int i = 0; i < 8; ++i) { const int ks = kb * 8 + i; const bf16x8 b0 = ldsA(ul + ks * 512), b1 = ldsA(ul + 16384 + ks * 512);
#pragma unroll
                for (int x = 0; x < 8; ++x) { const bf16x8 af = ldsA(kcl + (wave * 8 + x - 2 * ks) * 264); acc[0][x] = MFMA16(af, b0, acc[0][x]); acc[1][x] = MFMA16(af, b1, acc[1][x]); }
                if (i & 1) __builtin_amdgcn_sched_barrier(0); }
        }
        {
            bf16x8 Xa[8], Xb[8];
#pragma unroll
            for (int ks = 0; ks < 8; ++ks) { const float* xp = XC + ((size_t)g * 528 + colA) * 256 + ks * 32 + q * 8; Xa[ks] = pack_8(*(const f32x4*)xp, *(const f32x4*)(xp + 4));
                const float* xq = XC + ((size_t)g * 528 + colB) * 256 + ks * 32 + q * 8; Xb[ks] = pack_8(*(const f32x4*)xq, *(const f32x4*)(xq + 4)); }
            const unsigned foff = (unsigned)(l15 * 256 + q * 8) * 2u; const bf16_t* fu = FC + (size_t)(wave * 128) * 256;
#pragma unroll
            for (int ks = 0; ks < 8; ++ks) { bf16x8 Af[8]; unsigned fo = foff; asm volatile("" : "+v"(fo));
#pragma unroll
                for (int x = 0; x < 8; ++x) Af[x] = *(const bf16x8*)((const char*)(fu + (size_t)(x * 16) * 256 + ks * 32) + fo);
#pragma unroll
                for (int x = 0; x < 8; ++x) { acc[0][x] = MFMA16(Af[x], Xa[ks], acc[0][x]); acc[1][x] = MFMA16(Af[x], Xb[ks], acc[1][x]); }
                __builtin_amdgcn_sched_barrier(0); }
        }
#pragma unroll
        for (int x = 0; x < 8; ++x) { const int tp = wave * 8 + x;
            { const size_t row = (size_t)bA * TB + jA * 64 + tp; st_op4(OUT, row * 1024 + g * 16 + q * 4, gelu_tanh(acc[0][x][0]), gelu_tanh(acc[0][x][1]), gelu_tanh(acc[0][x][2]), gelu_tanh(acc[0][x][3])); }
            if (vB) { const size_t row = (size_t)bB * TB + jB * 64 + tp; st_op4(OUT, row * 1024 + g * 16 + q * 4, gelu_tanh(acc[1][x][0]), gelu_tanh(acc[1][x][1]), gelu_tanh(acc[1][x][2]), gelu_tanh(acc[1][x][3])); } }
    }
    __syncthreads();
}

__device__ __forceinline__ float logsigmoidf_(float x) { return fminf(x, 0.f) - __logf(1.0f + __expf(-fabsf(x))); }
__device__ __forceinline__ void mlstm_item(const Frame& F, int tid, int layer, int item) {
    const int vs = item & 3, h = (item >> 2) & 3, b = (item >> 4) & 3, d = item >> 6;
    const int lane = tid & 63, wave = __builtin_amdgcn_readfirstlane(tid >> 6), l15 = lane & 15, q = lane >> 4;
    const int y = wave & 3, p = wave >> 2;
    LAS bf16_t* Qs = (LAS bf16_t*)F.lds;
    LAS bf16_t* Ks = Qs + 64 * 264;
    LAS bf16_t* Kt = Ks + 64 * 264;
    LAS bf16_t* Vt = Kt + 256 * 72;
    LAS bf16_t* Vw = Vt + 64 * 72;
    LAS bf16_t* St = Vw + 64 * 72;
    LAS float* PX = (LAS float*)(St + 64 * 72);
    LAS float* fl = PX + 4 * 4 * 64 * 4;
    LAS float* gsc = fl;
    LAS float* rsum = fl + 384;
    LAS float* qn = fl + 512;
    LAS float* nvec = fl + 576;
    LAS float* wtsl = fl + 832;
    const bf16_t* P = (const bf16_t*)(F.ws + WS_P); const bf16_t* QK = (const bf16_t*)(F.ws + WS_QK);
    bf16_t* HO = (bf16_t*)(F.ws + WS_P);
    if (tid < 256) nvec[tid] = 0.f;
    f32x4 Cst[8];
#pragma unroll
    for (int x = 0; x < 8; ++x) Cst[x] = (f32x4){0.f, 0.f, 0.f, 0.f};
    float m_prev = 0.f;
    u32x4 pq[4], pk[4], pv; float pgi = 0.f, pgf = 0.f;
#define ML_LOAD(jj) do { const int rb_ = b * TB + nat_chunk(d, (jj)) * 64; int tl = tid; asm volatile("" : "+v"(tl));   \
        _Pragma("unroll") for (int i = 0; i < 4; ++i) { const int id = tl + i * NTHR; { const int t = id >> 5, seg = id & 31; const size_t row = (size_t)(rb_ + (d == 0 ? t : 63 - t)); pq[i] = *(const u32x4*)(QK + row * 2048 + h * 256 + seg * 8); } \
            { const int t = id & 63, seg = id >> 6; const size_t row = (size_t)(rb_ + (d == 0 ? t : 63 - t)); pk[i] = *(const u32x4*)(QK + row * 2048 + 1024 + h * 256 + seg * 8); } } \
        { const int t = tl & 63, seg = tl >> 6; const size_t row = (size_t)(rb_ + (d == 0 ? t : 63 - t)); pv = *(const u32x4*)(P + row * PW + PC_V + h * 256 + vs * 64 + seg * 8); } \
        if (wave == 7) { const size_t row = (size_t)(rb_ + (d == 0 ? lane : 63 - lane)); pgi = bf2f(P[row * PW + PC_IG + d * 4 + h]); pgf = bf2f(P[row * PW + PC_FG + d * 4 + h]); } } while (0)
#define ML_STAGE(jj) do { int tl = tid; asm volatile("" : "+v"(tl)); \
        _Pragma("unroll") for (int i = 0; i < 4; ++i) { const int id = tl + i * NTHR; { const int t = id >> 5, seg = id & 31; *(LAS u32x4*)(Qs + t * 264 + seg * 8) = pq[i]; } \
            { const int t = id & 63, seg = id >> 6; *(LAS u32x4*)(Ks + t * 264 + seg * 8) = pk[i]; const unsigned kw[4] = {pk[i].x, pk[i].y, pk[i].z, pk[i].w}; \
              _Pragma("unroll") for (int e = 0; e < 4; ++e) { Kt[(seg * 8 + 2 * e) * 72 + t] = (bf16_t)(kw[e] & 0xffffu); Kt[(seg * 8 + 2 * e + 1) * 72 + t] = (bf16_t)(kw[e] >> 16); } } } \
        { const int t = tl & 63, seg = tl >> 6; const unsigned vw_[4] = {pv.x, pv.y, pv.z, pv.w}; \
            _Pragma("unroll") for (int e = 0; e < 4; ++e) { Vt[(seg * 8 + 2 * e) * 72 + t] = (bf16_t)(vw_[e] & 0xffffu); Vt[(seg * 8 + 2 * e + 1) * 72 + t] = (bf16_t)(vw_[e] >> 16); } } \
        if (wave == 7) { const float igb = F.in[I_MLIGB][layer * 8 + d * 4 + h], fgb = F.in[I_MLFGB][layer * 8 + d * 4 + h];     \
            float bc = logsigmoidf_(pgf + fgb); \
            _Pragma("unroll") for (int o = 1; o < 64; o <<= 1) { const float t = shup(bc, o, lane); if (lane >= o) bc += t; } \
            const float g_ = (pgi + igb) - bc; float pm = g_; \
            _Pragma("unroll") for (int o = 1; o < 64; o <<= 1) { const float t = shup(pm, o, lane); if (lane >= o) pm = fmaxf(pm, t); } \
            LAS float* gs_ = gsc + ((jj) & 1) * 192; gs_[lane] = g_; gs_[64 + lane] = pm; gs_[128 + lane] = bc; } } while (0)
    ML_LOAD(0);
    __syncthreads();
    ML_STAGE(0);
    ML_LOAD(1);
    __syncthreads();
    for (int j = 0; j < NCH; ++j) {
        const int rb = b * TB + nat_chunk(d, j) * 64;
        const LAS float* gg = gsc + (j & 1) * 192; const LAS float* pmx = gg + 64; const LAS float* bcm = gg + 128;
        const float a63 = fmaxf(m_prev, pmx[63]), decay = __expf(m_prev - a63), m_new = bcm[63] + a63;
        { const int tr = wave >> 1; float rp[4] = {0.f, 0.f, 0.f, 0.f};
#pragma unroll
          for (int u = 0; u < 2; ++u) { const int tc = (wave & 1) * 2 + u; f32x4 acc = (f32x4){0.f, 0.f, 0.f, 0.f};
              if (tc <= tr) {
#pragma unroll
                  for (int ks = 0; ks < 8; ++ks) acc = MFMA16(ldsA(Qs + (tr * 16 + l15) * 264 + ks * 32 + q * 8), ldsA(Ks + (tc * 16 + l15) * 264 + ks * 32 + q * 8), acc);
              }
              const int s = tc * 16 + l15; const float gs = gg[s];
#pragma unroll
              for (int i = 0; i < 4; ++i) { const int jr = tr * 16 + q * 4 + i; const float v = (s <= jr) ? acc[i] * __expf(gs - fmaxf(pmx[jr], m_prev)) : 0.f; St[jr * 72 + s] = f2bf(v); rp[i] += v; } }
#pragma unroll
          for (int i = 0; i < 4; ++i) { float s_ = rp[i]; s_ += shx<1>(s_); s_ += shx<2>(s_); s_ += shx<4>(s_); s_ += shx<8>(s_); if (l15 == 0) rsum[(wave & 1) * 64 + tr * 16 + q * 4 + i] = s_; } }
#pragma unroll
        for (int i = 0; i < 8; ++i) { const int id = tid + i * NTHR, dv = id >> 6, s = id & 63; Vw[dv * 72 + s] = f2bf(bf2f(Vt[dv * 72 + s]) * __expf(gg[s] - a63)); }
        if (tid < 64) wtsl[tid] = __expf(gg[tid] - a63);
        { const int row = tid >> 3, part = tid & 7; float qv = 0.f;
#pragma unroll
          for (int e8 = 0; e8 < 4; ++e8) { float x8[8]; unpack8(*(const LAS u32x4*)(Qs + row * 264 + part * 32 + e8 * 8), x8); const f32x4 n0 = *(const LAS f32x4*)(nvec + part * 32 + e8 * 8), n1 = *(const LAS f32x4*)(nvec + part * 32 + e8 * 8 + 4);
              qv += (x8[0] * n0[0] + x8[1] * n0[1]) + (x8[2] * n0[2] + x8[3] * n0[3]) + (x8[4] * n1[0] + x8[5] * n1[1]) + (x8[6] * n1[2] + x8[7] * n1[3]); }
          qv += shx<1>(qv); qv += shx<2>(qv); qv += shx<4>(qv);
          if (part == 0) qn[row] = qv; }
        __syncthreads();
        f32x4 acc[4], PXs[4];
#pragma unroll
        for (int rt = 0; rt < 4; ++rt) PXs[rt] = (f32x4){0.f, 0.f, 0.f, 0.f};
        { bf16x8 Cb[4];
#pragma unroll
          for (int kk = 0; kk < 4; ++kk) Cb[kk] = pack_8(Cst[2 * kk], Cst[2 * kk + 1]);
#pragma unroll
          for (int rt = 0; rt < 4; ++rt) { acc[rt] = (f32x4){0.f, 0.f, 0.f, 0.f};
#pragma unroll
              for (int kk = 0; kk < 4; ++kk) { const LAS bf16_t* qp = Qs + (rt * 16 + l15) * 264 + (p * 8 + 2 * kk) * 16 + q * 4; acc[rt] = MFMA16(lds_2x8(qp, qp + 16), Cb[kk], acc[rt]); } } }
        if (p == 1) {
#pragma unroll
            for (int rt = 0; rt < 4; ++rt) *(LAS f32x4*)(PX + ((y * 4 + rt) * 64 + lane) * 4) = acc[rt];
        } else {
#pragma unroll
            for (int rt = 0; rt < 4; ++rt) { f32x4 a2 = (f32x4){0.f, 0.f, 0.f, 0.f};
#pragma unroll
                for (int ks = 0; ks < 2; ++ks) a2 = MFMA16(ldsA(St + (rt * 16 + l15) * 72 + ks * 32 + q * 8), ldsA(Vt + (y * 16 + l15) * 72 + ks * 32 + q * 8), a2);
                PXs[rt] = a2; }
        }
        { const bf16x8 vw0 = ldsA(Vw + (y * 16 + l15) * 72 + q * 8), vw1 = ldsA(Vw + (y * 16 + l15) * 72 + 32 + q * 8);
          bf16x8 wq0, wq1; { const f32x4 a0 = *(const LAS f32x4*)(wtsl + q * 8), a1 = *(const LAS f32x4*)(wtsl + q * 8 + 4), b0 = *(const LAS f32x4*)(wtsl + 32 + q * 8), b1 = *(const LAS f32x4*)(wtsl + 32 + q * 8 + 4);
              const f32x4 zz = (f32x4){0.f, 0.f, 0.f, 0.f}; wq0 = l15 == 0 ? pack_8(a0, a1) : pack_8(zz, zz); wq1 = l15 == 0 ? pack_8(b0, b1) : pack_8(zz, zz); }
#pragma unroll
          for (int x = 0; x < 8; ++x) { Cst[x] *= decay; const LAS bf16_t* kp = Kt + ((p * 8 + x) * 16 + l15) * 72 + q * 8; const bf16x8 k0 = ldsA(kp), k1 = ldsA(kp + 32);
              Cst[x] = MFMA16(k0, vw0, Cst[x]); Cst[x] = MFMA16(k1, vw1, Cst[x]);
              if (x == 2 * y || x == 2 * y + 1) { const int dkb = (p * 8 + x) * 16 + q * 4; f32x4 nn = (f32x4){0.f, 0.f, 0.f, 0.f};
                  if (l15 == 0) { nn = *(const LAS f32x4*)(nvec + dkb); nn *= decay; }
                  nn = MFMA16(k0, wq0, nn); nn = MFMA16(k1, wq1, nn);
                  if (l15 == 0) *(LAS f32x4*)(nvec + dkb) = nn; } } }
        __syncthreads();
        if (p == 0) {
#pragma unroll
            for (int rt = 0; rt < 4; ++rt) { const f32x4 px = *(const LAS f32x4*)(PX + ((y * 4 + rt) * 64 + lane) * 4);
#pragma unroll
                for (int i = 0; i < 4; ++i) { const int t = rt * 16 + q * 4 + i; const float a_ = fmaxf(pmx[t], m_prev), si = __expf(m_prev - a_);
                    const float hd = fmaxf(fabsf(rsum[t] + rsum[64 + t] + si * qn[t]), __expf(-(bcm[t] + a_)));
                    const float num = (acc[rt][i] + px[i]) * si + PXs[rt][i];
                    const size_t row = (size_t)(rb + (d == 0 ? t : 63 - t));
                    HO[row * PW + d * 1024 + h * 256 + vs * 64 + y * 16 + l15] = f2bf(num * __builtin_amdgcn_rcpf(hd)); } }
        }
        if (j + 1 < NCH) { ML_STAGE(j + 1); if (j + 2 < NCH) ML_LOAD(j + 2); }
        m_prev = m_new;
        __syncthreads();
    }
#undef ML_LOAD
#undef ML_STAGE
}

__device__ __forceinline__ void ml_finish_rows(const Frame& F, int lane, int layer) {
    const bf16_t* P = (const bf16_t*)(F.ws + WS_P); bf16_t* ML = (bf16_t*)(F.ws + WS_SC + SC_ML);
    const float* ng = F.in[I_MLNG] + layer * 1024; const float* nb = F.in[I_MLNB] + layer * 1024;
    const int c0 = lane * 16, stride = F.G * NWAVE;
    for (int r0 = F.bid * NWAVE + F.wave; r0 < R; r0 += 4 * stride) {
        u32x4 ha[4][2], hb[4][2], ho[4][2];
#pragma unroll
        for (int u = 0; u < 4; ++u) { const int r = r0 + u * stride < R ? r0 + u * stride : r0; const bf16_t* pr = P + (size_t)r * PW;
#pragma unroll
            for (int hh = 0; hh < 2; ++hh) { ha[u][hh] = *(const u32x4*)(pr + c0 + hh * 8); hb[u][hh] = *(const u32x4*)(pr + 1024 + c0 + hh * 8); ho[u][hh] = *(const u32x4*)(pr + PC_O + c0 + hh * 8); } }
#pragma unroll
        for (int u = 0; u < 4; ++u) { const int r = r0 + u * stride; if (r < R) {
            float v[16], o[16];
#pragma unroll
            for (int hh = 0; hh < 2; ++hh) { float a8[8], b8[8], o8[8]; unpack8(ha[u][hh], a8); unpack8(hb[u][hh], b8); unpack8(ho[u][hh], o8);
#pragma unroll
                for (int e2 = 0; e2 < 8; ++e2) { v[hh * 8 + e2] = a8[e2] + b8[e2]; o[hh * 8 + e2] = o8[e2]; } }
            float s = 0.f;
#pragma unroll
            for (int e2 = 0; e2 < 16; ++e2) s += v[e2];
            s += shx<1>(s); s += shx<2>(s); s += shx<4>(s); s += shx<8>(s);
            const float mean = s * (1.0f / 256.0f); float qq = 0.f;
#pragma unroll
            for (int e2 = 0; e2 < 16; ++e2) { v[e2] -= mean; qq += v[e2] * v[e2]; }
            qq += shx<1>(qq); qq += shx<2>(qq); qq += shx<4>(qq); qq += shx<8>(qq);
            const float rstd = rsqrtf(qq * (1.0f / 256.0f) + 1e-6f);
            float y8[8];
#pragma unroll
            for (int hh = 0; hh < 2; ++hh) {
#pragma unroll
                for (int e2 = 0; e2 < 8; ++e2) { const int ee = hh * 8 + e2; y8[e2] = (v[ee] * rstd * ng[c0 + ee] + nb[c0 + ee]) * sigmoidf_(o[ee]); }
                st_op8(ML, (size_t)r * 1024 + c0 + hh * 8, y8); } } }
    }
}


__device__ __forceinline__ void tshift8(const bf16_t* P, size_t row, int srow, int col, const float* mu, float (&o)[8]) {
    float z[8], zp[8], zn[8];
    const bool hp = (srow != 0 && srow != CTXL), hn = (srow != CTXL - 1 && srow != TB - 1);
    const u32x4 wz = *(const u32x4*)(P + row * PW + col), wp = *(const u32x4*)(P + (hp ? row - 1 : row) * PW + col), wn = *(const u32x4*)(P + (hn ? row + 1 : row) * PW + col);
    const f32x4 m0 = *(const f32x4*)mu, m1 = *(const f32x4*)(mu + 4);
    unpack8(wz, z); unpack8(wp, zp); unpack8(wn, zn);
    const float fp = hp ? 0.5f : 0.f, fn = hn ? 0.5f : 0.f;
#pragma unroll
    for (int e = 0; e < 8; ++e) { const float m = e < 4 ? m0[e & 3] : m1[e & 3]; o[e] = z[e] + m * (fp * zp[e] + fn * zn[e] - z[e]); }
}
__device__ __forceinline__ void rwkv_item(const Frame& F, int tid, int layer, int item) {
    const int h = item & 15, b = (item >> 4) & 3, d = item >> 6;
    const int lane = tid & 63, wave = __builtin_amdgcn_readfirstlane(tid >> 6), l15 = lane & 15, q = lane >> 4;
    LAS float* r_ = (LAS float*)F.lds;
    LAS float* w_ = r_ + 4096, *kd_ = w_ + 4096, *kk_ = kd_ + 4096, *bb_ = kk_ + 4096, *v_ = bb_ + 4096;
    LAS bf16_t* TW = (LAS bf16_t*)(v_ + 4096);
    LAS bf16_t* TA = TW + 64 * 72;
    LAS bf16_t* WU = TA + 64 * 72;
    LAS bf16_t* AU = WU + 64 * 72;
    LAS float* yout = (LAS float*)TW;
    const bf16_t* P = (const bf16_t*)(F.ws + WS_P);
    bf16_t* YO = (bf16_t*)(F.ws + WS_SC + (d == 0 ? SC_RWF : SC_RWB));
    float* BON = (float*)(F.ws + WS_BONUS) + (size_t)d * R * 16;
    const float* mu = F.in[I_RWMU] + layer * 3456;
    {
        const int rr = tid >> 3, c0 = (tid & 7) * 8;
        const float* wu = F.in[I_RWWUP] + (((size_t)layer * 2 + d) * 64 + rr) * 1024 + h * 64 + c0; const float* au = F.in[I_RWAUP] + (((size_t)layer * 2 + d) * 64 + rr) * 1024 + h * 64 + c0;
#pragma unroll
        for (int e = 0; e < 8; ++e) { WU[(c0 + e) * 72 + rr] = f2bf(wu[e]); AU[(c0 + e) * 72 + rr] = f2bf(au[e]); }
    }
    const int t_ = tid >> 3, c0 = (tid & 7) * 8;
    float mur[8], muk[8], muv[8], muw[8], mua[8], kkc[8], kac[8], rkc[8];
#pragma unroll
    for (int e = 0; e < 8; ++e) { mur[e] = mu[h * 64 + c0 + e]; muk[e] = mu[1024 + h * 64 + c0 + e]; muv[e] = mu[2048 + h * 64 + c0 + e]; muw[e] = mu[3072 + d * 64 + c0 + e]; mua[e] = mu[3200 + d * 64 + c0 + e];
        kkc[e] = F.in[I_RWKK][layer * 1024 + h * 64 + c0 + e]; kac[e] = F.in[I_RWKA][layer * 1024 + h * 64 + c0 + e]; rkc[e] = F.in[I_RWRK][layer * 1024 + h * 64 + c0 + e]; }
    float S[8];
#pragma unroll
    for (int e = 0; e < 8; ++e) S[e] = 0.f;
    const int vrow = tid >> 3, cg = tid & 7;
    __syncthreads();
    for (int j = 0; j < NCH; ++j) {
        const int jn = nat_chunk(d, j); const int srow = jn * 64 + (d == 0 ? t_ : 63 - t_); const size_t row = (size_t)b * TB + srow;
        float rs[8], ks[8], vs[8], tmp[8];
        tshift8(P, row, srow, PC_RR + h * 64 + c0, mur, rs); tshift8(P, row, srow, PC_RK + h * 64 + c0, muk, ks); tshift8(P, row, srow, PC_RV + h * 64 + c0, muv, vs);
        tshift8(P, row, srow, PC_WD + d * 64 + c0, muw, tmp);
#pragma unroll
        for (int e = 0; e < 8; ++e) TW[t_ * 72 + c0 + e] = f2bf(tanhf_(tmp[e]));
        tshift8(P, row, srow, PC_AD + d * 64 + c0, mua, tmp);
#pragma unroll
        for (int e = 0; e < 8; ++e) TA[t_ * 72 + c0 + e] = f2bf(tmp[e]);
        float kkv[8], ss = 0.f;
#pragma unroll
        for (int e = 0; e < 8; ++e) { r_[t_ * 64 + c0 + e] = rs[e]; v_[t_ * 64 + c0 + e] = vs[e]; kkv[e] = ks[e] * kkc[e]; ss += kkv[e] * kkv[e]; }
        ss += shx<1>(ss); ss += shx<2>(ss); ss += shx<4>(ss);
        const float inv = 1.0f / fmaxf(sqrtf(ss), 1e-12f);
        __syncthreads();
        {
            const int tr = wave >> 1;
#pragma unroll
            for (int u = 0; u < 2; ++u) { const int tc = (wave & 1) * 2 + u; f32x4 aw = (f32x4){0.f, 0.f, 0.f, 0.f}, aa = aw;
#pragma unroll
                for (int kq = 0; kq < 2; ++kq) { aw = MFMA16(ldsA(TW + (tr * 16 + l15) * 72 + kq * 32 + q * 8), ldsA(WU + (tc * 16 + l15) * 72 + kq * 32 + q * 8), aw);
                    aa = MFMA16(ldsA(TA + (tr * 16 + l15) * 72 + kq * 32 + q * 8), ldsA(AU + (tc * 16 + l15) * 72 + kq * 32 + q * 8), aa); }
                const int c = tc * 16 + l15; const float w0 = F.in[I_RWW0][((size_t)layer * 2 + d) * 1024 + h * 64 + c], a0 = F.in[I_RWA0][((size_t)layer * 2 + d) * 1024 + h * 64 + c];
#pragma unroll
                for (int i = 0; i < 4; ++i) { const int t = tr * 16 + q * 4 + i; w_[t * 64 + c] = __expf(-0.6065306597126334f * sigmoidf_(w0 + aw[i])); bb_[t * 64 + c] = sigmoidf_(a0 + aa[i]); } }
        }
        __syncthreads();
        { float bon = 0.f;
#pragma unroll
          for (int e = 0; e < 8; ++e) { const float a = bb_[t_ * 64 + c0 + e]; const float kdv = ks[e] * (1.0f + (a - 1.0f) * kac[e]); const float kkn = kkv[e] * inv;
              kd_[t_ * 64 + c0 + e] = kdv; kk_[t_ * 64 + c0 + e] = kkn; bb_[t_ * 64 + c0 + e] = kkn * a; bon += rs[e] * kdv * rkc[e]; }
          bon += shx<1>(bon); bon += shx<2>(bon); bon += shx<4>(bon);
          if ((tid & 7) == 0) BON[row * 16 + h] = bon; }
        __syncthreads();
        for (int t = 0; t < 64; ++t) {
            const LAS f32x4* pk = (const LAS f32x4*)(kk_ + t * 64 + cg * 8); const LAS f32x4* pw = (const LAS f32x4*)(w_ + t * 64 + cg * 8);
            const LAS f32x4* pb = (const LAS f32x4*)(bb_ + t * 64 + cg * 8); const LAS f32x4* pd = (const LAS f32x4*)(kd_ + t * 64 + cg * 8); const LAS f32x4* pr = (const LAS f32x4*)(r_ + t * 64 + cg * 8);
            const f32x4 k0 = pk[0], k1 = pk[1], w0 = pw[0], w1 = pw[1], b0 = pb[0], b1 = pb[1], d0 = pd[0], d1 = pd[1], r0 = pr[0], r1 = pr[1];
            const float vv = v_[t * 64 + vrow];
            float skk = (S[0] * k0[0] + S[1] * k0[1]) + (S[2] * k0[2] + S[3] * k0[3]) + (S[4] * k1[0] + S[5] * k1[1]) + (S[6] * k1[2] + S[7] * k1[3]);
            skk += shx<1>(skk); skk += shx<2>(skk); skk += shx<4>(skk);
#pragma unroll
            for (int e = 0; e < 4; ++e) { S[e] = S[e] * w0[e] - skk * b0[e] + vv * d0[e]; S[4 + e] = S[4 + e] * w1[e] - skk * b1[e] + vv * d1[e]; }
            float y = (S[0] * r0[0] + S[1] * r0[1]) + (S[2] * r0[2] + S[3] * r0[3]) + (S[4] * r1[0] + S[5] * r1[1]) + (S[6] * r1[2] + S[7] * r1[3]);
            y += shx<1>(y); y += shx<2>(y); y += shx<4>(y);
            if (cg == 0) yout[t * 64 + vrow] = y;
        }
        __syncthreads();
        { float yv[8];
#pragma unroll
          for (int e = 0; e < 8; ++e) yv[e] = yout[t_ * 64 + c0 + e];
          u32x4 w; w.x = pk_bf16(yv[0], yv[1]); w.y = pk_bf16(yv[2], yv[3]); w.z = pk_bf16(yv[4], yv[5]); w.w = pk_bf16(yv[6], yv[7]);
          *(u32x4*)(YO + row * 1024 + h * 64 + c0) = w; }
        __syncthreads();
    }
}

#define MFMAF32(a, b, c) __builtin_amdgcn_mfma_f32_16x16x4f32((a), (b), (c), 0, 0, 0)
__device__ __forceinline__ f32x4 mm16(const f32x4 P, const f32x4 Y) {
    f32x4 acc = (f32x4){0.f, 0.f, 0.f, 0.f};
#pragma unroll
    for (int i = 0; i < 4; ++i) acc = MFMAF32(P[i], Y[i], acc);
    return acc;
}
__device__ __forceinline__ bf16x8 pack_lo4(const f32x4 x) { u32x4 w; w.x = pk_bf16(x[0], x[1]); w.y = pk_bf16(x[2], x[3]); w.z = 0u; w.w = 0u; bf16x8 r; __builtin_memcpy(&r, &w, 16); return r; }
__device__ __forceinline__ bf16x8 pack_hi4(const f32x4 x) { u32x4 w; w.x = 0u; w.y = 0u; w.z = pk_bf16(x[0], x[1]); w.w = pk_bf16(x[2], x[3]); bf16x8 r; __builtin_memcpy(&r, &w, 16); return r; }
#define WAVE_SYNC() do { asm volatile("s_waitcnt lgkmcnt(0)" ::: "memory"); __builtin_amdgcn_wave_barrier(); } while (0)
constexpr int RWC_WREG = 15360;
constexpr int RWC_R0 = 0, RWC_R1 = 2304, RWC_R2 = 4608, RWC_R3 = 6912, RWC_BK = 9216, RWC_V = 13312, RWC_NN = RWC_R1, RWC_TM = RWC_R1 + 1024, RWC_GL = RWC_R1 + 1536;
__device__ __forceinline__ void rwkvc_item(const Frame& F, int tid, int layer, int item) {
    const int h = item & 15, b = (item >> 4) & 3, d = item >> 6;
    const int lane = tid & 63, wave = __builtin_amdgcn_readfirstlane(tid >> 6), l15 = lane & 15, q = lane >> 4;
    LAS bf16_t* WU = (LAS bf16_t*)F.lds;
    LAS bf16_t* AU = WU + 64 * 72;
    LAS unsigned char* wreg0 = F.lds + 2 * 64 * 72 * 2;
    LAS unsigned char* wb = wreg0 + wave * RWC_WREG;
    LAS float* MUL = (LAS float*)(wreg0 + 8 * RWC_WREG);
    const bf16_t* P = (const bf16_t*)(F.ws + WS_P);
    bf16_t* YO = (bf16_t*)(F.ws + WS_SC + (d == 0 ? SC_RWF : SC_RWB));
    float* BON = (float*)(F.ws + WS_BONUS) + (size_t)d * R * 16;
    const float* mu = F.in[I_RWMU] + layer * 3456;
    if (tid < 320) { const int a = tid >> 6, c = tid & 63; const int off = a == 0 ? h * 64 : a == 1 ? 1024 + h * 64 : a == 2 ? 2048 + h * 64 : a == 3 ? 3072 + d * 64 : 3200 + d * 64; MUL[tid] = mu[off + c]; }
    {   const int rr = tid >> 3, c0 = (tid & 7) * 8;
        const float* wu = F.in[I_RWWUP] + (((size_t)layer * 2 + d) * 64 + rr) * 1024 + h * 64 + c0; const float* au = F.in[I_RWAUP] + (((size_t)layer * 2 + d) * 64 + rr) * 1024 + h * 64 + c0;
#pragma unroll
        for (int e = 0; e < 8; ++e) { WU[(c0 + e) * 72 + rr] = f2bf(wu[e]); AU[(c0 + e) * 72 + rr] = f2bf(au[e]); } }
    float kkc[4], kac[4], rkc[4], w0c[4], a0c[4];
#pragma unroll
    for (int ct = 0; ct < 4; ++ct) { const int c = h * 64 + ct * 16 + l15; kkc[ct] = F.in[I_RWKK][layer * 1024 + c]; kac[ct] = F.in[I_RWKA][layer * 1024 + c]; rkc[ct] = F.in[I_RWRK][layer * 1024 + c];
        w0c[ct] = F.in[I_RWW0][((size_t)layer * 2 + d) * 1024 + c]; a0c[ct] = F.in[I_RWA0][((size_t)layer * 2 + d) * 1024 + c]; }
    f32x4 Sacc[4];
#pragma unroll
    for (int x = 0; x < 4; ++x) Sacc[x] = (f32x4){0.f, 0.f, 0.f, 0.f};
    __syncthreads();
    for (int rnd = 0; rnd < NCH * 4 / 8; ++rnd) {
        {
            const int ch = rnd * 8 + wave, j64 = ch >> 2, jn = nat_chunk(d, j64), o0 = (ch & 3) * 16;
            LAS bf16_t* R0 = (LAS bf16_t*)(wb + RWC_R0); LAS bf16_t* R1 = (LAS bf16_t*)(wb + RWC_R1); LAS bf16_t* R2 = (LAS bf16_t*)(wb + RWC_R2); LAS bf16_t* R3 = (LAS bf16_t*)(wb + RWC_R3);
            LAS bf16_t* TAp = (LAS bf16_t*)(wb + RWC_BK); LAS bf16_t* BKT = (LAS bf16_t*)(wb + RWC_BK); LAS bf16_t* VF = (LAS bf16_t*)(wb + RWC_V);
            {
                const int t = lane >> 2, cq = (lane & 3) * 16; const int o = o0 + t; const int srow = jn * 64 + (d == 0 ? o : 63 - o); const size_t row = (size_t)b * TB + srow;
                const bool hp = (srow != 0 && srow != CTXL), hn = (srow != CTXL - 1 && srow != TB - 1); const float fp = hp ? 0.5f : 0.f, fn = hn ? 0.5f : 0.f;
                const bf16_t* pz = P + row * PW; const bf16_t* pp = P + (hp ? row - 1 : row) * PW; const bf16_t* pn = P + (hn ? row + 1 : row) * PW;
                const int colA[5] = {PC_RR + h * 64, PC_RK + h * 64, PC_RV + h * 64, PC_WD + d * 64, PC_AD + d * 64};
                u32x4 wz[5][2], wp[5][2], wn[5][2];
#pragma unroll
                for (int a = 0; a < 5; ++a)
#pragma unroll
                    for (int hh = 0; hh < 2; ++hh) { const int c = colA[a] + cq + hh * 8; wz[a][hh] = *(const u32x4*)(pz + c); wp[a][hh] = *(const u32x4*)(pp + c); wn[a][hh] = *(const u32x4*)(pn + c); }
                LAS bf16_t* dst[5] = {R0, R1, R2, R3, TAp};
#pragma unroll
                for (int a = 0; a < 5; ++a)
#pragma unroll
                    for (int hh = 0; hh < 2; ++hh) { const int cc = cq + hh * 8; float z[8], zp[8], zn[8], x8[8];
                        unpack8(wz[a][hh], z); unpack8(wp[a][hh], zp); unpack8(wn[a][hh], zn);
                        const f32x4 m0 = *(const LAS f32x4*)(MUL + a * 64 + cc), m1 = *(const LAS f32x4*)(MUL + a * 64 + cc + 4);
#pragma unroll
                        for (int e = 0; e < 8; ++e) { const float m = e < 4 ? m0[e & 3] : m1[e & 3]; x8[e] = z[e] + m * (fp * zp[e] + fn * zn[e] - z[e]); if (a == 3) x8[e] = tanhf_(x8[e]); }
                        u32x4 w; w.x = pk_bf16(x8[0], x8[1]); w.y = pk_bf16(x8[2], x8[3]); w.z = pk_bf16(x8[4], x8[5]); w.w = pk_bf16(x8[6], x8[7]); *(LAS u32x4*)(dst[a] + t * 72 + cc) = w; }
            }
            WAVE_SYNC();
            f32x4 lw[4], av[4];
            {   const bf16x8 tw0 = ldsA(R3 + l15 * 72 + q * 8), tw1 = ldsA(R3 + l15 * 72 + 32 + q * 8), ta0 = ldsA(TAp + l15 * 72 + q * 8), ta1 = ldsA(TAp + l15 * 72 + 32 + q * 8);
#pragma unroll
                for (int ct = 0; ct < 4; ++ct) { f32x4 aw = (f32x4){0.f, 0.f, 0.f, 0.f}, aa = aw;
                    aw = MFMA16(tw0, ldsA(WU + (ct * 16 + l15) * 72 + q * 8), aw); aw = MFMA16(tw1, ldsA(WU + (ct * 16 + l15) * 72 + 32 + q * 8), aw);
                    aa = MFMA16(ta0, ldsA(AU + (ct * 16 + l15) * 72 + q * 8), aa); aa = MFMA16(ta1, ldsA(AU + (ct * 16 + l15) * 72 + 32 + q * 8), aa);
#pragma unroll
                    for (int i = 0; i < 4; ++i) { lw[ct][i] = -0.6065306597126334f * sigmoidf_(w0c[ct] + aw[i]); av[ct][i] = sigmoidf_(a0c[ct] + aa[i]); } } }
            WAVE_SYNC();
            float ssq[4] = {0.f, 0.f, 0.f, 0.f};
#pragma unroll
            for (int ct = 0; ct < 4; ++ct)
#pragma unroll
                for (int i = 0; i < 4; ++i) { const float kk = bf2f(R1[(q * 4 + i) * 72 + ct * 16 + l15]) * kkc[ct]; ssq[i] += kk * kk; }
            float inv[4];
#pragma unroll
            for (int i = 0; i < 4; ++i) { float s = ssq[i]; s += shx<1>(s); s += shx<2>(s); s += shx<4>(s); s += shx<8>(s); inv[i] = 1.0f / fmaxf(sqrtf(s), 1e-12f); }
            float bon[4] = {0.f, 0.f, 0.f, 0.f};
            bf16x8 Apk[4];
            float glv[4];
#pragma unroll
            for (int ct = 0; ct < 4; ++ct) {
                f32x4 lg; lg[0] = lw[ct][0]; lg[1] = lg[0] + lw[ct][1]; lg[2] = lg[1] + lw[ct][2]; lg[3] = lg[2] + lw[ct][3];
                const float tot = lg[3];
                float x1 = tot; { const float t1 = shup(x1, 16, lane); if (q >= 1) x1 += t1; }
                float x2 = x1;  { const float t2 = shup(x1, 32, lane); if (q >= 2) x2 += t2; }
                const float excl = x2 - tot;
                const float lgL = __int_as_float(__builtin_amdgcn_ds_bpermute((48 + l15) << 2, __float_as_int(x2)));
                f32x4 At, Bh, Kh, vv; const float eex = __expf(excl), egL = __expf(lgL); float egprev = eex;
#pragma unroll
                for (int i = 0; i < 4; ++i) { const int idx = (q * 4 + i) * 72 + ct * 16 + l15; const float lgt = excl + lg[i];
                    const float rs = bf2f(R0[idx]), ks = bf2f(R1[idx]), vs = bf2f(R2[idx]); const float a = av[ct][i];
                    const float kkn = ks * kkc[ct] * inv[i], kd = ks * (1.0f + (a - 1.0f) * kac[ct]), beta = -kkn * a;
                    bon[i] += rs * kd * rkc[ct];
                    const float eg = __expf(lgt), egm = (i == 0) ? eex : egprev, ig = __builtin_amdgcn_rcpf(eg), gl = egL * ig; egprev = eg;
                    At[i] = kkn * egm; R0[idx] = f2bf(At[i]); R3[idx] = f2bf(rs * eg); R1[idx] = f2bf(beta * ig); R2[idx] = f2bf(kd * ig);
                    Bh[i] = beta * gl; Kh[i] = kd * gl; vv[i] = vs; }
                Apk[ct] = pack_lo4(At);
                { u32x2 w; w.x = pk_bf16(Bh[0], Bh[1]); w.y = pk_bf16(Bh[2], Bh[3]); *(LAS u32x2*)(BKT + (ct * 16 + l15) * 32 + q * 4) = w;
                  w.x = pk_bf16(Kh[0], Kh[1]); w.y = pk_bf16(Kh[2], Kh[3]); *(LAS u32x2*)(BKT + (ct * 16 + l15) * 32 + 16 + q * 4) = w;
                  w.x = pk_bf16(vv[0], vv[1]); w.y = pk_bf16(vv[2], vv[3]); *(LAS u32x2*)(VF + (ct * 64 + lane) * 4) = w; }
                glv[ct] = egL;
            }
#pragma unroll
            for (int i = 0; i < 4; ++i) { float s = bon[i]; s += shx<1>(s); s += shx<2>(s); s += shx<4>(s); s += shx<8>(s);
                if (l15 == 0) { const int o = o0 + q * 4 + i; const int srow = jn * 64 + (d == 0 ? o : 63 - o); BON[((size_t)b * TB + srow) * 16 + h] = s; } }
            WAVE_SYNC();
            f32x4 Mab = (f32x4){0.f, 0.f, 0.f, 0.f}, MabT = Mab, Mak = Mab, Nrb = Mab, Nrk = Mab;
#pragma unroll
            for (int kq = 0; kq < 2; ++kq) { const bf16x8 fa = ldsA(R0 + l15 * 72 + kq * 32 + q * 8), fr = ldsA(R3 + l15 * 72 + kq * 32 + q * 8), fb = ldsA(R1 + l15 * 72 + kq * 32 + q * 8), fk = ldsA(R2 + l15 * 72 + kq * 32 + q * 8);
                Mab = MFMA16(fa, fb, Mab); MabT = MFMA16(fb, fa, MabT); Mak = MFMA16(fa, fk, Mak); Nrb = MFMA16(fr, fb, Nrb); Nrk = MFMA16(fr, fk, Nrk); }
#pragma unroll
            for (int i = 0; i < 4; ++i) { const int rr_ = q * 4 + i; if (!(l15 < rr_)) { Mab[i] = 0.f; Mak[i] = 0.f; } if (!(rr_ < l15)) MabT[i] = 0.f; if (!(l15 <= rr_)) { Nrb[i] = 0.f; Nrk[i] = 0.f; } }
            f32x4 TT;
            {   f32x4 eye;
#pragma unroll
                for (int i = 0; i < 4; ++i) eye[i] = (q * 4 + i == l15) ? 1.0f : 0.0f;
                const f32x4 M2 = mm16(MabT, Mab), N2 = mm16(Mab, MabT);
                const f32x4 M4 = mm16(N2, M2), N4 = mm16(M2, N2);
                const f32x4 N8 = mm16(M4, N4);
                const f32x4 W1 = mm16(M4 + eye, N8 + eye);
                const f32x4 W2 = mm16(M2 + eye, W1);
                TT = mm16(Mab + eye, W2); }
            WAVE_SYNC();
            {   const bf16x8 Tp = pack_lo4(TT);
                LAS bf16_t* AH = R0; LAS bf16_t* NN = (LAS bf16_t*)(wb + RWC_NN); LAS bf16_t* TMm = (LAS bf16_t*)(wb + RWC_TM);
#pragma unroll
                for (int ct = 0; ct < 4; ++ct) { f32x4 ah = (f32x4){0.f, 0.f, 0.f, 0.f}; ah = MFMA16(Tp, Apk[ct], ah);
#pragma unroll
                    for (int i = 0; i < 4; ++i) AH[(q * 4 + i) * 72 + ct * 16 + l15] = f2bf(ah[i]); }
                f32x4 tm = (f32x4){0.f, 0.f, 0.f, 0.f}; tm = MFMA16(Tp, pack_lo4(Mak), tm);
#pragma unroll
                for (int i = 0; i < 4; ++i) { const int t = q * 4 + i; NN[t * 32 + l15] = f2bf(Nrb[i]); NN[t * 32 + 16 + l15] = f2bf(Nrk[i]); TMm[t * 16 + l15] = f2bf(tm[i]); }
                if (q == 0) {
#pragma unroll
                    for (int ct = 0; ct < 4; ++ct) ((LAS float*)(wb + RWC_GL))[ct * 16 + l15] = glv[ct]; } }
        }
        __syncthreads();
        if (wave < 4) {
            for (int c = 0; c < 8; ++c) {
                const LAS unsigned char* sb = wreg0 + c * RWC_WREG;
                const LAS bf16_t* AH = (const LAS bf16_t*)(sb + RWC_R0); const LAS bf16_t* RT = (const LAS bf16_t*)(sb + RWC_R3); const LAS bf16_t* BKT = (const LAS bf16_t*)(sb + RWC_BK);
                const LAS bf16_t* VF = (const LAS bf16_t*)(sb + RWC_V); const LAS bf16_t* NN = (const LAS bf16_t*)(sb + RWC_NN); const LAS bf16_t* TMm = (const LAS bf16_t*)(sb + RWC_TM); const LAS float* GL = (const LAS float*)(sb + RWC_GL);
                const bf16x8 Sb0 = pack_8(Sacc[0], Sacc[1]), Sb1 = pack_8(Sacc[2], Sacc[3]);
                const u32x2 vw = *(const LAS u32x2*)(VF + (wave * 64 + lane) * 4);
                bf16x8 V0; { u32x4 w; w.x = 0u; w.y = 0u; w.z = vw.x; w.w = vw.y; __builtin_memcpy(&V0, &w, 16); }
                bf16x8 TMf; { const u32x2 tq = *(const LAS u32x2*)(TMm + l15 * 16 + q * 4); u32x4 w; w.x = 0u; w.y = 0u; w.z = tq.x; w.w = tq.y; __builtin_memcpy(&TMf, &w, 16); }
                f32x4 U = (f32x4){0.f, 0.f, 0.f, 0.f};
                U = MFMA16(lds_2x8(AH + l15 * 72 + q * 4, AH + l15 * 72 + 16 + q * 4), Sb0, U);
                U = MFMA16(lds_2x8(AH + l15 * 72 + 32 + q * 4, AH + l15 * 72 + 48 + q * 4), Sb1, U);
                U = MFMA16(TMf, V0, U);
                bf16x8 UV; { u32x4 w; w.x = pk_bf16(U[0], U[1]); w.y = pk_bf16(U[2], U[3]); w.z = vw.x; w.w = vw.y; __builtin_memcpy(&UV, &w, 16); }
                f32x4 Y = (f32x4){0.f, 0.f, 0.f, 0.f};
                Y = MFMA16(lds_2x8(RT + l15 * 72 + q * 4, RT + l15 * 72 + 16 + q * 4), Sb0, Y);
                Y = MFMA16(lds_2x8(RT + l15 * 72 + 32 + q * 4, RT + l15 * 72 + 48 + q * 4), Sb1, Y);
                Y = MFMA16(lds_2x8(NN + l15 * 32 + q * 4, NN + l15 * 32 + 16 + q * 4), UV, Y);
#pragma unroll
                for (int x = 0; x < 4; ++x) { const f32x4 gl = *(const LAS f32x4*)(GL + x * 16 + q * 4); Sacc[x] *= gl;
                    Sacc[x] = MFMA16(lds_2x8(BKT + (x * 16 + l15) * 32 + q * 4, BKT + (x * 16 + l15) * 32 + 16 + q * 4), UV, Sacc[x]); }
                const int ch = rnd * 8 + c, j64 = ch >> 2, jn = nat_chunk(d, j64), o0 = (ch & 3) * 16;
#pragma unroll
                for (int i = 0; i < 4; ++i) { const int o = o0 + q * 4 + i; const int srow = jn * 64 + (d == 0 ? o : 63 - o);
                    YO[((size_t)b * TB + srow) * 1024 + h * 64 + wave * 16 + l15] = f2bf(Y[i]); }
            }
        }
        __syncthreads();
    }
}

__device__ __forceinline__ void rw_finish_item(const Frame& F, int tid, int layer, int it) {
    const int lane = tid & 63, wave = __builtin_amdgcn_readfirstlane(tid >> 6), l15 = lane & 15, q = lane >> 4;
    LAS bf16_t* GA = (LAS bf16_t*)F.lds;
    LAS float* mean_ = (LAS float*)(GA + 64 * 136);
    LAS float* rstd_ = mean_ + 1024, *bon_ = rstd_ + 1024;
    const bf16_t* P = (const bf16_t*)(F.ws + WS_P);
    bf16_t* YF = (bf16_t*)(F.ws + WS_SC + SC_RWF); const bf16_t* YB = (const bf16_t*)(F.ws + WS_SC + SC_RWB); void* RWO = (void*)(F.ws + WS_SC + SC_RWO);
    const float* BON = (const float*)(F.ws + WS_BONUS); const bf16_t* GUPT = (const bf16_t*)(F.ws + WS_GUPT);
    const float* mu = F.in[I_RWMU] + layer * 3456;
    const int hf = it & 1, it2 = it >> 1;
    const int b = it2 / NCH, jn = it2 - b * NCH; const size_t rb = (size_t)b * TB + jn * 64 + hf * 32; const int sb = jn * 64 + hf * 32;
    if (tid < 256) { const int t = tid >> 3, c0 = (tid & 7) * 16;
#pragma unroll
      for (int hh = 0; hh < 2; ++hh) { float m8[8], g8[8];
#pragma unroll
          for (int e = 0; e < 8; ++e) m8[e] = mu[3328 + c0 + hh * 8 + e];
          tshift8(P, rb + t, sb + t, PC_GD + c0 + hh * 8, m8, g8);
#pragma unroll
          for (int e = 0; e < 8; ++e) GA[t * 136 + c0 + hh * 8 + e] = f2bf(sigmoidf_(g8[e])); } }
    { const int p = tid, t = p >> 4, hd = p & 15; const size_t row = rb + t; float v[64]; float s = 0.f;
#pragma unroll
        for (int c8 = 0; c8 < 8; ++c8) { float a[8], bq[8]; unpack8(*(const u32x4*)(YF + row * 1024 + hd * 64 + c8 * 8), a); unpack8(*(const u32x4*)(YB + row * 1024 + hd * 64 + c8 * 8), bq);
#pragma unroll
            for (int e = 0; e < 8; ++e) { v[c8 * 8 + e] = a[e] + bq[e]; s += v[c8 * 8 + e]; } }
        const float mean = s * (1.0f / 64.0f); float qq = 0.f;
#pragma unroll
        for (int e = 0; e < 64; ++e) { const float dlt = v[e] - mean; qq += dlt * dlt; }
        mean_[t * 16 + hd] = mean; rstd_[t * 16 + hd] = rsqrtf(qq * (1.0f / 64.0f) + 64e-5f);
        bon_[t * 16 + hd] = BON[row * 16 + hd] + BON[((size_t)R + row) * 16 + hd]; }
    __syncthreads();
    const float* ng = F.in[I_RWNG] + layer * 1024; const float* nb = F.in[I_RWNB] + layer * 1024;
    for (int cc = 0; cc < 8; ++cc) { const int ct = wave * 8 + cc; const int c0 = ct * 16 + q * 4, hd = c0 >> 6;
        bf16x8 afr[4];
#pragma unroll
        for (int kq = 0; kq < 4; ++kq) afr[kq] = *(const bf16x8*)(GUPT + (size_t)(ct * 16 + l15) * 128 + kq * 32 + q * 8);
        const f32x4 muv = *(const f32x4*)(mu + 2048 + c0), ngc = *(const f32x4*)(ng + c0), nbc = *(const f32x4*)(nb + c0);
        u32x2 wf[2], wbk[2], wz[2], wp[2], wn[2]; float fpv[2], fnv[2];
#pragma unroll
        for (int rt = 0; rt < 2; ++rt) { const int t = rt * 16 + l15; const size_t row = rb + t; const int srow = sb + t;
            const bool hp = (srow != 0 && srow != CTXL), hn = (srow != CTXL - 1 && srow != TB - 1); fpv[rt] = hp ? 0.5f : 0.f; fnv[rt] = hn ? 0.5f : 0.f;
            wf[rt] = *(const u32x2*)(YF + row * 1024 + c0); wbk[rt] = *(const u32x2*)(YB + row * 1024 + c0);
            wz[rt] = *(const u32x2*)(P + row * PW + PC_RV + c0); wp[rt] = *(const u32x2*)(P + (hp ? row - 1 : row) * PW + PC_RV + c0); wn[rt] = *(const u32x2*)(P + (hn ? row + 1 : row) * PW + PC_RV + c0); }
#pragma unroll
        for (int rt = 0; rt < 2; ++rt) { f32x4 acc = (f32x4){0.f, 0.f, 0.f, 0.f};
#pragma unroll
            for (int kq = 0; kq < 4; ++kq) acc = MFMA16(afr[kq], ldsA(GA + (rt * 16 + l15) * 136 + kq * 32 + q * 8), acc);
            const int t = rt * 16 + l15; const size_t row = rb + t;
            const float fp = fpv[rt], fn = fnv[rt]; const float mean = mean_[t * 16 + hd], rstd = rstd_[t * 16 + hd], bon = bon_[t * 16 + hd];
            float o4[4];
#pragma unroll
            for (int i = 0; i < 4; ++i) { const unsigned sf = 16u;
                const unsigned uf = (i < 2 ? wf[rt].x : wf[rt].y), ub_ = (i < 2 ? wbk[rt].x : wbk[rt].y), uz = (i < 2 ? wz[rt].x : wz[rt].y), up = (i < 2 ? wp[rt].x : wp[rt].y), un = (i < 2 ? wn[rt].x : wn[rt].y);
                const float yf_ = (i & 1) ? __uint_as_float(uf & 0xffff0000u) : __uint_as_float(uf << sf), yb_ = (i & 1) ? __uint_as_float(ub_ & 0xffff0000u) : __uint_as_float(ub_ << sf);
                const float vz = (i & 1) ? __uint_as_float(uz & 0xffff0000u) : __uint_as_float(uz << sf), vp = (i & 1) ? __uint_as_float(up & 0xffff0000u) : __uint_as_float(up << sf), vn = (i & 1) ? __uint_as_float(un & 0xffff0000u) : __uint_as_float(un << sf);
                const float yn = (yf_ + yb_ - mean) * rstd * ngc[i] + nbc[i];
                const float vsft = vz + muv[i] * (fp * vp + fn * vn - vz);
                o4[i] = (yn + bon * vsft) * acc[i]; }
            st_op4(RWO, row * 1024 + c0, o4[0], o4[1], o4[2], o4[3]); }
    }
    __syncthreads();
}

__device__ __forceinline__ void phase_prep(const Frame& F, int layer) {
    const int tid = ltid();
    for (int it = F.bid; it < 64; it += F.G) s5_tables_item(F, tid, layer, it);
}
__device__ __forceinline__ void phase_gin(const Frame& F) {
    dense_gemm<0, false>(F, F.ws + WS_U, F.ws + WS_WIN, R, PW, 2048, F.ws + WS_P, nullptr, nullptr, PW);
}
__device__ __forceinline__ void phase_conv_s5a(const Frame& F, int layer) {
    const int tid = ltid(), lane = tid & 63;
    for (int it = F.bid; it < 528 + 144; it += F.G) { if (it < 528) conv_item(F, tid, layer, it); else s5a_wave_item(F, lane, (it - 528) * 8 + F.wave); }
}
__device__ __forceinline__ void phase_scan(const Frame& F, int layer) {
    const int tid = ltid();
    if (F.bid < 128) rwkvc_item(F, tid, layer, F.bid);
    else { if (F.bid < 192) { s5b_item(F, tid, layer, F.bid - 128); __syncthreads(); } mlstm_item(F, tid, layer, F.bid - 128); }
}
__device__ __forceinline__ void phase_fin(const Frame& F, int layer) {
    const int tid = ltid(), lane = tid & 63;
    for (int it = F.bid; it < 1056; it += F.G) rw_finish_item(F, tid, layer, it);
    for (int it = F.bid; it < 256; it += F.G) s5c_block_item(F, tid, it);
    ml_finish_rows(F, lane, layer);
}

#ifndef MK_ABL
#define MK_ABL 0
#endif
constexpr int NPH_LAYER = 19;
constexpr int NPH = 2 * NPH_LAYER;
__global__ void __launch_bounds__(NTHR, 2) mega_fwd(Args args) {
    extern __shared__ __attribute__((aligned(16))) unsigned char lds_raw[];
    Frame F; F.in = args.in; F.out = args.out; F.ws = args.ws; F.lds = (LAS unsigned char*)lds_raw;
    F.wave = __builtin_amdgcn_readfirstlane(threadIdx.x >> 6); F.G = gridDim.x; F.bid = blockIdx.x;
    volatile LAS unsigned* xbw = (volatile LAS unsigned*)(F.lds + LDS_BYTES - 16);
    if (threadIdx.x == 0) { xbw[0] = 0u; xbw[1] = 0u; xbw[2] = 0u; xbw[3] = 0u; }
    __syncthreads();
    const int lo = args.ph_lo, hi = args.ph_hi;
    const bool one_launch = (hi - lo) > 1;
    XcdBarrier bar; bar.bar = (unsigned*)(F.ws + WS_CTL) + CW_BAR; bar.x = 0; bar.st = xbw;
    if (one_launch) bar = xcd_barrier_post((unsigned*)(F.ws + WS_CTL) + CW_BAR, xbw);
#define IN(k) (lo <= (k) && (k) < hi)
#define SEAM(k) do { if (IN(k) && IN((k) + 1)) xcd_barrier(bar); } while (0)
#define TILE_SEAM() do { asm volatile("s_waitcnt vmcnt(0)" ::: "memory"); __syncthreads(); } while (0)
    bf16_t* const T1 = (bf16_t*)(F.ws + WS_T1); bf16_t* const T2 = (bf16_t*)(F.ws + WS_T2); bf16_t* const T1b = (bf16_t*)(F.ws + WS_SC + SC_RWF);     bf16_t* const Z = (bf16_t*)(F.ws + WS_Z); bf16_t* const MIX = (bf16_t*)(F.ws + WS_MIX);
    unsigned char* const Zop = F8 ? F.ws + WS_QK : F.ws + WS_Z;
    const unsigned char* const U = F.ws + WS_U; const unsigned char* const WG = F.ws + WS_WG; const unsigned char* const WML = F.ws + WS_WML;
    const unsigned char* const ML = F.ws + WS_SC + SC_ML; const unsigned char* const RWo = F.ws + WS_SC + SC_RWO; const unsigned char* const S5o = F.ws + WS_SC + SC_S5;
    for (int layer = 0; layer < 2; ++layer) {
        const int pb = layer * NPH_LAYER;
        const int rA = 0, rB = layer == 0 ? 32 : 0, rC = layer == 0 ? 64 : 0;
        if (IN(pb + 0)) { phase_prep(F, layer); if (layer == 0) phase_mods(F); phase_wprep(F, layer); }
        SEAM(pb + 0);
        if (IN(pb + 1)) { if (layer == 0) phase_ln1(F, layer); }
        if (layer == 0) SEAM(pb + 1);
        if (IN(pb + 2)) { phase_gin(F); }
        SEAM(pb + 2);
        if (IN(pb + 3)) { phase_conv_s5a(F, layer); }
        SEAM(pb + 3);
        if (IN(pb + 4)) { phase_scan(F, layer); }
        SEAM(pb + 4);
        if (IN(pb + 5)) { phase_fin(F, layer); }
        SEAM(pb + 5);
        if (IN(pb + 6)) { dense_gemm<0, false>(F, ML, WML, R, 2048, 1024, T1, nullptr, nullptr, 2048, layer == 1, rA); }
        TILE_SEAM();
        if (IN(pb + 8)) { dense_gemm<0, false>(F, RWo, WML + (size_t)1 * 2048 * 1024 * OPB, R, 2048, 1024, T1b, nullptr, nullptr, 2048, layer == 1, rB); }
        SEAM(pb + 8);
        if (IN(pb + 9)) { dense_gemm<6, false>(F, U, WG, R, 4096, 2048, Z, T1, T1b, 2048, layer == 1); }
        TILE_SEAM();
        if (IN(pb + 10)) { dense_gemm<5, false>(F, S5o, WML + (size_t)2 * 2048 * 1024 * OPB, R, 4096, 1024, T2, nullptr, nullptr, 2048, layer == 1); }
        SEAM(pb + 10);
        if (IN(pb + 12)) { dense_gemm<2, true>(F, U, WG + (size_t)4096 * 2048 * OPB, R, 2048, 2048, Zop, T2, Z, 2048, layer == 1, rC); }
        SEAM(pb + 12);
        if (IN(pb + 13)) { dense_gemm<0, false>(F, Zop, F.ws + WS_WOUT, R, 2048, 2048, MIX, nullptr, nullptr, 2048, layer == 1); }
        SEAM(pb + 13);
        if (IN(pb + 14)) { phase_post1_route(F, layer, true); }
        SEAM(pb + 14);
        if (IN(pb + 15)) { phase_gather(F, layer); }
        SEAM(pb + 15);
        if (IN(pb + 16)) { phase_moe_gemm(F, layer, 0); }
        SEAM(pb + 16);
        if (IN(pb + 17)) { phase_moe_gemm(F, layer, 1); }
        SEAM(pb + 17);
        if (IN(pb + 18)) { phase_post2_moe(F, layer, true); }
        SEAM(pb + 18);
    }
#undef IN
#undef SEAM
#undef TILE_SEAM
}

#ifndef MK_ONE_LAUNCH
#define MK_ONE_LAUNCH 1
#endif
extern "C" void kernel_launch(void* const* d_in, const int* in_sizes, int n_in, void* d_out, int out_size, void* d_ws, size_t ws_size, hipStream_t stream) {
    static int grid = 0;
    if (grid == 0) {
        if (n_in != N_IN || ws_size < WS_END) { fprintf(stderr, "kernel_launch: unexpected n_in %d / ws_size %zu (need %zu)\n", n_in, ws_size, (size_t)WS_END); grid = -1; return; }
        int dev = 0, cus = 0, per_cu = 0;
        if (hipGetDevice(&dev) != hipSuccess || hipDeviceGetAttribute(&cus, hipDeviceAttributeMultiprocessorCount, dev) != hipSuccess) { grid = -1; return; }
        if (hipFuncSetAttribute((const void*)mega_fwd, hipFuncAttributeMaxDynamicSharedMemorySize, LDS_BYTES) != hipSuccess) { fprintf(stderr, "kernel_launch: hipFuncSetAttribute failed\n"); grid = -1; return; }
        if (hipOccupancyMaxActiveBlocksPerMultiprocessor(&per_cu, (const void*)mega_fwd, NTHR, LDS_BYTES) != hipSuccess || per_cu < 1) { fprintf(stderr, "kernel_launch: occupancy query says %d\n", per_cu); }
        (void)hipGetLastError();
        grid = 256;
        if (cus != 256) fprintf(stderr, "kernel_launch: %d CUs, this kernel is laid out for 256\n", cus);
    }
    if (grid < 0) return;
    (void)hipMemsetAsync((char*)d_ws + WS_CTL, 0, CTL_BYTES, stream);
    Args a{};
    for (int i = 0; i < N_IN; ++i) a.in[i] = (const float*)d_in[i];
    a.out = (float*)d_out; a.ws = (unsigned char*)d_ws;
#if MK_ONE_LAUNCH
    a.ph_lo = 0; a.ph_hi = NPH;
    hipLaunchKernelGGL(mega_fwd, dim3(grid), dim3(NTHR), LDS_BYTES, stream, a);
#else
    for (int p = 0; p < NPH; ++p) { a.ph_lo = p; a.ph_hi = p + 1; hipLaunchKernelGGL(mega_fwd, dim3(grid), dim3(NTHR), LDS_BYTES, stream, a); }
#endif
}
```

```cpp
#include <hip/hip_runtime.h>
#include <stdint.h>
#include <stdio.h>

#define LAS __attribute__((address_space(3)))
typedef unsigned short bf16_t;
typedef short bf16x8 __attribute__((ext_vector_type(8)));
typedef float f32x4 __attribute__((ext_vector_type(4)));
typedef float f32x2 __attribute__((ext_vector_type(2)));
typedef unsigned u32x4 __attribute__((ext_vector_type(4)));
typedef unsigned u32x2 __attribute__((ext_vector_type(2)));

constexpr int D = 2048, NB = 4, SEQ = 8192, CTXL = 256, TB = SEQ + CTXL, R = NB * TB;
constexpr int NCH = TB / 64;
constexpr int PW = 8704;
constexpr int PC_Q = 0, PC_K = 1024, PC_V = 2048, PC_O = 3072, PC_IG = 4096, PC_FG = 4104, PC_RR = 4112, PC_RK = 5136, PC_RV = 6160,
              PC_WD = 7184, PC_AD = 7312, PC_GD = 7440, PC_S5 = 7568, PC_END = 8592;
constexpr int NTHR = 512, NWAVE = 8;
constexpr int LDS_BYTES = 163840;
constexpr float ALPHA = 1.4142135623730951f;
constexpr float LN_EPS = 1e-5f;

enum { I_X = 0, I_C, I_CTX, I_CCTX, I_ADAW, I_ADAB, I_WIN, I_MLCW, I_MLCB, I_MLIGB, I_MLFGB, I_MLNG, I_MLNB, I_MLPROJ, I_RWMU, I_RWW0, I_RWWUP, I_RWA0, I_RWAUP,
       I_RWGUP, I_RWKK, I_RWKA, I_RWRK, I_RWNG, I_RWNB, I_RWPROJ, I_S5LRE, I_S5LIM, I_S5LDT, I_S5BRE, I_S5BIM, I_S5CRE, I_S5CIM, I_S5D, I_S5WV, I_S5WG, I_WOUT,
       I_LN1G, I_LN1B, I_LN2G, I_LN2B, I_ROUTW, I_ROUTB, I_EWG, I_EWU, I_EWD, N_IN };

constexpr size_t al256(size_t x) { return (x + 255) & ~(size_t)255; }
constexpr size_t WS_CTL = 0, CTL_BYTES = 65536;
constexpr size_t WS_MODS = WS_CTL + CTL_BYTES;
constexpr size_t WS_ROUTE = al256(WS_MODS + 2 * 5 * 12288 * 4);
constexpr size_t WS_BONUS = al256(WS_ROUTE + (size_t)R * 8 * 4);
constexpr size_t WS_S5KC = al256(WS_BONUS + (size_t)2 * R * 16 * 4);
constexpr size_t WS_S5E = al256(WS_S5KC + (size_t)64 * 128 * 256 * 2);
constexpr size_t WS_S5F = al256(WS_S5E + (size_t)64 * 256 * 1024 * 2);
constexpr size_t WS_S5X = al256(WS_S5F + (size_t)64 * 1024 * 256 * 2);
constexpr size_t WS_GUPT = al256(WS_S5X + (size_t)64 * 528 * 256 * 4);
constexpr size_t WS_WIN = al256(WS_GUPT + (size_t)1024 * 128 * 2);
constexpr size_t WS_WG = al256(WS_WIN + (size_t)PW * D * 2);
constexpr size_t WS_WML = al256(WS_WG + (size_t)6144 * D * 2);
constexpr size_t WS_WOUT = al256(WS_WML + (size_t)4 * 2048 * 1024 * 2);
constexpr size_t WS_EGU = al256(WS_WOUT + (size_t)2048 * 2048 * 2);
constexpr size_t WS_EDN = al256(WS_EGU + (size_t)16 * 2048 * 2048 * 2);
constexpr size_t WS_P = al256(WS_EDN + (size_t)16 * 2048 * 1024 * 2);
constexpr size_t WS_U = al256(WS_P + (size_t)R * PW * 2);
constexpr size_t WS_QK = al256(WS_U + (size_t)R * D * 2);
constexpr size_t WS_SC = al256(WS_QK + (size_t)R * D * 2);
constexpr size_t SC_BYTES = (size_t)71680 * 2048 * 2;
constexpr size_t WS_XC = al256(WS_SC + SC_BYTES);
constexpr size_t WS_END = al256(WS_XC + (size_t)NB * CTXL * D * 4);
constexpr size_t WS_X1 = WS_P;
constexpr size_t WS_T1 = WS_P;
constexpr size_t WS_T2 = WS_P + (size_t)R * D * 2;
constexpr size_t WS_MIX = WS_P + (size_t)R * D * 4;
constexpr size_t WS_Z = WS_MIX + (size_t)R * D * 2;
static_assert(WS_Z + (size_t)R * D * 2 <= WS_U, "P-region aliases overflow");
static_assert(WS_END <= 1633652928ull, "workspace too large");

constexpr int CW_BAR = 0;
constexpr int CW_ECNT = 4096;

__device__ __forceinline__ float bf2f(bf16_t b) { return __uint_as_float(((unsigned)b) << 16); }
typedef __bf16 bf16x2_t __attribute__((ext_vector_type(2)));
__device__ __forceinline__ unsigned pk_bf16(float lo, float hi) { const f32x2 v = {lo, hi}; const bf16x2_t r = __builtin_convertvector(v, bf16x2_t); unsigned u; __builtin_memcpy(&u, &r, 4); return u; }
constexpr bool F8 = true;
constexpr int OPB = F8 ? 1 : 2;
constexpr float W8_SCALE = 64.0f;
typedef int v8i __attribute__((ext_vector_type(8)));
typedef int v4i __attribute__((ext_vector_type(4)));
__device__ __forceinline__ float clamp8(float x) { return fminf(fmaxf(x, -448.0f), 448.0f); }
__device__ __forceinline__ unsigned pk4_fp8(float a, float b, float c, float d) { int w = 0; w = __builtin_amdgcn_cvt_pk_fp8_f32(clamp8(a), clamp8(b), w, false); w = __builtin_amdgcn_cvt_pk_fp8_f32(clamp8(c), clamp8(d), w, true); return (unsigned)w; }
__device__ __forceinline__ bf16_t f2bf(float f) { return (bf16_t)(pk_bf16(f, 0.f) & 0xffffu); }
__device__ __forceinline__ float sigmoidf_(float x) { return __builtin_amdgcn_rcpf(1.0f + __expf(-x)); }
__device__ __forceinline__ float tanhf_(float x) { return 1.0f - 2.0f * __builtin_amdgcn_rcpf(1.0f + __expf(2.0f * x)); }
__device__ __forceinline__ void unpack8(const u32x4 p, float (&o)[8]) { const unsigned w[4] = {p.x, p.y, p.z, p.w};
#pragma unroll
    for (int e = 0; e < 4; ++e) { o[2 * e] = __uint_as_float(w[e] << 16); o[2 * e + 1] = __uint_as_float(w[e] & 0xffff0000u); } }
__device__ __forceinline__ void st_op4(void* base, size_t ei, float a, float b, float c, float d) {
    if (F8) *(unsigned*)((char*)base + ei) = pk4_fp8(a, b, c, d);
    else { u32x2 w; w.x = pk_bf16(a, b); w.y = pk_bf16(c, d); *(u32x2*)((char*)base + ei * 2) = w; } }
__device__ __forceinline__ void st_op8(void* base, size_t ei, const float (&v)[8]) {
    if (F8) { u32x2 w; w.x = pk4_fp8(v[0], v[1], v[2], v[3]); w.y = pk4_fp8(v[4], v[5], v[6], v[7]); *(u32x2*)((char*)base + ei) = w; }
    else { u32x4 w; w.x = pk_bf16(v[0], v[1]); w.y = pk_bf16(v[2], v[3]); w.z = pk_bf16(v[4], v[5]); w.w = pk_bf16(v[6], v[7]); *(u32x4*)((char*)base + ei * 2) = w; } }
__device__ __forceinline__ void st_op1(void* base, size_t ei, float a) {
    if (F8) ((unsigned char*)base)[ei] = (unsigned char)(pk4_fp8(a, 0.f, 0.f, 0.f) & 0xffu);
    else ((bf16_t*)base)[ei] = f2bf(a); }
__device__ __forceinline__ float siluf_(float x) { return x * sigmoidf_(x); }
template <int M> __device__ __forceinline__ float shx(float v) { return __int_as_float(__builtin_amdgcn_ds_swizzle(__float_as_int(v), 0x1f | (M << 10))); }
__device__ __forceinline__ float shx32(float v, int lane) { return __int_as_float(__builtin_amdgcn_ds_bpermute((lane ^ 32) << 2, __float_as_int(v))); }
__device__ __forceinline__ float shup(float v, int o, int lane) { return __int_as_float(__builtin_amdgcn_ds_bpermute((lane - o) << 2, __float_as_int(v))); }
__device__ __forceinline__ float rdlane(float v, int l) { return __int_as_float(__builtin_amdgcn_readlane(__float_as_int(v), l)); }
__device__ __forceinline__ float wave_sum(float v, int lane) {
    v += shx32(v, lane); v += shx<16>(v); v += shx<8>(v); v += shx<4>(v); v += shx<2>(v); v += shx<1>(v);
    return v;
}

#define XB_TMO      128
#define XB_XCNT(j)  (256  + 64 * (j))
#define XB_XSUB(j)  (1280 + 64 * (j))
#define XB_XGEN(j)  (2304 + 64 * (j))
#define XB_TOP      3328
#define XB_TOPGEN   3392
#define XCD_BAR_WORDS 3456
#define XB_SPIN_CAP (1u << 18)
__device__ __forceinline__ unsigned xb_ld(unsigned* p)              { return __hip_atomic_load(p, __ATOMIC_RELAXED, __HIP_MEMORY_SCOPE_AGENT); }
__device__ __forceinline__ unsigned xb_add(unsigned* p, unsigned v) { return __hip_atomic_fetch_add(p, v, __ATOMIC_RELAXED, __HIP_MEMORY_SCOPE_AGENT); }
__device__ __forceinline__ unsigned xb_xcc_id() { return (unsigned)__builtin_amdgcn_s_getreg((3 << 11) | 20) & 0xFu; }
#define XB_SPIN(cond, bar) do { unsigned _sp = 0; while (cond) { __builtin_amdgcn_s_sleep(1); \
    if ((++_sp & 255u) == 0u) { if (xb_ld(&(bar)[XB_TMO])) break; if (_sp > XB_SPIN_CAP) { atomicAdd(&(bar)[XB_TMO], 1u); break; } } } } while (0)
struct XcdBarrier { unsigned* bar; unsigned x; volatile LAS unsigned* st; };
__device__ __forceinline__ XcdBarrier xcd_barrier_post(unsigned* bar, volatile LAS unsigned* st) {
    XcdBarrier b; b.bar = bar; b.x = xb_xcc_id(); b.st = st;
    if (threadIdx.x == 0) (void)xb_add(&bar[XB_XCNT(b.x)], 1u);
    return b;
}
__device__ __forceinline__ void xcd_barrier_complete(unsigned* bar, unsigned x, unsigned& nloc, unsigned& nx) {
    const unsigned G = gridDim.x * gridDim.y * gridDim.z;
    unsigned sum, cnt, mine, sp = 0u;
    for (;;) {
        sum = 0u; cnt = 0u; mine = 0u;
#pragma unroll
        for (unsigned j = 0; j < 16; ++j) { const unsigned c = xb_ld(&bar[XB_XCNT(j)]); sum += c; cnt += (c > 0u) ? 1u : 0u; mine = (j == x) ? c : mine; }
        if (sum == G) break;
        __builtin_amdgcn_s_sleep(1);
        if ((++sp & 255u) == 0u) { if (xb_ld(&bar[XB_TMO])) break; if (sp > XB_SPIN_CAP) { atomicAdd(&bar[XB_TMO], 1u); break; } }
    }
    nloc = mine > 0u ? mine : 1u; nx = cnt > 0u ? cnt : 1u;
}
__device__ __forceinline__ void xcd_barrier(const XcdBarrier& b) {
    asm volatile("s_waitcnt vmcnt(0)" ::: "memory");
    __syncthreads();
    if (threadIdx.x == 0) {
        unsigned* bar = b.bar;
        __builtin_amdgcn_s_waitcnt(0);
        unsigned nloc = b.st[0], nx = b.st[1];
        if (nloc == 0u) { xcd_barrier_complete(bar, b.x, nloc, nx); b.st[0] = nloc; b.st[1] = nx; }
        const unsigned old = xb_add(&bar[XB_XSUB(b.x)], 1u);
        const unsigned gen = old / nloc;
        if (old + 1u == (gen + 1u) * nloc) {
            __builtin_amdgcn_fence(__ATOMIC_RELEASE, "agent");
            asm volatile("s_waitcnt vmcnt(0)" ::: "memory");
            const unsigned og = xb_add(&bar[XB_TOP], 1u);
            const unsigned tg = og / nx;
            if (og + 1u == (tg + 1u) * nx) xb_add(&bar[XB_TOPGEN], 1u);
            else XB_SPIN(xb_ld(&bar[XB_TOPGEN]) == tg, bar);
            __builtin_amdgcn_fence(__ATOMIC_ACQUIRE, "agent");
            xb_add(&bar[XB_XGEN(b.x)], 1u);
            asm volatile("s_waitcnt vmcnt(0)" ::: "memory");
        } else {
            XB_SPIN(xb_ld(&bar[XB_XGEN(b.x)]) == gen, bar);
            __builtin_amdgcn_fence(__ATOMIC_ACQUIRE, "agent");
            asm volatile("s_waitcnt vmcnt(0)" ::: "memory");
        }
    }
    __syncthreads();
}

struct Args { const float* in[N_IN]; float* out; unsigned char* ws; int ph_lo, ph_hi; };
struct Frame {
    const float* const* in; float* out; unsigned char* ws; LAS unsigned char* lds;
    int wave, G, bid;
};
__device__ __forceinline__ int ltid_(int wave) { int l; asm volatile("v_mbcnt_lo_u32_b32 %0, -1, 0\n\tv_mbcnt_hi_u32_b32 %0, -1, %0" : "=v"(l)); return wave * 64 + l; }
#define ltid() ltid_(F.wave)

__device__ __forceinline__ const float* xin_row(const Frame& F, int layer, int r) {
    const int b = r / TB, s = r - b * TB;
    if (s < CTXL) return (layer == 0 ? F.in[I_CTX] : (const float*)(F.ws + WS_XC)) + ((size_t)b * CTXL + s) * D;
    return (layer == 0 ? F.in[I_X] : (const float*)F.out) + ((size_t)b * SEQ + (s - CTXL)) * D;
}
__device__ __forceinline__ float* xout_row(const Frame& F, int r) {
    const int b = r / TB, s = r - b * TB;
    if (s < CTXL) return (float*)(F.ws + WS_XC) + ((size_t)b * CTXL + s) * D;
    return F.out + ((size_t)b * SEQ + (s - CTXL)) * D;
}

__device__ __forceinline__ void phase_mods(const Frame& F) {
    const int tid = ltid(), lane = tid & 63; (void)lane;
    LAS float* sc = (LAS float*)F.lds;
    LAS float* red = (LAS float*)(F.lds + 5 * 2048 * 4);
    float* mods = (float*)(F.ws + WS_MODS);
    for (int i = tid; i < 5 * 2048; i += NTHR) { const int r = i >> 11, k = i & 2047; const float v = r < 4 ? F.in[I_C][r * 2048 + k] : F.in[I_CCTX][k]; sc[i] = siluf_(v); }
    __syncthreads();
    for (int it = F.bid; it < 2 * 96; it += F.G) {
        const int l = it / 96, cg = it - l * 96, c4 = (tid & 31) * 4, ks = tid >> 5;
        const float* w = F.in[I_ADAW] + (size_t)l * 2048 * 12288 + cg * 128 + c4;
        f32x4 a0 = (f32x4){0.f, 0.f, 0.f, 0.f}, a1 = a0, a2 = a0, a3 = a0, a4 = a0;
#pragma unroll 8
        for (int k = ks; k < 2048; k += 16) { const f32x4 wv = *(const f32x4*)(w + (size_t)k * 12288); a0 += sc[k] * wv; a1 += sc[2048 + k] * wv; a2 += sc[4096 + k] * wv; a3 += sc[6144 + k] * wv; a4 += sc[8192 + k] * wv; }
        *(LAS f32x4*)(red + (ks * 5 + 0) * 128 + c4) = a0; *(LAS f32x4*)(red + (ks * 5 + 1) * 128 + c4) = a1; *(LAS f32x4*)(red + (ks * 5 + 2) * 128 + c4) = a2;
        *(LAS f32x4*)(red + (ks * 5 + 3) * 128 + c4) = a3; *(LAS f32x4*)(red + (ks * 5 + 4) * 128 + c4) = a4;
        __syncthreads();
        for (int i = tid; i < 5 * 128; i += NTHR) { const int r = i >> 7, cc = i & 127; float s = 0.f;
#pragma unroll
            for (int s16 = 0; s16 < 16; ++s16) s += red[(s16 * 5 + r) * 128 + cc];
            mods[((size_t)l * 5 + r) * 12288 + cg * 128 + cc] = s + F.in[I_ADAB][l * 12288 + cg * 128 + cc]; }
        __syncthreads();
    }
}

__device__ __forceinline__ void phase_ln1(const Frame& F, int layer) {
    const int tid = ltid(), lane = tid & 63; (void)lane;
    const float* mods = (const float*)(F.ws + WS_MODS) + (size_t)layer * 5 * 12288;
    bf16_t* U = (bf16_t*)(F.ws + WS_U);
    const int stride = F.G * NWAVE; f32x4 xq[8];
    { const float* x = xin_row(F, layer, F.bid * NWAVE + F.wave);
#pragma unroll
      for (int i = 0; i < 8; ++i) xq[i] = *(const f32x4*)(x + (i * 64 + lane) * 4); }
    for (int r = F.bid * NWAVE + F.wave; r < R; r += stride) {
        const int b = r / TB, s = r - b * TB; const float* md = mods + (size_t)(s < CTXL ? 4 : b) * 12288;
        f32x4 v[8]; float sum = 0.f;
#pragma unroll
        for (int i = 0; i < 8; ++i) { v[i] = xq[i]; sum += (v[i][0] + v[i][1]) + (v[i][2] + v[i][3]); }
        { const float* xn = xin_row(F, layer, r + stride < R ? r + stride : r);
#pragma unroll
          for (int i = 0; i < 8; ++i) xq[i] = *(const f32x4*)(xn + (i * 64 + lane) * 4); }
        const float mean = wave_sum(sum, lane) * (1.0f / D); float q = 0.f;
#pragma unroll
        for (int i = 0; i < 8; ++i) { v[i] -= mean; q += (v[i][0] * v[i][0] + v[i][1] * v[i][1]) + (v[i][2] * v[i][2] + v[i][3] * v[i][3]); }
        const float rstd = rsqrtf(wave_sum(q, lane) * (1.0f / D) + LN_EPS);
#pragma unroll
        for (int i = 0; i < 8; ++i) { const int e = (i * 64 + lane) * 4; const f32x4 sh = *(const f32x4*)(md + e), scl = *(const f32x4*)(md + 2048 + e);
            const f32x4 u = v[i] * rstd * (scl + 1.0f) + sh; st_op4(U, (size_t)r * D + e, u[0], u[1], u[2], u[3]); }
    }
}

namespace pg8 {
constexpr int BM = 256, BK = 64, HALF = 128, HTB = HALF * BK * 2, STAGE_BYTES = 8 * HTB, NXCD = 8, WGM = 8;
__host__ __device__ __forceinline__ int lds_byte(int r, int c) { const int st = (r >> 4) * 2 + (c >> 5), rr = r & 15, cc = c & 31, ob = rr * 64 + cc * 2; return st * 1024 + (ob ^ (((ob >> 9) & 1) << 5)); }
__host__ __device__ __forceinline__ void stage_rc(int b, int& Rr, int& C) { const int st = b / 1024, sb = b % 1024, swz = sb ^ (((sb >> 9) & 1) << 5); Rr = (st >> 1) * 16 + swz / 64; C = (st & 1) * 32 + (swz % 64) / 2; }
__host__ __device__ __forceinline__ int perm32(int rho) { const int n = rho >> 4, i = rho & 15; return 8 * (i >> 2) + 4 * n + (i & 3); }
struct Unit { int pm, pn; };
struct Gemm { const bf16_t* A; const bf16_t* Bt; int lda, ldb, K; };
struct StaticOrder {
    int nM, nN, nwg, G, c, skipctx;
    __device__ void init(int M, int N, int G_, int c_, int skipctx_ = 0) { nM = M / BM; nN = N / BM; nwg = nM * nN; G = G_; c = c_; skipctx = skipctx_; }
    __device__ bool next(int i, Unit& u) const {
        const long L = (long)i * G + c; if (L >= nwg) return false;
        int wgid = (int)L; { const int q = nwg / NXCD, r = nwg % NXCD, xcd = wgid % NXCD, off = wgid / NXCD; wgid = (xcd < r ? xcd * (q + 1) : r * (q + 1) + (xcd - r) * q) + off; }
        const int nig = WGM * nN, gid = wgid / nig, fm = gid * WGM, gsz = (nM - fm) < WGM ? (nM - fm) : WGM;
        u.pm = fm + ((wgid % nig) % gsz); u.pn = (wgid % nig) / gsz;
        if (skipctx) u.pm += (u.pm >> 5) + 1;
        return true;
    }
};
struct GroupedOrder {
    const LAS int* ts; int nN, G, c;
    __device__ bool next(int i, Unit& u) const {
        const int L = i * G + c; const int tot = __builtin_amdgcn_readfirstlane(ts[16]) * nN; if (L >= tot) return false;
        const int pm = L / nN, pl = L - pm * nN; int e = 0;
#pragma unroll 1
        for (int j = 1; j < 16; ++j) e += (pm >= ts[j]) ? 1 : 0;
        u.pm = __builtin_amdgcn_readfirstlane(pm); u.pn = __builtin_amdgcn_readfirstlane(e * nN + pl); return true;
    }
};
__device__ __forceinline__ unsigned cvt_pk_bf16(float lo, float hi) { return pk_bf16(lo, hi); }
__device__ __forceinline__ float fsig(float x) { return __builtin_amdgcn_rcpf(1.0f + __expf(-x)); }
template <int MODE, bool O8> struct Epi {
    static constexpr bool PERM = true; static constexpr float ASC = F8 ? 1.0f / W8_SCALE : 1.0f;
    void* O; const bf16_t* X; const bf16_t* Zin; int ldc; int pn_mod;
    __device__ __forceinline__ void put8(size_t ei, const float (&h)[8]) const {
        if (O8) st_op8(O, ei, h);
        else { u32x4 w; w.x = cvt_pk_bf16(h[0], h[1]); w.y = cvt_pk_bf16(h[2], h[3]); w.z = cvt_pk_bf16(h[4], h[5]); w.w = cvt_pk_bf16(h[6], h[7]); *(u32x4*)((bf16_t*)O + ei) = w; } }
    __device__ __forceinline__ void operator()(const f32x4 (&acc)[2][2][4][2], const Unit& u, int wr, int wc, int fr, int fq) const {
        const int row0 = u.pm * BM + wr * 64 + fr; const int pnl = u.pn % pn_mod;
        if (MODE == 4 || MODE == 5 || MODE == 6) {
            const int col0 = pnl * HALF + wc * 32 + 8 * fq;
            u32x4 xw6[2][4], zw6[2][4];
            if (MODE == 6) {
#pragma unroll
                for (int ai = 0; ai < 2; ++ai)
#pragma unroll
                    for (int m = 0; m < 4; ++m) { const size_t ei = (size_t)(row0 + ai * HALF + m * 16) * ldc + col0; xw6[ai][m] = *(const u32x4*)(X + ei); zw6[ai][m] = *(const u32x4*)(Zin + ei); }
            }
#pragma unroll
            for (int ai = 0; ai < 2; ++ai)
#pragma unroll
                for (int m = 0; m < 4; ++m) { const size_t ei = (size_t)(row0 + ai * HALF + m * 16) * ldc + col0;
                    const f32x4 g0 = acc[ai][0][m][0], g1 = acc[ai][0][m][1], u0 = acc[ai][1][m][0], u1 = acc[ai][1][m][1]; float h[8];
                    float xa[8], xb[8]; if (MODE == 6) { unpack8(xw6[ai][m], xa); unpack8(zw6[ai][m], xb); }
#pragma unroll
                    for (int j = 0; j < 4; ++j) { const float ga = g0[j] * ASC, gb = g1[j] * ASC;
                        if (MODE == 4) { h[j] = ga * fsig(ga) * (u0[j] * ASC); h[4 + j] = gb * fsig(gb) * (u1[j] * ASC); }
                        else if (MODE == 5) { h[j] = ga * fsig(u0[j] * ASC); h[4 + j] = gb * fsig(u1[j] * ASC); }
                        else { h[j] = fsig(ga) * xa[j] + fsig(u0[j] * ASC) * xb[j]; h[4 + j] = fsig(gb) * xa[4 + j] + fsig(u1[j] * ASC) * xb[4 + j]; } }
                    put8(ei, h); }
        } else {
            const int col0 = pnl * BM + wc * 32 + 8 * fq;
#pragma unroll
            for (int ai = 0; ai < 2; ++ai)
#pragma unroll
              for (int mh = 0; mh < 2; ++mh) {
                u32x4 xw[2][2], zw[2][2];
                if (MODE == 1 || MODE == 2) {
#pragma unroll
                    for (int m2 = 0; m2 < 2; ++m2)
#pragma unroll
                        for (int bj = 0; bj < 2; ++bj) { const size_t ro = (size_t)(row0 + ai * HALF + (mh * 2 + m2) * 16) * ldc + col0 + bj * HALF;
                            xw[m2][bj] = *(const u32x4*)(X + ro); if (MODE == 2) zw[m2][bj] = *(const u32x4*)(Zin + ro); }
                }
#pragma unroll
                for (int m2 = 0; m2 < 2; ++m2) { const int m = mh * 2 + m2; const size_t ro = (size_t)(row0 + ai * HALF + m * 16) * ldc + col0;
#pragma unroll
                    for (int bj = 0; bj < 2; ++bj) { const f32x4 v0 = acc[ai][bj][m][0], v1 = acc[ai][bj][m][1]; float h[8];
#pragma unroll
                        for (int j = 0; j < 4; ++j) { h[j] = v0[j] * ASC; h[4 + j] = v1[j] * ASC; }
                        if (MODE == 1 || MODE == 2) { float x8[8]; unpack8(xw[m2][bj], x8);
#pragma unroll
                            for (int j = 0; j < 8; ++j) h[j] = fsig(h[j]) * x8[j];
                            if (MODE == 2) { float z8[8]; unpack8(zw[m2][bj], z8);
#pragma unroll
                                for (int j = 0; j < 8; ++j) h[j] += z8[j]; } }
                        put8(ro + bj * HALF, h); } }
              }
        }
    }
};

template <class EpiT, class Sched>
__device__ __forceinline__ void gemm_phase(LAS unsigned char* lds, const Gemm g, const Sched& S, const EpiT& E, int wave_id) {
    const int tid = ltid_(wave_id), wid = __builtin_amdgcn_readfirstlane(tid >> 6), lane = tid & 63, wr = wid >> 2, wc = wid & 3, fr = lane & 15, fq = lane >> 4;
    const int K = g.K, nt = K / BK;
    unsigned voffA[2], voffB[2];
#pragma unroll
    for (int i = 0; i < 2; ++i) { int Rr, C; stage_rc(tid * 16 + i * 8192, Rr, C); const int Rb = EpiT::PERM ? ((Rr & ~31) + perm32(Rr & 31)) : Rr;
        voffA[i] = (unsigned)(Rr * g.lda + C) * 2u; voffB[i] = (unsigned)(Rb * g.ldb + C) * 2u; }
    const size_t kstep = (size_t)(BK * 2);
    const size_t hstepA = (size_t)HALF * g.lda * 2, hstepB = (size_t)HALF * g.ldb * 2;
    const size_t tstepA = 2 * hstepA, tstepB = 2 * hstepB;
    const unsigned ldsw = (unsigned)wid * 1024u;
    const int aoff = lds_byte(wr * 64 + fr, fq * 8), boff = lds_byte(wc * 32 + fr, fq * 8);
#define PG8_SA(b, h) (((b) * 2 + (h)) * HTB)
#define PG8_SB(b, h) ((4 + (b) * 2 + (h)) * HTB)
#define PG8_STAGE(bufoff, gbase, voff) do { _Pragma("unroll") for (int _i = 0; _i < 2; ++_i) \
        __builtin_amdgcn_global_load_lds((const unsigned*)((const char*)(gbase) + (voff)[_i]), (LAS unsigned*)(lds + (bufoff) + ldsw + _i * 8192), 16, 0, 0); } while (0)
#define PG8_LD8(dst, addr) do { const v4i lo_ = *(const LAS v4i*)(addr), hi_ = *(const LAS v4i*)((addr) + 1024); dst = __builtin_shufflevector(lo_, hi_, 0, 1, 2, 3, 4, 5, 6, 7); } while (0)
#define PG8_LDA(dst, b, h) do { _Pragma("unroll") for (int m = 0; m < 4; ++m) PG8_LD8(dst[m], lds + PG8_SA(b, h) + aoff + m * 2048); } while (0)
#define PG8_LDB(dst, b, h) do { _Pragma("unroll") for (int n = 0; n < 2; ++n) PG8_LD8(dst[n], lds + PG8_SB(b, h) + boff + n * 2048); } while (0)
#define PG8_HALF(v, k) __builtin_bit_cast(bf16x8, __builtin_shufflevector(v, v, 4 * (k), 4 * (k) + 1, 4 * (k) + 2, 4 * (k) + 3))
#define PG8_MMA(ai, bj, At, Bt) do { __builtin_amdgcn_s_setprio(1); _Pragma("unroll") for (int m = 0; m < 4; ++m) _Pragma("unroll") for (int n = 0; n < 2; ++n) { \
        if (F8) asm volatile("v_mfma_f32_16x16x128_f8f6f4 %0, %1, %2, %0" : "+v"(acc[ai][bj][m][n]) : "v"(Bt[n]), "v"(At[m]));     \
        else { acc[ai][bj][m][n] = __builtin_amdgcn_mfma_f32_16x16x32_bf16(PG8_HALF(Bt[n], 0), PG8_HALF(At[m], 0), acc[ai][bj][m][n], 0, 0, 0); \
               acc[ai][bj][m][n] = __builtin_amdgcn_mfma_f32_16x16x32_bf16(PG8_HALF(Bt[n], 1), PG8_HALF(At[m], 1), acc[ai][bj][m][n], 0, 0, 0); } } \
        __builtin_amdgcn_s_setprio(0); } while (0)
#define PG8_WAIT_V(n) asm volatile("s_waitcnt vmcnt(" #n ")" ::: "memory")
#define PG8_WAIT_L(n) asm volatile("s_waitcnt lgkmcnt(" #n ")" ::: "memory")
#define PG8_BAR __builtin_amdgcn_s_barrier()
#define PG8_SCHED __builtin_amdgcn_sched_barrier(0)
    Unit cur, nxt; int ui = 0;
    if (!S.next(0, cur)) return;
    f32x4 acc[2][2][4][2];
#pragma unroll
    for (int a = 0; a < 2; ++a)
#pragma unroll
        for (int b = 0; b < 2; ++b)
#pragma unroll
            for (int m = 0; m < 4; ++m)
#pragma unroll
                for (int n = 0; n < 2; ++n) acc[a][b][m][n] = (f32x4){0.f, 0.f, 0.f, 0.f};
    v8i At[4], B0[2], B1[2];
    const char* cA = (const char*)g.A + (size_t)cur.pm * tstepA; const char* cB = (const char*)g.Bt + (size_t)cur.pn * tstepB;
    PG8_STAGE(PG8_SB(0, 0), cB, voffB); PG8_STAGE(PG8_SA(0, 0), cA, voffA); PG8_STAGE(PG8_SB(0, 1), cB + hstepB, voffB); PG8_STAGE(PG8_SA(0, 1), cA + hstepA, voffA);
    if (wr == 1) PG8_BAR;
    PG8_WAIT_V(4); PG8_BAR;
    PG8_STAGE(PG8_SB(1, 0), cB + kstep, voffB); PG8_STAGE(PG8_SA(1, 0), cA + kstep, voffA); PG8_STAGE(PG8_SB(1, 1), cB + hstepB + kstep, voffB);
    PG8_WAIT_V(6); PG8_BAR;
    for (;;) {
        const bool has_next = S.next(ui + 1, nxt);
        const char* nA = has_next ? (const char*)g.A + (size_t)nxt.pm * tstepA : cA; const char* nB = has_next ? (const char*)g.Bt + (size_t)nxt.pn * tstepB : cB;
        for (int t = 0; t < nt; t += 2) {
            const bool last = (t == nt - 2);
            const char* a1 = cA + (size_t)(t + 1) * kstep;
            const char* a2 = last ? nA : cA + (size_t)(t + 2) * kstep; const char* b2 = last ? nB : cB + (size_t)(t + 2) * kstep;
            const char* a3 = a2 + kstep; const char* b3 = b2 + kstep;
            PG8_LDB(B0, 0, 0); PG8_SCHED; PG8_LDA(At, 0, 0); PG8_STAGE(PG8_SA(1, 1), a1 + hstepA, voffA);
            PG8_WAIT_L(8); PG8_BAR; PG8_WAIT_L(0); PG8_MMA(0, 0, At, B0); PG8_BAR; PG8_SCHED;
            PG8_LDB(B1, 0, 1); PG8_STAGE(PG8_SB(0, 0), b2, voffB);
            PG8_BAR; PG8_WAIT_L(0); PG8_MMA(0, 1, At, B1); PG8_BAR;
            PG8_LDA(At, 0, 1); PG8_STAGE(PG8_SA(0, 0), a2, voffA);
            PG8_BAR; PG8_WAIT_L(0); PG8_MMA(1, 0, At, B0); PG8_BAR; PG8_SCHED;
            PG8_STAGE(PG8_SB(0, 1), b2 + hstepB, voffB);
            PG8_WAIT_V(6); PG8_BAR; PG8_MMA(1, 1, At, B1); PG8_BAR;
            PG8_LDB(B0, 1, 0); PG8_SCHED; PG8_LDA(At, 1, 0); PG8_STAGE(PG8_SA(0, 1), a2 + hstepA, voffA);
            PG8_WAIT_L(8); PG8_BAR; PG8_WAIT_L(0); PG8_MMA(0, 0, At, B0); PG8_BAR; PG8_SCHED;
            PG8_LDB(B1, 1, 1); PG8_STAGE(PG8_SB(1, 0), b3, voffB);
            PG8_BAR; PG8_WAIT_L(0); PG8_MMA(0, 1, At, B1); PG8_BAR;
            PG8_LDA(At, 1, 1); PG8_STAGE(PG8_SA(1, 0), a3, voffA);
            PG8_BAR; PG8_WAIT_L(0); PG8_MMA(1, 0, At, B0); PG8_BAR; PG8_SCHED;
            PG8_STAGE(PG8_SB(1, 1), b3 + hstepB, voffB);
            PG8_WAIT_V(6); PG8_BAR; PG8_MMA(1, 1, At, B1); PG8_BAR;
        }
        if (F8) { __builtin_amdgcn_sched_barrier(0); asm volatile("s_nop 15\n\ts_nop 15" ::: "memory"); __builtin_amdgcn_sched_barrier(0); }
        E(acc, cur, wr, wc, fr, fq);
        if (!has_next) break;
#pragma unroll
        for (int a = 0; a < 2; ++a)
#pragma unroll
            for (int b = 0; b < 2; ++b)
#pragma unroll
                for (int m = 0; m < 4; ++m)
#pragma unroll
                    for (int n = 0; n < 2; ++n) acc[a][b][m][n] = (f32x4){0.f, 0.f, 0.f, 0.f};
        cur = nxt; cA = nA; cB = nB; ++ui;
    }
    PG8_WAIT_V(0);
    if (wr == 0) PG8_BAR;
    PG8_BAR;
#undef PG8_SA
#undef PG8_SB
#undef PG8_STAGE
#undef PG8_LDA
#undef PG8_LD8
#undef PG8_HALF
#undef PG8_LDB
#undef PG8_MMA
#undef PG8_WAIT_V
#undef PG8_WAIT_L
#undef PG8_BAR
#undef PG8_SCHED
}
}

template <int MODE, bool O8>
__device__ __forceinline__ void dense_gemm(const Frame& F, const void* A, const void* Bt, int M, int N, int K, void* O, const bf16_t* X, const bf16_t* Zin, int ldc, int skipctx = 0, int rot = 0) {
    pg8::Gemm g{(const bf16_t*)A, (const bf16_t*)Bt, K * OPB / 2, K * OPB / 2, K * OPB / 2}; pg8::StaticOrder S; S.init(skipctx ? NB * SEQ : M, N, F.G, (F.bid + rot) % F.G, skipctx);
    pg8::Epi<MODE, O8> E{O, X, Zin, ldc, 1 << 30};
    pg8::gemm_phase<pg8::Epi<MODE, O8>, pg8::StaticOrder>(F.lds, g, S, E, F.wave);
}

struct TJob { const float* src; bf16_t* dst; size_t src_bstride; int src_pitch, K, Nvalid, Npad, dst_pitch, blk, blk_stride, row_off, nbatch, dst_brow; bool f8; };
constexpr int N_TJOBS = 13;
__device__ __forceinline__ TJob get_tjob(const Frame& F, int layer, int j) {
    TJob t; t.src_bstride = 0; t.blk = 1 << 30; t.blk_stride = 0; t.row_off = 0; t.nbatch = 1; t.dst_brow = 0; t.f8 = F8 && (j != 10);
    unsigned char* ws = F.ws;
    switch (j) {
    case 0: t.src = F.in[I_WIN] + (size_t)layer * 2048 * 14736; t.src_pitch = 14736; t.K = 2048; t.Nvalid = PC_END; t.Npad = PW; t.dst = (bf16_t*)(ws + WS_WIN); t.dst_pitch = 2048; break;
    case 1: t.src = F.in[I_WIN] + (size_t)layer * 2048 * 14736 + PC_END; t.src_pitch = 14736; t.K = 2048; t.Nvalid = 2048; t.Npad = 2048; t.dst = (bf16_t*)(ws + WS_WG); t.dst_pitch = 2048; t.blk = 128; t.blk_stride = 256; t.row_off = 0; break;
    case 11: t.src = F.in[I_WIN] + (size_t)layer * 2048 * 14736 + PC_END + 2048; t.src_pitch = 14736; t.K = 2048; t.Nvalid = 2048; t.Npad = 2048; t.dst = (bf16_t*)(ws + WS_WG); t.dst_pitch = 2048; t.blk = 128; t.blk_stride = 256; t.row_off = 128; break;
    case 12: t.src = F.in[I_WIN] + (size_t)layer * 2048 * 14736 + PC_END + 4096; t.src_pitch = 14736; t.K = 2048; t.Nvalid = 2048; t.Npad = 2048; t.dst = (bf16_t*)(ws + WS_WG + (size_t)4096 * 2048 * OPB); t.dst_pitch = 2048; break;
    case 2: t.src = F.in[I_MLPROJ] + (size_t)layer * 1024 * 2048; t.src_pitch = 2048; t.K = 1024; t.Nvalid = 2048; t.Npad = 2048; t.dst = (bf16_t*)(ws + WS_WML); t.dst_pitch = 1024; break;
    case 3: t.src = F.in[I_RWPROJ] + (size_t)layer * 1024 * 2048; t.src_pitch = 2048; t.K = 1024; t.Nvalid = 2048; t.Npad = 2048; t.dst = (bf16_t*)(ws + WS_WML + (size_t)1 * 2048 * 1024 * OPB); t.dst_pitch = 1024; break;
    case 4: t.src = F.in[I_S5WV] + (size_t)layer * 1024 * 2048; t.src_pitch = 2048; t.K = 1024; t.Nvalid = 2048; t.Npad = 2048; t.dst = (bf16_t*)(ws + WS_WML + (size_t)2 * 2048 * 1024 * OPB); t.dst_pitch = 1024; t.blk = 128; t.blk_stride = 256; t.row_off = 0; break;
    case 5: t.src = F.in[I_S5WG] + (size_t)layer * 1024 * 2048; t.src_pitch = 2048; t.K = 1024; t.Nvalid = 2048; t.Npad = 2048; t.dst = (bf16_t*)(ws + WS_WML + (size_t)2 * 2048 * 1024 * OPB); t.dst_pitch = 1024; t.blk = 128; t.blk_stride = 256; t.row_off = 128; break;
    case 6: t.src = F.in[I_WOUT] + (size_t)layer * 2048 * 2048; t.src_pitch = 2048; t.K = 2048; t.Nvalid = 2048; t.Npad = 2048; t.dst = (bf16_t*)(ws + WS_WOUT); t.dst_pitch = 2048; break;
    case 7: t.src = F.in[I_EWG] + (size_t)layer * 16 * 2048 * 1024; t.src_bstride = (size_t)2048 * 1024; t.src_pitch = 1024; t.K = 2048; t.Nvalid = 1024; t.Npad = 1024; t.dst = (bf16_t*)(ws + WS_EGU); t.dst_pitch = 2048;
            t.blk = 128; t.blk_stride = 256; t.row_off = 0; t.nbatch = 16; t.dst_brow = 2048; break;
    case 8: t.src = F.in[I_EWU] + (size_t)layer * 16 * 2048 * 1024; t.src_bstride = (size_t)2048 * 1024; t.src_pitch = 1024; t.K = 2048; t.Nvalid = 1024; t.Npad = 1024; t.dst = (bf16_t*)(ws + WS_EGU); t.dst_pitch = 2048;
            t.blk = 128; t.blk_stride = 256; t.row_off = 128; t.nbatch = 16; t.dst_brow = 2048; break;
    case 9: t.src = F.in[I_EWD] + (size_t)layer * 16 * 1024 * 2048; t.src_bstride = (size_t)1024 * 2048; t.src_pitch = 2048; t.K = 1024; t.Nvalid = 2048; t.Npad = 2048; t.dst = (bf16_t*)(ws + WS_EDN); t.dst_pitch = 1024;
            t.nbatch = 16; t.dst_brow = 2048; break;
    default: t.src = F.in[I_RWGUP] + (size_t)layer * 128 * 1024; t.src_pitch = 1024; t.K = 128; t.Nvalid = 1024; t.Npad = 1024; t.dst = (bf16_t*)(ws + WS_GUPT); t.dst_pitch = 128; break;
    }
    return t;
}
__device__ __forceinline__ int tjob_tiles(const TJob& t) { return t.nbatch * (t.Npad / 64) * (t.K / (t.f8 ? 128 : 64)); }
__device__ __forceinline__ void transpose_tile(LAS float* T, int lane, const TJob& t, int tile) {
    const int nkt = t.K / 64, nnt = t.Npad / 64;
    const int b = tile / (nnt * nkt), rem = tile - b * nnt * nkt, ktile = rem / nnt, ntile = rem - ktile * nnt;
    const int n0 = ntile * 64, k0 = ktile * 64;
    const float* src = t.src + (size_t)b * t.src_bstride;
    f32x4 v[16];
#pragma unroll
    for (int p = 0; p < 16; ++p) { const int kk = p * 4 + (lane >> 4), nn = (lane & 15) * 4;
        v[p] = (f32x4){0.f, 0.f, 0.f, 0.f};
        if (n0 + nn < t.Nvalid) v[p] = *(const f32x4*)(src + (size_t)(k0 + kk) * t.src_pitch + n0 + nn); }
#pragma unroll
    for (int p = 0; p < 16; ++p) { const int kk = p * 4 + (lane >> 4), nn = (lane & 15) * 4; T[kk * 65 + nn] = v[p][0]; T[kk * 65 + nn + 1] = v[p][1]; T[kk * 65 + nn + 2] = v[p][2]; T[kk * 65 + nn + 3] = v[p][3]; }
    asm volatile("s_waitcnt lgkmcnt(0)" ::: "memory"); __builtin_amdgcn_wave_barrier();
#pragma unroll
    for (int ps = 0; ps < 8; ++ps) { const int n = ps * 8 + (lane >> 3), kq = (lane & 7) * 8; float x[8];
#pragma unroll
        for (int j = 0; j < 8; ++j) x[j] = T[(kq + j) * 65 + n];
        const int ng = n0 + n; const int drow = b * t.dst_brow + (ng / t.blk) * t.blk_stride + (ng % t.blk) + t.row_off;
        if (t.f8) { u32x2 w; w.x = pk4_fp8(x[0] * W8_SCALE, x[1] * W8_SCALE, x[2] * W8_SCALE, x[3] * W8_SCALE); w.y = pk4_fp8(x[4] * W8_SCALE, x[5] * W8_SCALE, x[6] * W8_SCALE, x[7] * W8_SCALE);
            *(u32x2*)((char*)t.dst + (size_t)drow * t.dst_pitch + k0 + kq) = w; }
        else { u32x4 w; w.x = pk_bf16(x[0], x[1]); w.y = pk_bf16(x[2], x[3]); w.z = pk_bf16(x[4], x[5]); w.w = pk_bf16(x[6], x[7]);
            *(u32x4*)(t.dst + (size_t)drow * t.dst_pitch + k0 + kq) = w; } }
    asm volatile("s_waitcnt lgkmcnt(0)" ::: "memory"); __builtin_amdgcn_wave_barrier();
}
__device__ __forceinline__ void transpose_tile8(LAS unsigned* T8, int lane, const TJob& t, int tile) {
    const int nkt = t.K / 128, nnt = t.Npad / 64;
    const int b = tile / (nnt * nkt), rem = tile - b * nnt * nkt, ktile = rem / nnt, ntile = rem - ktile * nnt;
    const int n0 = ntile * 64, k0 = ktile * 128;
    const float* src = t.src + (size_t)b * t.src_bstride;
    const int nn = (lane & 15) * 4, kq = lane >> 4;
    f32x4 v[32];
#pragma unroll
    for (int p = 0; p < 32; ++p) { const int kk = (p >> 2) * 16 + kq * 4 + (p & 3);
        v[p] = (f32x4){0.f, 0.f, 0.f, 0.f};
        if (n0 + nn < t.Nvalid) v[p] = *(const f32x4*)(src + (size_t)(k0 + kk) * t.src_pitch + n0 + nn); }
#pragma unroll
    for (int g = 0; g < 8; ++g)
#pragma unroll
        for (int j = 0; j < 4; ++j)
            T8[(nn + j) * 36 + g * 4 + kq] = pk4_fp8(v[4 * g][j] * W8_SCALE, v[4 * g + 1][j] * W8_SCALE, v[4 * g + 2][j] * W8_SCALE, v[4 * g + 3][j] * W8_SCALE);
    asm volatile("s_waitcnt lgkmcnt(0)" ::: "memory"); __builtin_amdgcn_wave_barrier();
#pragma unroll
    for (int ps = 0; ps < 8; ++ps) { const int n = ps * 8 + (lane >> 3), pc = lane & 7;
        const u32x4 w = *(const LAS u32x4*)(T8 + n * 36 + pc * 4);
        const int ng = n0 + n; const int drow = b * t.dst_brow + (ng / t.blk) * t.blk_stride + (ng % t.blk) + t.row_off;
        *(u32x4*)((char*)t.dst + (size_t)drow * t.dst_pitch + k0 + pc * 16) = w; }
    asm volatile("s_waitcnt lgkmcnt(0)" ::: "memory"); __builtin_amdgcn_wave_barrier();
}
__device__ __forceinline__ void phase_wprep(const Frame& F, int layer) {
    const int tid = ltid(), lane = tid & 63; (void)lane;
    LAS float* T = (LAS float*)F.lds + F.wave * (64 * 65);
    const int gw = F.bid * NWAVE + F.wave, nw = F.G * NWAVE;
    int base = 0;
#pragma unroll
    for (int j = 0; j < N_TJOBS; ++j) {
        const TJob t = get_tjob(F, layer, j); const int nt = tjob_tiles(t);
        const int first = (gw - (base % nw) + nw) % nw;
        for (int tile = first; tile < nt; tile += nw) { if (t.f8) transpose_tile8((LAS unsigned*)T, lane, t, tile); else transpose_tile(T, lane, t, tile); }
        base += nt;
    }
    __syncthreads();
}

__device__ __forceinline__ void phase_post1_route(const Frame& F, int layer, bool use_mix) {
    const int tid = ltid(), lane = tid & 63; (void)lane;
    const float* mods = (const float*)(F.ws + WS_MODS) + (size_t)layer * 5 * 12288;
    const bf16_t* MIX = (const bf16_t*)(F.ws + WS_MIX);
    bf16_t* X1 = (bf16_t*)(F.ws + WS_X1);
    unsigned* route = (unsigned*)(F.ws + WS_ROUTE);
    unsigned* ecnt = (unsigned*)(F.ws + WS_CTL) + CW_ECNT + layer * 64;
    const float* g1 = F.in[I_LN1G] + layer * D; const float* b1 = F.in[I_LN1B] + layer * D;
    LAS float* RW = (LAS float*)F.lds;
    LAS unsigned* lcnt = (LAS unsigned*)(F.lds + 131072 + 256);
    if (tid < 32) lcnt[tid] = 0u;
    for (int i4 = tid; i4 < 2048 * 16 / 4; i4 += NTHR) { const int k = i4 >> 2, qd = i4 & 3; const int ii = k >> 8, ln = (k >> 2) & 63, c = k & 3;
        *(LAS f32x4*)(RW + ((((qd * 8 + ii) * 4 + c) * 64 + ln) * 4)) = *(const f32x4*)(F.in[I_ROUTW] + (size_t)k * 16 + qd * 4); }
    __syncthreads();
    const int stride = F.G * NWAVE;
    f32x4 xq[8]; u32x2 mq[8];
    const int nrows = layer == 1 ? NB * SEQ : R;
#define ROW_OF(qi) (layer == 1 ? (qi) + ((qi) >> 13) * CTXL + CTXL : (qi))
    { const int r = ROW_OF(F.bid * NWAVE + F.wave); const float* x = xin_row(F, layer, r);
#pragma unroll
      for (int i = 0; i < 8; ++i) { const int e = (i * 64 + lane) * 4; xq[i] = *(const f32x4*)(x + e); mq[i] = *(const u32x2*)(MIX + (size_t)r * D + e); } }
    for (int qi = F.bid * NWAVE + F.wave; qi < nrows; qi += stride) { const int r = ROW_OF(qi);
        const int b = r / TB, s = r - b * TB; const float* md = mods + (size_t)(s < CTXL ? 4 : b) * 12288;
        f32x4 v[8]; float sum = 0.f;
#pragma unroll
        for (int i = 0; i < 8; ++i) { const int e = (i * 64 + lane) * 4; v[i] = xq[i] * ALPHA;
            if (use_mix) { const u32x2 m = mq[i]; const f32x4 g = *(const f32x4*)(md + 2 * 2048 + e);
                v[i][0] += g[0] * __uint_as_float(m.x << 16); v[i][1] += g[1] * __uint_as_float(m.x & 0xffff0000u); v[i][2] += g[2] * __uint_as_float(m.y << 16); v[i][3] += g[3] * __uint_as_float(m.y & 0xffff0000u); }
            sum += (v[i][0] + v[i][1]) + (v[i][2] + v[i][3]); }
        { const int rn = ROW_OF(qi + stride < nrows ? qi + stride : qi); const float* xn = xin_row(F, layer, rn);
#pragma unroll
          for (int i = 0; i < 8; ++i) { const int e = (i * 64 + lane) * 4; xq[i] = *(const f32x4*)(xn + e); mq[i] = *(const u32x2*)(MIX + (size_t)rn * D + e); } }
        float mean = wave_sum(sum, lane) * (1.0f / D); float q = 0.f;
#pragma unroll
        for (int i = 0; i < 8; ++i) { v[i] -= mean; q += (v[i][0] * v[i][0] + v[i][1] * v[i][1]) + (v[i][2] * v[i][2] + v[i][3] * v[i][3]); }
        float rstd = rsqrtf(wave_sum(q, lane) * (1.0f / D) + LN_EPS);
        sum = 0.f;
#pragma unroll
        for (int i = 0; i < 8; ++i) { const int e = (i * 64 + lane) * 4; const f32x4 gg = *(const f32x4*)(g1 + e), bb = *(const f32x4*)(b1 + e);
            v[i] = v[i] * rstd * gg + bb; { u32x2 w; w.x = pk_bf16(v[i][0], v[i][1]); w.y = pk_bf16(v[i][2], v[i][3]); *(u32x2*)(X1 + (size_t)r * D + e) = w; } sum += (v[i][0] + v[i][1]) + (v[i][2] + v[i][3]); }
        mean = wave_sum(sum, lane) * (1.0f / D); q = 0.f;
#pragma unroll
        for (int i = 0; i < 8; ++i) { v[i] -= mean; q += (v[i][0] * v[i][0] + v[i][1] * v[i][1]) + (v[i][2] * v[i][2] + v[i][3] * v[i][3]); }
        rstd = rsqrtf(wave_sum(q, lane) * (1.0f / D) + LN_EPS);
        float lg[16];
#pragma unroll
        for (int e = 0; e < 16; ++e) lg[e] = 0.f;
#pragma unroll
        for (int i = 0; i < 8; ++i) { const int e0 = (i * 64 + lane) * 4; const f32x4 sh = *(const f32x4*)(md + 3 * 2048 + e0), scl = *(const f32x4*)(md + 4 * 2048 + e0);
            const f32x4 u = v[i] * rstd * (scl + 1.0f) + sh;
#pragma unroll
            for (int j = 0; j < 4; ++j) {
#pragma unroll
                for (int qd = 0; qd < 4; ++qd) { const f32x4 w = *(const LAS f32x4*)(RW + ((((qd * 8 + i) * 4 + j) * 64 + lane) * 4)); lg[qd * 4 + 0] += u[j] * w[0]; lg[qd * 4 + 1] += u[j] * w[1]; lg[qd * 4 + 2] += u[j] * w[2]; lg[qd * 4 + 3] += u[j] * w[3]; } }
            __builtin_amdgcn_sched_barrier(0); }
#pragma unroll
        for (int e = 0; e < 16; ++e) lg[e] = wave_sum(lg[e], lane);
        float aff[16], gsc[16];
#pragma unroll
        for (int e = 0; e < 16; ++e) { aff[e] = __builtin_amdgcn_rcpf(1.0f + __expf(-lg[e])); gsc[e] = aff[e] + F.in[I_ROUTB][e]; }
        int best = 0; float bestv = -1e30f;
#pragma unroll
        for (int gI = 0; gI < 4; ++gI) { float m1 = -1e30f, m2 = -1e30f;
#pragma unroll
            for (int j = 0; j < 4; ++j) { const float t = gsc[gI * 4 + j]; if (t > m1) { m2 = m1; m1 = t; } else if (t > m2) m2 = t; }
            const float sc = m1 + m2; if (sc > bestv) { bestv = sc; best = gI; } }
        int i0 = 0, i1 = 0; { float m1 = -1e30f, m2 = -1e30f;
#pragma unroll
            for (int gI = 0; gI < 4; ++gI) if (gI == best) {
#pragma unroll
                for (int j = 0; j < 4; ++j) { const float t = gsc[gI * 4 + j]; if (t > m1) { m2 = m1; i1 = i0; m1 = t; i0 = gI * 4 + j; } else if (t > m2) { m2 = t; i1 = gI * 4 + j; } } } }
        float a0 = 0.f, a1 = 0.f;
#pragma unroll
        for (int e = 0; e < 16; ++e) { a0 = (e == i0) ? aff[e] : a0; a1 = (e == i1) ? aff[e] : a1; }
        const float inv = 1.0f / (a0 + a1);
        if (lane == 0) {
            const unsigned s0 = __hip_atomic_fetch_add(lcnt + i0, 1u, __ATOMIC_RELAXED, __HIP_MEMORY_SCOPE_WORKGROUP), s1 = __hip_atomic_fetch_add(lcnt + i1, 1u, __ATOMIC_RELAXED, __HIP_MEMORY_SCOPE_WORKGROUP);
            u32x4 w0; w0.x = (unsigned)i0; w0.y = (unsigned)i1; w0.z = __float_as_uint(a0 * inv); w0.w = __float_as_uint(a1 * inv);
            *(u32x4*)(route + (size_t)r * 8) = w0; u32x2 w1; w1.x = s0; w1.y = s1; *(u32x2*)(route + (size_t)r * 8 + 4) = w1;
        }
    }
    __syncthreads();
    if (tid < 16) lcnt[16 + tid] = atomicAdd(ecnt + tid, lcnt[tid]);
    __syncthreads();
    for (int qi = F.bid * NWAVE + F.wave; qi < nrows; qi += stride) { const int r = ROW_OF(qi);
        if (lane == 0) { const u32x2 e01 = *(const u32x2*)(route + (size_t)r * 8); u32x2 sl = *(const u32x2*)(route + (size_t)r * 8 + 4);
            sl.x += lcnt[16 + e01.x]; sl.y += lcnt[16 + e01.y]; *(u32x2*)(route + (size_t)r * 8 + 4) = sl; } }
}
__device__ __forceinline__ void load_tile_starts(const Frame& F, int tid, int layer, LAS int* ts) {
    if (tid == 0) { const unsigned* ecnt = (const unsigned*)(F.ws + WS_CTL) + CW_ECNT + layer * 64; int a = 0;
        for (int e = 0; e < 16; ++e) { ts[e] = a; a += (int)((__hip_atomic_load(ecnt + e, __ATOMIC_RELAXED, __HIP_MEMORY_SCOPE_AGENT) + 255u) >> 8); } ts[16] = a; }
    __syncthreads();
}
__device__ __forceinline__ void phase_gather(const Frame& F, int layer) {
    const int tid = ltid(), lane = tid & 63; (void)lane;
    LAS int* ts = (LAS int*)(F.lds + LDS_BYTES - 512);
    const float* mods = (const float*)(F.ws + WS_MODS) + (size_t)layer * 5 * 12288;
    LAS float* ML = (LAS float*)F.lds;
    for (int i = tid; i < 5 * 2 * 512; i += NTHR) { const int mr = i >> 10, v = (i >> 9) & 1, c4 = i & 511; *(LAS f32x4*)(ML + (mr * 2 + v) * 2048 + c4 * 4) = *(const f32x4*)(mods + (size_t)mr * 12288 + (3 + v) * 2048 + c4 * 4); }
    load_tile_starts(F, tid, layer, ts);
    const bf16_t* X1 = (const bf16_t*)(F.ws + WS_X1);
    const unsigned* route = (const unsigned*)(F.ws + WS_ROUTE);
    bf16_t* UG = (bf16_t*)(F.ws + WS_SC);
    const int stride = F.G * NWAVE;
    u32x2 xw[8]; u32x4 rr; u32x2 sl;
    const int nrows = layer == 1 ? NB * SEQ : R;
    { const int r = ROW_OF(F.bid * NWAVE + F.wave);
#pragma unroll
      for (int i = 0; i < 8; ++i) xw[i] = *(const u32x2*)(X1 + (size_t)r * D + (i * 64 + lane) * 4);
      rr = *(const u32x4*)(route + (size_t)r * 8); sl = *(const u32x2*)(route + (size_t)r * 8 + 4); }
    for (int qi = F.bid * NWAVE + F.wave; qi < nrows; qi += stride) { const int r = ROW_OF(qi);
        const int b = r / TB, s = r - b * TB; const LAS float* md = ML + (s < CTXL ? 4 : b) * 4096;
        f32x4 v[8]; float sum = 0.f;
#pragma unroll
        for (int i = 0; i < 8; ++i) { const u32x2 w = xw[i]; v[i][0] = __uint_as_float(w.x << 16); v[i][1] = __uint_as_float(w.x & 0xffff0000u); v[i][2] = __uint_as_float(w.y << 16); v[i][3] = __uint_as_float(w.y & 0xffff0000u); sum += (v[i][0] + v[i][1]) + (v[i][2] + v[i][3]); }
        const u32x4 rc = rr; const u32x2 sc_ = sl;
        { const int rn = ROW_OF(qi + stride < nrows ? qi + stride : qi);
#pragma unroll
          for (int i = 0; i < 8; ++i) xw[i] = *(const u32x2*)(X1 + (size_t)rn * D + (i * 64 + lane) * 4);
          rr = *(const u32x4*)(route + (size_t)rn * 8); sl = *(const u32x2*)(route + (size_t)rn * 8 + 4); }
        const float mean = wave_sum(sum, lane) * (1.0f / D); float q = 0.f;
#pragma unroll
        for (int i = 0; i < 8; ++i) { v[i] -= mean; q += (v[i][0] * v[i][0] + v[i][1] * v[i][1]) + (v[i][2] * v[i][2] + v[i][3] * v[i][3]); }
        const float rstd = rsqrtf(wave_sum(q, lane) * (1.0f / D) + LN_EPS);
        const size_t row0 = (size_t)ts[rc.x] * 256 + sc_.x, row1 = (size_t)ts[rc.y] * 256 + sc_.y;
#pragma unroll
        for (int i = 0; i < 8; ++i) { const int e = (i * 64 + lane) * 4; const f32x4 sh = *(const LAS f32x4*)(md + e), scl = *(const LAS f32x4*)(md + 2048 + e);
            const f32x4 u = v[i] * rstd * (scl + 1.0f) + sh;
            st_op4(UG, row0 * D + e, u[0], u[1], u[2], u[3]); st_op4(UG, row1 * D + e, u[0], u[1], u[2], u[3]); }
    }
}
__device__ __forceinline__ void phase_moe_gemm(const Frame& F, int layer, int which) {
    const int tid = ltid(), lane = tid & 63; (void)lane;
    LAS int* ts = (LAS int*)(F.lds + pg8::STAGE_BYTES);
    load_tile_starts(F, tid, layer, ts);
    if (which == 0) {
        pg8::Gemm g{(const bf16_t*)(F.ws + WS_SC), (const bf16_t*)(F.ws + WS_EGU), 2048 * OPB / 2, 2048 * OPB / 2, 2048 * OPB / 2};
        pg8::GroupedOrder S{ts, 8, F.G, F.bid}; pg8::Epi<4, true> E{(void*)(F.ws + WS_U), nullptr, nullptr, 1024, 8};
        pg8::gemm_phase<pg8::Epi<4, true>, pg8::GroupedOrder>(F.lds, g, S, E, F.wave);
    } else {
        pg8::Gemm g{(const bf16_t*)(F.ws + WS_U), (const bf16_t*)(F.ws + WS_EDN), 1024 * OPB / 2, 1024 * OPB / 2, 1024 * OPB / 2};
        pg8::GroupedOrder S{ts, 8, F.G, F.bid}; pg8::Epi<0, false> E{(void*)(F.ws + WS_SC), nullptr, nullptr, 2048, 8};
        pg8::gemm_phase<pg8::Epi<0, false>, pg8::GroupedOrder>(F.lds, g, S, E, F.wave);
    }
}
__device__ __forceinline__ void phase_post2_moe(const Frame& F, int layer, bool use_ffn) {
    const int tid = ltid(), lane = tid & 63; (void)lane;
    LAS int* ts = (LAS int*)(F.lds + LDS_BYTES - 512);
    const float* mods = (const float*)(F.ws + WS_MODS) + (size_t)layer * 5 * 12288;
    LAS float* GL5 = (LAS float*)F.lds;
    LAS float* G2L = GL5 + 5 * 2048; LAS float* NXL = G2L + 2 * 2048;
    for (int i = tid; i < 5 * 512; i += NTHR) { const int mr = i >> 9, c4 = i & 511; *(LAS f32x4*)(GL5 + mr * 2048 + c4 * 4) = *(const f32x4*)(mods + (size_t)mr * 12288 + 5 * 2048 + c4 * 4); }
    for (int i = tid; i < 2 * 512; i += NTHR) { const int v = i >> 9, c4 = i & 511; *(LAS f32x4*)(G2L + v * 2048 + c4 * 4) = *(const f32x4*)((v == 0 ? F.in[I_LN2G] : F.in[I_LN2B]) + layer * D + c4 * 4); }
    if (layer == 0) for (int i = tid; i < 5 * 2 * 512; i += NTHR) { const int mr = i >> 10, v = (i >> 9) & 1, c4 = i & 511; *(LAS f32x4*)(NXL + (mr * 2 + v) * 2048 + c4 * 4) = *(const f32x4*)(mods + (size_t)5 * 12288 + (size_t)mr * 12288 + v * 2048 + c4 * 4); }
    load_tile_starts(F, tid, layer, ts);
    const bf16_t* X1 = (const bf16_t*)(F.ws + WS_X1);
    const unsigned* route = (const unsigned*)(F.ws + WS_ROUTE);
    const bf16_t* Y = (const bf16_t*)(F.ws + WS_SC);
    const float* g2 = F.in[I_LN2G] + layer * D; const float* b2 = F.in[I_LN2B] + layer * D;
    const int stride = F.G * NWAVE;
    u32x2 xw[8], y0w[8], y1w[8]; u32x4 rrN; u32x2 slN; float w0c, w1c;
    const int nrows = layer == 1 ? NB * SEQ : R;
    { const int r = ROW_OF(F.bid * NWAVE + F.wave); const u32x4 rr = *(const u32x4*)(route + (size_t)r * 8); const u32x2 sl = *(const u32x2*)(route + (size_t)r * 8 + 4);
      const size_t row0 = (size_t)ts[rr.x] * 256 + sl.x, row1 = (size_t)ts[rr.y] * 256 + sl.y; w0c = __uint_as_float(rr.z); w1c = __uint_as_float(rr.w);
#pragma unroll
      for (int i = 0; i < 8; ++i) { const int e = (i * 64 + lane) * 4; xw[i] = *(const u32x2*)(X1 + (size_t)r * D + e); y0w[i] = *(const u32x2*)(Y + row0 * D + e); y1w[i] = *(const u32x2*)(Y + row1 * D + e); }
      const int q0 = F.bid * NWAVE + F.wave; const int rn = ROW_OF(q0 + stride < nrows ? q0 + stride : q0); rrN = *(const u32x4*)(route + (size_t)rn * 8); slN = *(const u32x2*)(route + (size_t)rn * 8 + 4); }
    for (int qi = F.bid * NWAVE + F.wave; qi < nrows; qi += stride) { const int r = ROW_OF(qi);
        const int b = r / TB, s = r - b * TB; const int mr = s < CTXL ? 4 : b;
        const float w0 = w0c, w1 = w1c;
        f32x4 v[8]; float sum = 0.f;
#pragma unroll
        for (int i = 0; i < 8; ++i) { const int e = (i * 64 + lane) * 4; { const u32x2 w = xw[i]; v[i][0] = __uint_as_float(w.x << 16); v[i][1] = __uint_as_float(w.x & 0xffff0000u); v[i][2] = __uint_as_float(w.y << 16); v[i][3] = __uint_as_float(w.y & 0xffff0000u); v[i] *= ALPHA; }
            if (use_ffn) { const u32x2 y0 = y0w[i], y1 = y1w[i]; const f32x4 g = *(const LAS f32x4*)(GL5 + mr * 2048 + e);
                v[i][0] += g[0] * (w0 * __uint_as_float(y0.x << 16) + w1 * __uint_as_float(y1.x << 16));
                v[i][1] += g[1] * (w0 * __uint_as_float(y0.x & 0xffff0000u) + w1 * __uint_as_float(y1.x & 0xffff0000u));
                v[i][2] += g[2] * (w0 * __uint_as_float(y0.y << 16) + w1 * __uint_as_float(y1.y << 16));
                v[i][3] += g[3] * (w0 * __uint_as_float(y0.y & 0xffff0000u) + w1 * __uint_as_float(y1.y & 0xffff0000u)); }
            sum += (v[i][0] + v[i][1]) + (v[i][2] + v[i][3]); }
        {
            const int rn = ROW_OF(qi + stride < nrows ? qi + stride : qi); const int rn2 = ROW_OF(qi + 2 * stride < nrows ? qi + 2 * stride : qi);
            const size_t row0 = (size_t)ts[rrN.x] * 256 + slN.x, row1 = (size_t)ts[rrN.y] * 256 + slN.y; w0c = __uint_as_float(rrN.z); w1c = __uint_as_float(rrN.w);
#pragma unroll
            for (int i = 0; i < 8; ++i) { const int e = (i * 64 + lane) * 4; xw[i] = *(const u32x2*)(X1 + (size_t)rn * D + e); y0w[i] = *(const u32x2*)(Y + row0 * D + e); y1w[i] = *(const u32x2*)(Y + row1 * D + e); }
            rrN = *(const u32x4*)(route + (size_t)rn2 * 8); slN = *(const u32x2*)(route + (size_t)rn2 * 8 + 4); }
        const float mean = wave_sum(sum, lane) * (1.0f / D); float q = 0.f;
#pragma unroll
        for (int i = 0; i < 8; ++i) { v[i] -= mean; q += (v[i][0] * v[i][0] + v[i][1] * v[i][1]) + (v[i][2] * v[i][2] + v[i][3] * v[i][3]); }
        const float rstd = rsqrtf(wave_sum(q, lane) * (1.0f / D) + LN_EPS);
        float* o = xout_row(F, r); float sum2 = 0.f;
#pragma unroll
        for (int i = 0; i < 8; ++i) { const int e = (i * 64 + lane) * 4; const f32x4 gg = *(const LAS f32x4*)(G2L + e), bb = *(const LAS f32x4*)(G2L + 2048 + e);
            v[i] = v[i] * rstd * gg + bb; *(f32x4*)(o + e) = v[i]; sum2 += (v[i][0] + v[i][1]) + (v[i][2] + v[i][3]); }
        if (layer == 0) {
            const LAS float* mdn = NXL + mr * 4096; void* U = (void*)(F.ws + WS_U);
            const float mean2 = wave_sum(sum2, lane) * (1.0f / D); float q2 = 0.f;
#pragma unroll
            for (int i = 0; i < 8; ++i) { v[i] -= mean2; q2 += (v[i][0] * v[i][0] + v[i][1] * v[i][1]) + (v[i][2] * v[i][2] + v[i][3] * v[i][3]); }
            const float rstd2 = rsqrtf(wave_sum(q2, lane) * (1.0f / D) + LN_EPS);
#pragma unroll
            for (int i = 0; i < 8; ++i) { const int e = (i * 64 + lane) * 4; const f32x4 sh = *(const LAS f32x4*)(mdn + e), scl = *(const LAS f32x4*)(mdn + 2048 + e);
                const f32x4 u = v[i] * rstd2 * (scl + 1.0f) + sh; st_op4(U, (size_t)r * D + e, u[0], u[1], u[2], u[3]); }
        }
    }
}


__device__ __forceinline__ bf16x8 pack_8(const f32x4 a, const f32x4 b) { u32x4 w; w.x = pk_bf16(a[0], a[1]); w.y = pk_bf16(a[2], a[3]); w.z = pk_bf16(b[0], b[1]); w.w = pk_bf16(b[2], b[3]); bf16x8 r; __builtin_memcpy(&r, &w, 16); return r; }
__device__ __forceinline__ bf16x8 lds_2x8(const LAS bf16_t* p0, const LAS bf16_t* p1) { const u32x2 a = *(const LAS u32x2*)p0, b = *(const LAS u32x2*)p1; u32x4 w; w.x = a.x; w.y = a.y; w.z = b.x; w.w = b.y; bf16x8 r; __builtin_memcpy(&r, &w, 16); return r; }
__device__ __forceinline__ int nat_chunk(int d, int j) { return d == 0 ? j : (j < 4 ? 3 - j : 135 - j); }
__device__ __forceinline__ bf16x8 ldsA(const LAS bf16_t* p) { return *(const LAS bf16x8*)p; }
#define MFMA16(a, b, c) __builtin_amdgcn_mfma_f32_16x16x32_bf16((a), (b), (c), 0, 0, 0)
constexpr size_t SC_RWF = 0, SC_RWB = (size_t)R * 1024 * 2, SC_S5 = 2 * SC_RWB, SC_ML = SC_S5 + (size_t)R * 1024 * OPB, SC_RWO = F8 ? SC_ML + (size_t)R * 1024 * OPB : SC_RWF;
static_assert(SC_RWO + (size_t)R * 1024 * OPB <= SC_BYTES, "SC region overflow");

__device__ __forceinline__ void conv_item(const Frame& F, int tid, int layer, int it) {
    const bf16_t* P = (const bf16_t*)(F.ws + WS_P); bf16_t* QK = (bf16_t*)(F.ws + WS_QK);
    int b, rowbase[3], jmin, jmax; bool rv[3];
    if (it < 512) { b = it >> 7; const int i = it & 127; jmin = 0; jmax = 63;
        _Pragma("unroll") for (int a = 0; a < 3; ++a) { const int ii = i + a - 1; rv[a] = (ii >= 0 && ii < 128); rowbase[a] = b * TB + CTXL + ii * 64; } }
    else { const int q = it - 512; b = q >> 2; const int seg = q & 3; jmin = seg == 0 ? 0 : -1; jmax = seg == 3 ? 63 : 64;
        rv[0] = false; rv[2] = false; rv[1] = true; rowbase[0] = rowbase[2] = rowbase[1] = b * TB + seg * 64; }
    const int c0 = tid * 4;
    const float* cw = F.in[I_MLCW] + (size_t)layer * 9 * 2048; const float* cb = F.in[I_MLCB] + layer * 2048;
    f32x4 w[3][3];
#pragma unroll
    for (int a = 0; a < 3; ++a)
#pragma unroll
        for (int bb = 0; bb < 3; ++bb) w[a][bb] = *(const f32x4*)(cw + (a * 3 + bb) * 2048 + c0);
    const f32x4 bias = *(const f32x4*)(cb + c0);
    const float osc = c0 >= 1024 ? 0.0625f : 1.0f;
    f32x4 win[3][3];
#pragma unroll
    for (int a = 0; a < 3; ++a) { win[a][0] = (f32x4){0.f, 0.f, 0.f, 0.f}; win[a][1] = win[a][0]; win[a][2] = win[a][0]; }
    auto ldcol = [&](int a, int jj) -> f32x4 {
        const bool ok = rv[a] && jj >= jmin && jj <= jmax; const int rr = ok ? rowbase[a] + jj : rowbase[1];
        const u32x2 p = *(const u32x2*)(P + (size_t)rr * PW + c0); const float mk = ok ? 1.0f : 0.0f; f32x4 r;
        r[0] = mk * __uint_as_float(p.x << 16); r[1] = mk * __uint_as_float(p.x & 0xffff0000u); r[2] = mk * __uint_as_float(p.y << 16); r[3] = mk * __uint_as_float(p.y & 0xffff0000u);
        return r; };
#pragma unroll
    for (int a = 0; a < 3; ++a) { win[a][1] = ldcol(a, -1); win[a][2] = ldcol(a, 0); }
    for (int j0 = 0; j0 < 64; j0 += 8) {
        f32x4 nw[3][8];
#pragma unroll
        for (int u = 0; u < 8; ++u)
#pragma unroll
            for (int a = 0; a < 3; ++a) nw[a][u] = ldcol(a, j0 + u + 1);
#pragma unroll
        for (int u = 0; u < 8; ++u) {
            f32x4 acc = bias;
#pragma unroll
            for (int a = 0; a < 3; ++a) { win[a][0] = win[a][1]; win[a][1] = win[a][2]; win[a][2] = nw[a][u];
                acc += win[a][0] * w[a][0] + win[a][1] * w[a][1] + win[a][2] * w[a][2]; }
            u32x2 o; o.x = pk_bf16(siluf_(acc[0]) * osc, siluf_(acc[1]) * osc); o.y = pk_bf16(siluf_(acc[2]) * osc, siluf_(acc[3]) * osc);
            *(u32x2*)(QK + (size_t)(rowbase[1] + j0 + u) * 2048 + c0) = o;
        }
    }
}

__device__ __forceinline__ void fsincos(float a, float* s, float* c) { const float k = rintf(a * 0.15915494309189535f); const float r = fmaf(-k, 6.2831854820251465f, a) + k * 1.7484555e-7f; *s = __sinf(r); *c = __cosf(r); }
__device__ __forceinline__ void s5_tables_item(const Frame& F, int tid, int layer, int g) {
    LAS float* pwr = (LAS float*)F.lds;
    LAS float* pwi = pwr + 2 * 65 * 64;
    LAS float* bbr = pwi + 2 * 65 * 64;
    LAS float* bbi = bbr + 2 * 64 * 16;
    LAS float* ccr = bbi + 2 * 64 * 16;
    LAS float* cci = ccr + 2 * 16 * 64;
    LAS float* k0b = cci + 2 * 16 * 64;
    bf16_t* KC = (bf16_t*)(F.ws + WS_S5KC) + (size_t)g * 128 * 256;
    bf16_t* EC = (bf16_t*)(F.ws + WS_S5E) + (size_t)g * 256 * 1024;
    bf16_t* FC = (bf16_t*)(F.ws + WS_S5F) + (size_t)g * 1024 * 256;
    {
        const int dn = tid & 127, d = dn >> 6, n = dn & 63, tg = tid >> 7;
        const size_t li = (((size_t)layer * 2 + d) * 64 + g) * 64 + n;
        const float lre = F.in[I_S5LRE][li], lim = F.in[I_S5LIM][li], dt = expf(F.in[I_S5LDT][((size_t)layer * 2 + d) * 64 + g]);
        const float zr = lre * dt, zi = lim * dt;
        for (int tau = tg; tau <= 64; tau += 4) { const float mag = expf(zr * (float)tau); float sn, cs; fsincos(zi * (float)tau, &sn, &cs);
            pwr[(d * 65 + tau) * 64 + n] = mag * cs; pwi[(d * 65 + tau) * 64 + n] = mag * sn; }
        if (tg == 0) {
            const float mag = expf(zr); float sn, cs; fsincos(zi, &sn, &cs);
            const float nr = mag * cs - 1.0f, ni = mag * sn, den = 1.0f / (lre * lre + lim * lim);
            const float cr = (nr * lre + ni * lim) * den, ci = (ni * lre - nr * lim) * den;
            const float* br = F.in[I_S5BRE] + li * 16; const float* bi = F.in[I_S5BIM] + li * 16;
            for (int c = 0; c < 16; ++c) { bbr[(d * 64 + n) * 16 + c] = cr * br[c] - ci * bi[c]; bbi[(d * 64 + n) * 16 + c] = cr * bi[c] + ci * br[c]; }
        }
        for (int i = tid; i < 2 * 16 * 64; i += NTHR) { const int dd = i >> 10, rem = i & 1023;
            const size_t ci_ = (((size_t)layer * 2 + dd) * 64 + g) * 1024 + rem; ccr[i] = F.in[I_S5CRE][ci_]; cci[i] = F.in[I_S5CIM][ci_]; }
    }
    __syncthreads();
    {
        const int d = tid >> 8, co = (tid >> 4) & 15, ci = tid & 15;
        for (int half = 0; half < 2; ++half) {
            float acc[32];
#pragma unroll
            for (int t = 0; t < 32; ++t) acc[t] = 0.f;
            for (int n = 0; n < 64; ++n) {
                const float c_r = ccr[(d * 16 + co) * 64 + n], c_i = cci[(d * 16 + co) * 64 + n], b_r = bbr[(d * 64 + n) * 16 + ci], b_i = bbi[(d * 64 + n) * 16 + ci];
                const float gr = c_r * b_r - c_i * b_i, gi = c_r * b_i + c_i * b_r;
#pragma unroll
                for (int t = 0; t < 32; ++t) acc[t] += gr * pwr[(d * 65 + half * 32 + t) * 64 + n] - gi * pwi[(d * 65 + half * 32 + t) * 64 + n];
            }
            if (half == 0) {
                if (d == 1) k0b[tid & 255] = acc[0];
                __syncthreads();
                if (d == 0) acc[0] += k0b[tid & 255] + (co == ci ? F.in[I_S5D][layer * 1024 + g * 16 + co] : 0.f);
            }
#pragma unroll
            for (int t = 0; t < 32; ++t) { const int tau = half * 32 + t; if (d == 1 && tau == 0) continue; const int delta = d == 0 ? tau : -tau; KC[(size_t)(delta + 63) * 256 + co * 16 + ci] = f2bf(acc[t]); }
        }
        if (d == 1) KC[(size_t)127 * 256 + (tid & 255)] = 0;
    }
    for (int u = tid; u < 2 * 64 * 64 * 2; u += NTHR) {
        const int ch = u & 1, sp = (u >> 1) & 63, n = (u >> 7) & 63, d = u >> 13;
        const int tau = d == 0 ? 63 - sp : sp; const float pr = pwr[(d * 65 + tau) * 64 + n], pi = pwi[(d * 65 + tau) * 64 + n];
        float er[8], ei[8];
#pragma unroll
        for (int e = 0; e < 8; ++e) { const float b_r = bbr[(d * 64 + n) * 16 + ch * 8 + e], b_i = bbi[(d * 64 + n) * 16 + ch * 8 + e]; er[e] = pr * b_r - pi * b_i; ei[e] = pr * b_i + pi * b_r; }
        u32x4 wr_, wi_; wr_.x = pk_bf16(er[0], er[1]); wr_.y = pk_bf16(er[2], er[3]); wr_.z = pk_bf16(er[4], er[5]); wr_.w = pk_bf16(er[6], er[7]);
        wi_.x = pk_bf16(ei[0], ei[1]); wi_.y = pk_bf16(ei[2], ei[3]); wi_.z = pk_bf16(ei[4], ei[5]); wi_.w = pk_bf16(ei[6], ei[7]);
        *(u32x4*)(EC + (size_t)(d * 128 + n) * 1024 + sp * 16 + ch * 8) = wr_;
        *(u32x4*)(EC + (size_t)(d * 128 + 64 + n) * 1024 + sp * 16 + ch * 8) = wi_;
    }
    for (int u = tid; u < 1024 * 32; u += NTHR) {
        const int n8 = u & 7, part = (u >> 3) & 1, d = (u >> 4) & 1, co = (u >> 5) & 15, tp = u >> 9;
        const int tau = d == 0 ? tp + 1 : 64 - tp; float f[8];
#pragma unroll
        for (int e = 0; e < 8; ++e) { const int n = n8 * 8 + e; const float c_r = ccr[(d * 16 + co) * 64 + n], c_i = cci[(d * 16 + co) * 64 + n], pr = pwr[(d * 65 + tau) * 64 + n], pi = pwi[(d * 65 + tau) * 64 + n];
            f[e] = part == 0 ? (c_r * pr - c_i * pi) : -(c_r * pi + c_i * pr); }
        u32x4 w; w.x = pk_bf16(f[0], f[1]); w.y = pk_bf16(f[2], f[3]); w.z = pk_bf16(f[4], f[5]); w.w = pk_bf16(f[6], f[7]);
        *(u32x4*)(FC + (size_t)(tp * 16 + co) * 256 + d * 128 + part * 64 + n8 * 8) = w;
    }
    __syncthreads();
}

__device__ __forceinline__ void s5a_wave_item(const Frame& F, int lane, int wi) {
    const int rh = wi & 1, w2 = wi >> 1, g = w2 / 9, cq = w2 - g * 9, l15 = lane & 15, q = lane >> 4;
    const bf16_t* P = (const bf16_t*)(F.ws + WS_P); const bf16_t* EC = (const bf16_t*)(F.ws + WS_S5E) + (size_t)g * 256 * 1024 + (size_t)rh * 128 * 1024;
    float* XL = (float*)(F.ws + WS_S5X);
    const bf16_t* ub[4]; int colv[4];
#pragma unroll
    for (int c = 0; c < 4; ++c) { const int ct = (cq * 4 + c) < 33 ? cq * 4 + c : 32; const int col = ct * 16 + l15, b = col / NCH, jn = col - b * NCH; colv[c] = col;
        ub[c] = P + (size_t)(b * TB + jn * 64 + (q >> 1)) * PW + PC_S5 + g * 16 + (q & 1) * 8; }
    const unsigned eoff = (unsigned)(l15 * 1024 + q * 8) * 2u;
    f32x4 acc[4][8];
#pragma unroll
    for (int c = 0; c < 4; ++c)
#pragma unroll
        for (int x = 0; x < 8; ++x) acc[c][x] = (f32x4){0.f, 0.f, 0.f, 0.f};
    for (int ks = 0; ks < 32; ks += 2) {
        bf16x8 Bf[2][4], Af[2][8];
#pragma unroll
        for (int u = 0; u < 2; ++u) {
#pragma unroll
            for (int c = 0; c < 4; ++c) Bf[u][c] = *(const bf16x8*)(ub[c] + (size_t)((ks + u) * 2) * PW);
            unsigned eo = eoff; asm volatile("" : "+v"(eo));
#pragma unroll
            for (int x = 0; x < 8; ++x) Af[u][x] = *(const bf16x8*)((const char*)(EC + (size_t)(x * 16) * 1024 + (ks + u) * 32) + eo); }
#pragma unroll
        for (int u = 0; u < 2; ++u)
#pragma unroll
            for (int x = 0; x < 8; ++x)
#pragma unroll
                for (int c = 0; c < 4; ++c) acc[c][x] = MFMA16(Af[u][x], Bf[u][c], acc[c][x]);
    }
#pragma unroll
    for (int c = 0; c < 4; ++c) if (cq * 4 + c < 33) {
#pragma unroll
        for (int x = 0; x < 8; ++x) *(f32x4*)(XL + ((size_t)g * 528 + colv[c]) * 256 + rh * 128 + x * 16 + q * 4) = acc[c][x]; }
}

__device__ __forceinline__ void s5b_item(const Frame& F, int tid, int layer, int it) {
    const int idx = it * NTHR + tid, n = idx & 63, g = (idx >> 6) & 63, b = (idx >> 12) & 3, d = idx >> 14;
    const size_t li = (((size_t)layer * 2 + d) * 64 + g) * 64 + n;
    const float dt = expf(F.in[I_S5LDT][((size_t)layer * 2 + d) * 64 + g]);
    const float zr = F.in[I_S5LRE][li] * dt * 64.0f, zi = F.in[I_S5LIM][li] * dt * 64.0f;
    const float mag = expf(zr); float sn, cs; fsincos(zi, &sn, &cs); const float ar = mag * cs, ai = mag * sn;
    float* XL = (float*)(F.ws + WS_S5X);
    float cr = 0.f, ci = 0.f;
    for (int j0 = 0; j0 < NCH; j0 += 12) {
        float xr[12], xi[12];
#pragma unroll
        for (int u = 0; u < 12; ++u) { const int col = b * NCH + nat_chunk(d, j0 + u); const float* p = XL + ((size_t)g * 528 + col) * 256 + d * 128 + n; xr[u] = p[0]; xi[u] = p[64]; }
#pragma unroll
        for (int u = 0; u < 12; ++u) { const int col = b * NCH + nat_chunk(d, j0 + u); float* p = XL + ((size_t)g * 528 + col) * 256 + d * 128 + n;
            p[0] = cr; p[64] = ci; const float nr = ar * cr - ai * ci + xr[u], ni = ar * ci + ai * cr + xi[u]; cr = nr; ci = ni; }
    }
}

__device__ __forceinline__ float gelu_tanh(float x) { const float u = 0.7978845608028654f * (x + 0.044715f * x * x * x); const float e = __expf(2.0f * u); const float th = 1.0f - 2.0f / (e + 1.0f); return 0.5f * x * (1.0f + th); }
__device__ __forceinline__ void s5c_block_item(const Frame& F, int tid, int it) {
    const int g = it >> 2, part = it & 3, lane = tid & 63, l15 = lane & 15, q = lane >> 4;
    const int wave = __builtin_amdgcn_readfirstlane(tid >> 6);
    LAS bf16_t* KL = (LAS bf16_t*)F.lds;
    LAS bf16_t* UL = KL + 127 * 264;
    { const bf16_t* KC = (const bf16_t*)(F.ws + WS_S5KC) + (size_t)g * 128 * 256;
      for (int i = tid; i < 127 * 32; i += NTHR) { const int r = i >> 5, sgm = i & 31, co = sgm >> 1, hf = sgm & 1;
          *(LAS u32x4*)(KL + r * 264 + hf * 128 + co * 8) = *(const u32x4*)(KC + (size_t)r * 256 + sgm * 8); } }
    const bf16_t* P = (const bf16_t*)(F.ws + WS_P);
    const bf16_t* FC = (const bf16_t*)(F.ws + WS_S5F) + (size_t)g * 1024 * 256; const float* XC = (const float*)(F.ws + WS_S5X);
    void* OUT = (void*)(F.ws + WS_SC + SC_S5);
    const int c0 = part == 0 ? 0 : 9 + (part - 1) * 8, nct = part == 0 ? 9 : 8;
    for (int cp = 0; cp < (nct + 1) / 2; ++cp) {
        const int ctA = c0 + 2 * cp; const bool vB = (2 * cp + 1) < nct; const int ctB = vB ? ctA + 1 : ctA;
        __syncthreads();
        { const int grp = tid >> 8; const int ct = grp == 0 ? ctA : ctB;
#pragma unroll
          for (int i = 0; i < 8; ++i) { const int id = (tid & 255) + i * 256, s = id >> 5, rem = id & 31, cl = rem >> 1, hf = rem & 1;
              const int colg = ct * 16 + cl, bb = colg / NCH, jj = colg - bb * NCH;
              *(LAS u32x4*)(UL + grp * 16384 + s * 256 + hf * 128 + cl * 8) = *(const u32x4*)(P + (size_t)(bb * TB + jj * 64 + s) * PW + PC_S5 + g * 16 + hf * 8); } }
        __syncthreads();
        const int colA = ctA * 16 + l15, bA = colA / NCH, jA = colA - bA * NCH, colB = ctB * 16 + l15, bB = colB / NCH, jB = colB - bB * NCH;
        const LAS bf16_t* kcl = KL + (63 - (q >> 1)) * 264 + (q & 1) * 128 + l15 * 8;
        const LAS bf16_t* ul = UL + (q >> 1) * 256 + (q & 1) * 128 + l15 * 8;
        f32x4 acc[2][8];
#pragma unroll
        for (int c = 0; c < 2; ++c)
#pragma unroll
            for (int x = 0; x < 8; ++x) acc[c][x] = (f32x4){0.f, 0.f, 0.f, 0.f};
        for (int kb = 0; kb < 4; ++kb) {
#pragma unroll
            for (int i = 0; i < 8; ++i) { const int ks = kb * 8 + i; const bf16x8 b0 = ldsA(ul + ks * 512), b1 = ldsA(ul + 16384 + ks * 512);
#pragma unroll
                for (int x = 0; x < 8; ++x) { const bf16x8 af = ldsA(kcl + (wave * 8 + x - 2 * ks) * 264); acc[0][x] = MFMA16(af, b0, acc[0][x]); acc[1][x] = MFMA16(af, b1, acc[1][x]); }
                if (i & 1) __builtin_amdgcn_sched_barrier(0); }
        }
        {
            const unsigned foff = (unsigned)(l15 * 256 + q * 8) * 2u; const bf16_t* fu = FC + (size_t)(wave * 128) * 256;
            bf16x8 Af[8];
            { unsigned fo = foff; asm volatile("" : "+v"(fo));
#pragma unroll
              for (int x = 0; x < 8; ++x) Af[x] = *(const bf16x8*)((const char*)(fu + (size_t)(x * 16) * 256) + fo); }
            bf16x8 Xa[8], Xb[8];
#pragma unroll
            for (int ks = 0; ks < 8; ++ks) { const float* xp = XC + ((size_t)g * 528 + colA) * 256 + ks * 32 + q * 8; Xa[ks] = pack_8(*(const f32x4*)xp, *(const f32x4*)(xp + 4));
                const float* xq = XC + ((size_t)g * 528 + colB) * 256 + ks * 32 + q * 8; Xb[ks] = pack_8(*(const f32x4*)xq, *(const f32x4*)(xq + 4)); }
#pragma unroll
            for (int ks = 0; ks < 8; ++ks) { bf16x8 An[8]; unsigned fo = foff; asm volatile("" : "+v"(fo));
                if (ks + 1 < 8) {
#pragma unroll
                    for (int x = 0; x < 8; ++x) An[x] = *(const bf16x8*)((const char*)(fu + (size_t)(x * 16) * 256 + (ks + 1) * 32) + fo); }
#pragma unroll
                for (int x = 0; x < 8; ++x) { acc[0][x] = MFMA16(Af[x], Xa[ks], acc[0][x]); acc[1][x] = MFMA16(Af[x], Xb[ks], acc[1][x]); }
                if (ks + 1 < 8) {
#pragma unroll
                    for (int x = 0; x < 8; ++x) Af[x] = An[x]; }
                __builtin_amdgcn_sched_barrier(0); }
        }
#pragma unroll
        for (int x = 0; x < 8; ++x) { const int tp = wave * 8 + x;
            { const size_t row = (size_t)bA * TB + jA * 64 + tp; st_op4(OUT, row * 1024 + g * 16 + q * 4, gelu_tanh(acc[0][x][0]), gelu_tanh(acc[0][x][1]), gelu_tanh(acc[0][x][2]), gelu_tanh(acc[0][x][3])); }
            if (vB) { const size_t row = (size_t)bB * TB + jB * 64 + tp; st_op4(OUT, row * 1024 + g * 16 + q * 4, gelu_tanh(acc[1][x][0]), gelu_tanh(acc[1][x][1]), gelu_tanh(acc[1][x][2]), gelu_tanh(acc[1][x][3])); } }
    }
    __syncthreads();
}

__device__ __forceinline__ float logsigmoidf_(float x) { return fminf(x, 0.f) - __logf(1.0f + __expf(-fabsf(x))); }
__device__ __forceinline__ void mlstm_item(const Frame& F, int tid, int layer, int item) {
    const int vs = item & 3, h = (item >> 2) & 3, b = (item >> 4) & 3, d = item >> 6;
    const int lane = tid & 63, wave = __builtin_amdgcn_readfirstlane(tid >> 6), l15 = lane & 15, q = lane >> 4;
    const int y = wave & 3, p = wave >> 2;
    LAS bf16_t* Qs = (LAS bf16_t*)F.lds;
    LAS bf16_t* Ks = Qs + 64 * 264;
    LAS bf16_t* Kt = Ks + 64 * 264;
    LAS bf16_t* Vt = Kt + 256 * 72;
    LAS bf16_t* Vw = Vt + 64 * 72;
    LAS bf16_t* St = Vw + 64 * 72;
    LAS float* PX = (LAS float*)(St + 64 * 72);
    LAS float* fl = PX + 4 * 4 * 64 * 4;
    LAS float* gsc = fl;
    LAS float* rsum = fl + 384;
    LAS float* qn = fl + 512;
    LAS float* nvec = fl + 576;
    LAS float* wtsl = fl + 832;
    const bf16_t* P = (const bf16_t*)(F.ws + WS_P); const bf16_t* QK = (const bf16_t*)(F.ws + WS_QK);
    bf16_t* HO = (bf16_t*)(F.ws + WS_P);
    if (tid < 256) nvec[tid] = 0.f;
    f32x4 Cst[8];
#pragma unroll
    for (int x = 0; x < 8; ++x) Cst[x] = (f32x4){0.f, 0.f, 0.f, 0.f};
    float m_prev = 0.f;
    u32x4 pq[4], pk[4], pv; float pgi = 0.f, pgf = 0.f;
#define ML_LOAD(jj) do { const int rb_ = b * TB + nat_chunk(d, (jj)) * 64; int tl = tid; asm volatile("" : "+v"(tl));   \
        _Pragma("unroll") for (int i = 0; i < 4; ++i) { const int id = tl + i * NTHR; { const int t = id >> 5, seg = id & 31; const size_t row = (size_t)(rb_ + (d == 0 ? t : 63 - t)); pq[i] = *(const u32x4*)(QK + row * 2048 + h * 256 + seg * 8); } \
            { const int t = id & 63, seg = id >> 6; const size_t row = (size_t)(rb_ + (d == 0 ? t : 63 - t)); pk[i] = *(const u32x4*)(QK + row * 2048 + 1024 + h * 256 + seg * 8); } } \
        { const int t = tl & 63, seg = tl >> 6; const size_t row = (size_t)(rb_ + (d == 0 ? t : 63 - t)); pv = *(const u32x4*)(P + row * PW + PC_V + h * 256 + vs * 64 + seg * 8); } \
        if (wave == 7) { const size_t row = (size_t)(rb_ + (d == 0 ? lane : 63 - lane)); pgi = bf2f(P[row * PW + PC_IG + d * 4 + h]); pgf = bf2f(P[row * PW + PC_FG + d * 4 + h]); } } while (0)
#define ML_STAGE(jj) do { int tl = tid; asm volatile("" : "+v"(tl)); \
        _Pragma("unroll") for (int i = 0; i < 4; ++i) { const int id = tl + i * NTHR; { const int t = id >> 5, seg = id & 31; *(LAS u32x4*)(Qs + t * 264 + seg * 8) = pq[i]; } \
            { const int t = id & 63, seg = id >> 6; *(LAS u32x4*)(Ks + t * 264 + seg * 8) = pk[i]; const unsigned kw[4] = {pk[i].x, pk[i].y, pk[i].z, pk[i].w}; \
              _Pragma("unroll") for (int e = 0; e < 4; ++e) { Kt[(seg * 8 + 2 * e) * 72 + t] = (bf16_t)(kw[e] & 0xffffu); Kt[(seg * 8 + 2 * e + 1) * 72 + t] = (bf16_t)(kw[e] >> 16); } } } \
        { const int t = tl & 63, seg = tl >> 6; const unsigned vw_[4] = {pv.x, pv.y, pv.z, pv.w}; \
            _Pragma("unroll") for (int e = 0; e < 4; ++e) { Vt[(seg * 8 + 2 * e) * 72 + t] = (bf16_t)(vw_[e] & 0xffffu); Vt[(seg * 8 + 2 * e + 1) * 72 + t] = (bf16_t)(vw_[e] >> 16); } } \
        if (wave == 7) { const float igb = F.in[I_MLIGB][layer * 8 + d * 4 + h], fgb = F.in[I_MLFGB][layer * 8 + d * 4 + h];     \
            float bc = logsigmoidf_(pgf + fgb); \
            _Pragma("unroll") for (int o = 1; o < 64; o <<= 1) { const float t = shup(bc, o, lane); if (lane >= o) bc += t; } \
            const float g_ = (pgi + igb) - bc; float pm = g_; \
            _Pragma("unroll") for (int o = 1; o < 64; o <<= 1) { const float t = shup(pm, o, lane); if (lane >= o) pm = fmaxf(pm, t); } \
            LAS float* gs_ = gsc + ((jj) & 1) * 192; gs_[lane] = g_; gs_[64 + lane] = pm; gs_[128 + lane] = bc; } } while (0)
    ML_LOAD(0);
    __syncthreads();
    ML_STAGE(0);
    ML_LOAD(1);
    __syncthreads();
    for (int j = 0; j < NCH; ++j) {
        const int rb = b * TB + nat_chunk(d, j) * 64;
        const LAS float* gg = gsc + (j & 1) * 192; const LAS float* pmx = gg + 64; const LAS float* bcm = gg + 128;
        const float a63 = fmaxf(m_prev, pmx[63]), decay = __expf(m_prev - a63), m_new = bcm[63] + a63;
        { const int tr = wave >> 1; float rp[4] = {0.f, 0.f, 0.f, 0.f};
#pragma unroll
          for (int u = 0; u < 2; ++u) { const int tc = (wave & 1) * 2 + u; f32x4 acc = (f32x4){0.f, 0.f, 0.f, 0.f};
              if (tc <= tr) {
#pragma unroll
                  for (int ks = 0; ks < 8; ++ks) acc = MFMA16(ldsA(Qs + (tr * 16 + l15) * 264 + ks * 32 + q * 8), ldsA(Ks + (tc * 16 + l15) * 264 + ks * 32 + q * 8), acc);
              }
              const int s = tc * 16 + l15; const float gs = gg[s];
#pragma unroll
              for (int i = 0; i < 4; ++i) { const int jr = tr * 16 + q * 4 + i; const float v = (s <= jr) ? acc[i] * __expf(gs - fmaxf(pmx[jr], m_prev)) : 0.f; St[jr * 72 + s] = f2bf(v); rp[i] += v; } }
#pragma unroll
          for (int i = 0; i < 4; ++i) { float s_ = rp[i]; s_ += shx<1>(s_); s_ += shx<2>(s_); s_ += shx<4>(s_); s_ += shx<8>(s_); if (l15 == 0) rsum[(wave & 1) * 64 + tr * 16 + q * 4 + i] = s_; } }
#pragma unroll
        for (int i = 0; i < 8; ++i) { const int id = tid + i * NTHR, dv = id >> 6, s = id & 63; Vw[dv * 72 + s] = f2bf(bf2f(Vt[dv * 72 + s]) * __expf(gg[s] - a63)); }
        if (tid < 64) wtsl[tid] = __expf(gg[tid] - a63);
        { const int row = tid >> 3, part = tid & 7; float qv = 0.f;
#pragma unroll
          for (int e8 = 0; e8 < 4; ++e8) { float x8[8]; unpack8(*(const LAS u32x4*)(Qs + row * 264 + part * 32 + e8 * 8), x8); const f32x4 n0 = *(const LAS f32x4*)(nvec + part * 32 + e8 * 8), n1 = *(const LAS f32x4*)(nvec + part * 32 + e8 * 8 + 4);
              qv += (x8[0] * n0[0] + x8[1] * n0[1]) + (x8[2] * n0[2] + x8[3] * n0[3]) + (x8[4] * n1[0] + x8[5] * n1[1]) + (x8[6] * n1[2] + x8[7] * n1[3]); }
          qv += shx<1>(qv); qv += shx<2>(qv); qv += shx<4>(qv);
          if (part == 0) qn[row] = qv; }
        __syncthreads();
        f32x4 acc[4], PXs[4];
#pragma unroll
        for (int rt = 0; rt < 4; ++rt) PXs[rt] = (f32x4){0.f, 0.f, 0.f, 0.f};
        { bf16x8 Cb[4];
#pragma unroll
          for (int kk = 0; kk < 4; ++kk) Cb[kk] = pack_8(Cst[2 * kk], Cst[2 * kk + 1]);
#pragma unroll
          for (int rt = 0; rt < 4; ++rt) { acc[rt] = (f32x4){0.f, 0.f, 0.f, 0.f};
#pragma unroll
              for (int kk = 0; kk < 4; ++kk) { const LAS bf16_t* qp = Qs + (rt * 16 + l15) * 264 + (p * 8 + 2 * kk) * 16 + q * 4; acc[rt] = MFMA16(lds_2x8(qp, qp + 16), Cb[kk], acc[rt]); } } }
        if (p == 1) {
#pragma unroll
            for (int rt = 0; rt < 4; ++rt) *(LAS f32x4*)(PX + ((y * 4 + rt) * 64 + lane) * 4) = acc[rt];
        } else {
#pragma unroll
            for (int rt = 0; rt < 4; ++rt) { f32x4 a2 = (f32x4){0.f, 0.f, 0.f, 0.f};
#pragma unroll
                for (int ks = 0; ks < 2; ++ks) a2 = MFMA16(ldsA(St + (rt * 16 + l15) * 72 + ks * 32 + q * 8), ldsA(Vt + (y * 16 + l15) * 72 + ks * 32 + q * 8), a2);
                PXs[rt] = a2; }
        }
        { const bf16x8 vw0 = ldsA(Vw + (y * 16 + l15) * 72 + q * 8), vw1 = ldsA(Vw + (y * 16 + l15) * 72 + 32 + q * 8);
          bf16x8 wq0, wq1; { const f32x4 a0 = *(const LAS f32x4*)(wtsl + q * 8), a1 = *(const LAS f32x4*)(wtsl + q * 8 + 4), b0 = *(const LAS f32x4*)(wtsl + 32 + q * 8), b1 = *(const LAS f32x4*)(wtsl + 32 + q * 8 + 4);
              const f32x4 zz = (f32x4){0.f, 0.f, 0.f, 0.f}; wq0 = l15 == 0 ? pack_8(a0, a1) : pack_8(zz, zz); wq1 = l15 == 0 ? pack_8(b0, b1) : pack_8(zz, zz); }
#pragma unroll
          for (int x = 0; x < 8; ++x) { Cst[x] *= decay; const LAS bf16_t* kp = Kt + ((p * 8 + x) * 16 + l15) * 72 + q * 8; const bf16x8 k0 = ldsA(kp), k1 = ldsA(kp + 32);
              Cst[x] = MFMA16(k0, vw0, Cst[x]); Cst[x] = MFMA16(k1, vw1, Cst[x]);
              if (x == 2 * y || x == 2 * y + 1) { const int dkb = (p * 8 + x) * 16 + q * 4; f32x4 nn = (f32x4){0.f, 0.f, 0.f, 0.f};
                  if (l15 == 0) { nn = *(const LAS f32x4*)(nvec + dkb); nn *= decay; }
                  nn = MFMA16(k0, wq0, nn); nn = MFMA16(k1, wq1, nn);
                  if (l15 == 0) *(LAS f32x4*)(nvec + dkb) = nn; } } }
        __syncthreads();
        if (p == 0) {
#pragma unroll
            for (int rt = 0; rt < 4; ++rt) { const f32x4 px = *(const LAS f32x4*)(PX + ((y * 4 + rt) * 64 + lane) * 4);
#pragma unroll
                for (int i = 0; i < 4; ++i) { const int t = rt * 16 + q * 4 + i; const float a_ = fmaxf(pmx[t], m_prev), si = __expf(m_prev - a_);
                    const float hd = fmaxf(fabsf(rsum[t] + rsum[64 + t] + si * qn[t]), __expf(-(bcm[t] + a_)));
                    const float num = (acc[rt][i] + px[i]) * si + PXs[rt][i];
                    const size_t row = (size_t)(rb + (d == 0 ? t : 63 - t));
                    HO[row * PW + d * 1024 + h * 256 + vs * 64 + y * 16 + l15] = f2bf(num * __builtin_amdgcn_rcpf(hd)); } }
        }
        if (j + 1 < NCH) { ML_STAGE(j + 1); if (j + 2 < NCH) ML_LOAD(j + 2); }
        m_prev = m_new;
        __syncthreads();
    }
#undef ML_LOAD
#undef ML_STAGE
}

__device__ __forceinline__ void ml_finish_rows(const Frame& F, int lane, int layer) {
    const bf16_t* P = (const bf16_t*)(F.ws + WS_P); bf16_t* ML = (bf16_t*)(F.ws + WS_SC + SC_ML);
    const float* ng = F.in[I_MLNG] + layer * 1024; const float* nb = F.in[I_MLNB] + layer * 1024;
    const int c0 = lane * 16, stride = F.G * NWAVE;
    for (int r0 = F.bid * NWAVE + F.wave; r0 < R; r0 += 4 * stride) {
        u32x4 ha[4][2], hb[4][2], ho[4][2];
#pragma unroll
        for (int u = 0; u < 4; ++u) { const int r = r0 + u * stride < R ? r0 + u * stride : r0; const bf16_t* pr = P + (size_t)r * PW;
#pragma unroll
            for (int hh = 0; hh < 2; ++hh) { ha[u][hh] = *(const u32x4*)(pr + c0 + hh * 8); hb[u][hh] = *(const u32x4*)(pr + 1024 + c0 + hh * 8); ho[u][hh] = *(const u32x4*)(pr + PC_O + c0 + hh * 8); } }
#pragma unroll
        for (int u = 0; u < 4; ++u) { const int r = r0 + u * stride; if (r < R) {
            float v[16], o[16];
#pragma unroll
            for (int hh = 0; hh < 2; ++hh) { float a8[8], b8[8], o8[8]; unpack8(ha[u][hh], a8); unpack8(hb[u][hh], b8); unpack8(ho[u][hh], o8);
#pragma unroll
                for (int e2 = 0; e2 < 8; ++e2) { v[hh * 8 + e2] = a8[e2] + b8[e2]; o[hh * 8 + e2] = o8[e2]; } }
            float s = 0.f;
#pragma unroll
            for (int e2 = 0; e2 < 16; ++e2) s += v[e2];
            s += shx<1>(s); s += shx<2>(s); s += shx<4>(s); s += shx<8>(s);
            const float mean = s * (1.0f / 256.0f); float qq = 0.f;
#pragma unroll
            for (int e2 = 0; e2 < 16; ++e2) { v[e2] -= mean; qq += v[e2] * v[e2]; }
            qq += shx<1>(qq); qq += shx<2>(qq); qq += shx<4>(qq); qq += shx<8>(qq);
            const float rstd = rsqrtf(qq * (1.0f / 256.0f) + 1e-6f);
            float y8[8];
#pragma unroll
            for (int hh = 0; hh < 2; ++hh) {
#pragma unroll
                for (int e2 = 0; e2 < 8; ++e2) { const int ee = hh * 8 + e2; y8[e2] = (v[ee] * rstd * ng[c0 + ee] + nb[c0 + ee]) * sigmoidf_(o[ee]); }
                st_op8(ML, (size_t)r * 1024 + c0 + hh * 8, y8); } } }
    }
}


__device__ __forceinline__ void tshift8(const bf16_t* P, size_t row, int srow, int col, const float* mu, float (&o)[8]) {
    float z[8], zp[8], zn[8];
    const bool hp = (srow != 0 && srow != CTXL), hn = (srow != CTXL - 1 && srow != TB - 1);
    const u32x4 wz = *(const u32x4*)(P + row * PW + col), wp = *(const u32x4*)(P + (hp ? row - 1 : row) * PW + col), wn = *(const u32x4*)(P + (hn ? row + 1 : row) * PW + col);
    const f32x4 m0 = *(const f32x4*)mu, m1 = *(const f32x4*)(mu + 4);
    unpack8(wz, z); unpack8(wp, zp); unpack8(wn, zn);
    const float fp = hp ? 0.5f : 0.f, fn = hn ? 0.5f : 0.f;
#pragma unroll
    for (int e = 0; e < 8; ++e) { const float m = e < 4 ? m0[e & 3] : m1[e & 3]; o[e] = z[e] + m * (fp * zp[e] + fn * zn[e] - z[e]); }
}
__device__ __forceinline__ void rwkv_item(const Frame& F, int tid, int layer, int item) {
    const int h = item & 15, b = (item >> 4) & 3, d = item >> 6;
    const int lane = tid & 63, wave = __builtin_amdgcn_readfirstlane(tid >> 6), l15 = lane & 15, q = lane >> 4;
    LAS float* r_ = (LAS float*)F.lds;
    LAS float* w_ = r_ + 4096, *kd_ = w_ + 4096, *kk_ = kd_ + 4096, *bb_ = kk_ + 4096, *v_ = bb_ + 4096;
    LAS bf16_t* TW = (LAS bf16_t*)(v_ + 4096);
    LAS bf16_t* TA = TW + 64 * 72;
    LAS bf16_t* WU = TA + 64 * 72;
    LAS bf16_t* AU = WU + 64 * 72;
    LAS float* yout = (LAS float*)TW;
    const bf16_t* P = (const bf16_t*)(F.ws + WS_P);
    bf16_t* YO = (bf16_t*)(F.ws + WS_SC + (d == 0 ? SC_RWF : SC_RWB));
    float* BON = (float*)(F.ws + WS_BONUS) + (size_t)d * R * 16;
    const float* mu = F.in[I_RWMU] + layer * 3456;
    {
        const int rr = tid >> 3, c0 = (tid & 7) * 8;
        const float* wu = F.in[I_RWWUP] + (((size_t)layer * 2 + d) * 64 + rr) * 1024 + h * 64 + c0; const float* au = F.in[I_RWAUP] + (((size_t)layer * 2 + d) * 64 + rr) * 1024 + h * 64 + c0;
#pragma unroll
        for (int e = 0; e < 8; ++e) { WU[(c0 + e) * 72 + rr] = f2bf(wu[e]); AU[(c0 + e) * 72 + rr] = f2bf(au[e]); }
    }
    const int t_ = tid >> 3, c0 = (tid & 7) * 8;
    float mur[8], muk[8], muv[8], muw[8], mua[8], kkc[8], kac[8], rkc[8];
#pragma unroll
    for (int e = 0; e < 8; ++e) { mur[e] = mu[h * 64 + c0 + e]; muk[e] = mu[1024 + h * 64 + c0 + e]; muv[e] = mu[2048 + h * 64 + c0 + e]; muw[e] = mu[3072 + d * 64 + c0 + e]; mua[e] = mu[3200 + d * 64 + c0 + e];
        kkc[e] = F.in[I_RWKK][layer * 1024 + h * 64 + c0 + e]; kac[e] = F.in[I_RWKA][layer * 1024 + h * 64 + c0 + e]; rkc[e] = F.in[I_RWRK][layer * 1024 + h * 64 + c0 + e]; }
    float S[8];
#pragma unroll
    for (int e = 0; e < 8; ++e) S[e] = 0.f;
    const int vrow = tid >> 3, cg = tid & 7;
    __syncthreads();
    for (int j = 0; j < NCH; ++j) {
        const int jn = nat_chunk(d, j); const int srow = jn * 64 + (d == 0 ? t_ : 63 - t_); const size_t row = (size_t)b * TB + srow;
        float rs[8], ks[8], vs[8], tmp[8];
        tshift8(P, row, srow, PC_RR + h * 64 + c0, mur, rs); tshift8(P, row, srow, PC_RK + h * 64 + c0, muk, ks); tshift8(P, row, srow, PC_RV + h * 64 + c0, muv, vs);
        tshift8(P, row, srow, PC_WD + d * 64 + c0, muw, tmp);
#pragma unroll
        for (int e = 0; e < 8; ++e) TW[t_ * 72 + c0 + e] = f2bf(tanhf_(tmp[e]));
        tshift8(P, row, srow, PC_AD + d * 64 + c0, mua, tmp);
#pragma unroll
        for (int e = 0; e < 8; ++e) TA[t_ * 72 + c0 + e] = f2bf(tmp[e]);
        float kkv[8], ss = 0.f;
#pragma unroll
        for (int e = 0; e < 8; ++e) { r_[t_ * 64 + c0 + e] = rs[e]; v_[t_ * 64 + c0 + e] = vs[e]; kkv[e] = ks[e] * kkc[e]; ss += kkv[e] * kkv[e]; }
        ss += shx<1>(ss); ss += shx<2>(ss); ss += shx<4>(ss);
        const float inv = 1.0f / fmaxf(sqrtf(ss), 1e-12f);
        __syncthreads();
        {
            const int tr = wave >> 1;
#pragma unroll
            for (int u = 0; u < 2; ++u) { const int tc = (wave & 1) * 2 + u; f32x4 aw = (f32x4){0.f, 0.f, 0.f, 0.f}, aa = aw;
#pragma unroll
                for (int kq = 0; kq < 2; ++kq) { aw = MFMA16(ldsA(TW + (tr * 16 + l15) * 72 + kq * 32 + q * 8), ldsA(WU + (tc * 16 + l15) * 72 + kq * 32 + q * 8), aw);
                    aa = MFMA16(ldsA(TA + (tr * 16 + l15) * 72 + kq * 32 + q * 8), ldsA(AU + (tc * 16 + l15) * 72 + kq * 32 + q * 8), aa); }
                const int c = tc * 16 + l15; const float w0 = F.in[I_RWW0][((size_t)layer * 2 + d) * 1024 + h * 64 + c], a0 = F.in[I_RWA0][((size_t)layer * 2 + d) * 1024 + h * 64 + c];
#pragma unroll
                for (int i = 0; i < 4; ++i) { const int t = tr * 16 + q * 4 + i; w_[t * 64 + c] = __expf(-0.6065306597126334f * sigmoidf_(w0 + aw[i])); bb_[t * 64 + c] = sigmoidf_(a0 + aa[i]); } }
        }
        __syncthreads();
        { float bon = 0.f;
#pragma unroll
          for (int e = 0; e < 8; ++e) { const float a = bb_[t_ * 64 + c0 + e]; const float kdv = ks[e] * (1.0f + (a - 1.0f) * kac[e]); const float kkn = kkv[e] * inv;
              kd_[t_ * 64 + c0 + e] = kdv; kk_[t_ * 64 + c0 + e] = kkn; bb_[t_ * 64 + c0 + e] = kkn * a; bon += rs[e] * kdv * rkc[e]; }
          bon += shx<1>(bon); bon += shx<2>(bon); bon += shx<4>(bon);
          if ((tid & 7) == 0) BON[row * 16 + h] = bon; }
        __syncthreads();
        for (int t = 0; t < 64; ++t) {
            const LAS f32x4* pk = (const LAS f32x4*)(kk_ + t * 64 + cg * 8); const LAS f32x4* pw = (const LAS f32x4*)(w_ + t * 64 + cg * 8);
            const LAS f32x4* pb = (const LAS f32x4*)(bb_ + t * 64 + cg * 8); const LAS f32x4* pd = (const LAS f32x4*)(kd_ + t * 64 + cg * 8); const LAS f32x4* pr = (const LAS f32x4*)(r_ + t * 64 + cg * 8);
            const f32x4 k0 = pk[0], k1 = pk[1], w0 = pw[0], w1 = pw[1], b0 = pb[0], b1 = pb[1], d0 = pd[0], d1 = pd[1], r0 = pr[0], r1 = pr[1];
            const float vv = v_[t * 64 + vrow];
            float skk = (S[0] * k0[0] + S[1] * k0[1]) + (S[2] * k0[2] + S[3] * k0[3]) + (S[4] * k1[0] + S[5] * k1[1]) + (S[6] * k1[2] + S[7] * k1[3]);
            skk += shx<1>(skk); skk += shx<2>(skk); skk += shx<4>(skk);
#pragma unroll
            for (int e = 0; e < 4; ++e) { S[e] = S[e] * w0[e] - skk * b0[e] + vv * d0[e]; S[4 + e] = S[4 + e] * w1[e] - skk * b1[e] + vv * d1[e]; }
            float y = (S[0] * r0[0] + S[1] * r0[1]) + (S[2] * r0[2] + S[3] * r0[3]) + (S[4] * r1[0] + S[5] * r1[1]) + (S[6] * r1[2] + S[7] * r1[3]);
            y += shx<1>(y); y += shx<2>(y); y += shx<4>(y);
            if (cg == 0) yout[t * 64 + vrow] = y;
        }
        __syncthreads();
        { float yv[8];
#pragma unroll
          for (int e = 0; e < 8; ++e) yv[e] = yout[t_ * 64 + c0 + e];
          u32x4 w; w.x = pk_bf16(yv[0], yv[1]); w.y = pk_bf16(yv[2], yv[3]); w.z = pk_bf16(yv[4], yv[5]); w.w = pk_bf16(yv[6], yv[7]);
          *(u32x4*)(YO + row * 1024 + h * 64 + c0) = w; }
        __syncthreads();
    }
}

#define MFMAF32(a, b, c) __builtin_amdgcn_mfma_f32_16x16x4f32((a), (b), (c), 0, 0, 0)
__device__ __forceinline__ f32x4 mm16(const f32x4 P, const f32x4 Y) {
    f32x4 acc = (f32x4){0.f, 0.f, 0.f, 0.f};
#pragma unroll
    for (int i = 0; i < 4; ++i) acc = MFMAF32(P[i], Y[i], acc);
    return acc;
}
__device__ __forceinline__ bf16x8 pack_lo4(const f32x4 x) { u32x4 w; w.x = pk_bf16(x[0], x[1]); w.y = pk_bf16(x[2], x[3]); w.z = 0u; w.w = 0u; bf16x8 r; __builtin_memcpy(&r, &w, 16); return r; }
__device__ __forceinline__ bf16x8 pack_hi4(const f32x4 x) { u32x4 w; w.x = 0u; w.y = 0u; w.z = pk_bf16(x[0], x[1]); w.w = pk_bf16(x[2], x[3]); bf16x8 r; __builtin_memcpy(&r, &w, 16); return r; }
#define WAVE_SYNC() do { asm volatile("s_waitcnt lgkmcnt(0)" ::: "memory"); __builtin_amdgcn_wave_barrier(); } while (0)
constexpr int RWC_WREG = 15360;
constexpr int RWC_R0 = 0, RWC_R1 = 2304, RWC_R2 = 4608, RWC_R3 = 6912, RWC_BK = 9216, RWC_V = 13312, RWC_NN = RWC_R1, RWC_TM = RWC_R1 + 1024, RWC_GL = RWC_R1 + 1536;
__device__ __forceinline__ void rwkvc_item(const Frame& F, int tid, int layer, int item) {
    const int h = item & 15, b = (item >> 4) & 3, d = item >> 6;
    const int lane = tid & 63, wave = __builtin_amdgcn_readfirstlane(tid >> 6), l15 = lane & 15, q = lane >> 4;
    LAS bf16_t* WU = (LAS bf16_t*)F.lds;
    LAS bf16_t* AU = WU + 64 * 72;
    LAS unsigned char* wreg0 = F.lds + 2 * 64 * 72 * 2;
    LAS unsigned char* wb = wreg0 + wave * RWC_WREG;
    LAS float* MUL = (LAS float*)(wreg0 + 8 * RWC_WREG);
    const bf16_t* P = (const bf16_t*)(F.ws + WS_P);
    bf16_t* YO = (bf16_t*)(F.ws + WS_SC + (d == 0 ? SC_RWF : SC_RWB));
    float* BON = (float*)(F.ws + WS_BONUS) + (size_t)d * R * 16;
    const float* mu = F.in[I_RWMU] + layer * 3456;
    if (tid < 320) { const int a = tid >> 6, c = tid & 63; const int off = a == 0 ? h * 64 : a == 1 ? 1024 + h * 64 : a == 2 ? 2048 + h * 64 : a == 3 ? 3072 + d * 64 : 3200 + d * 64; MUL[tid] = mu[off + c]; }
    {   const int rr = tid >> 3, c0 = (tid & 7) * 8;
        const float* wu = F.in[I_RWWUP] + (((size_t)layer * 2 + d) * 64 + rr) * 1024 + h * 64 + c0; const float* au = F.in[I_RWAUP] + (((size_t)layer * 2 + d) * 64 + rr) * 1024 + h * 64 + c0;
#pragma unroll
        for (int e = 0; e < 8; ++e) { WU[(c0 + e) * 72 + rr] = f2bf(wu[e]); AU[(c0 + e) * 72 + rr] = f2bf(au[e]); } }
    float kkc[4], kac[4], rkc[4], w0c[4], a0c[4];
#pragma unroll
    for (int ct = 0; ct < 4; ++ct) { const int c = h * 64 + ct * 16 + l15; kkc[ct] = F.in[I_RWKK][layer * 1024 + c]; kac[ct] = F.in[I_RWKA][layer * 1024 + c]; rkc[ct] = F.in[I_RWRK][layer * 1024 + c];
        w0c[ct] = F.in[I_RWW0][((size_t)layer * 2 + d) * 1024 + c]; a0c[ct] = F.in[I_RWA0][((size_t)layer * 2 + d) * 1024 + c]; }
    f32x4 Sacc[4];
#pragma unroll
    for (int x = 0; x < 4; ++x) Sacc[x] = (f32x4){0.f, 0.f, 0.f, 0.f};
    __syncthreads();
    for (int rnd = 0; rnd < NCH * 4 / 8; ++rnd) {
        {
            const int ch = rnd * 8 + wave, j64 = ch >> 2, jn = nat_chunk(d, j64), o0 = (ch & 3) * 16;
            LAS bf16_t* R0 = (LAS bf16_t*)(wb + RWC_R0); LAS bf16_t* R1 = (LAS bf16_t*)(wb + RWC_R1); LAS bf16_t* R2 = (LAS bf16_t*)(wb + RWC_R2); LAS bf16_t* R3 = (LAS bf16_t*)(wb + RWC_R3);
            LAS bf16_t* TAp = (LAS bf16_t*)(wb + RWC_BK); LAS bf16_t* BKT = (LAS bf16_t*)(wb + RWC_BK); LAS bf16_t* VF = (LAS bf16_t*)(wb + RWC_V);
            {
                const int t = lane >> 2, cq = (lane & 3) * 16; const int o = o0 + t; const int srow = jn * 64 + (d == 0 ? o : 63 - o); const size_t row = (size_t)b * TB + srow;
                const bool hp = (srow != 0 && srow != CTXL), hn = (srow != CTXL - 1 && srow != TB - 1); const float fp = hp ? 0.5f : 0.f, fn = hn ? 0.5f : 0.f;
                const bf16_t* pz = P + row * PW; const bf16_t* pp = P + (hp ? row - 1 : row) * PW; const bf16_t* pn = P + (hn ? row + 1 : row) * PW;
                const int colA[5] = {PC_RR + h * 64, PC_RK + h * 64, PC_RV + h * 64, PC_WD + d * 64, PC_AD + d * 64};
                u32x4 wz[5][2], wp[5][2], wn[5][2];
#pragma unroll
                for (int a = 0; a < 5; ++a)
#pragma unroll
                    for (int hh = 0; hh < 2; ++hh) { const int c = colA[a] + cq + hh * 8; wz[a][hh] = *(const u32x4*)(pz + c); wp[a][hh] = *(const u32x4*)(pp + c); wn[a][hh] = *(const u32x4*)(pn + c); }
                LAS bf16_t* dst[5] = {R0, R1, R2, R3, TAp};
#pragma unroll
                for (int a = 0; a < 5; ++a)
#pragma unroll
                    for (int hh = 0; hh < 2; ++hh) { const int cc = cq + hh * 8; float z[8], zp[8], zn[8], x8[8];
                        unpack8(wz[a][hh], z); unpack8(wp[a][hh], zp); unpack8(wn[a][hh], zn);
                        const f32x4 m0 = *(const LAS f32x4*)(MUL + a * 64 + cc), m1 = *(const LAS f32x4*)(MUL + a * 64 + cc + 4);
#pragma unroll
                        for (int e = 0; e < 8; ++e) { const float m = e < 4 ? m0[e & 3] : m1[e & 3]; x8[e] = z[e] + m * (fp * zp[e] + fn * zn[e] - z[e]); if (a == 3) x8[e] = tanhf_(x8[e]); }
                        u32x4 w; w.x = pk_bf16(x8[0], x8[1]); w.y = pk_bf16(x8[2], x8[3]); w.z = pk_bf16(x8[4], x8[5]); w.w = pk_bf16(x8[6], x8[7]); *(LAS u32x4*)(dst[a] + t * 72 + cc) = w; }
            }
            WAVE_SYNC();
            f32x4 lw[4], av[4];
            {   const bf16x8 tw0 = ldsA(R3 + l15 * 72 + q * 8), tw1 = ldsA(R3 + l15 * 72 + 32 + q * 8), ta0 = ldsA(TAp + l15 * 72 + q * 8), ta1 = ldsA(TAp + l15 * 72 + 32 + q * 8);
#pragma unroll
                for (int ct = 0; ct < 4; ++ct) { f32x4 aw = (f32x4){0.f, 0.f, 0.f, 0.f}, aa = aw;
                    aw = MFMA16(tw0, ldsA(WU + (ct * 16 + l15) * 72 + q * 8), aw); aw = MFMA16(tw1, ldsA(WU + (ct * 16 + l15) * 72 + 32 + q * 8), aw);
                    aa = MFMA16(ta0, ldsA(AU + (ct * 16 + l15) * 72 + q * 8), aa); aa = MFMA16(ta1, ldsA(AU + (ct * 16 + l15) * 72 + 32 + q * 8), aa);
#pragma unroll
                    for (int i = 0; i < 4; ++i) { lw[ct][i] = -0.6065306597126334f * sigmoidf_(w0c[ct] + aw[i]); av[ct][i] = sigmoidf_(a0c[ct] + aa[i]); } } }
            WAVE_SYNC();
            float ssq[4] = {0.f, 0.f, 0.f, 0.f};
#pragma unroll
            for (int ct = 0; ct < 4; ++ct)
#pragma unroll
                for (int i = 0; i < 4; ++i) { const float kk = bf2f(R1[(q * 4 + i) * 72 + ct * 16 + l15]) * kkc[ct]; ssq[i] += kk * kk; }
            float inv[4];
#pragma unroll
            for (int i = 0; i < 4; ++i) { float s = ssq[i]; s += shx<1>(s); s += shx<2>(s); s += shx<4>(s); s += shx<8>(s); inv[i] = 1.0f / fmaxf(sqrtf(s), 1e-12f); }
            float bon[4] = {0.f, 0.f, 0.f, 0.f};
            bf16x8 Apk[4];
            float glv[4];
#pragma unroll
            for (int ct = 0; ct < 4; ++ct) {
                f32x4 lg; lg[0] = lw[ct][0]; lg[1] = lg[0] + lw[ct][1]; lg[2] = lg[1] + lw[ct][2]; lg[3] = lg[2] + lw[ct][3];
                const float tot = lg[3];
                float x1 = tot; { const float t1 = shup(x1, 16, lane); if (q >= 1) x1 += t1; }
                float x2 = x1;  { const float t2 = shup(x1, 32, lane); if (q >= 2) x2 += t2; }
                const float excl = x2 - tot;
                const float lgL = __int_as_float(__builtin_amdgcn_ds_bpermute((48 + l15) << 2, __float_as_int(x2)));
                f32x4 At, Bh, Kh, vv; const float eex = __expf(excl), egL = __expf(lgL); float egprev = eex;
#pragma unroll
                for (int i = 0; i < 4; ++i) { const int idx = (q * 4 + i) * 72 + ct * 16 + l15; const float lgt = excl + lg[i];
                    const float rs = bf2f(R0[idx]), ks = bf2f(R1[idx]), vs = bf2f(R2[idx]); const float a = av[ct][i];
                    const float kkn = ks * kkc[ct] * inv[i], kd = ks * (1.0f + (a - 1.0f) * kac[ct]), beta = -kkn * a;
                    bon[i] += rs * kd * rkc[ct];
                    const float eg = __expf(lgt), egm = (i == 0) ? eex : egprev, ig = __builtin_amdgcn_rcpf(eg), gl = egL * ig; egprev = eg;
                    At[i] = kkn * egm; R0[idx] = f2bf(At[i]); R3[idx] = f2bf(rs * eg); R1[idx] = f2bf(beta * ig); R2[idx] = f2bf(kd * ig);
                    Bh[i] = beta * gl; Kh[i] = kd * gl; vv[i] = vs; }
                Apk[ct] = pack_lo4(At);
                { u32x2 w; w.x = pk_bf16(Bh[0], Bh[1]); w.y = pk_bf16(Bh[2], Bh[3]); *(LAS u32x2*)(BKT + (ct * 16 + l15) * 32 + q * 4) = w;
                  w.x = pk_bf16(Kh[0], Kh[1]); w.y = pk_bf16(Kh[2], Kh[3]); *(LAS u32x2*)(BKT + (ct * 16 + l15) * 32 + 16 + q * 4) = w;
                  w.x = pk_bf16(vv[0], vv[1]); w.y = pk_bf16(vv[2], vv[3]); *(LAS u32x2*)(VF + (ct * 64 + lane) * 4) = w; }
                glv[ct] = egL;
            }
#pragma unroll
            for (int i = 0; i < 4; ++i) { float s = bon[i]; s += shx<1>(s); s += shx<2>(s); s += shx<4>(s); s += shx<8>(s);
                if (l15 == 0) { const int o = o0 + q * 4 + i; const int srow = jn * 64 + (d == 0 ? o : 63 - o); BON[((size_t)b * TB + srow) * 16 + h] = s; } }
            WAVE_SYNC();
            f32x4 Mab = (f32x4){0.f, 0.f, 0.f, 0.f}, MabT = Mab, Mak = Mab, Nrb = Mab, Nrk = Mab;
#pragma unroll
            for (int kq = 0; kq < 2; ++kq) { const bf16x8 fa = ldsA(R0 + l15 * 72 + kq * 32 + q * 8), fr = ldsA(R3 + l15 * 72 + kq * 32 + q * 8), fb = ldsA(R1 + l15 * 72 + kq * 32 + q * 8), fk = ldsA(R2 + l15 * 72 + kq * 32 + q * 8);
                Mab = MFMA16(fa, fb, Mab); MabT = MFMA16(fb, fa, MabT); Mak = MFMA16(fa, fk, Mak); Nrb = MFMA16(fr, fb, Nrb); Nrk = MFMA16(fr, fk, Nrk); }
#pragma unroll
            for (int i = 0; i < 4; ++i) { const int rr_ = q * 4 + i; if (!(l15 < rr_)) { Mab[i] = 0.f; Mak[i] = 0.f; } if (!(rr_ < l15)) MabT[i] = 0.f; if (!(l15 <= rr_)) { Nrb[i] = 0.f; Nrk[i] = 0.f; } }
            f32x4 TT;
            {   f32x4 eye;
#pragma unroll
                for (int i = 0; i < 4; ++i) eye[i] = (q * 4 + i == l15) ? 1.0f : 0.0f;
                const f32x4 M2 = mm16(MabT, Mab), N2 = mm16(Mab, MabT);
                const f32x4 M4 = mm16(N2, M2), N4 = mm16(M2, N2);
                const f32x4 N8 = mm16(M4, N4);
                const f32x4 W1 = mm16(M4 + eye, N8 + eye);
                const f32x4 W2 = mm16(M2 + eye, W1);
                TT = mm16(Mab + eye, W2); }
            WAVE_SYNC();
            {   const bf16x8 Tp = pack_lo4(TT);
                LAS bf16_t* AH = R0; LAS bf16_t* NN = (LAS bf16_t*)(wb + RWC_NN); LAS bf16_t* TMm = (LAS bf16_t*)(wb + RWC_TM);
#pragma unroll
                for (int ct = 0; ct < 4; ++ct) { f32x4 ah = (f32x4){0.f, 0.f, 0.f, 0.f}; ah = MFMA16(Tp, Apk[ct], ah);
#pragma unroll
                    for (int i = 0; i < 4; ++i) AH[(q * 4 + i) * 72 + ct * 16 + l15] = f2bf(ah[i]); }
                f32x4 tm = (f32x4){0.f, 0.f, 0.f, 0.f}; tm = MFMA16(Tp, pack_lo4(Mak), tm);
#pragma unroll
                for (int i = 0; i < 4; ++i) { const int t = q * 4 + i; NN[t * 32 + l15] = f2bf(Nrb[i]); NN[t * 32 + 16 + l15] = f2bf(Nrk[i]); TMm[t * 16 + l15] = f2bf(tm[i]); }
                if (q == 0) {
#pragma unroll
                    for (int ct = 0; ct < 4; ++ct) ((LAS float*)(wb + RWC_GL))[ct * 16 + l15] = glv[ct]; } }
        }
        __syncthreads();
        if (wave < 4) {
            for (int c = 0; c < 8; ++c) {
                const LAS unsigned char* sb = wreg0 + c * RWC_WREG;
                const LAS bf16_t* AH = (const LAS bf16_t*)(sb + RWC_R0); const LAS bf16_t* RT = (const LAS bf16_t*)(sb + RWC_R3); const LAS bf16_t* BKT = (const LAS bf16_t*)(sb + RWC_BK);
                const LAS bf16_t* VF = (const LAS bf16_t*)(sb + RWC_V); const LAS bf16_t* NN = (const LAS bf16_t*)(sb + RWC_NN); const LAS bf16_t* TMm = (const LAS bf16_t*)(sb + RWC_TM); const LAS float* GL = (const LAS float*)(sb + RWC_GL);
                const bf16x8 Sb0 = pack_8(Sacc[0], Sacc[1]), Sb1 = pack_8(Sacc[2], Sacc[3]);
                const u32x2 vw = *(const LAS u32x2*)(VF + (wave * 64 + lane) * 4);
                bf16x8 V0; { u32x4 w; w.x = 0u; w.y = 0u; w.z = vw.x; w.w = vw.y; __builtin_memcpy(&V0, &w, 16); }
                bf16x8 TMf; { const u32x2 tq = *(const LAS u32x2*)(TMm + l15 * 16 + q * 4); u32x4 w; w.x = 0u; w.y = 0u; w.z = tq.x; w.w = tq.y; __builtin_memcpy(&TMf, &w, 16); }
                f32x4 U = (f32x4){0.f, 0.f, 0.f, 0.f};
                U = MFMA16(lds_2x8(AH + l15 * 72 + q * 4, AH + l15 * 72 + 16 + q * 4), Sb0, U);
                U = MFMA16(lds_2x8(AH + l15 * 72 + 32 + q * 4, AH + l15 * 72 + 48 + q * 4), Sb1, U);
                U = MFMA16(TMf, V0, U);
                bf16x8 UV; { u32x4 w; w.x = pk_bf16(U[0], U[1]); w.y = pk_bf16(U[2], U[3]); w.z = vw.x; w.w = vw.y; __builtin_memcpy(&UV, &w, 16); }
                f32x4 Y = (f32x4){0.f, 0.f, 0.f, 0.f};
                Y = MFMA16(lds_2x8(RT + l15 * 72 + q * 4, RT + l15 * 72 + 16 + q * 4), Sb0, Y);
                Y = MFMA16(lds_2x8(RT + l15 * 72 + 32 + q * 4, RT + l15 * 72 + 48 + q * 4), Sb1, Y);
                Y = MFMA16(lds_2x8(NN + l15 * 32 + q * 4, NN + l15 * 32 + 16 + q * 4), UV, Y);
#pragma unroll
                for (int x = 0; x < 4; ++x) { const f32x4 gl = *(const LAS f32x4*)(GL + x * 16 + q * 4); Sacc[x] *= gl;
                    Sacc[x] = MFMA16(lds_2x8(BKT + (x * 16 + l15) * 32 + q * 4, BKT + (x * 16 + l15) * 32 + 16 + q * 4), UV, Sacc[x]); }
                const int ch = rnd * 8 + c, j64 = ch >> 2, jn = nat_chunk(d, j64), o0 = (ch & 3) * 16;
#pragma unroll
                for (int i = 0; i < 4; ++i) { const int o = o0 + q * 4 + i; const int srow = jn * 64 + (d == 0 ? o : 63 - o);
                    YO[((size_t)b * TB + srow) * 1024 + h * 64 + wave * 16 + l15] = f2bf(Y[i]); }
            }
        }
        __syncthreads();
    }
}

__device__ __forceinline__ void rw_finish_item(const Frame& F, int tid, int layer, int it) {
    const int lane = tid & 63, wave = __builtin_amdgcn_readfirstlane(tid >> 6), l15 = lane & 15, q = lane >> 4;
    LAS bf16_t* GA = (LAS bf16_t*)F.lds;
    LAS float* mean_ = (LAS float*)(GA + 64 * 136);
    LAS float* rstd_ = mean_ + 1024, *bon_ = rstd_ + 1024;
    const bf16_t* P = (const bf16_t*)(F.ws + WS_P);
    bf16_t* YF = (bf16_t*)(F.ws + WS_SC + SC_RWF); const bf16_t* YB = (const bf16_t*)(F.ws + WS_SC + SC_RWB); void* RWO = (void*)(F.ws + WS_SC + SC_RWO);
    const float* BON = (const float*)(F.ws + WS_BONUS); const bf16_t* GUPT = (const bf16_t*)(F.ws + WS_GUPT);
    const float* mu = F.in[I_RWMU] + layer * 3456;
    const int hf = it & 1, it2 = it >> 1;
    const int b = it2 / NCH, jn = it2 - b * NCH; const size_t rb = (size_t)b * TB + jn * 64 + hf * 32; const int sb = jn * 64 + hf * 32;
    if (tid < 256) { const int t = tid >> 3, c0 = (tid & 7) * 16;
#pragma unroll
      for (int hh = 0; hh < 2; ++hh) { float m8[8], g8[8];
#pragma unroll
          for (int e = 0; e < 8; ++e) m8[e] = mu[3328 + c0 + hh * 8 + e];
          tshift8(P, rb + t, sb + t, PC_GD + c0 + hh * 8, m8, g8);
#pragma unroll
          for (int e = 0; e < 8; ++e) GA[t * 136 + c0 + hh * 8 + e] = f2bf(sigmoidf_(g8[e])); } }
    { const int p = tid, t = p >> 4, hd = p & 15; const size_t row = rb + t; float v[64]; float s = 0.f;
#pragma unroll
        for (int c8 = 0; c8 < 8; ++c8) { float a[8], bq[8]; unpack8(*(const u32x4*)(YF + row * 1024 + hd * 64 + c8 * 8), a); unpack8(*(const u32x4*)(YB + row * 1024 + hd * 64 + c8 * 8), bq);
#pragma unroll
            for (int e = 0; e < 8; ++e) { v[c8 * 8 + e] = a[e] + bq[e]; s += v[c8 * 8 + e]; } }
        const float mean = s * (1.0f / 64.0f); float qq = 0.f;
#pragma unroll
        for (int e = 0; e < 64; ++e) { const float dlt = v[e] - mean; qq += dlt * dlt; }
        mean_[t * 16 + hd] = mean; rstd_[t * 16 + hd] = rsqrtf(qq * (1.0f / 64.0f) + 64e-5f);
        bon_[t * 16 + hd] = BON[row * 16 + hd] + BON[((size_t)R + row) * 16 + hd]; }
    __syncthreads();
    const float* ng = F.in[I_RWNG] + layer * 1024; const float* nb = F.in[I_RWNB] + layer * 1024;
    float fpv[2], fnv[2];
#pragma unroll
    for (int rt = 0; rt < 2; ++rt) { const int srow = sb + rt * 16 + l15; const bool hp = (srow != 0 && srow != CTXL), hn = (srow != CTXL - 1 && srow != TB - 1); fpv[rt] = hp ? 0.5f : 0.f; fnv[rt] = hn ? 0.5f : 0.f; }
    bf16x8 afr[4]; f32x4 muv, ngc, nbc; u32x2 wf[2], wbk[2], wz[2], wp[2], wn[2];
#define RWF_LOAD(cc_, AFR, MUV, NGC, NBC, WF, WBK, WZ, WP, WN) do { const int ct_ = wave * 8 + (cc_); const int c0_ = ct_ * 16 + q * 4; \
        _Pragma("unroll") for (int kq = 0; kq < 4; ++kq) AFR[kq] = *(const bf16x8*)(GUPT + (size_t)(ct_ * 16 + l15) * 128 + kq * 32 + q * 8); \
        MUV = *(const f32x4*)(mu + 2048 + c0_); NGC = *(const f32x4*)(ng + c0_); NBC = *(const f32x4*)(nb + c0_); \
        _Pragma("unroll") for (int rt = 0; rt < 2; ++rt) { const int t = rt * 16 + l15; const size_t row = rb + t; const bool hp = fpv[rt] != 0.f, hn = fnv[rt] != 0.f; \
            WF[rt] = *(const u32x2*)(YF + row * 1024 + c0_); WBK[rt] = *(const u32x2*)(YB + row * 1024 + c0_); \
            WZ[rt] = *(const u32x2*)(P + row * PW + PC_RV + c0_); WP[rt] = *(const u32x2*)(P + (hp ? row - 1 : row) * PW + PC_RV + c0_); WN[rt] = *(const u32x2*)(P + (hn ? row + 1 : row) * PW + PC_RV + c0_); } } while (0)
    RWF_LOAD(0, afr, muv, ngc, nbc, wf, wbk, wz, wp, wn);
#pragma unroll
    for (int cc = 0; cc < 8; ++cc) { const int ct = wave * 8 + cc; const int c0 = ct * 16 + q * 4, hd = c0 >> 6;
        bf16x8 afr2[4]; f32x4 muv2, ngc2, nbc2; u32x2 wf2[2], wbk2[2], wz2[2], wp2[2], wn2[2];
        if (cc + 1 < 8) RWF_LOAD(cc + 1, afr2, muv2, ngc2, nbc2, wf2, wbk2, wz2, wp2, wn2);
#pragma unroll
        for (int rt = 0; rt < 2; ++rt) { f32x4 acc = (f32x4){0.f, 0.f, 0.f, 0.f};
#pragma unroll
            for (int kq = 0; kq < 4; ++kq) acc = MFMA16(afr[kq], ldsA(GA + (rt * 16 + l15) * 136 + kq * 32 + q * 8), acc);
            const int t = rt * 16 + l15; const size_t row = rb + t;
            const float fp = fpv[rt], fn = fnv[rt]; const float mean = mean_[t * 16 + hd], rstd = rstd_[t * 16 + hd], bon = bon_[t * 16 + hd];
            float o4[4];
#pragma unroll
            for (int i = 0; i < 4; ++i) { const unsigned sf = 16u;
                const unsigned uf = (i < 2 ? wf[rt].x : wf[rt].y), ub_ = (i < 2 ? wbk[rt].x : wbk[rt].y), uz = (i < 2 ? wz[rt].x : wz[rt].y), up = (i < 2 ? wp[rt].x : wp[rt].y), un = (i < 2 ? wn[rt].x : wn[rt].y);
                const float yf_ = (i & 1) ? __uint_as_float(uf & 0xffff0000u) : __uint_as_float(uf << sf), yb_ = (i & 1) ? __uint_as_float(ub_ & 0xffff0000u) : __uint_as_float(ub_ << sf);
                const float vz = (i & 1) ? __uint_as_float(uz & 0xffff0000u) : __uint_as_float(uz << sf), vp = (i & 1) ? __uint_as_float(up & 0xffff0000u) : __uint_as_float(up << sf), vn = (i & 1) ? __uint_as_float(un & 0xffff0000u) : __uint_as_float(un << sf);
                const float yn = (yf_ + yb_ - mean) * rstd * ngc[i] + nbc[i];
                const float vsft = vz + muv[i] * (fp * vp + fn * vn - vz);
                o4[i] = (yn + bon * vsft) * acc[i]; }
            st_op4(RWO, row * 1024 + c0, o4[0], o4[1], o4[2], o4[3]); }
        if (cc + 1 < 8) {
#pragma unroll
            for (int kq = 0; kq < 4; ++kq) afr[kq] = afr2[kq];
            muv = muv2; ngc = ngc2; nbc = nbc2;
#pragma unroll
            for (int rt = 0; rt < 2; ++rt) { wf[rt] = wf2[rt]; wbk[rt] = wbk2[rt]; wz[rt] = wz2[rt]; wp[rt] = wp2[rt]; wn[rt] = wn2[rt]; } }
    }
#undef RWF_LOAD
    __syncthreads();
}

__device__ __forceinline__ void phase_prep(const Frame& F, int layer) {
    const int tid = ltid();
    for (int it = F.bid; it < 64; it += F.G) s5_tables_item(F, tid, layer, it);
}
__device__ __forceinline__ void phase_gin(const Frame& F) {
    dense_gemm<0, false>(F, F.ws + WS_U, F.ws + WS_WIN, R, PW, 2048, F.ws + WS_P, nullptr, nullptr, PW);
}
__device__ __forceinline__ void phase_conv_s5a(const Frame& F, int layer) {
    const int tid = ltid(), lane = tid & 63;
    for (int it = F.bid; it < 528 + 144; it += F.G) { if (it < 528) conv_item(F, tid, layer, it); else s5a_wave_item(F, lane, (it - 528) * 8 + F.wave); }
}
__device__ __forceinline__ void phase_scan(const Frame& F, int layer) {
    const int tid = ltid();
    if (F.bid < 128) rwkvc_item(F, tid, layer, F.bid);
    else { if (F.bid < 192) { s5b_item(F, tid, layer, F.bid - 128); __syncthreads(); } mlstm_item(F, tid, layer, F.bid - 128); }
}
__device__ __forceinline__ void phase_fin(const Frame& F, int layer) {
    const int tid = ltid(), lane = tid & 63;
    for (int it = F.bid; it < 1056; it += F.G) rw_finish_item(F, tid, layer, it);
    for (int it = F.bid; it < 256; it += F.G) s5c_block_item(F, tid, it);
    ml_finish_rows(F, lane, layer);
}

#ifndef MK_ABL
#define MK_ABL 0
#endif
constexpr int NPH_LAYER = 19;
constexpr int NPH = 2 * NPH_LAYER;
__global__ void __launch_bounds__(NTHR, 2) mega_fwd(Args args) {
    extern __shared__ __attribute__((aligned(16))) unsigned char lds_raw[];
    Frame F; F.in = args.in; F.out = args.out; F.ws = args.ws; F.lds = (LAS unsigned char*)lds_raw;
    F.wave = __builtin_amdgcn_readfirstlane(threadIdx.x >> 6); F.G = gridDim.x; F.bid = blockIdx.x;
    volatile LAS unsigned* xbw = (volatile LAS unsigned*)(F.lds + LDS_BYTES - 16);
    if (threadIdx.x == 0) { xbw[0] = 0u; xbw[1] = 0u; xbw[2] = 0u; xbw[3] = 0u; }
    __syncthreads();
    const int lo = args.ph_lo, hi = args.ph_hi;
    const bool one_launch = (hi - lo) > 1;
    XcdBarrier bar; bar.bar = (unsigned*)(F.ws + WS_CTL) + CW_BAR; bar.x = 0; bar.st = xbw;
    if (one_launch) bar = xcd_barrier_post((unsigned*)(F.ws + WS_CTL) + CW_BAR, xbw);
#define IN(k) (lo <= (k) && (k) < hi)
#define SEAM(k) do { if (IN(k) && IN((k) + 1)) xcd_barrier(bar); } while (0)
#define TILE_SEAM() do { asm volatile("s_waitcnt vmcnt(0)" ::: "memory"); __syncthreads(); } while (0)
    bf16_t* const T1 = (bf16_t*)(F.ws + WS_T1); bf16_t* const T2 = (bf16_t*)(F.ws + WS_T2); bf16_t* const T1b = (bf16_t*)(F.ws + WS_SC + SC_RWF);     bf16_t* const Z = (bf16_t*)(F.ws + WS_Z); bf16_t* const MIX = (bf16_t*)(F.ws + WS_MIX);
    unsigned char* const Zop = F8 ? F.ws + WS_QK : F.ws + WS_Z;
    const unsigned char* const U = F.ws + WS_U; const unsigned char* const WG = F.ws + WS_WG; const unsigned char* const WML = F.ws + WS_WML;
    const unsigned char* const ML = F.ws + WS_SC + SC_ML; const unsigned char* const RWo = F.ws + WS_SC + SC_RWO; const unsigned char* const S5o = F.ws + WS_SC + SC_S5;
    for (int layer = 0; layer < 2; ++layer) {
        const int pb = layer * NPH_LAYER;
        const int rA = 0, rB = layer == 0 ? 32 : 0, rC = layer == 0 ? 64 : 0;
        if (IN(pb + 0)) { phase_prep(F, layer); if (layer == 0) phase_mods(F); phase_wprep(F, layer); }
        SEAM(pb + 0);
        if (IN(pb + 1)) { if (layer == 0) phase_ln1(F, layer); }
        if (layer == 0) SEAM(pb + 1);
        if (IN(pb + 2)) { phase_gin(F); }
        SEAM(pb + 2);
        if (IN(pb + 3)) { phase_conv_s5a(F, layer); }
        SEAM(pb + 3);
        if (IN(pb + 4)) { phase_scan(F, layer); }
        SEAM(pb + 4);
        if (IN(pb + 5)) { phase_fin(F, layer); }
        SEAM(pb + 5);
        if (IN(pb + 6)) { dense_gemm<0, false>(F, ML, WML, R, 2048, 1024, T1, nullptr, nullptr, 2048, layer == 1, rA); }
        TILE_SEAM();
        if (IN(pb + 8)) { dense_gemm<0, false>(F, RWo, WML + (size_t)1 * 2048 * 1024 * OPB, R, 2048, 1024, T1b, nullptr, nullptr, 2048, layer == 1, rB); }
        SEAM(pb + 8);
        if (IN(pb + 9)) { dense_gemm<6, false>(F, U, WG, R, 4096, 2048, Z, T1, T1b, 2048, layer == 1); }
        TILE_SEAM();
        if (IN(pb + 10)) { dense_gemm<5, false>(F, S5o, WML + (size_t)2 * 2048 * 1024 * OPB, R, 4096, 1024, T2, nullptr, nullptr, 2048, layer == 1); }
        SEAM(pb + 10);
        if (IN(pb + 12)) { dense_gemm<2, true>(F, U, WG + (size_t)4096 * 2048 * OPB, R, 2048, 2048, Zop, T2, Z, 2048, layer == 1, rC); }
        SEAM(pb + 12);
        if (IN(pb + 13)) { dense_gemm<0, false>(F, Zop, F.ws + WS_WOUT, R, 2048, 2048, MIX, nullptr, nullptr, 2048, layer == 1); }
        SEAM(pb + 13);
        if (IN(pb + 14)) { phase_post1_route(F, layer, true); }
        SEAM(pb + 14);
        if (IN(pb + 15)) { phase_gather(F, layer); }
        SEAM(pb + 15);
        if (IN(pb + 16)) { phase_moe_gemm(F, layer, 0); }
        SEAM(pb + 16);
        if (IN(pb + 17)) { phase_moe_gemm(F, layer, 1); }
        SEAM(pb + 17);
        if (IN(pb + 18)) { phase_post2_moe(F, layer, true); }
        SEAM(pb + 18);
    }
#undef IN
#undef SEAM
#undef TILE_SEAM
}

#ifndef MK_ONE_LAUNCH
#define MK_ONE_LAUNCH 1
#endif
extern "C" void kernel_launch(void* const* d_in, const int* in_sizes, int n_in, void* d_out, int out_size, void* d_ws, size_t ws_size, hipStream_t stream) {
    static int grid = 0;
    if (grid == 0) {
        if (n_in != N_IN || ws_size < WS_END) { fprintf(stderr, "kernel_launch: unexpected n_in %d / ws_size %zu (need %zu)\n", n_in, ws_size, (size_t)WS_END); grid = -1; return; }
        int dev = 0, cus = 0, per_cu = 0;
        if (hipGetDevice(&dev) != hipSuccess || hipDeviceGetAttribute(&cus, hipDeviceAttributeMultiprocessorCount, dev) != hipSuccess) { grid = -1; return; }
        if (hipFuncSetAttribute((const void*)mega_fwd, hipFuncAttributeMaxDynamicSharedMemorySize, LDS_BYTES) != hipSuccess) { fprintf(stderr, "kernel_launch: hipFuncSetAttribute failed\n"); grid = -1; return; }
        if (hipOccupancyMaxActiveBlocksPerMultiprocessor(&per_cu, (const void*)mega_fwd, NTHR, LDS_BYTES) != hipSuccess || per_cu < 1) { fprintf(stderr, "kernel_launch: occupancy query says %d\n", per_cu); }
        (void)hipGetLastError();
        grid = 256;
        if (cus != 256) fprintf(stderr, "kernel_launch: %d CUs, this kernel is laid out for 256\n", cus);
    }
    if (grid < 0) return;
    (void)hipMemsetAsync((char*)d_ws + WS_CTL, 0, CTL_BYTES, stream);
    Args a{};
    for (int i = 0; i < N_IN; ++i) a.in[i] = (const float*)d_in[i];
    a.out = (float*)d_out; a.ws = (unsigned char*)d_ws;
#if MK_ONE_LAUNCH
    a.ph_lo = 0; a.ph_hi = NPH;
    hipLaunchKernelGGL(mega_fwd, dim3(grid), dim3(NTHR), LDS_BYTES, stream, a);
#else
    for (int p = 0; p < NPH; ++p) { a.ph_lo = p; a.ph_hi = p + 1; hipLaunchKernelGGL(mega_fwd, dim3(grid), dim3(NTHR), LDS_BYTES, stream, a); }
#endif
}
```

```cpp
#include <hip/hip_runtime.h>
#include <stdint.h>
#include <stdio.h>

#define LAS __attribute__((address_space(3)))
typedef unsigned short bf16_t;
typedef short bf16x8 __attribute__((ext_vector_type(8)));
typedef float f32x4 __attribute__((ext_vector_type(4)));
typedef float f32x2 __attribute__((ext_vector_type(2)));
typedef unsigned u32x4 __attribute__((ext_vector_type(4)));
typedef unsigned u32x2 __attribute__((ext_vector_type(2)));

constexpr int D = 2048, NB = 4, SEQ = 8192, CTXL = 256, TB = SEQ + CTXL, R = NB * TB;
constexpr int NCH = TB / 64;
constexpr int PW = 8704;
constexpr int PC_Q = 0, PC_K = 1024, PC_V = 2048, PC_O = 3072, PC_IG = 4096, PC_FG = 4104, PC_RR = 4112, PC_RK = 5136, PC_RV = 6160,
              PC_WD = 7184, PC_AD = 7312, PC_GD = 7440, PC_S5 = 7568, PC_END = 8592;
constexpr int NTHR = 512, NWAVE = 8;
constexpr int LDS_BYTES = 163840;
constexpr float ALPHA = 1.4142135623730951f;
constexpr float LN_EPS = 1e-5f;

enum { I_X = 0, I_C, I_CTX, I_CCTX, I_ADAW, I_ADAB, I_WIN, I_MLCW, I_MLCB, I_MLIGB, I_MLFGB, I_MLNG, I_MLNB, I_MLPROJ, I_RWMU, I_RWW0, I_RWWUP, I_RWA0, I_RWAUP,
       I_RWGUP, I_RWKK, I_RWKA, I_RWRK, I_RWNG, I_RWNB, I_RWPROJ, I_S5LRE, I_S5LIM, I_S5LDT, I_S5BRE, I_S5BIM, I_S5CRE, I_S5CIM, I_S5D, I_S5WV, I_S5WG, I_WOUT,
       I_LN1G, I_LN1B, I_LN2G, I_LN2B, I_ROUTW, I_ROUTB, I_EWG, I_EWU, I_EWD, N_IN };

constexpr size_t al256(size_t x) { return (x + 255) & ~(size_t)255; }
constexpr size_t WS_CTL = 0, CTL_BYTES = 65536;
constexpr size_t WS_MODS = WS_CTL + CTL_BYTES;
constexpr size_t WS_ROUTE = al256(WS_MODS + 2 * 5 * 12288 * 4);
constexpr size_t WS_BONUS = al256(WS_ROUTE + (size_t)R * 8 * 4);
constexpr size_t WS_S5KC = al256(WS_BONUS + (size_t)2 * R * 16 * 4);
constexpr size_t WS_S5E = al256(WS_S5KC + (size_t)64 * 128 * 256 * 2);
constexpr size_t WS_S5F = al256(WS_S5E + (size_t)64 * 256 * 1024 * 2);
constexpr size_t WS_S5X = al256(WS_S5F + (size_t)64 * 1024 * 256 * 2);
constexpr size_t WS_GUPT = al256(WS_S5X + (size_t)64 * 528 * 256 * 4);
constexpr size_t WS_WIN = al256(WS_GUPT + (size_t)1024 * 128 * 2);
constexpr size_t WS_WG = al256(WS_WIN + (size_t)PW * D * 2);
constexpr size_t WS_WML = al256(WS_WG + (size_t)6144 * D * 2);
constexpr size_t WS_WOUT = al256(WS_WML + (size_t)4 * 2048 * 1024 * 2);
constexpr size_t WS_EGU = al256(WS_WOUT + (size_t)2048 * 2048 * 2);
constexpr size_t WS_EDN = al256(WS_EGU + (size_t)16 * 2048 * 2048 * 2);
constexpr size_t WS_P = al256(WS_EDN + (size_t)16 * 2048 * 1024 * 2);
constexpr size_t WS_U = al256(WS_P + (size_t)R * PW * 2);
constexpr size_t WS_QK = al256(WS_U + (size_t)R * D * 2);
constexpr size_t WS_SC = al256(WS_QK + (size_t)R * D * 2);
constexpr size_t SC_BYTES = (size_t)71680 * 2048 * 2;
constexpr size_t WS_XC = al256(WS_SC + SC_BYTES);
constexpr size_t WS_END = al256(WS_XC + (size_t)NB * CTXL * D * 4);
constexpr size_t WS_X1 = WS_P;
constexpr size_t WS_T1 = WS_P;
constexpr size_t WS_T2 = WS_P + (size_t)R * D * 2;
constexpr size_t WS_MIX = WS_P + (size_t)R * D * 4;
constexpr size_t WS_Z = WS_MIX + (size_t)R * D * 2;
static_assert(WS_Z + (size_t)R * D * 2 <= WS_U, "P-region aliases overflow");
static_assert(WS_END <= 1633652928ull, "workspace too large");

constexpr int CW_BAR = 0;
constexpr int CW_ECNT = 4096;

__device__ __forceinline__ float bf2f(bf16_t b) { return __uint_as_float(((unsigned)b) << 16); }
typedef __bf16 bf16x2_t __attribute__((ext_vector_type(2)));
__device__ __forceinline__ unsigned pk_bf16(float lo, float hi) { const f32x2 v = {lo, hi}; const bf16x2_t r = __builtin_convertvector(v, bf16x2_t); unsigned u; __builtin_memcpy(&u, &r, 4); return u; }
constexpr bool F8 = true;
constexpr int OPB = F8 ? 1 : 2;
constexpr float W8_SCALE = 64.0f;
typedef int v8i __attribute__((ext_vector_type(8)));
typedef int v4i __attribute__((ext_vector_type(4)));
__device__ __forceinline__ float clamp8(float x) { return fminf(fmaxf(x, -448.0f), 448.0f); }
__device__ __forceinline__ unsigned pk4_fp8(float a, float b, float c, float d) { int w = 0; w = __builtin_amdgcn_cvt_pk_fp8_f32(clamp8(a), clamp8(b), w, false); w = __builtin_amdgcn_cvt_pk_fp8_f32(clamp8(c), clamp8(d), w, true); return (unsigned)w; }
__device__ __forceinline__ bf16_t f2bf(float f) { return (bf16_t)(pk_bf16(f, 0.f) & 0xffffu); }
__device__ __forceinline__ float sigmoidf_(float x) { return __builtin_amdgcn_rcpf(1.0f + __expf(-x)); }
__device__ __forceinline__ float tanhf_(float x) { return 1.0f - 2.0f * __builtin_amdgcn_rcpf(1.0f + __expf(2.0f * x)); }
__device__ __forceinline__ void unpack8(const u32x4 p, float (&o)[8]) { const unsigned w[4] = {p.x, p.y, p.z, p.w};
#pragma unroll
    for (int e = 0; e < 4; ++e) { o[2 * e] = __uint_as_float(w[e] << 16); o[2 * e + 1] = __uint_as_float(w[e] & 0xffff0000u); } }
__device__ __forceinline__ void st_op4(void* base, size_t ei, float a, float b, float c, float d) {
    if (F8) *(unsigned*)((char*)base + ei) = pk4_fp8(a, b, c, d);
    else { u32x2 w; w.x = pk_bf16(a, b); w.y = pk_bf16(c, d); *(u32x2*)((char*)base + ei * 2) = w; } }
__device__ __forceinline__ void st_op8(void* base, size_t ei, const float (&v)[8]) {
    if (F8) { u32x2 w; w.x = pk4_fp8(v[0], v[1], v[2], v[3]); w.y = pk4_fp8(v[4], v[5], v[6], v[7]); *(u32x2*)((char*)base + ei) = w; }
    else { u32x4 w; w.x = pk_bf16(v[0], v[1]); w.y = pk_bf16(v[2], v[3]); w.z = pk_bf16(v[4], v[5]); w.w = pk_bf16(v[6], v[7]); *(u32x4*)((char*)base + ei * 2) = w; } }
__device__ __forceinline__ void st_op1(void* base, size_t ei, float a) {
    if (F8) ((unsigned char*)base)[ei] = (unsigned char)(pk4_fp8(a, 0.f, 0.f, 0.f) & 0xffu);
    else ((bf16_t*)base)[ei] = f2bf(a); }
__device__ __forceinline__ float siluf_(float x) { return x * sigmoidf_(x); }
template <int M> __device__ __forceinline__ float shx(float v) { return __int_as_float(__builtin_amdgcn_ds_swizzle(__float_as_int(v), 0x1f | (M << 10))); }
__device__ __forceinline__ float shx32(float v, int lane) { return __int_as_float(__builtin_amdgcn_ds_bpermute((lane ^ 32) << 2, __float_as_int(v))); }
__device__ __forceinline__ float shup(float v, int o, int lane) { return __int_as_float(__builtin_amdgcn_ds_bpermute((lane - o) << 2, __float_as_int(v))); }
__device__ __forceinline__ float rdlane(float v, int l) { return __int_as_float(__builtin_amdgcn_readlane(__float_as_int(v), l)); }
__device__ __forceinline__ float wave_sum(float v, int lane) {
    v += shx32(v, lane); v += shx<16>(v); v += shx<8>(v); v += shx<4>(v); v += shx<2>(v); v += shx<1>(v);
    return v;
}

#define XB_TMO      128
#define XB_XCNT(j)  (256  + 64 * (j))
#define XB_XSUB(j)  (1280 + 64 * (j))
#define XB_XGEN(j)  (2304 + 64 * (j))
#define XB_TOP      3328
#define XB_TOPGEN   3392
#define XCD_BAR_WORDS 3456
#define XB_SPIN_CAP (1u << 18)
__device__ __forceinline__ unsigned xb_ld(unsigned* p)              { return __hip_atomic_load(p, __ATOMIC_RELAXED, __HIP_MEMORY_SCOPE_AGENT); }
__device__ __forceinline__ unsigned xb_add(unsigned* p, unsigned v) { return __hip_atomic_fetch_add(p, v, __ATOMIC_RELAXED, __HIP_MEMORY_SCOPE_AGENT); }
__device__ __forceinline__ unsigned xb_xcc_id() { return (unsigned)__builtin_amdgcn_s_getreg((3 << 11) | 20) & 0xFu; }
#define XB_SPIN(cond, bar) do { unsigned _sp = 0; while (cond) { __builtin_amdgcn_s_sleep(1); \
    if ((++_sp & 255u) == 0u) { if (xb_ld(&(bar)[XB_TMO])) break; if (_sp > XB_SPIN_CAP) { atomicAdd(&(bar)[XB_TMO], 1u); break; } } } } while (0)
struct XcdBarrier { unsigned* bar; unsigned x; volatile LAS unsigned* st; };
__device__ __forceinline__ XcdBarrier xcd_barrier_post(unsigned* bar, volatile LAS unsigned* st) {
    XcdBarrier b; b.bar = bar; b.x = xb_xcc_id(); b.st = st;
    if (threadIdx.x == 0) (void)xb_add(&bar[XB_XCNT(b.x)], 1u);
    return b;
}
__device__ __forceinline__ void xcd_barrier_complete(unsigned* bar, unsigned x, unsigned& nloc, unsigned& nx) {
    const unsigned G = gridDim.x * gridDim.y * gridDim.z;
    unsigned sum, cnt, mine, sp = 0u;
    for (;;) {
        sum = 0u; cnt = 0u; mine = 0u;
#pragma unroll
        for (unsigned j = 0; j < 16; ++j) { const unsigned c = xb_ld(&bar[XB_XCNT(j)]); sum += c; cnt += (c > 0u) ? 1u : 0u; mine = (j == x) ? c : mine; }
        if (sum == G) break;
        __builtin_amdgcn_s_sleep(1);
        if ((++sp & 255u) == 0u) { if (xb_ld(&bar[XB_TMO])) break; if (sp > XB_SPIN_CAP) { atomicAdd(&bar[XB_TMO], 1u); break; } }
    }
    nloc = mine > 0u ? mine : 1u; nx = cnt > 0u ? cnt : 1u;
}
__device__ __forceinline__ void xcd_barrier(const XcdBarrier& b) {
    asm volatile("s_waitcnt vmcnt(0)" ::: "memory");
    __syncthreads();
    if (threadIdx.x == 0) {
        unsigned* bar = b.bar;
        __builtin_amdgcn_s_waitcnt(0);
        unsigned nloc = b.st[0], nx = b.st[1];
        if (nloc == 0u) { xcd_barrier_complete(bar, b.x, nloc, nx); b.st[0] = nloc; b.st[1] = nx; }
        const unsigned old = xb_add(&bar[XB_XSUB(b.x)], 1u);
        const unsigned gen = old / nloc;
        if (old + 1u == (gen + 1u) * nloc) {
            __builtin_amdgcn_fence(__ATOMIC_RELEASE, "agent");
            asm volatile("s_waitcnt vmcnt(0)" ::: "memory");
            const unsigned og = xb_add(&bar[XB_TOP], 1u);
            const unsigned tg = og / nx;
            if (og + 1u == (tg + 1u) * nx) xb_add(&bar[XB_TOPGEN], 1u);
            else XB_SPIN(xb_ld(&bar[XB_TOPGEN]) == tg, bar);
            __builtin_amdgcn_fence(__ATOMIC_ACQUIRE, "agent");
            xb_add(&bar[XB_XGEN(b.x)], 1u);
            asm volatile("s_waitcnt vmcnt(0)" ::: "memory");
        } else {
            XB_SPIN(xb_ld(&bar[XB_XGEN(b.x)]) == gen, bar);
            __builtin_amdgcn_fence(__ATOMIC_ACQUIRE, "agent");
            asm volatile("s_waitcnt vmcnt(0)" ::: "memory");
        }
    }
    __syncthreads();
}

struct Args { const float* in[N_IN]; float* out; unsigned char* ws; int ph_lo, ph_hi; };
struct Frame {
    const float* const* in; float* out; unsigned char* ws; LAS unsigned char* lds;
    int wave, G, bid;
};
__device__ __forceinline__ int ltid_(int wave) { int l; asm volatile("v_mbcnt_lo_u32_b32 %0, -1, 0\n\tv_mbcnt_hi_u32_b32 %0, -1, %0" : "=v"(l)); return wave * 64 + l; }
#define ltid() ltid_(F.wave)

__device__ __forceinline__ const float* xin_row(const Frame& F, int layer, int r) {
    const int b = r / TB, s = r - b * TB;
    if (s < CTXL) return (layer == 0 ? F.in[I_CTX] : (const float*)(F.ws + WS_XC)) + ((size_t)b * CTXL + s) * D;
    return (layer == 0 ? F.in[I_X] : (const float*)F.out) + ((size_t)b * SEQ + (s - CTXL)) * D;
}
__device__ __forceinline__ float* xout_row(const Frame& F, int r) {
    const int b = r / TB, s = r - b * TB;
    if (s < CTXL) return (float*)(F.ws + WS_XC) + ((size_t)b * CTXL + s) * D;
    return F.out + ((size_t)b * SEQ + (s - CTXL)) * D;
}

__device__ __forceinline__ void phase_mods(const Frame& F) {
    const int tid = ltid(), lane = tid & 63; (void)lane;
    LAS float* sc = (LAS float*)F.lds;
    LAS float* red = (LAS float*)(F.lds + 5 * 2048 * 4);
    float* mods = (float*)(F.ws + WS_MODS);
    for (int i = tid; i < 5 * 2048; i += NTHR) { const int r = i >> 11, k = i & 2047; const float v = r < 4 ? F.in[I_C][r * 2048 + k] : F.in[I_CCTX][k]; sc[i] = siluf_(v); }
    __syncthreads();
    for (int it = F.bid; it < 2 * 96; it += F.G) {
        const int l = it / 96, cg = it - l * 96, c4 = (tid & 31) * 4, ks = tid >> 5;
        const float* w = F.in[I_ADAW] + (size_t)l * 2048 * 12288 + cg * 128 + c4;
        f32x4 a0 = (f32x4){0.f, 0.f, 0.f, 0.f}, a1 = a0, a2 = a0, a3 = a0, a4 = a0;
#pragma unroll 8
        for (int k = ks; k < 2048; k += 16) { const f32x4 wv = *(const f32x4*)(w + (size_t)k * 12288); a0 += sc[k] * wv; a1 += sc[2048 + k] * wv; a2 += sc[4096 + k] * wv; a3 += sc[6144 + k] * wv; a4 += sc[8192 + k] * wv; }
        *(LAS f32x4*)(red + (ks * 5 + 0) * 128 + c4) = a0; *(LAS f32x4*)(red + (ks * 5 + 1) * 128 + c4) = a1; *(LAS f32x4*)(red + (ks * 5 + 2) * 128 + c4) = a2;
        *(LAS f32x4*)(red + (ks * 5 + 3) * 128 + c4) = a3; *(LAS f32x4*)(red + (ks * 5 + 4) * 128 + c4) = a4;
        __syncthreads();
        for (int i = tid; i < 5 * 128; i += NTHR) { const int r = i >> 7, cc = i & 127; float s = 0.f;
#pragma unroll
            for (int s16 = 0; s16 < 16; ++s16) s += red[(s16 * 5 + r) * 128 + cc];
            mods[((size_t)l * 5 + r) * 12288 + cg * 128 + cc] = s + F.in[I_ADAB][l * 12288 + cg * 128 + cc]; }
        __syncthreads();
    }
}

__device__ __forceinline__ void phase_ln1(const Frame& F, int layer) {
    const int tid = ltid(), lane = tid & 63; (void)lane;
    const float* mods = (const float*)(F.ws + WS_MODS) + (size_t)layer * 5 * 12288;
    bf16_t* U = (bf16_t*)(F.ws + WS_U);
    const int stride = F.G * NWAVE; f32x4 xq[8];
    { const float* x = xin_row(F, layer, F.bid * NWAVE + F.wave);
#pragma unroll
      for (int i = 0; i < 8; ++i) xq[i] = *(const f32x4*)(x + (i * 64 + lane) * 4); }
    for (int r = F.bid * NWAVE + F.wave; r < R; r += stride) {
        const int b = r / TB, s = r - b * TB; const float* md = mods + (size_t)(s < CTXL ? 4 : b) * 12288;
        f32x4 v[8]; float sum = 0.f;
#pragma unroll
        for (int i = 0; i < 8; ++i) { v[i] = xq[i]; sum += (v[i][0] + v[i][1]) + (v[i][2] + v[i][3]); }
        { const float* xn = xin_row(F, layer, r + stride < R ? r + stride : r);
#pragma unroll
          for (int i = 0; i < 8; ++i) xq[i] = *(const f32x4*)(xn + (i * 64 + lane) * 4); }
        const float mean = wave_sum(sum, lane) * (1.0f / D); float q = 0.f;
#pragma unroll
        for (int i = 0; i < 8; ++i) { v[i] -= mean; q += (v[i][0] * v[i][0] + v[i][1] * v[i][1]) + (v[i][2] * v[i][2] + v[i][3] * v[i][3]); }
        const float rstd = rsqrtf(wave_sum(q, lane) * (1.0f / D) + LN_EPS);
#pragma unroll
        for (int i = 0; i < 8; ++i) { const int e = (i * 64 + lane) * 4; const f32x4 sh = *(const f32x4*)(md + e), scl = *(const f32x4*)(md + 2048 + e);
            const f32x4 u = v[i] * rstd * (scl + 1.0f) + sh; st_op4(U, (size_t)r * D + e, u[0], u[1], u[2], u[3]); }
    }
}

namespace pg8 {
constexpr int BM = 256, BK = 64, HALF = 128, HTB = HALF * BK * 2, STAGE_BYTES = 8 * HTB, NXCD = 8, WGM = 8;
__host__ __device__ __forceinline__ int lds_byte(int r, int c) { const int st = (r >> 4) * 2 + (c >> 5), rr = r & 15, cc = c & 31, ob = rr * 64 + cc * 2; return st * 1024 + (ob ^ (((ob >> 9) & 1) << 5)); }
__host__ __device__ __forceinline__ void stage_rc(int b, int& Rr, int& C) { const int st = b / 1024, sb = b % 1024, swz = sb ^ (((sb >> 9) & 1) << 5); Rr = (st >> 1) * 16 + swz / 64; C = (st & 1) * 32 + (swz % 64) / 2; }
__host__ __device__ __forceinline__ int perm32(int rho) { const int n = rho >> 4, i = rho & 15; return 8 * (i >> 2) + 4 * n + (i & 3); }
struct Unit { int pm, pn; };
struct Gemm { const bf16_t* A; const bf16_t* Bt; int lda, ldb, K; };
struct StaticOrder {
    int nM, nN, nwg, G, c, skipctx;
    __device__ void init(int M, int N, int G_, int c_, int skipctx_ = 0) { nM = M / BM; nN = N / BM; nwg = nM * nN; G = G_; c = c_; skipctx = skipctx_; }
    __device__ bool next(int i, Unit& u) const {
        const long L = (long)i * G + c; if (L >= nwg) return false;
        int wgid = (int)L; { const int q = nwg / NXCD, r = nwg % NXCD, xcd = wgid % NXCD, off = wgid / NXCD; wgid = (xcd < r ? xcd * (q + 1) : r * (q + 1) + (xcd - r) * q) + off; }
        const int nig = WGM * nN, gid = wgid / nig, fm = gid * WGM, gsz = (nM - fm) < WGM ? (nM - fm) : WGM;
        u.pm = fm + ((wgid % nig) % gsz); u.pn = (wgid % nig) / gsz;
        if (skipctx) u.pm += (u.pm >> 5) + 1;
        return true;
    }
};
struct GroupedOrder {
    const LAS int* ts; int nN, G, c;
    __device__ bool next(int i, Unit& u) const {
        const int L = i * G + c; const int tot = __builtin_amdgcn_readfirstlane(ts[16]) * nN; if (L >= tot) return false;
        const int pm = L / nN, pl = L - pm * nN; int e = 0;
#pragma unroll 1
        for (int j = 1; j < 16; ++j) e += (pm >= ts[j]) ? 1 : 0;
        u.pm = __builtin_amdgcn_readfirstlane(pm); u.pn = __builtin_amdgcn_readfirstlane(e * nN + pl); return true;
    }
};
__device__ __forceinline__ unsigned cvt_pk_bf16(float lo, float hi) { return pk_bf16(lo, hi); }
__device__ __forceinline__ float fsig(float x) { return __builtin_amdgcn_rcpf(1.0f + __expf(-x)); }
template <int MODE, bool O8> struct Epi {
    static constexpr bool PERM = true; static constexpr float ASC = F8 ? 1.0f / W8_SCALE : 1.0f;
    void* O; const bf16_t* X; const bf16_t* Zin; int ldc; int pn_mod;
    __device__ __forceinline__ void put8(size_t ei, const float (&h)[8]) const {
        if (O8) st_op8(O, ei, h);
        else { u32x4 w; w.x = cvt_pk_bf16(h[0], h[1]); w.y = cvt_pk_bf16(h[2], h[3]); w.z = cvt_pk_bf16(h[4], h[5]); w.w = cvt_pk_bf16(h[6], h[7]); *(u32x4*)((bf16_t*)O + ei) = w; } }
    __device__ __forceinline__ void operator()(const f32x4 (&acc)[2][2][4][2], const Unit& u, int wr, int wc, int fr, int fq) const {
        const int row0 = u.pm * BM + wr * 64 + fr; const int pnl = u.pn % pn_mod;
        if (MODE == 4 || MODE == 5 || MODE == 6) {
            const int col0 = pnl * HALF + wc * 32 + 8 * fq;
            u32x4 xw6[2][4], zw6[2][4];
            if (MODE == 6) {
#pragma unroll
                for (int ai = 0; ai < 2; ++ai)
#pragma unroll
                    for (int m = 0; m < 4; ++m) { const size_t ei = (size_t)(row0 + ai * HALF + m * 16) * ldc + col0; xw6[ai][m] = *(const u32x4*)(X + ei); zw6[ai][m] = *(const u32x4*)(Zin + ei); }
            }
#pragma unroll
            for (int ai = 0; ai < 2; ++ai)
#pragma unroll
                for (int m = 0; m < 4; ++m) { const size_t ei = (size_t)(row0 + ai * HALF + m * 16) * ldc + col0;
                    const f32x4 g0 = acc[ai][0][m][0], g1 = acc[ai][0][m][1], u0 = acc[ai][1][m][0], u1 = acc[ai][1][m][1]; float h[8];
                    float xa[8], xb[8]; if (MODE == 6) { unpack8(xw6[ai][m], xa); unpack8(zw6[ai][m], xb); }
#pragma unroll
                    for (int j = 0; j < 4; ++j) { const float ga = g0[j] * ASC, gb = g1[j] * ASC;
                        if (MODE == 4) { h[j] = ga * fsig(ga) * (u0[j] * ASC); h[4 + j] = gb * fsig(gb) * (u1[j] * ASC); }
                        else if (MODE == 5) { h[j] = ga * fsig(u0[j] * ASC); h[4 + j] = gb * fsig(u1[j] * ASC); }
                        else { h[j] = fsig(ga) * xa[j] + fsig(u0[j] * ASC) * xb[j]; h[4 + j] = fsig(gb) * xa[4 + j] + fsig(u1[j] * ASC) * xb[4 + j]; } }
                    put8(ei, h); }
        } else {
            const int col0 = pnl * BM + wc * 32 + 8 * fq;
#pragma unroll
            for (int ai = 0; ai < 2; ++ai)
#pragma unroll
              for (int mh = 0; mh < 2; ++mh) {
                u32x4 xw[2][2], zw[2][2];
                if (MODE == 1 || MODE == 2) {
#pragma unroll
                    for (int m2 = 0; m2 < 2; ++m2)
#pragma unroll
                        for (int bj = 0; bj < 2; ++bj) { const size_t ro = (size_t)(row0 + ai * HALF + (mh * 2 + m2) * 16) * ldc + col0 + bj * HALF;
                            xw[m2][bj] = *(const u32x4*)(X + ro); if (MODE == 2) zw[m2][bj] = *(const u32x4*)(Zin + ro); }
                }
#pragma unroll
                for (int m2 = 0; m2 < 2; ++m2) { const int m = mh * 2 + m2; const size_t ro = (size_t)(row0 + ai * HALF + m * 16) * ldc + col0;
#pragma unroll
                    for (int bj = 0; bj < 2; ++bj) { const f32x4 v0 = acc[ai][bj][m][0], v1 = acc[ai][bj][m][1]; float h[8];
#pragma unroll
                        for (int j = 0; j < 4; ++j) { h[j] = v0[j] * ASC; h[4 + j] = v1[j] * ASC; }
                        if (MODE == 1 || MODE == 2) { float x8[8]; unpack8(xw[m2][bj], x8);
#pragma unroll
                            for (int j = 0; j < 8; ++j) h[j] = fsig(h[j]) * x8[j];
                            if (MODE == 2) { float z8[8]; unpack8(zw[m2][bj], z8);
#pragma unroll
                                for (int j = 0; j < 8; ++j) h[j] += z8[j]; } }
                        put8(ro + bj * HALF, h); } }
              }
        }
    }
};

template <class EpiT, class Sched>
__device__ __forceinline__ void gemm_phase(LAS unsigned char* lds, const Gemm g, const Sched& S, const EpiT& E, int wave_id) {
    const int tid = ltid_(wave_id), wid = __builtin_amdgcn_readfirstlane(tid >> 6), lane = tid & 63, wr = wid >> 2, wc = wid & 3, fr = lane & 15, fq = lane >> 4;
    const int K = g.K, nt = K / BK;
    unsigned voffA[2], voffB[2];
#pragma unroll
    for (int i = 0; i < 2; ++i) { int Rr, C; stage_rc(tid * 16 + i * 8192, Rr, C); const int Rb = EpiT::PERM ? ((Rr & ~31) + perm32(Rr & 31)) : Rr;
        voffA[i] = (unsigned)(Rr * g.lda + C) * 2u; voffB[i] = (unsigned)(Rb * g.ldb + C) * 2u; }
    const size_t kstep = (size_t)(BK * 2);
    const size_t hstepA = (size_t)HALF * g.lda * 2, hstepB = (size_t)HALF * g.ldb * 2;
    const size_t tstepA = 2 * hstepA, tstepB = 2 * hstepB;
    const unsigned ldsw = (unsigned)wid * 1024u;
    const int aoff = lds_byte(wr * 64 + fr, fq * 8), boff = lds_byte(wc * 32 + fr, fq * 8);
#define PG8_SA(b, h) (((b) * 2 + (h)) * HTB)
#define PG8_SB(b, h) ((4 + (b) * 2 + (h)) * HTB)
#define PG8_STAGE(bufoff, gbase, voff) do { _Pragma("unroll") for (int _i = 0; _i < 2; ++_i) \
        __builtin_amdgcn_global_load_lds((const unsigned*)((const char*)(gbase) + (voff)[_i]), (LAS unsigned*)(lds + (bufoff) + ldsw + _i * 8192), 16, 0, 0); } while (0)
#define PG8_LD8(dst, addr) do { const v4i lo_ = *(const LAS v4i*)(addr), hi_ = *(const LAS v4i*)((addr) + 1024); dst = __builtin_shufflevector(lo_, hi_, 0, 1, 2, 3, 4, 5, 6, 7); } while (0)
#define PG8_LDA(dst, b, h) do { _Pragma("unroll") for (int m = 0; m < 4; ++m) PG8_LD8(dst[m], lds + PG8_SA(b, h) + aoff + m * 2048); } while (0)
#define PG8_LDB(dst, b, h) do { _Pragma("unroll") for (int n = 0; n < 2; ++n) PG8_LD8(dst[n], lds + PG8_SB(b, h) + boff + n * 2048); } while (0)
#define PG8_HALF(v, k) __builtin_bit_cast(bf16x8, __builtin_shufflevector(v, v, 4 * (k), 4 * (k) + 1, 4 * (k) + 2, 4 * (k) + 3))
#define PG8_MMA(ai, bj, At, Bt) do { __builtin_amdgcn_s_setprio(1); _Pragma("unroll") for (int m = 0; m < 4; ++m) _Pragma("unroll") for (int n = 0; n < 2; ++n) { \
        if (F8) asm volatile("v_mfma_f32_16x16x128_f8f6f4 %0, %1, %2, %0" : "+v"(acc[ai][bj][m][n]) : "v"(Bt[n]), "v"(At[m]));     \
        else { acc[ai][bj][m][n] = __builtin_amdgcn_mfma_f32_16x16x32_bf16(PG8_HALF(Bt[n], 0), PG8_HALF(At[m], 0), acc[ai][bj][m][n], 0, 0, 0); \
               acc[ai][bj][m][n] = __builtin_amdgcn_mfma_f32_16x16x32_bf16(PG8_HALF(Bt[n], 1), PG8_HALF(At[m], 1), acc[ai][bj][m][n], 0, 0, 0); } } \
        __builtin_amdgcn_s_setprio(0); } while (0)
#define PG8_WAIT_V(n) asm volatile("s_waitcnt vmcnt(" #n ")" ::: "memory")
#define PG8_WAIT_L(n) asm volatile("s_waitcnt lgkmcnt(" #n ")" ::: "memory")
#define PG8_BAR __builtin_amdgcn_s_barrier()
#define PG8_SCHED __builtin_amdgcn_sched_barrier(0)
    Unit cur, nxt; int ui = 0;
    if (!S.next(0, cur)) return;
    f32x4 acc[2][2][4][2];
#pragma unroll
    for (int a = 0; a < 2; ++a)
#pragma unroll
        for (int b = 0; b < 2; ++b)
#pragma unroll
            for (int m = 0; m < 4; ++m)
#pragma unroll
                for (int n = 0; n < 2; ++n) acc[a][b][m][n] = (f32x4){0.f, 0.f, 0.f, 0.f};
    v8i At[4], B0[2], B1[2];
    const char* cA = (const char*)g.A + (size_t)cur.pm * tstepA; const char* cB = (const char*)g.Bt + (size_t)cur.pn * tstepB;
    PG8_STAGE(PG8_SB(0, 0), cB, voffB); PG8_STAGE(PG8_SA(0, 0), cA, voffA); PG8_STAGE(PG8_SB(0, 1), cB + hstepB, voffB); PG8_STAGE(PG8_SA(0, 1), cA + hstepA, voffA);
    if (wr == 1) PG8_BAR;
    PG8_WAIT_V(4); PG8_BAR;
    PG8_STAGE(PG8_SB(1, 0), cB + kstep, voffB); PG8_STAGE(PG8_SA(1, 0), cA + kstep, voffA); PG8_STAGE(PG8_SB(1, 1), cB + hstepB + kstep, voffB);
    PG8_WAIT_V(6); PG8_BAR;
    for (;;) {
        const bool has_next = S.next(ui + 1, nxt);
        const char* nA = has_next ? (const char*)g.A + (size_t)nxt.pm * tstepA : cA; const char* nB = has_next ? (const char*)g.Bt + (size_t)nxt.pn * tstepB : cB;
        for (int t = 0; t < nt; t += 2) {
            const bool last = (t == nt - 2);
            const char* a1 = cA + (size_t)(t + 1) * kstep;
            const char* a2 = last ? nA : cA + (size_t)(t + 2) * kstep; const char* b2 = last ? nB : cB + (size_t)(t + 2) * kstep;
            const char* a3 = a2 + kstep; const char* b3 = b2 + kstep;
            PG8_LDB(B0, 0, 0); PG8_SCHED; PG8_LDA(At, 0, 0); PG8_STAGE(PG8_SA(1, 1), a1 + hstepA, voffA);
            PG8_WAIT_L(8); PG8_BAR; PG8_WAIT_L(0); PG8_MMA(0, 0, At, B0); PG8_BAR; PG8_SCHED;
            PG8_LDB(B1, 0, 1); PG8_STAGE(PG8_SB(0, 0), b2, voffB);
            PG8_BAR; PG8_WAIT_L(0); PG8_MMA(0, 1, At, B1); PG8_BAR;
            PG8_LDA(At, 0, 1); PG8_STAGE(PG8_SA(0, 0), a2, voffA);
            PG8_BAR; PG8_WAIT_L(0); PG8_MMA(1, 0, At, B0); PG8_BAR; PG8_SCHED;
            PG8_STAGE(PG8_SB(0, 1), b2 + hstepB, voffB);
            PG8_WAIT_V(6); PG8_BAR; PG8_MMA(1, 1, At, B1); PG8_BAR;
            PG8_LDB(B0, 1, 0); PG8_SCHED; PG8_LDA(At, 1, 0); PG8_STAGE(PG8_SA(0, 1), a2 + hstepA, voffA);
            PG8_WAIT_L(8); PG8_BAR; PG8_WAIT_L(0); PG8_MMA(0, 0, At, B0); PG8_BAR; PG8_SCHED;
            PG8_LDB(B1, 1, 1); PG8_STAGE(PG8_SB(1, 0), b3, voffB);
            PG8_BAR; PG8_WAIT_L(0); PG8_MMA(0, 1, At, B1); PG8_BAR;
            PG8_LDA(At, 1, 1); PG8_STAGE(PG8_SA(1, 0), a3, voffA);
            PG8_BAR; PG8_WAIT_L(0); PG8_MMA(1, 0, At, B0); PG8_BAR; PG8_SCHED;
            PG8_STAGE(PG8_SB(1, 1), b3 + hstepB, voffB);
            PG8_WAIT_V(6); PG8_BAR; PG8_MMA(1, 1, At, B1); PG8_BAR;
        }
        if (F8) { __builtin_amdgcn_sched_barrier(0); asm volatile("s_nop 15\n\ts_nop 15" ::: "memory"); __builtin_amdgcn_sched_barrier(0); }
        E(acc, cur, wr, wc, fr, fq);
        if (!has_next) break;
#pragma unroll
        for (int a = 0; a < 2; ++a)
#pragma unroll
            for (int b = 0; b < 2; ++b)
#pragma unroll
                for (int m = 0; m < 4; ++m)
#pragma unroll
                    for (int n = 0; n < 2; ++n) acc[a][b][m][n] = (f32x4){0.f, 0.f, 0.f, 0.f};
        cur = nxt; cA = nA; cB = nB; ++ui;
    }
    PG8_WAIT_V(0);
    if (wr == 0) PG8_BAR;
    PG8_BAR;
#undef PG8_SA
#undef PG8_SB
#undef PG8_STAGE
#undef PG8_LDA
#undef PG8_LD8
#undef PG8_HALF
#undef PG8_LDB
#undef PG8_MMA
#undef PG8_WAIT_V
#undef PG8_WAIT_L
#undef PG8_BAR
#undef PG8_SCHED
}
}

template <int MODE, bool O8>
__device__ __forceinline__ void dense_gemm(const Frame& F, const void* A, const void* Bt, int M, int N, int K, void* O, const bf16_t* X, const bf16_t* Zin, int ldc, int skipctx = 0, int rot = 0) {
    pg8::Gemm g{(const bf16_t*)A, (const bf16_t*)Bt, K * OPB / 2, K * OPB / 2, K * OPB / 2}; pg8::StaticOrder S; S.init(skipctx ? NB * SEQ : M, N, F.G, (F.bid + rot) % F.G, skipctx);
    pg8::Epi<MODE, O8> E{O, X, Zin, ldc, 1 << 30};
    pg8::gemm_phase<pg8::Epi<MODE, O8>, pg8::StaticOrder>(F.lds, g, S, E, F.wave);
}

struct TJob { const float* src; bf16_t* dst; size_t src_bstride; int src_pitch, K, Nvalid, Npad, dst_pitch, blk, blk_stride, row_off, nbatch, dst_brow; bool f8; };
constexpr int N_TJOBS = 13;
__device__ __forceinline__ TJob get_tjob(const Frame& F, int layer, int j) {
    TJob t; t.src_bstride = 0; t.blk = 1 << 30; t.blk_stride = 0; t.row_off = 0; t.nbatch = 1; t.dst_brow = 0; t.f8 = F8 && (j != 10);
    unsigned char* ws = F.ws;
    switch (j) {
    case 0: t.src = F.in[I_WIN] + (size_t)layer * 2048 * 14736; t.src_pitch = 14736; t.K = 2048; t.Nvalid = PC_END; t.Npad = PW; t.dst = (bf16_t*)(ws + WS_WIN); t.dst_pitch = 2048; break;
    case 1: t.src = F.in[I_WIN] + (size_t)layer * 2048 * 14736 + PC_END; t.src_pitch = 14736; t.K = 2048; t.Nvalid = 2048; t.Npad = 2048; t.dst = (bf16_t*)(ws + WS_WG); t.dst_pitch = 2048; t.blk = 128; t.blk_stride = 256; t.row_off = 0; break;
    case 11: t.src = F.in[I_WIN] + (size_t)layer * 2048 * 14736 + PC_END + 2048; t.src_pitch = 14736; t.K = 2048; t.Nvalid = 2048; t.Npad = 2048; t.dst = (bf16_t*)(ws + WS_WG); t.dst_pitch = 2048; t.blk = 128; t.blk_stride = 256; t.row_off = 128; break;
    case 12: t.src = F.in[I_WIN] + (size_t)layer * 2048 * 14736 + PC_END + 4096; t.src_pitch = 14736; t.K = 2048; t.Nvalid = 2048; t.Npad = 2048; t.dst = (bf16_t*)(ws + WS_WG + (size_t)4096 * 2048 * OPB); t.dst_pitch = 2048; break;
    case 2: t.src = F.in[I_MLPROJ] + (size_t)layer * 1024 * 2048; t.src_pitch = 2048; t.K = 1024; t.Nvalid = 2048; t.Npad = 2048; t.dst = (bf16_t*)(ws + WS_WML); t.dst_pitch = 1024; break;
    case 3: t.src = F.in[I_RWPROJ] + (size_t)layer * 1024 * 2048; t.src_pitch = 2048; t.K = 1024; t.Nvalid = 2048; t.Npad = 2048; t.dst = (bf16_t*)(ws + WS_WML + (size_t)1 * 2048 * 1024 * OPB); t.dst_pitch = 1024; break;
    case 4: t.src = F.in[I_S5WV] + (size_t)layer * 1024 * 2048; t.src_pitch = 2048; t.K = 1024; t.Nvalid = 2048; t.Npad = 2048; t.dst = (bf16_t*)(ws + WS_WML + (size_t)2 * 2048 * 1024 * OPB); t.dst_pitch = 1024; t.blk = 128; t.blk_stride = 256; t.row_off = 0; break;
    case 5: t.src = F.in[I_S5WG] + (size_t)layer * 1024 * 2048; t.src_pitch = 2048; t.K = 1024; t.Nvalid = 2048; t.Npad = 2048; t.dst = (bf16_t*)(ws + WS_WML + (size_t)2 * 2048 * 1024 * OPB); t.dst_pitch = 1024; t.blk = 128; t.blk_stride = 256; t.row_off = 128; break;
    case 6: t.src = F.in[I_WOUT] + (size_t)layer * 2048 * 2048; t.src_pitch = 2048; t.K = 2048; t.Nvalid = 2048; t.Npad = 2048; t.dst = (bf16_t*)(ws + WS_WOUT); t.dst_pitch = 2048; break;
    case 7: t.src = F.in[I_EWG] + (size_t)layer * 16 * 2048 * 1024; t.src_bstride = (size_t)2048 * 1024; t.src_pitch = 1024; t.K = 2048; t.Nvalid = 1024; t.Npad = 1024; t.dst = (bf16_t*)(ws + WS_EGU); t.dst_pitch = 2048;
            t.blk = 128; t.blk_stride = 256; t.row_off = 0; t.nbatch = 16; t.dst_brow = 2048; break;
    case 8: t.src = F.in[I_EWU] + (size_t)layer * 16 * 2048 * 1024; t.src_bstride = (size_t)2048 * 1024; t.src_pitch = 1024; t.K = 2048; t.Nvalid = 1024; t.Npad = 1024; t.dst = (bf16_t*)(ws + WS_EGU); t.dst_pitch = 2048;
            t.blk = 128; t.blk_stride = 256; t.row_off = 128; t.nbatch = 16; t.dst_brow = 2048; break;
    case 9: t.src = F.in[I_EWD] + (size_t)layer * 16 * 1024 * 2048; t.src_bstride = (size_t)1024 * 2048; t.src_pitch = 2048; t.K = 1024; t.Nvalid = 2048; t.Npad = 2048; t.dst = (bf16_t*)(ws + WS_EDN); t.dst_pitch = 1024;
            t.nbatch = 16; t.dst_brow = 2048; break;
    default: t.src = F.in[I_RWGUP] + (size_t)layer * 128 * 1024; t.src_pitch = 1024; t.K = 128; t.Nvalid = 1024; t.Npad = 1024; t.dst = (bf16_t*)(ws + WS_GUPT); t.dst_pitch = 128; break;
    }
    return t;
}
__device__ __forceinline__ int tjob_tiles(const TJob& t) { return t.nbatch * (t.Npad / 64) * (t.K / (t.f8 ? 128 : 64)); }
__device__ __forceinline__ void transpose_tile(LAS float* T, int lane, const TJob& t, int tile) {
    const int nkt = t.K / 64, nnt = t.Npad / 64;
    const int b = tile / (nnt * nkt), rem = tile - b * nnt * nkt, ktile = rem / nnt, ntile = rem - ktile * nnt;
    const int n0 = ntile * 64, k0 = ktile * 64;
    const float* src = t.src + (size_t)b * t.src_bstride;
    f32x4 v[16];
#pragma unroll
    for (int p = 0; p < 16; ++p) { const int kk = p * 4 + (lane >> 4), nn = (lane & 15) * 4;
        v[p] = (f32x4){0.f, 0.f, 0.f, 0.f};
        if (n0 + nn < t.Nvalid) v[p] = *(const f32x4*)(src + (size_t)(k0 + kk) * t.src_pitch + n0 + nn); }
#pragma unroll
    for (int p = 0; p < 16; ++p) { const int kk = p * 4 + (lane >> 4), nn = (lane & 15) * 4; T[kk * 65 + nn] = v[p][0]; T[kk * 65 + nn + 1] = v[p][1]; T[kk * 65 + nn + 2] = v[p][2]; T[kk * 65 + nn + 3] = v[p][3]; }
    asm volatile("s_waitcnt lgkmcnt(0)" ::: "memory"); __builtin_amdgcn_wave_barrier();
#pragma unroll
    for (int ps = 0; ps < 8; ++ps) { const int n = ps * 8 + (lane >> 3), kq = (lane & 7) * 8; float x[8];
#pragma unroll
        for (int j = 0; j < 8; ++j) x[j] = T[(kq + j) * 65 + n];
        const int ng = n0 + n; const int drow = b * t.dst_brow + (ng / t.blk) * t.blk_stride + (ng % t.blk) + t.row_off;
        if (t.f8) { u32x2 w; w.x = pk4_fp8(x[0] * W8_SCALE, x[1] * W8_SCALE, x[2] * W8_SCALE, x[3] * W8_SCALE); w.y = pk4_fp8(x[4] * W8_SCALE, x[5] * W8_SCALE, x[6] * W8_SCALE, x[7] * W8_SCALE);
            *(u32x2*)((char*)t.dst + (size_t)drow * t.dst_pitch + k0 + kq) = w; }
        else { u32x4 w; w.x = pk_bf16(x[0], x[1]); w.y = pk_bf16(x[2], x[3]); w.z = pk_bf16(x[4], x[5]); w.w = pk_bf16(x[6], x[7]);
            *(u32x4*)(t.dst + (size_t)drow * t.dst_pitch + k0 + kq) = w; } }
    asm volatile("s_waitcnt lgkmcnt(0)" ::: "memory"); __builtin_amdgcn_wave_barrier();
}
__device__ __forceinline__ void transpose_tile8(LAS unsigned* T8, int lane, const TJob& t, int tile) {
    const int nkt = t.K / 128, nnt = t.Npad / 64;
    const int b = tile / (nnt * nkt), rem = tile - b * nnt * nkt, ktile = rem / nnt, ntile = rem - ktile * nnt;
    const int n0 = ntile * 64, k0 = ktile * 128;
    const float* src = t.src + (size_t)b * t.src_bstride;
    const int nn = (lane & 15) * 4, kq = lane >> 4;
    f32x4 v[32];
#pragma unroll
    for (int p = 0; p < 32; ++p) { const int kk = (p >> 2) * 16 + kq * 4 + (p & 3);
        v[p] = (f32x4){0.f, 0.f, 0.f, 0.f};
        if (n0 + nn < t.Nvalid) v[p] = *(const f32x4*)(src + (size_t)(k0 + kk) * t.src_pitch + n0 + nn); }
#pragma unroll
    for (int g = 0; g < 8; ++g)
#pragma unroll
        for (int j = 0; j < 4; ++j)
            T8[(nn + j) * 36 + g * 4 + kq] = pk4_fp8(v[4 * g][j] * W8_SCALE, v[4 * g + 1][j] * W8_SCALE, v[4 * g + 2][j] * W8_SCALE, v[4 * g + 3][j] * W8_SCALE);
    asm volatile("s_waitcnt lgkmcnt(0)" ::: "memory"); __builtin_amdgcn_wave_barrier();
#pragma unroll
    for (int ps = 0; ps < 8; ++ps) { const int n = ps * 8 + (lane >> 3), pc = lane & 7;
        const u32x4 w = *(const LAS u32x4*)(T8 + n * 36 + pc * 4);
        const int ng = n0 + n; const int drow = b * t.dst_brow + (ng / t.blk) * t.blk_stride + (ng % t.blk) + t.row_off;
        *(u32x4*)((char*)t.dst + (size_t)drow * t.dst_pitch + k0 + pc * 16) = w; }
    asm volatile("s_waitcnt lgkmcnt(0)" ::: "memory"); __builtin_amdgcn_wave_barrier();
}
__device__ __forceinline__ void phase_wprep(const Frame& F, int layer) {
    const int tid = ltid(), lane = tid & 63; (void)lane;
    LAS float* T = (LAS float*)F.lds + F.wave * (64 * 65);
    const int gw = F.bid * NWAVE + F.wave, nw = F.G * NWAVE;
    int base = 0;
#pragma unroll
    for (int j = 0; j < N_TJOBS; ++j) {
        const TJob t = get_tjob(F, layer, j); const int nt = tjob_tiles(t);
        const int first = (gw - (base % nw) + nw) % nw;
        for (int tile = first; tile < nt; tile += nw) { if (t.f8) transpose_tile8((LAS unsigned*)T, lane, t, tile); else transpose_tile(T, lane, t, tile); }
        base += nt;
    }
    __syncthreads();
}

__device__ __forceinline__ void phase_post1_route(const Frame& F, int layer, bool use_mix) {
    const int tid = ltid(), lane = tid & 63; (void)lane;
    const float* mods = (const float*)(F.ws + WS_MODS) + (size_t)layer * 5 * 12288;
    const bf16_t* MIX = (const bf16_t*)(F.ws + WS_MIX);
    bf16_t* X1 = (bf16_t*)(F.ws + WS_X1);
    unsigned* route = (unsigned*)(F.ws + WS_ROUTE);
    unsigned* ecnt = (unsigned*)(F.ws + WS_CTL) + CW_ECNT + layer * 64;
    const float* g1 = F.in[I_LN1G] + layer * D; const float* b1 = F.in[I_LN1B] + layer * D;
    LAS float* RW = (LAS float*)F.lds;
    LAS unsigned* lcnt = (LAS unsigned*)(F.lds + 131072 + 256);
    if (tid < 32) lcnt[tid] = 0u;
    for (int i4 = tid; i4 < 2048 * 16 / 4; i4 += NTHR) { const int k = i4 >> 2, qd = i4 & 3; const int ii = k >> 8, ln = (k >> 2) & 63, c = k & 3;
        *(LAS f32x4*)(RW + ((((qd * 8 + ii) * 4 + c) * 64 + ln) * 4)) = *(const f32x4*)(F.in[I_ROUTW] + (size_t)k * 16 + qd * 4); }
    __syncthreads();
    const int stride = F.G * NWAVE;
    f32x4 xq[8]; u32x2 mq[8];
    const int nrows = layer == 1 ? NB * SEQ : R;
#define ROW_OF(qi) (layer == 1 ? (qi) + ((qi) >> 13) * CTXL + CTXL : (qi))
    { const int r = ROW_OF(F.bid * NWAVE + F.wave); const float* x = xin_row(F, layer, r);
#pragma unroll
      for (int i = 0; i < 8; ++i) { const int e = (i * 64 + lane) * 4; xq[i] = *(const f32x4*)(x + e); mq[i] = *(const u32x2*)(MIX + (size_t)r * D + e); } }
    for (int qi = F.bid * NWAVE + F.wave; qi < nrows; qi += stride) { const int r = ROW_OF(qi);
        const int b = r / TB, s = r - b * TB; const float* md = mods + (size_t)(s < CTXL ? 4 : b) * 12288;
        f32x4 v[8]; float sum = 0.f;
#pragma unroll
        for (int i = 0; i < 8; ++i) { const int e = (i * 64 + lane) * 4; v[i] = xq[i] * ALPHA;
            if (use_mix) { const u32x2 m = mq[i]; const f32x4 g = *(const f32x4*)(md + 2 * 2048 + e);
                v[i][0] += g[0] * __uint_as_float(m.x << 16); v[i][1] += g[1] * __uint_as_float(m.x & 0xffff0000u); v[i][2] += g[2] * __uint_as_float(m.y << 16); v[i][3] += g[3] * __uint_as_float(m.y & 0xffff0000u); }
            sum += (v[i][0] + v[i][1]) + (v[i][2] + v[i][3]); }
        { const int rn = ROW_OF(qi + stride < nrows ? qi + stride : qi); const float* xn = xin_row(F, layer, rn);
#pragma unroll
          for (int i = 0; i < 8; ++i) { const int e = (i * 64 + lane) * 4; xq[i] = *(const f32x4*)(xn + e); mq[i] = *(const u32x2*)(MIX + (size_t)rn * D + e); } }
        float mean = wave_sum(sum, lane) * (1.0f / D); float q = 0.f;
#pragma unroll
        for (int i = 0; i < 8; ++i) { v[i] -= mean; q += (v[i][0] * v[i][0] + v[i][1] * v[i][1]) + (v[i][2] * v[i][2] + v[i][3] * v[i][3]); }
        float rstd = rsqrtf(wave_sum(q, lane) * (1.0f / D) + LN_EPS);
        sum = 0.f;
#pragma unroll
        for (int i = 0; i < 8; ++i) { const int e = (i * 64 + lane) * 4; const f32x4 gg = *(const f32x4*)(g1 + e), bb = *(const f32x4*)(b1 + e);
            v[i] = v[i] * rstd * gg + bb; { u32x2 w; w.x = pk_bf16(v[i][0], v[i][1]); w.y = pk_bf16(v[i][2], v[i][3]); *(u32x2*)(X1 + (size_t)r * D + e) = w; } sum += (v[i][0] + v[i][1]) + (v[i][2] + v[i][3]); }
        mean = wave_sum(sum, lane) * (1.0f / D); q = 0.f;
#pragma unroll
        for (int i = 0; i < 8; ++i) { v[i] -= mean; q += (v[i][0] * v[i][0] + v[i][1] * v[i][1]) + (v[i][2] * v[i][2] + v[i][3] * v[i][3]); }
        rstd = rsqrtf(wave_sum(q, lane) * (1.0f / D) + LN_EPS);
        float lg[16];
#pragma unroll
        for (int e = 0; e < 16; ++e) lg[e] = 0.f;
#pragma unroll
        for (int i = 0; i < 8; ++i) { const int e0 = (i * 64 + lane) * 4; const f32x4 sh = *(const f32x4*)(md + 3 * 2048 + e0), scl = *(const f32x4*)(md + 4 * 2048 + e0);
            const f32x4 u = v[i] * rstd * (scl + 1.0f) + sh;
#pragma unroll
            for (int j = 0; j < 4; ++j) {
#pragma unroll
                for (int qd = 0; qd < 4; ++qd) { const f32x4 w = *(const LAS f32x4*)(RW + ((((qd * 8 + i) * 4 + j) * 64 + lane) * 4)); lg[qd * 4 + 0] += u[j] * w[0]; lg[qd * 4 + 1] += u[j] * w[1]; lg[qd * 4 + 2] += u[j] * w[2]; lg[qd * 4 + 3] += u[j] * w[3]; } }
            __builtin_amdgcn_sched_barrier(0); }
#pragma unroll
        for (int e = 0; e < 16; ++e) lg[e] = wave_sum(lg[e], lane);
        float aff[16], gsc[16];
#pragma unroll
        for (int e = 0; e < 16; ++e) { aff[e] = __builtin_amdgcn_rcpf(1.0f + __expf(-lg[e])); gsc[e] = aff[e] + F.in[I_ROUTB][e]; }
        int best = 0; float bestv = -1e30f;
#pragma unroll
        for (int gI = 0; gI < 4; ++gI) { float m1 = -1e30f, m2 = -1e30f;
#pragma unroll
            for (int j = 0; j < 4; ++j) { const float t = gsc[gI * 4 + j]; if (t > m1) { m2 = m1; m1 = t; } else if (t > m2) m2 = t; }
            const float sc = m1 + m2; if (sc > bestv) { bestv = sc; best = gI; } }
        int i0 = 0, i1 = 0; { float m1 = -1e30f, m2 = -1e30f;
#pragma unroll
            for (int gI = 0; gI < 4; ++gI) if (gI == best) {
#pragma unroll
                for (int j = 0; j < 4; ++j) { const float t = gsc[gI * 4 + j]; if (t > m1) { m2 = m1; i1 = i0; m1 = t; i0 = gI * 4 + j; } else if (t > m2) { m2 = t; i1 = gI * 4 + j; } } } }
        float a0 = 0.f, a1 = 0.f;
#pragma unroll
        for (int e = 0; e < 16; ++e) { a0 = (e == i0) ? aff[e] : a0; a1 = (e == i1) ? aff[e] : a1; }
        const float inv = 1.0f / (a0 + a1);
        if (lane == 0) {
            const unsigned s0 = __hip_atomic_fetch_add(lcnt + i0, 1u, __ATOMIC_RELAXED, __HIP_MEMORY_SCOPE_WORKGROUP), s1 = __hip_atomic_fetch_add(lcnt + i1, 1u, __ATOMIC_RELAXED, __HIP_MEMORY_SCOPE_WORKGROUP);
            u32x4 w0; w0.x = (unsigned)i0; w0.y = (unsigned)i1; w0.z = __float_as_uint(a0 * inv); w0.w = __float_as_uint(a1 * inv);
            *(u32x4*)(route + (size_t)r * 8) = w0; u32x2 w1; w1.x = s0; w1.y = s1; *(u32x2*)(route + (size_t)r * 8 + 4) = w1;
        }
    }
    __syncthreads();
    if (tid < 16) lcnt[16 + tid] = atomicAdd(ecnt + tid, lcnt[tid]);
    __syncthreads();
    for (int qi = F.bid * NWAVE + F.wave; qi < nrows; qi += stride) { const int r = ROW_OF(qi);
        if (lane == 0) { const u32x2 e01 = *(const u32x2*)(route + (size_t)r * 8); u32x2 sl = *(const u32x2*)(route + (size_t)r * 8 + 4);
            sl.x += lcnt[16 + e01.x]; sl.y += lcnt[16 + e01.y]; *(u32x2*)(route + (size_t)r * 8 + 4) = sl; } }
}
__device__ __forceinline__ void load_tile_starts(const Frame& F, int tid, int layer, LAS int* ts) {
    if (tid == 0) { const unsigned* ecnt = (const unsigned*)(F.ws + WS_CTL) + CW_ECNT + layer * 64; int a = 0;
        for (int e = 0; e < 16; ++e) { ts[e] = a; a += (int)((__hip_atomic_load(ecnt + e, __ATOMIC_RELAXED, __HIP_MEMORY_SCOPE_AGENT) + 255u) >> 8); } ts[16] = a; }
    __syncthreads();
}
__device__ __forceinline__ void phase_gather(const Frame& F, int layer) {
    const int tid = ltid(), lane = tid & 63; (void)lane;
    LAS int* ts = (LAS int*)(F.lds + LDS_BYTES - 512);
    const float* mods = (const float*)(F.ws + WS_MODS) + (size_t)layer * 5 * 12288;
    LAS float* ML = (LAS float*)F.lds;
    for (int i = tid; i < 5 * 2 * 512; i += NTHR) { const int mr = i >> 10, v = (i >> 9) & 1, c4 = i & 511; *(LAS f32x4*)(ML + (mr * 2 + v) * 2048 + c4 * 4) = *(const f32x4*)(mods + (size_t)mr * 12288 + (3 + v) * 2048 + c4 * 4); }
    load_tile_starts(F, tid, layer, ts);
    const bf16_t* X1 = (const bf16_t*)(F.ws + WS_X1);
    const unsigned* route = (const unsigned*)(F.ws + WS_ROUTE);
    bf16_t* UG = (bf16_t*)(F.ws + WS_SC);
    const int stride = F.G * NWAVE;
    u32x2 xw[8]; u32x4 rr; u32x2 sl;
    const int nrows = layer == 1 ? NB * SEQ : R;
    { const int r = ROW_OF(F.bid * NWAVE + F.wave);
#pragma unroll
      for (int i = 0; i < 8; ++i) xw[i] = *(const u32x2*)(X1 + (size_t)r * D + (i * 64 + lane) * 4);
      rr = *(const u32x4*)(route + (size_t)r * 8); sl = *(const u32x2*)(route + (size_t)r * 8 + 4); }
    for (int qi = F.bid * NWAVE + F.wave; qi < nrows; qi += stride) { const int r = ROW_OF(qi);
        const int b = r / TB, s = r - b * TB; const LAS float* md = ML + (s < CTXL ? 4 : b) * 4096;
        f32x4 v[8]; float sum = 0.f;
#pragma unroll
        for (int i = 0; i < 8; ++i) { const u32x2 w = xw[i]; v[i][0] = __uint_as_float(w.x << 16); v[i][1] = __uint_as_float(w.x & 0xffff0000u); v[i][2] = __uint_as_float(w.y << 16); v[i][3] = __uint_as_float(w.y & 0xffff0000u); sum += (v[i][0] + v[i][1]) + (v[i][2] + v[i][3]); }
        const u32x4 rc = rr; const u32x2 sc_ = sl;
        { const int rn = ROW_OF(qi + stride < nrows ? qi + stride : qi);
#pragma unroll
          for (int i = 0; i < 8; ++i) xw[i] = *(const u32x2*)(X1 + (size_t)rn * D + (i * 64 + lane) * 4);
          rr = *(const u32x4*)(route + (size_t)rn * 8); sl = *(const u32x2*)(route + (size_t)rn * 8 + 4); }
        const float mean = wave_sum(sum, lane) * (1.0f / D); float q = 0.f;
#pragma unroll
        for (int i = 0; i < 8; ++i) { v[i] -= mean; q += (v[i][0] * v[i][0] + v[i][1] * v[i][1]) + (v[i][2] * v[i][2] + v[i][3] * v[i][3]); }
        const float rstd = rsqrtf(wave_sum(q, lane) * (1.0f / D) + LN_EPS);
        const size_t row0 = (size_t)ts[rc.x] * 256 + sc_.x, row1 = (size_t)ts[rc.y] * 256 + sc_.y;
#pragma unroll
        for (int i = 0; i < 8; ++i) { const int e = (i * 64 + lane) * 4; const f32x4 sh = *(const LAS f32x4*)(md + e), scl = *(const LAS f32x4*)(md + 2048 + e);
            const f32x4 u = v[i] * rstd * (scl + 1.0f) + sh;
            st_op4(UG, row0 * D + e, u[0], u[1], u[2], u[3]); st_op4(UG, row1 * D + e, u[0], u[1], u[2], u[3]); }
    }
}
__device__ __forceinline__ void phase_moe_gemm(const Frame& F, int layer, int which) {
    const int tid = ltid(), lane = tid & 63; (void)lane;
    LAS int* ts = (LAS int*)(F.lds + pg8::STAGE_BYTES);
    load_tile_starts(F, tid, layer, ts);
    if (which == 0) {
        pg8::Gemm g{(const bf16_t*)(F.ws + WS_SC), (const bf16_t*)(F.ws + WS_EGU), 2048 * OPB / 2, 2048 * OPB / 2, 2048 * OPB / 2};
        pg8::GroupedOrder S{ts, 8, F.G, F.bid}; pg8::Epi<4, true> E{(void*)(F.ws + WS_U), nullptr, nullptr, 1024, 8};
        pg8::gemm_phase<pg8::Epi<4, true>, pg8::GroupedOrder>(F.lds, g, S, E, F.wave);
    } else {
        pg8::Gemm g{(const bf16_t*)(F.ws + WS_U), (const bf16_t*)(F.ws + WS_EDN), 1024 * OPB / 2, 1024 * OPB / 2, 1024 * OPB / 2};
        pg8::GroupedOrder S{ts, 8, F.G, F.bid}; pg8::Epi<0, false> E{(void*)(F.ws + WS_SC), nullptr, nullptr, 2048, 8};
        pg8::gemm_phase<pg8::Epi<0, false>, pg8::GroupedOrder>(F.lds, g, S, E, F.wave);
    }
}
__device__ __forceinline__ void phase_post2_moe(const Frame& F, int layer, bool use_ffn) {
    const int tid = ltid(), lane = tid & 63; (void)lane;
    LAS int* ts = (LAS int*)(F.lds + LDS_BYTES - 512);
    const float* mods = (const float*)(F.ws + WS_MODS) + (size_t)layer * 5 * 12288;
    LAS float* GL5 = (LAS float*)F.lds;
    LAS float* G2L = GL5 + 5 * 2048; LAS float* NXL = G2L + 2 * 2048;
    for (int i = tid; i < 5 * 512; i += NTHR) { const int mr = i >> 9, c4 = i & 511; *(LAS f32x4*)(GL5 + mr * 2048 + c4 * 4) = *(const f32x4*)(mods + (size_t)mr * 12288 + 5 * 2048 + c4 * 4); }
    for (int i = tid; i < 2 * 512; i += NTHR) { const int v = i >> 9, c4 = i & 511; *(LAS f32x4*)(G2L + v * 2048 + c4 * 4) = *(const f32x4*)((v == 0 ? F.in[I_LN2G] : F.in[I_LN2B]) + layer * D + c4 * 4); }
    if (layer == 0) for (int i = tid; i < 5 * 2 * 512; i += NTHR) { const int mr = i >> 10, v = (i >> 9) & 1, c4 = i & 511; *(LAS f32x4*)(NXL + (mr * 2 + v) * 2048 + c4 * 4) = *(const f32x4*)(mods + (size_t)5 * 12288 + (size_t)mr * 12288 + v * 2048 + c4 * 4); }
    load_tile_starts(F, tid, layer, ts);
    const bf16_t* X1 = (const bf16_t*)(F.ws + WS_X1);
    const unsigned* route = (const unsigned*)(F.ws + WS_ROUTE);
    const bf16_t* Y = (const bf16_t*)(F.ws + WS_SC);
    const float* g2 = F.in[I_LN2G] + layer * D; const float* b2 = F.in[I_LN2B] + layer * D;
    const int stride = F.G * NWAVE;
    u32x2 xw[8], y0w[8], y1w[8]; u32x4 rrN; u32x2 slN; float w0c, w1c;
    const int nrows = layer == 1 ? NB * SEQ : R;
    { const int r = ROW_OF(F.bid * NWAVE + F.wave); const u32x4 rr = *(const u32x4*)(route + (size_t)r * 8); const u32x2 sl = *(const u32x2*)(route + (size_t)r * 8 + 4);
      const size_t row0 = (size_t)ts[rr.x] * 256 + sl.x, row1 = (size_t)ts[rr.y] * 256 + sl.y; w0c = __uint_as_float(rr.z); w1c = __uint_as_float(rr.w);
#pragma unroll
      for (int i = 0; i < 8; ++i) { const int e = (i * 64 + lane) * 4; xw[i] = *(const u32x2*)(X1 + (size_t)r * D + e); y0w[i] = *(const u32x2*)(Y + row0 * D + e); y1w[i] = *(const u32x2*)(Y + row1 * D + e); }
      const int q0 = F.bid * NWAVE + F.wave; const int rn = ROW_OF(q0 + stride < nrows ? q0 + stride : q0); rrN = *(const u32x4*)(route + (size_t)rn * 8); slN = *(const u32x2*)(route + (size_t)rn * 8 + 4); }
    for (int qi = F.bid * NWAVE + F.wave; qi < nrows; qi += stride) { const int r = ROW_OF(qi);
        const int b = r / TB, s = r - b * TB; const int mr = s < CTXL ? 4 : b;
        const float w0 = w0c, w1 = w1c;
        f32x4 v[8]; float sum = 0.f;
#pragma unroll
        for (int i = 0; i < 8; ++i) { const int e = (i * 64 + lane) * 4; { const u32x2 w = xw[i]; v[i][0] = __uint_as_float(w.x << 16); v[i][1] = __uint_as_float(w.x & 0xffff0000u); v[i][2] = __uint_as_float(w.y << 16); v[i][3] = __uint_as_float(w.y & 0xffff0000u); v[i] *= ALPHA; }
            if (use_ffn) { const u32x2 y0 = y0w[i], y1 = y1w[i]; const f32x4 g = *(const LAS f32x4*)(GL5 + mr * 2048 + e);
                v[i][0] += g[0] * (w0 * __uint_as_float(y0.x << 16) + w1 * __uint_as_float(y1.x << 16));
                v[i][1] += g[1] * (w0 * __uint_as_float(y0.x & 0xffff0000u) + w1 * __uint_as_float(y1.x & 0xffff0000u));
                v[i][2] += g[2] * (w0 * __uint_as_float(y0.y << 16) + w1 * __uint_as_float(y1.y << 16));
                v[i][3] += g[3] * (w0 * __uint_as_float(y0.y & 0xffff0000u) + w1 * __uint_as_float(y1.y & 0xffff0000u)); }
            sum += (v[i][0] + v[i][1]) + (v[i][2] + v[i][3]); }
        {
            const int rn = ROW_OF(qi + stride < nrows ? qi + stride : qi); const int rn2 = ROW_OF(qi + 2 * stride < nrows ? qi + 2 * stride : qi);
            const size_t row0 = (size_t)ts[rrN.x] * 256 + slN.x, row1 = (size_t)ts[rrN.y] * 256 + slN.y; w0c = __uint_as_float(rrN.z); w1c = __uint_as_float(rrN.w);
#pragma unroll
            for (int i = 0; i < 8; ++i) { const int e = (i * 64 + lane) * 4; xw[i] = *(const u32x2*)(X1 + (size_t)rn * D + e); y0w[i] = *(const u32x2*)(Y + row0 * D + e); y1w[i] = *(const u32x2*)(Y + row1 * D + e); }
            rrN = *(const u32x4*)(route + (size_t)rn2 * 8); slN = *(const u32x2*)(route + (size_t)rn2 * 8 + 4); }
        const float mean = wave_sum(sum, lane) * (1.0f / D); float q = 0.f;
#pragma unroll
        for (int i = 0; i < 8; ++i) { v[i] -= mean; q += (v[i][0] * v[i][0] + v[i][1] * v[i][1]) + (v[i][2] * v[i][2] + v[i][3] * v[i][3]); }
        const float rstd = rsqrtf(wave_sum(q, lane) * (1.0f / D) + LN_EPS);
        float* o = xout_row(F, r); float sum2 = 0.f;
#pragma unroll
        for (int i = 0; i < 8; ++i) { const int e = (i * 64 + lane) * 4; const f32x4 gg = *(const LAS f32x4*)(G2L + e), bb = *(const LAS f32x4*)(G2L + 2048 + e);
            v[i] = v[i] * rstd * gg + bb; *(f32x4*)(o + e) = v[i]; sum2 += (v[i][0] + v[i][1]) + (v[i][2] + v[i][3]); }
        if (layer == 0) {
            const LAS float* mdn = NXL + mr * 4096; void* U = (void*)(F.ws + WS_U);
            const float mean2 = wave_sum(sum2, lane) * (1.0f / D); float q2 = 0.f;
#pragma unroll
            for (int i = 0; i < 8; ++i) { v[i] -= mean2; q2 += (v[i][0] * v[i][0] + v[i][1] * v[i][1]) + (v[i][2] * v[i][2] + v[i][3] * v[i][3]); }
            const float rstd2 = rsqrtf(wave_sum(q2, lane) * (1.0f / D) + LN_EPS);
#pragma unroll
            for (int i = 0; i < 8; ++i) { const int e = (i * 64 + lane) * 4; const f32x4 sh = *(const LAS f32x4*)(mdn + e), scl = *(const LAS f32x4*)(mdn + 2048 + e);
                const f32x4 u = v[i] * rstd2 * (scl + 1.0f) + sh; st_op4(U, (size_t)r * D + e, u[0], u[1], u[2], u[3]); }
        }
    }
}


__device__ __forceinline__ bf16x8 pack_8(const f32x4 a, const f32x4 b) { u32x4 w; w.x = pk_bf16(a[0], a[1]); w.y = pk_bf16(a[2], a[3]); w.z = pk_bf16(b[0], b[1]); w.w = pk_bf16(b[2], b[3]); bf16x8 r; __builtin_memcpy(&r, &w, 16); return r; }
__device__ __forceinline__ bf16x8 lds_2x8(const LAS bf16_t* p0, const LAS bf16_t* p1) { const u32x2 a = *(const LAS u32x2*)p0, b = *(const LAS u32x2*)p1; u32x4 w; w.x = a.x; w.y = a.y; w.z = b.x; w.w = b.y; bf16x8 r; __builtin_memcpy(&r, &w, 16); return r; }
__device__ __forceinline__ int nat_chunk(int d, int j) { return d == 0 ? j : (j < 4 ? 3 - j : 135 - j); }
__device__ __forceinline__ bf16x8 ldsA(const LAS bf16_t* p) { return *(const LAS bf16x8*)p; }
#define MFMA16(a, b, c) __builtin_amdgcn_mfma_f32_16x16x32_bf16((a), (b), (c), 0, 0, 0)
constexpr size_t SC_RWF = 0, SC_RWB = (size_t)R * 1024 * 2, SC_S5 = 2 * SC_RWB, SC_ML = SC_S5 + (size_t)R * 1024 * OPB, SC_RWO = F8 ? SC_ML + (size_t)R * 1024 * OPB : SC_RWF;
static_assert(SC_RWO + (size_t)R * 1024 * OPB <= SC_BYTES, "SC region overflow");

__device__ __forceinline__ void conv_item(const Frame& F, int tid, int layer, int it) {
    const bf16_t* P = (const bf16_t*)(F.ws + WS_P); bf16_t* QK = (bf16_t*)(F.ws + WS_QK);
    int b, rowbase[3], jmin, jmax; bool rv[3];
    if (it < 512) { b = it >> 7; const int i = it & 127; jmin = 0; jmax = 63;
        _Pragma("unroll") for (int a = 0; a < 3; ++a) { const int ii = i + a - 1; rv[a] = (ii >= 0 && ii < 128); rowbase[a] = b * TB + CTXL + ii * 64; } }
    else { const int q = it - 512; b = q >> 2; const int seg = q & 3; jmin = seg == 0 ? 0 : -1; jmax = seg == 3 ? 63 : 64;
        rv[0] = false; rv[2] = false; rv[1] = true; rowbase[0] = rowbase[2] = rowbase[1] = b * TB + seg * 64; }
    const int c0 = tid * 4;
    const float* cw = F.in[I_MLCW] + (size_t)layer * 9 * 2048; const float* cb = F.in[I_MLCB] + layer * 2048;
    f32x4 w[3][3];
#pragma unroll
    for (int a = 0; a < 3; ++a)
#pragma unroll
        for (int bb = 0; bb < 3; ++bb) w[a][bb] = *(const f32x4*)(cw + (a * 3 + bb) * 2048 + c0);
    const f32x4 bias = *(const f32x4*)(cb + c0);
    const float osc = c0 >= 1024 ? 0.0625f : 1.0f;
    f32x4 win[3][3];
#pragma unroll
    for (int a = 0; a < 3; ++a) { win[a][0] = (f32x4){0.f, 0.f, 0.f, 0.f}; win[a][1] = win[a][0]; win[a][2] = win[a][0]; }
    auto ldcol = [&](int a, int jj) -> f32x4 {
        const bool ok = rv[a] && jj >= jmin && jj <= jmax; const int rr = ok ? rowbase[a] + jj : rowbase[1];
        const u32x2 p = *(const u32x2*)(P + (size_t)rr * PW + c0); const float mk = ok ? 1.0f : 0.0f; f32x4 r;
        r[0] = mk * __uint_as_float(p.x << 16); r[1] = mk * __uint_as_float(p.x & 0xffff0000u); r[2] = mk * __uint_as_float(p.y << 16); r[3] = mk * __uint_as_float(p.y & 0xffff0000u);
        return r; };
#pragma unroll
    for (int a = 0; a < 3; ++a) { win[a][1] = ldcol(a, -1); win[a][2] = ldcol(a, 0); }
    for (int j0 = 0; j0 < 64; j0 += 8) {
        f32x4 nw[3][8];
#pragma unroll
        for (int u = 0; u < 8; ++u)
#pragma unroll
            for (int a = 0; a < 3; ++a) nw[a][u] = ldcol(a, j0 + u + 1);
#pragma unroll
        for (int u = 0; u < 8; ++u) {
            f32x4 acc = bias;
#pragma unroll
            for (int a = 0; a < 3; ++a) { win[a][0] = win[a][1]; win[a][1] = win[a][2]; win[a][2] = nw[a][u];
                acc += win[a][0] * w[a][0] + win[a][1] * w[a][1] + win[a][2] * w[a][2]; }
            u32x2 o; o.x = pk_bf16(siluf_(acc[0]) * osc, siluf_(acc[1]) * osc); o.y = pk_bf16(siluf_(acc[2]) * osc, siluf_(acc[3]) * osc);
            *(u32x2*)(QK + (size_t)(rowbase[1] + j0 + u) * 2048 + c0) = o;
        }
    }
}

__device__ __forceinline__ void fsincos(float a, float* s, float* c) { const float k = rintf(a * 0.15915494309189535f); const float r = fmaf(-k, 6.2831854820251465f, a) + k * 1.7484555e-7f; *s = __sinf(r); *c = __cosf(r); }
__device__ __forceinline__ void s5_tables_item(const Frame& F, int tid, int layer, int g) {
    LAS float* pwr = (LAS float*)F.lds;
    LAS float* pwi = pwr + 2 * 65 * 64;
    LAS float* bbr = pwi + 2 * 65 * 64;
    LAS float* bbi = bbr + 2 * 64 * 16;
    LAS float* ccr = bbi + 2 * 64 * 16;
    LAS float* cci = ccr + 2 * 16 * 64;
    LAS float* k0b = cci + 2 * 16 * 64;
    bf16_t* KC = (bf16_t*)(F.ws + WS_S5KC) + (size_t)g * 128 * 256;
    bf16_t* EC = (bf16_t*)(F.ws + WS_S5E) + (size_t)g * 256 * 1024;
    bf16_t* FC = (bf16_t*)(F.ws + WS_S5F) + (size_t)g * 1024 * 256;
    {
        const int dn = tid & 127, d = dn >> 6, n = dn & 63, tg = tid >> 7;
        const size_t li = (((size_t)layer * 2 + d) * 64 + g) * 64 + n;
        const float lre = F.in[I_S5LRE][li], lim = F.in[I_S5LIM][li], dt = expf(F.in[I_S5LDT][((size_t)layer * 2 + d) * 64 + g]);
        const float zr = lre * dt, zi = lim * dt;
        for (int tau = tg; tau <= 64; tau += 4) { const float mag = expf(zr * (float)tau); float sn, cs; fsincos(zi * (float)tau, &sn, &cs);
            pwr[(d * 65 + tau) * 64 + n] = mag * cs; pwi[(d * 65 + tau) * 64 + n] = mag * sn; }
        if (tg == 0) {
            const float mag = expf(zr); float sn, cs; fsincos(zi, &sn, &cs);
            const float nr = mag * cs - 1.0f, ni = mag * sn, den = 1.0f / (lre * lre + lim * lim);
            const float cr = (nr * lre + ni * lim) * den, ci = (ni * lre - nr * lim) * den;
            const float* br = F.in[I_S5BRE] + li * 16; const float* bi = F.in[I_S5BIM] + li * 16;
            for (int c = 0; c < 16; ++c) { bbr[(d * 64 + n) * 16 + c] = cr * br[c] - ci * bi[c]; bbi[(d * 64 + n) * 16 + c] = cr * bi[c] + ci * br[c]; }
        }
        for (int i = tid; i < 2 * 16 * 64; i += NTHR) { const int dd = i >> 10, rem = i & 1023;
            const size_t ci_ = (((size_t)layer * 2 + dd) * 64 + g) * 1024 + rem; ccr[i] = F.in[I_S5CRE][ci_]; cci[i] = F.in[I_S5CIM][ci_]; }
    }
    __syncthreads();
    {
        const int d = tid >> 8, co = (tid >> 4) & 15, ci = tid & 15;
        for (int half = 0; half < 2; ++half) {
            float acc[32];
#pragma unroll
            for (int t = 0; t < 32; ++t) acc[t] = 0.f;
            for (int n = 0; n < 64; ++n) {
                const float c_r = ccr[(d * 16 + co) * 64 + n], c_i = cci[(d * 16 + co) * 64 + n], b_r = bbr[(d * 64 + n) * 16 + ci], b_i = bbi[(d * 64 + n) * 16 + ci];
                const float gr = c_r * b_r - c_i * b_i, gi = c_r * b_i + c_i * b_r;
#pragma unroll
                for (int t = 0; t < 32; ++t) acc[t] += gr * pwr[(d * 65 + half * 32 + t) * 64 + n] - gi * pwi[(d * 65 + half * 32 + t) * 64 + n];
            }
            if (half == 0) {
                if (d == 1) k0b[tid & 255] = acc[0];
                __syncthreads();
                if (d == 0) acc[0] += k0b[tid & 255] + (co == ci ? F.in[I_S5D][layer * 1024 + g * 16 + co] : 0.f);
            }
#pragma unroll
            for (int t = 0; t < 32; ++t) { const int tau = half * 32 + t; if (d == 1 && tau == 0) continue; const int delta = d == 0 ? tau : -tau; KC[(size_t)(delta + 63) * 256 + co * 16 + ci] = f2bf(acc[t]); }
        }
        if (d == 1) KC[(size_t)127 * 256 + (tid & 255)] = 0;
    }
    for (int u = tid; u < 2 * 64 * 64 * 2; u += NTHR) {
        const int ch = u & 1, sp = (u >> 1) & 63, n = (u >> 7) & 63, d = u >> 13;
        const int tau = d == 0 ? 63 - sp : sp; const float pr = pwr[(d * 65 + tau) * 64 + n], pi = pwi[(d * 65 + tau) * 64 + n];
        float er[8], ei[8];
#pragma unroll
        for (int e = 0; e < 8; ++e) { const float b_r = bbr[(d * 64 + n) * 16 + ch * 8 + e], b_i = bbi[(d * 64 + n) * 16 + ch * 8 + e]; er[e] = pr * b_r - pi * b_i; ei[e] = pr * b_i + pi * b_r; }
        u32x4 wr_, wi_; wr_.x = pk_bf16(er[0], er[1]); wr_.y = pk_bf16(er[2], er[3]); wr_.z = pk_bf16(er[4], er[5]); wr_.w = pk_bf16(er[6], er[7]);
        wi_.x = pk_bf16(ei[0], ei[1]); wi_.y = pk_bf16(ei[2], ei[3]); wi_.z = pk_bf16(ei[4], ei[5]); wi_.w = pk_bf16(ei[6], ei[7]);
        *(u32x4*)(EC + (size_t)(d * 128 + n) * 1024 + sp * 16 + ch * 8) = wr_;
        *(u32x4*)(EC + (size_t)(d * 128 + 64 + n) * 1024 + sp * 16 + ch * 8) = wi_;
    }
    for (int u = tid; u < 1024 * 32; u += NTHR) {
        const int n8 = u & 7, part = (u >> 3) & 1, d = (u >> 4) & 1, co = (u >> 5) & 15, tp = u >> 9;
        const int tau = d == 0 ? tp + 1 : 64 - tp; float f[8];
#pragma unroll
        for (int e = 0; e < 8; ++e) { const int n = n8 * 8 + e; const float c_r = ccr[(d * 16 + co) * 64 + n], c_i = cci[(d * 16 + co) * 64 + n], pr = pwr[(d * 65 + tau) * 64 + n], pi = pwi[(d * 65 + tau) * 64 + n];
            f[e] = part == 0 ? (c_r * pr - c_i * pi) : -(c_r * pi + c_i * pr); }
        u32x4 w; w.x = pk_bf16(f[0], f[1]); w.y = pk_bf16(f[2], f[3]); w.z = pk_bf16(f[4], f[5]); w.w = pk_bf16(f[6], f[7]);
        *(u32x4*)(FC + (size_t)(tp * 16 + co) * 256 + d * 128 + part * 64 + n8 * 8) = w;
    }
    __syncthreads();
}

__device__ __forceinline__ void s5a_wave_item(const Frame& F, int lane, int wi) {
    const int rh = wi & 1, w2 = wi >> 1, g = w2 / 9, cq = w2 - g * 9, l15 = lane & 15, q = lane >> 4;
    const bf16_t* P = (const bf16_t*)(F.ws + WS_P); const bf16_t* EC = (const bf16_t*)(F.ws + WS_S5E) + (size_t)g * 256 * 1024 + (size_t)rh * 128 * 1024;
    float* XL = (float*)(F.ws + WS_S5X);
    const bf16_t* ub[4]; int colv[4];
#pragma unroll
    for (int c = 0; c < 4; ++c) { const int ct = (cq * 4 + c) < 33 ? cq * 4 + c : 32; const int col = ct * 16 + l15, b = col / NCH, jn = col - b * NCH; colv[c] = col;
        ub[c] = P + (size_t)(b * TB + jn * 64 + (q >> 1)) * PW + PC_S5 + g * 16 + (q & 1) * 8; }
    const unsigned eoff = (unsigned)(l15 * 1024 + q * 8) * 2u;
    f32x4 acc[4][8];
#pragma unroll
    for (int c = 0; c < 4; ++c)
#pragma unroll
        for (int x = 0; x < 8; ++x) acc[c][x] = (f32x4){0.f, 0.f, 0.f, 0.f};
    for (int ks = 0; ks < 32; ks += 2) {
        bf16x8 Bf[2][4], Af[2][8];
#pragma unroll
        for (int u = 0; u < 2; ++u) {
#pragma unroll
            for (int c = 0; c < 4; ++c) Bf[u][c] = *(const bf16x8*)(ub[c] + (size_t)((ks + u) * 2) * PW);
            unsigned eo = eoff; asm volatile("" : "+v"(eo));
#pragma unroll
            for (int x = 0; x < 8; ++x) Af[u][x] = *(const bf16x8*)((const char*)(EC + (size_t)(x * 16) * 1024 + (ks + u) * 32) + eo); }
#pragma unroll
        for (int u = 0; u < 2; ++u)
#pragma unroll
            for (int x = 0; x < 8; ++x)
#pragma unroll
                for (int c = 0; c < 4; ++c) acc[c][x] = MFMA16(Af[u][x], Bf[u][c], acc[c][x]);
    }
#pragma unroll
    for (int c = 0; c < 4; ++c) if (cq * 4 + c < 33) {
#pragma unroll
        for (int x = 0; x < 8; ++x) *(f32x4*)(XL + ((size_t)g * 528 + colv[c]) * 256 + rh * 128 + x * 16 + q * 4) = acc[c][x]; }
}

__device__ __forceinline__ void s5b_item(const Frame& F, int tid, int layer, int it) {
    const int idx = it * NTHR + tid, n = idx & 63, g = (idx >> 6) & 63, b = (idx >> 12) & 3, d = idx >> 14;
    const size_t li = (((size_t)layer * 2 + d) * 64 + g) * 64 + n;
    const float dt = expf(F.in[I_S5LDT][((size_t)layer * 2 + d) * 64 + g]);
    const float zr = F.in[I_S5LRE][li] * dt * 64.0f, zi = F.in[I_S5LIM][li] * dt * 64.0f;
    const float mag = expf(zr); float sn, cs; fsincos(zi, &sn, &cs); const float ar = mag * cs, ai = mag * sn;
    float* XL = (float*)(F.ws + WS_S5X);
    float cr = 0.f, ci = 0.f;
    for (int j0 = 0; j0 < NCH; j0 += 12) {
        float xr[12], xi[12];
#pragma unroll
        for (int u = 0; u < 12; ++u) { const int col = b * NCH + nat_chunk(d, j0 + u); const float* p = XL + ((size_t)g * 528 + col) * 256 + d * 128 + n; xr[u] = p[0]; xi[u] = p[64]; }
#pragma unroll
        for (int u = 0; u < 12; ++u) { const int col = b * NCH + nat_chunk(d, j0 + u); float* p = XL + ((size_t)g * 528 + col) * 256 + d * 128 + n;
            p[0] = cr; p[64] = ci; const float nr = ar * cr - ai * ci + xr[u], ni = ar * ci + ai * cr + xi[u]; cr = nr; ci = ni; }
    }
}

__device__ __forceinline__ float gelu_tanh(float x) { const float u = 0.7978845608028654f * (x + 0.044715f * x * x * x); const float e = __expf(2.0f * u); const float th = 1.0f - 2.0f / (e + 1.0f); return 0.5f * x * (1.0f + th); }
__device__ __forceinline__ void s5c_block_item(const Frame& F, int tid, int it) {
    const int g = it >> 2, part = it & 3, lane = tid & 63, l15 = lane & 15, q = lane >> 4;
    const int wave = __builtin_amdgcn_readfirstlane(tid >> 6);
    LAS bf16_t* KL = (LAS bf16_t*)F.lds;
    LAS bf16_t* UL = KL + 127 * 264;
    { const bf16_t* KC = (const bf16_t*)(F.ws + WS_S5KC) + (size_t)g * 128 * 256;
      for (int i = tid; i < 127 * 32; i += NTHR) { const int r = i >> 5, sgm = i & 31, co = sgm >> 1, hf = sgm & 1;
          *(LAS u32x4*)(KL + r * 264 + hf * 128 + co * 8) = *(const u32x4*)(KC + (size_t)r * 256 + sgm * 8); } }
    const bf16_t* P = (const bf16_t*)(F.ws + WS_P);
    const bf16_t* FC = (const bf16_t*)(F.ws + WS_S5F) + (size_t)g * 1024 * 256; const float* XC = (const float*)(F.ws + WS_S5X);
    void* OUT = (void*)(F.ws + WS_SC + SC_S5);
    const int c0 = part == 0 ? 0 : 9 + (part - 1) * 8, nct = part == 0 ? 9 : 8;
    for (int cp = 0; cp < (nct + 1) / 2; ++cp) {
        const int ctA = c0 + 2 * cp; const bool vB = (2 * cp + 1) < nct; const int ctB = vB ? ctA + 1 : ctA;
        __syncthreads();
        { const int grp = tid >> 8; const int ct = grp == 0 ? ctA : ctB;
#pragma unroll
          for (int i = 0; i < 8; ++i) { const int id = (tid & 255) + i * 256, s = id >> 5, rem = id & 31, cl = rem >> 1, hf = rem & 1;
              const int colg = ct * 16 + cl, bb = colg / NCH, jj = colg - bb * NCH;
              *(LAS u32x4*)(UL + grp * 16384 + s * 256 + hf * 128 + cl * 8) = *(const u32x4*)(P + (size_t)(bb * TB + jj * 64 + s) * PW + PC_S5 + g * 16 + hf * 8); } }
        __syncthreads();
        const int colA = ctA * 16 + l15, bA = colA / NCH, jA = colA - bA * NCH, colB = ctB * 16 + l15, bB = colB / NCH, jB = colB - bB * NCH;
        const LAS bf16_t* kcl = KL + (63 - (q >> 1)) * 264 + (q & 1) * 128 + l15 * 8;
        const LAS bf16_t* ul = UL + (q >> 1) * 256 + (q & 1) * 128 + l15 * 8;
        f32x4 acc[2][8];
#pragma unroll
        for (int c = 0; c < 2; ++c)
#pragma unroll
            for (int x = 0; x < 8; ++x) acc[c][x] = (f32x4){0.f, 0.f, 0.f, 0.f};
        for (int kb = 0; kb < 4; ++kb) {
#pragma unroll
            for (int i = 0; i < 8; ++i) { const int ks = kb * 8 + i; const bf16x8 b0 = ldsA(ul + ks * 512), b1 = ldsA(ul + 16384 + ks * 512);
#pragma unroll
                for (int x = 0; x < 8; ++x) { const bf16x8 af = ldsA(kcl + (wave * 8 + x - 2 * ks) * 264); acc[0][x] = MFMA16(af, b0, acc[0][x]); acc[1][x] = MFMA16(af, b1, acc[1][x]); }
                if (i & 1) __builtin_amdgcn_sched_barrier(0); }
        }
        {
            const unsigned foff = (unsigned)(l15 * 256 + q * 8) * 2u; const bf16_t* fu = FC + (size_t)(wave * 128) * 256;
            bf16x8 Af[8];
            { unsigned fo = foff; asm volatile("" : "+v"(fo));
#pragma unroll
              for (int x = 0; x < 8; ++x) Af[x] = *(const bf16x8*)((const char*)(fu + (size_t)(x * 16) * 256) + fo); }
            bf16x8 Xa[8], Xb[8];
#pragma unroll
            for (int ks = 0; ks < 8; ++ks) { const float* xp = XC + ((size_t)g * 528 + colA) * 256 + ks * 32 + q * 8; Xa[ks] = pack_8(*(const f32x4*)xp, *(const f32x4*)(xp + 4));
                const float* xq = XC + ((size_t)g * 528 + colB) * 256 + ks * 32 + q * 8; Xb[ks] = pack_8(*(const f32x4*)xq, *(const f32x4*)(xq + 4)); }
#pragma unroll
            for (int ks = 0; ks < 8; ++ks) { bf16x8 An[8]; unsigned fo = foff; asm volatile("" : "+v"(fo));
                if (ks + 1 < 8) {
#pragma unroll
                    for (int x = 0; x < 8; ++x) An[x] = *(const bf16x8*)((const char*)(fu + (size_t)(x * 16) * 256 + (ks + 1) * 32) + fo); }
#pragma unroll
                for (int x = 0; x < 8; ++x) { acc[0][x] = MFMA16(Af[x], Xa[ks], acc[0][x]); acc[1][x] = MFMA16(Af[x], Xb[ks], acc[1][x]); }
                if (ks + 1 < 8) {
#pragma unroll
                    for (int x = 0; x < 8; ++x) Af[x] = An[x]; }
                __builtin_amdgcn_sched_barrier(0); }
        }
#pragma unroll
        for (int x = 0; x < 8; ++x) { const int tp = wave * 8 + x;
            { const size_t row = (size_t)bA * TB + jA * 64 + tp; st_op4(OUT, row * 1024 + g * 16 + q * 4, gelu_tanh(acc[0][x][0]), gelu_tanh(acc[0][x][1]), gelu_tanh(acc[0][x][2]), gelu_tanh(acc[0][x][3])); }
            if (vB) { const size_t row = (size_t)bB * TB + jB * 64 + tp; st_op4(OUT, row * 1024 + g * 16 + q * 4, gelu_tanh(acc[1][x][0]), gelu_tanh(acc[1][x][1]), gelu_tanh(acc[1][x][2]), gelu_tanh(acc[1][x][3])); } }
    }
    __syncthreads();
}

__device__ __forceinline__ float logsigmoidf_(float x) { return fminf(x, 0.f) - __logf(1.0f + __expf(-fabsf(x))); }
__device__ __forceinline__ void mlstm_item(const Frame& F, int tid, int layer, int item) {
    const int vs = item & 3, h = (item >> 2) & 3, b = (item >> 4) & 3, d = item >> 6;
    const int lane = tid & 63, wave = __builtin_amdgcn_readfirstlane(tid >> 6), l15 = lane & 15, q = lane >> 4;
    const int y = wave & 3, p = wave >> 2;
    LAS bf16_t* Qs = (LAS bf16_t*)F.lds;
    LAS bf16_t* Ks = Qs + 64 * 264;
    LAS bf16_t* Kt = Ks + 64 * 264;
    LAS bf16_t* Vt = Kt + 256 * 72;
    LAS bf16_t* Vw = Vt + 64 * 72;
    LAS bf16_t* St = Vw + 64 * 72;
    LAS float* PX = (LAS float*)(St + 64 * 72);
    LAS float* fl = PX + 4 * 4 * 64 * 4;
    LAS float* gsc = fl;
    LAS float* rsum = fl + 384;
    LAS float* qn = fl + 512;
    LAS float* nvec = fl + 576;
    LAS float* wtsl = fl + 832;
    const bf16_t* P = (const bf16_t*)(F.ws + WS_P); const bf16_t* QK = (const bf16_t*)(F.ws + WS_QK);
    bf16_t* HO = (bf16_t*)(F.ws + WS_P);
    if (tid < 256) nvec[tid] = 0.f;
    f32x4 Cst[8];
#pragma unroll
    for (int x = 0; x < 8; ++x) Cst[x] = (f32x4){0.f, 0.f, 0.f, 0.f};
    float m_prev = 0.f;
    u32x4 pq[4], pk[4], pv; float pgi = 0.f, pgf = 0.f;
#define ML_LOAD(jj) do { const int rb_ = b * TB + nat_chunk(d, (jj)) * 64; int tl = tid; asm volatile("" : "+v"(tl));   \
        _Pragma("unroll") for (int i = 0; i < 4; ++i) { const int id = tl + i * NTHR; { const int t = id >> 5, seg = id & 31; const size_t row = (size_t)(rb_ + (d == 0 ? t : 63 - t)); pq[i] = *(const u32x4*)(QK + row * 2048 + h * 256 + seg * 8); } \
            { const int t = id & 63, seg = id >> 6; const size_t row = (size_t)(rb_ + (d == 0 ? t : 63 - t)); pk[i] = *(const u32x4*)(QK + row * 2048 + 1024 + h * 256 + seg * 8); } } \
        { const int t = tl & 63, seg = tl >> 6; const size_t row = (size_t)(rb_ + (d == 0 ? t : 63 - t)); pv = *(const u32x4*)(P + row * PW + PC_V + h * 256 + vs * 64 + seg * 8); } \
        if (wave == 7) { const size_t row = (size_t)(rb_ + (d == 0 ? lane : 63 - lane)); pgi = bf2f(P[row * PW + PC_IG + d * 4 + h]); pgf = bf2f(P[row * PW + PC_FG + d * 4 + h]); } } while (0)
#define ML_STAGE(jj) do { int tl = tid; asm volatile("" : "+v"(tl)); \
        _Pragma("unroll") for (int i = 0; i < 4; ++i) { const int id = tl + i * NTHR; { const int t = id >> 5, seg = id & 31; *(LAS u32x4*)(Qs + t * 264 + seg * 8) = pq[i]; } \
            { const int t = id & 63, seg = id >> 6; *(LAS u32x4*)(Ks + t * 264 + seg * 8) = pk[i]; const unsigned kw[4] = {pk[i].x, pk[i].y, pk[i].z, pk[i].w}; \
              _Pragma("unroll") for (int e = 0; e < 4; ++e) { Kt[(seg * 8 + 2 * e) * 72 + t] = (bf16_t)(kw[e] & 0xffffu); Kt[(seg * 8 + 2 * e + 1) * 72 + t] = (bf16_t)(kw[e] >> 16); } } } \
        { const int t = tl & 63, seg = tl >> 6; const unsigned vw_[4] = {pv.x, pv.y, pv.z, pv.w}; \
            _Pragma("unroll") for (int e = 0; e < 4; ++e) { Vt[(seg * 8 + 2 * e) * 72 + t] = (bf16_t)(vw_[e] & 0xffffu); Vt[(seg * 8 + 2 * e + 1) * 72 + t] = (bf16_t)(vw_[e] >> 16); } } \
        if (wave == 7) { const float igb = F.in[I_MLIGB][layer * 8 + d * 4 + h], fgb = F.in[I_MLFGB][layer * 8 + d * 4 + h];     \
            float bc = logsigmoidf_(pgf + fgb); \
            _Pragma("unroll") for (int o = 1; o < 64; o <<= 1) { const float t = shup(bc, o, lane); if (lane >= o) bc += t; } \
            const float g_ = (pgi + igb) - bc; float pm = g_; \
            _Pragma("unroll") for (int o = 1; o < 64; o <<= 1) { const float t = shup(pm, o, lane); if (lane >= o) pm = fmaxf(pm, t); } \
            LAS float* gs_ = gsc + ((jj) & 1) * 192; gs_[lane] = g_; gs_[64 + lane] = pm; gs_[128 + lane] = bc; } } while (0)
    ML_LOAD(0);
    __syncthreads();
    ML_STAGE(0);
    ML_LOAD(1);
    __syncthreads();
    for (int j = 0; j < NCH; ++j) {
        const int rb = b * TB + nat_chunk(d, j) * 64;
        const LAS float* gg = gsc + (j & 1) * 192; const LAS float* pmx = gg + 64; const LAS float* bcm = gg + 128;
        const float a63 = fmaxf(m_prev, pmx[63]), decay = __expf(m_prev - a63), m_new = bcm[63] + a63;
        { const int tr = wave >> 1; float rp[4] = {0.f, 0.f, 0.f, 0.f};
#pragma unroll
          for (int u = 0; u < 2; ++u) { const int tc = (wave & 1) * 2 + u; f32x4 acc = (f32x4){0.f, 0.f, 0.f, 0.f};
              if (tc <= tr) {
#pragma unroll
                  for (int ks = 0; ks < 8; ++ks) acc = MFMA16(ldsA(Qs + (tr * 16 + l15) * 264 + ks * 32 + q * 8), ldsA(Ks + (tc * 16 + l15) * 264 + ks * 32 + q * 8), acc);
              }
              const int s = tc * 16 + l15; const float gs = gg[s];
#pragma unroll
              for (int i = 0; i < 4; ++i) { const int jr = tr * 16 + q * 4 + i; const float v = (s <= jr) ? acc[i] * __expf(gs - fmaxf(pmx[jr], m_prev)) : 0.f; St[jr * 72 + s] = f2bf(v); rp[i] += v; } }
#pragma unroll
          for (int i = 0; i < 4; ++i) { float s_ = rp[i]; s_ += shx<1>(s_); s_ += shx<2>(s_); s_ += shx<4>(s_); s_ += shx<8>(s_); if (l15 == 0) rsum[(wave & 1) * 64 + tr * 16 + q * 4 + i] = s_; } }
#pragma unroll
        for (int i = 0; i < 8; ++i) { const int id = tid + i * NTHR, dv = id >> 6, s = id & 63; Vw[dv * 72 + s] = f2bf(bf2f(Vt[dv * 72 + s]) * __expf(gg[s] - a63)); }
        if (tid < 64) wtsl[tid] = __expf(gg[tid] - a63);
        { const int row = tid >> 3, part = tid & 7; float qv = 0.f;
#pragma unroll
          for (int e8 = 0; e8 < 4; ++e8) { float x8[8]; unpack8(*(const LAS u32x4*)(Qs + row * 264 + part * 32 + e8 * 8), x8); const f32x4 n0 = *(const LAS f32x4*)(nvec + part * 32 + e8 * 8), n1 = *(const LAS f32x4*)(nvec + part * 32 + e8 * 8 + 4);
              qv += (x8[0] * n0[0] + x8[1] * n0[1]) + (x8[2] * n0[2] + x8[3] * n0[3]) + (x8[4] * n1[0] + x8[5] * n1[1]) + (x8[6] * n1[2] + x8[7] * n1[3]); }
          qv += shx<1>(qv); qv += shx<2>(qv); qv += shx<4>(qv);
          if (part == 0) qn[row] = qv; }
        __syncthreads();
        f32x4 acc[4], PXs[4];
#pragma unroll
        for (int rt = 0; rt < 4; ++rt) PXs[rt] = (f32x4){0.f, 0.f, 0.f, 0.f};
        { bf16x8 Cb[4];
#pragma unroll
          for (int kk = 0; kk < 4; ++kk) Cb[kk] = pack_8(Cst[2 * kk], Cst[2 * kk + 1]);
#pragma unroll
          for (int rt = 0; rt < 4; ++rt) { acc[rt] = (f32x4){0.f, 0.f, 0.f, 0.f};
#pragma unroll
              for (int kk = 0; kk < 4; ++kk) { const LAS bf16_t* qp = Qs + (rt * 16 + l15) * 264 + (p * 8 + 2 * kk) * 16 + q * 4; acc[rt] = MFMA16(lds_2x8(qp, qp + 16), Cb[kk], acc[rt]); } } }
        if (p == 1) {
#pragma unroll
            for (int rt = 0; rt < 4; ++rt) *(LAS f32x4*)(PX + ((y * 4 + rt) * 64 + lane) * 4) = acc[rt];
        } else {
#pragma unroll
            for (int rt = 0; rt < 4; ++rt) { f32x4 a2 = (f32x4){0.f, 0.f, 0.f, 0.f};
#pragma unroll
                for (int ks = 0; ks < 2; ++ks) a2 = MFMA16(ldsA(St + (rt * 16 + l15) * 72 + ks * 32 + q * 8), ldsA(Vt + (y * 16 + l15) * 72 + ks * 32 + q * 8), a2);
                PXs[rt] = a2; }
        }
        { const bf16x8 vw0 = ldsA(Vw + (y * 16 + l15) * 72 + q * 8), vw1 = ldsA(Vw + (y * 16 + l15) * 72 + 32 + q * 8);
          bf16x8 wq0, wq1; { const f32x4 a0 = *(const LAS f32x4*)(wtsl + q * 8), a1 = *(const LAS f32x4*)(wtsl + q * 8 + 4), b0 = *(const LAS f32x4*)(wtsl + 32 + q * 8), b1 = *(const LAS f32x4*)(wtsl + 32 + q * 8 + 4);
              const f32x4 zz = (f32x4){0.f, 0.f, 0.f, 0.f}; wq0 = l15 == 0 ? pack_8(a0, a1) : pack_8(zz, zz); wq1 = l15 == 0 ? pack_8(b0, b1) : pack_8(zz, zz); }
#pragma unroll
          for (int x = 0; x < 8; ++x) { Cst[x] *= decay; const LAS bf16_t* kp = Kt + ((p * 8 + x) * 16 + l15) * 72 + q * 8; const bf16x8 k0 = ldsA(kp), k1 = ldsA(kp + 32);
              Cst[x] = MFMA16(k0, vw0, Cst[x]); Cst[x] = MFMA16(k1, vw1, Cst[x]);
              if (x == 2 * y || x == 2 * y + 1) { const int dkb = (p * 8 + x) * 16 + q * 4; f32x4 nn = (f32x4){0.f, 0.f, 0.f, 0.f};
                  if (l15 == 0) { nn = *(const LAS f32x4*)(nvec + dkb); nn *= decay; }
                  nn = MFMA16(k0, wq0, nn); nn = MFMA16(k1, wq1, nn);
                  if (l15 == 0) *(LAS f32x4*)(nvec + dkb) = nn; } } }
        __syncthreads();
        if (p == 0) {
#pragma unroll
            for (int rt = 0; rt < 4; ++rt) { const f32x4 px = *(const LAS f32x4*)(PX + ((y * 4 + rt) * 64 + lane) * 4);
#pragma unroll
                for (int i = 0; i < 4; ++i) { const int t = rt * 16 + q * 4 + i; const float a_ = fmaxf(pmx[t], m_prev), si = __expf(m_prev - a_);
                    const float hd = fmaxf(fabsf(rsum[t] + rsum[64 + t] + si * qn[t]), __expf(-(bcm[t] + a_)));
                    const float num = (acc[rt][i] + px[i]) * si + PXs[rt][i];
                    const size_t row = (size_t)(rb + (d == 0 ? t : 63 - t));
                    HO[row * PW + d * 1024 + h * 256 + vs * 64 + y * 16 + l15] = f2bf(num * __builtin_amdgcn_rcpf(hd)); } }
        }
        if (j + 1 < NCH) { ML_STAGE(j + 1); if (j + 2 < NCH) ML_LOAD(j + 2); }
        m_prev = m_new;
        __syncthreads();
    }
#undef ML_LOAD
#undef ML_STAGE
}

__device__ __forceinline__ void ml_finish_rows(const Frame& F, int lane, int layer) {
    const bf16_t* P = (const bf16_t*)(F.ws + WS_P); bf16_t* ML = (bf16_t*)(F.ws + WS_SC + SC_ML);
    const float* ng = F.in[I_MLNG] + layer * 1024; const float* nb = F.in[I_MLNB] + layer * 1024;
    const int c0 = lane * 16, stride = F.G * NWAVE;
    for (int r0 = F.bid * NWAVE + F.wave; r0 < R; r0 += 4 * stride) {
        u32x4 ha[4][2], hb[4][2], ho[4][2];
#pragma unroll
        for (int u = 0; u < 4; ++u) { const int r = r0 + u * stride < R ? r0 + u * stride : r0; const bf16_t* pr = P + (size_t)r * PW;
#pragma unroll
            for (int hh = 0; hh < 2; ++hh) { ha[u][hh] = *(const u32x4*)(pr + c0 + hh * 8); hb[u][hh] = *(const u32x4*)(pr + 1024 + c0 + hh * 8); ho[u][hh] = *(const u32x4*)(pr + PC_O + c0 + hh * 8); } }
#pragma unroll
        for (int u = 0; u < 4; ++u) { const int r = r0 + u * stride; if (r < R) {
            float v[16], o[16];
#pragma unroll
            for (int hh = 0; hh < 2; ++hh) { float a8[8], b8[8], o8[8]; unpack8(ha[u][hh], a8); unpack8(hb[u][hh], b8); unpack8(ho[u][hh], o8);
#pragma unroll
                for (int e2 = 0; e2 < 8; ++e2) { v[hh * 8 + e2] = a8[e2] + b8[e2]; o[hh * 8 + e2] = o8[e2]; } }
            float s = 0.f;
#pragma unroll
            for (int e2 = 0; e2 < 16; ++e2) s += v[e2];
            s += shx<1>(s); s += shx<2>(s); s += shx<4>(s); s += shx<8>(s);
            const float mean = s * (1.0f / 256.0f); float qq = 0.f;
#pragma unroll
            for (int e2 = 0; e2 < 16; ++e2) { v[e2] -= mean; qq += v[e2] * v[e2]; }
            qq += shx<1>(qq); qq += shx<2>(qq); qq += shx<4>(qq); qq += shx<8>(qq);
            const float rstd = rsqrtf(qq * (1.0f / 256.0f) + 1e-6f);
            float y8[8];
#pragma unroll
            for (int hh = 0; hh < 2; ++hh) {
#pragma unroll
                for (int e2 = 0; e2 < 8; ++e2) { const int ee = hh * 8 + e2; y8[e2] = (v[ee] * rstd * ng[c0 + ee] + nb[c0 + ee]) * sigmoidf_(o[ee]); }
                st_op8(ML, (size_t)r * 1024 + c0 + hh * 8, y8); } } }
    }
}


__device__ __forceinline__ void tshift8(const bf16_t* P, size_t row, int srow, int col, const float* mu, float (&o)[8]) {
    float z[8], zp[8], zn[8];
    const bool hp = (srow != 0 && srow != CTXL), hn = (srow != CTXL - 1 && srow != TB - 1);
    const u32x4 wz = *(const u32x4*)(P + row * PW + col), wp = *(const u32x4*)(P + (hp ? row - 1 : row) * PW + col), wn = *(const u32x4*)(P + (hn ? row + 1 : row) * PW + col);
    const f32x4 m0 = *(const f32x4*)mu, m1 = *(const f32x4*)(mu + 4);
    unpack8(wz, z); unpack8(wp, zp); unpack8(wn, zn);
    const float fp = hp ? 0.5f : 0.f, fn = hn ? 0.5f : 0.f;
#pragma unroll
    for (int e = 0; e < 8; ++e) { const float m = e < 4 ? m0[e & 3] : m1[e & 3]; o[e] = z[e] + m * (fp * zp[e] + fn * zn[e] - z[e]); }
}
__device__ __forceinline__ void rwkv_item(const Frame& F, int tid, int layer, int item) {
    const int h = item & 15, b = (item >> 4) & 3, d = item >> 6;
    const int lane = tid & 63, wave = __builtin_amdgcn_readfirstlane(tid >> 6), l15 = lane & 15, q = lane >> 4;
    LAS float* r_ = (LAS float*)F.lds;
    LAS float* w_ = r_ + 4096, *kd_ = w_ + 4096, *kk_ = kd_ + 4096, *bb_ = kk_ + 4096, *v_ = bb_ + 4096;
    LAS bf16_t* TW = (LAS bf16_t*)(v_ + 4096);
    LAS bf16_t* TA = TW + 64 * 72;
    LAS bf16_t* WU = TA + 64 * 72;
    LAS bf16_t* AU = WU + 64 * 72;
    LAS float* yout = (LAS float*)TW;
    const bf16_t* P = (const bf16_t*)(F.ws + WS_P);
    bf16_t* YO = (bf16_t*)(F.ws + WS_SC + (d == 0 ? SC_RWF : SC_RWB));
    float* BON = (float*)(F.ws + WS_BONUS) + (size_t)d * R * 16;
    const float* mu = F.in[I_RWMU] + layer * 3456;
    {
        const int rr = tid >> 3, c0 = (tid & 7) * 8;
        const float* wu = F.in[I_RWWUP] + (((size_t)layer * 2 + d) * 64 + rr) * 1024 + h * 64 + c0; const float* au = F.in[I_RWAUP] + (((size_t)layer * 2 + d) * 64 + rr) * 1024 + h * 64 + c0;
#pragma unroll
        for (int e = 0; e < 8; ++e) { WU[(c0 + e) * 72 + rr] = f2bf(wu[e]); AU[(c0 + e) * 72 + rr] = f2bf(au[e]); }
    }
    const int t_ = tid >> 3, c0 = (tid & 7) * 8;
    float mur[8], muk[8], muv[8], muw[8], mua[8], kkc[8], kac[8], rkc[8];
#pragma unroll
    for (int e = 0; e < 8; ++e) { mur[e] = mu[h * 64 + c0 + e]; muk[e] = mu[1024 + h * 64 + c0 + e]; muv[e] = mu[2048 + h * 64 + c0 + e]; muw[e] = mu[3072 + d * 64 + c0 + e]; mua[e] = mu[3200 + d * 64 + c0 + e];
        kkc[e] = F.in[I_RWKK][layer * 1024 + h * 64 + c0 + e]; kac[e] = F.in[I_RWKA][layer * 1024 + h * 64 + c0 + e]; rkc[e] = F.in[I_RWRK][layer * 1024 + h * 64 + c0 + e]; }
    float S[8];
#pragma unroll
    for (int e = 0; e < 8; ++e) S[e] = 0.f;
    const int vrow = tid >> 3, cg = tid & 7;
    __syncthreads();
    for (int j = 0; j < NCH; ++j) {
        const int jn = nat_chunk(d, j); const int srow = jn * 64 + (d == 0 ? t_ : 63 - t_); const size_t row = (size_t)b * TB + srow;
        float rs[8], ks[8], vs[8], tmp[8];
        tshift8(P, row, srow, PC_RR + h * 64 + c0, mur, rs); tshift8(P, row, srow, PC_RK + h * 64 + c0, muk, ks); tshift8(P, row, srow, PC_RV + h * 64 + c0, muv, vs);
        tshift8(P, row, srow, PC_WD + d * 64 + c0, muw, tmp);
#pragma unroll
        for (int e = 0; e < 8; ++e) TW[t_ * 72 + c0 + e] = f2bf(tanhf_(tmp[e]));
        tshift8(P, row, srow, PC_AD + d * 64 + c0, mua, tmp);
#pragma unroll
        for (int e = 0; e < 8; ++e) TA[t_ * 72 + c0 + e] = f2bf(tmp[e]);
        float kkv[8], ss = 0.f;
#pragma unroll
        for (int e = 0; e < 8; ++e) { r_[t_ * 64 + c0 + e] = rs[e]; v_[t_ * 64 + c0 + e] = vs[e]; kkv[e] = ks[e] * kkc[e]; ss += kkv[e] * kkv[e]; }
        ss += shx<1>(ss); ss += shx<2>(ss); ss += shx<4>(ss);
        const float inv = 1.0f / fmaxf(sqrtf(ss), 1e-12f);
        __syncthreads();
        {
            const int tr = wave >> 1;
#pragma unroll
            for (int u = 0; u < 2; ++u) { const int tc = (wave & 1) * 2 + u; f32x4 aw = (f32x4){0.f, 0.f, 0.f, 0.f}, aa = aw;
#pragma unroll
                for (int kq = 0; kq < 2; ++kq) { aw = MFMA16(ldsA(TW + (tr * 16 + l15) * 72 + kq * 32 + q * 8), ldsA(WU + (tc * 16 + l15) * 72 + kq * 32 + q * 8), aw);
                    aa = MFMA16(ldsA(TA + (tr * 16 + l15) * 72 + kq * 32 + q * 8), ldsA(AU + (tc * 16 + l15) * 72 + kq * 32 + q * 8), aa); }
                const int c = tc * 16 + l15; const float w0 = F.in[I_RWW0][((size_t)layer * 2 + d) * 1024 + h * 64 + c], a0 = F.in[I_RWA0][((size_t)layer * 2 + d) * 1024 + h * 64 + c];
#pragma unroll
                for (int i = 0; i < 4; ++i) { const int t = tr * 16 + q * 4 + i; w_[t * 64 + c] = __expf(-0.6065306597126334f * sigmoidf_(w0 + aw[i])); bb_[t * 64 + c] = sigmoidf_(a0 + aa[i]); } }
        }
        __syncthreads();
        { float bon = 0.f;
#pragma unroll
          for (int e = 0; e < 8; ++e) { const float a = bb_[t_ * 64 + c0 + e]; const float kdv = ks[e] * (1.0f + (a - 1.0f) * kac[e]); const float kkn = kkv[e] * inv;
              kd_[t_ * 64 + c0 + e] = kdv; kk_[t_ * 64 + c0 + e] = kkn; bb_[t_ * 64 + c0 + e] = kkn * a; bon += rs[e] * kdv * rkc[e]; }
          bon += shx<1>(bon); bon += shx<2>(bon); bon += shx<4>(bon);
          if ((tid & 7) == 0) BON[row * 16 + h] = bon; }
        __syncthreads();
        for (int t = 0; t < 64; ++t) {
            const LAS f32x4* pk = (const LAS f32x4*)(kk_ + t * 64 + cg * 8); const LAS f32x4* pw = (const LAS f32x4*)(w_ + t * 64 + cg * 8);
            const LAS f32x4* pb = (const LAS f32x4*)(bb_ + t * 64 + cg * 8); const LAS f32x4* pd = (const LAS f32x4*)(kd_ + t * 64 + cg * 8); const LAS f32x4* pr = (const LAS f32x4*)(r_ + t * 64 + cg * 8);
            const f32x4 k0 = pk[0], k1 = pk[1], w0 = pw[0], w1 = pw[1], b0 = pb[0], b1 = pb[1], d0 = pd[0], d1 = pd[1], r0 = pr[0], r1 = pr[1];
            const float vv = v_[t * 64 + vrow];
            float skk = (S[0] * k0[0] + S[1] * k0[1]) + (S[2] * k0[2] + S[3] * k0[3]) + (S[4] * k1[0] + S[5] * k1[1]) + (S[6] * k1[2] + S[7] * k1[3]);
            skk += shx<1>(skk); skk += shx<2>(skk); skk += shx<4>(skk);
#pragma unroll
            for (int e = 0; e < 4; ++e) { S[e] = S[e] * w0[e] - skk * b0[e] + vv * d0[e]; S[4 + e] = S[4 + e] * w1[e] - skk * b1[e] + vv * d1[e]; }
            float y = (S[0] * r0[0] + S[1] * r0[1]) + (S[2] * r0[2] + S[3] * r0[3]) + (S[4] * r1[0] + S[5] * r1[1]) + (S[6] * r1[2] + S[7] * r1[3]);
            y += shx<1>(y); y += shx<2>(y); y += shx<4>(y);
            if (cg == 0) yout[t * 64 + vrow] = y;
        }
        __syncthreads();
        { float yv[8];
#pragma unroll
          for (int e = 0; e < 8; ++e) yv[e] = yout[t_ * 64 + c0 + e];
          u32x4 w; w.x = pk_bf16(yv[0], yv[1]); w.y = pk_bf16(yv[2], yv[3]); w.z = pk_bf16(yv[4], yv[5]); w.w = pk_bf16(yv[6], yv[7]);
          *(u32x4*)(YO + row * 1024 + h * 64 + c0) = w; }
        __syncthreads();
    }
}

#define MFMAF32(a, b, c) __builtin_amdgcn_mfma_f32_16x16x4f32((a), (b), (c), 0, 0, 0)
__device__ __forceinline__ f32x4 mm16(const f32x4 P, const f32x4 Y) {
    f32x4 acc = (f32x4){0.f, 0.f, 0.f, 0.f};
#pragma unroll
    for (int i = 0; i < 4; ++i) acc = MFMAF32(P[i], Y[i], acc);
    return acc;
}
__device__ __forceinline__ bf16x8 pack_lo4(const f32x4 x) { u32x4 w; w.x = pk_bf16(x[0], x[1]); w.y = pk_bf16(x[2], x[3]); w.z = 0u; w.w = 0u; bf16x8 r; __builtin_memcpy(&r, &w, 16); return r; }
__device__ __forceinline__ bf16x8 pack_hi4(const f32x4 x) { u32x4 w; w.x = 0u; w.y = 0u; w.z = pk_bf16(x[0], x[1]); w.w = pk_bf16(x[2], x[3]); bf16x8 r; __builtin_memcpy(&r, &w, 16); return r; }
#define WAVE_SYNC() do { asm volatile("s_waitcnt lgkmcnt(0)" ::: "memory"); __builtin_amdgcn_wave_barrier(); } while (0)
constexpr int RWC_WREG = 15360;
constexpr int RWC_R0 = 0, RWC_R1 = 2304, RWC_R2 = 4608, RWC_R3 = 6912, RWC_BK = 9216, RWC_V = 13312, RWC_NN = RWC_R1, RWC_TM = RWC_R1 + 1024, RWC_GL = RWC_R1 + 1536;
__device__ __forceinline__ void rwkvc_item(const Frame& F, int tid, int layer, int item) {
    const int h = item & 15, b = (item >> 4) & 3, d = item >> 6;
    const int lane = tid & 63, wave = __builtin_amdgcn_readfirstlane(tid >> 6), l15 = lane & 15, q = lane >> 4;
    LAS bf16_t* WU = (LAS bf16_t*)F.lds;
    LAS bf16_t* AU = WU + 64 * 72;
    LAS unsigned char* wreg0 = F.lds + 2 * 64 * 72 * 2;
    LAS unsigned char* wb = wreg0 + wave * RWC_WREG;
    LAS float* MUL = (LAS float*)(wreg0 + 8 * RWC_WREG);
    const bf16_t* P = (const bf16_t*)(F.ws + WS_P);
    bf16_t* YO = (bf16_t*)(F.ws + WS_SC + (d == 0 ? SC_RWF : SC_RWB));
    float* BON = (float*)(F.ws + WS_BONUS) + (size_t)d * R * 16;
    const float* mu = F.in[I_RWMU] + layer * 3456;
    if (tid < 320) { const int a = tid >> 6, c = tid & 63; const int off = a == 0 ? h * 64 : a == 1 ? 1024 + h * 64 : a == 2 ? 2048 + h * 64 : a == 3 ? 3072 + d * 64 : 3200 + d * 64; MUL[tid] = mu[off + c]; }
    {   const int rr = tid >> 3, c0 = (tid & 7) * 8;
        const float* wu = F.in[I_RWWUP] + (((size_t)layer * 2 + d) * 64 + rr) * 1024 + h * 64 + c0; const float* au = F.in[I_RWAUP] + (((size_t)layer * 2 + d) * 64 + rr) * 1024 + h * 64 + c0;
#pragma unroll
        for (int e = 0; e < 8; ++e) { WU[(c0 + e) * 72 + rr] = f2bf(wu[e]); AU[(c0 + e) * 72 + rr] = f2bf(au[e]); } }
    float kkc[4], kac[4], rkc[4], w0c[4], a0c[4];
#pragma unroll
    for (int ct = 0; ct < 4; ++ct) { const int c = h * 64 + ct * 16 + l15; kkc[ct] = F.in[I_RWKK][layer * 1024 + c]; kac[ct] = F.in[I_RWKA][layer * 1024 + c]; rkc[ct] = F.in[I_RWRK][layer * 1024 + c];
        w0c[ct] = F.in[I_RWW0][((size_t)layer * 2 + d) * 1024 + c]; a0c[ct] = F.in[I_RWA0][((size_t)layer * 2 + d) * 1024 + c]; }
    f32x4 Sacc[4];
#pragma unroll
    for (int x = 0; x < 4; ++x) Sacc[x] = (f32x4){0.f, 0.f, 0.f, 0.f};
    __syncthreads();
    for (int rnd = 0; rnd < NCH * 4 / 8; ++rnd) {
        {
            const int ch = rnd * 8 + wave, j64 = ch >> 2, jn = nat_chunk(d, j64), o0 = (ch & 3) * 16;
            LAS bf16_t* R0 = (LAS bf16_t*)(wb + RWC_R0); LAS bf16_t* R1 = (LAS bf16_t*)(wb + RWC_R1); LAS bf16_t* R2 = (LAS bf16_t*)(wb + RWC_R2); LAS bf16_t* R3 = (LAS bf16_t*)(wb + RWC_R3);
            LAS bf16_t* TAp = (LAS bf16_t*)(wb + RWC_BK); LAS bf16_t* BKT = (LAS bf16_t*)(wb + RWC_BK); LAS bf16_t* VF = (LAS bf16_t*)(wb + RWC_V);
            {
                const int t = lane >> 2, cq = (lane & 3) * 16; const int o = o0 + t; const int srow = jn * 64 + (d == 0 ? o : 63 - o); const size_t row = (size_t)b * TB + srow;
                const bool hp = (srow != 0 && srow != CTXL), hn = (srow != CTXL - 1 && srow != TB - 1); const float fp = hp ? 0.5f : 0.f, fn = hn ? 0.5f : 0.f;
                const bf16_t* pz = P + row * PW; const bf16_t* pp = P + (hp ? row - 1 : row) * PW; const bf16_t* pn = P + (hn ? row + 1 : row) * PW;
                const int colA[5] = {PC_RR + h * 64, PC_RK + h * 64, PC_RV + h * 64, PC_WD + d * 64, PC_AD + d * 64};
                u32x4 wz[5][2], wp[5][2], wn[5][2];
#pragma unroll
                for (int a = 0; a < 5; ++a)
#pragma unroll
                    for (int hh = 0; hh < 2; ++hh) { const int c = colA[a] + cq + hh * 8; wz[a][hh] = *(const u32x4*)(pz + c); wp[a][hh] = *(const u32x4*)(pp + c); wn[a][hh] = *(const u32x4*)(pn + c); }
                LAS bf16_t* dst[5] = {R0, R1, R2, R3, TAp};
#pragma unroll
                for (int a = 0; a < 5; ++a)
#pragma unroll
                    for (int hh = 0; hh < 2; ++hh) { const int cc = cq + hh * 8; float z[8], zp[8], zn[8], x8[8];
                        unpack8(wz[a][hh], z); unpack8(wp[a][hh], zp); unpack8(wn[a][hh], zn);
                        const f32x4 m0 = *(const LAS f32x4*)(MUL + a * 64 + cc), m1 = *(const LAS f32x4*)(MUL + a * 64 + cc + 4);
#pragma unroll
                        for (int e = 0; e < 8; ++e) { const float m = e < 4 ? m0[e & 3] : m1[e & 3]; x8[e] = z[e] + m * (fp * zp[e] + fn * zn[e] - z[e]); if (a == 3) x8[e] = tanhf_(x8[e]); }
                        u32x4 w; w.x = pk_bf16(x8[0], x8[1]); w.y = pk_bf16(x8[2], x8[3]); w.z = pk_bf16(x8[4], x8[5]); w.w = pk_bf16(x8[6], x8[7]); *(LAS u32x4*)(dst[a] + t * 72 + cc) = w; }
            }
            WAVE_SYNC();
            f32x4 lw[4], av[4];
            {   const bf16x8 tw0 = ldsA(R3 + l15 * 72 + q * 8), tw1 = ldsA(R3 + l15 * 72 + 32 + q * 8), ta0 = ldsA(TAp + l15 * 72 + q * 8), ta1 = ldsA(TAp + l15 * 72 + 32 + q * 8);
#pragma unroll
                for (int ct = 0; ct < 4; ++ct) { f32x4 aw = (f32x4){0.f, 0.f, 0.f, 0.f}, aa = aw;
                    aw = MFMA16(tw0, ldsA(WU + (ct * 16 + l15) * 72 + q * 8), aw); aw = MFMA16(tw1, ldsA(WU + (ct * 16 + l15) * 72 + 32 + q * 8), aw);
                    aa = MFMA16(ta0, ldsA(AU + (ct * 16 + l15) * 72 + q * 8), aa); aa = MFMA16(ta1, ldsA(AU + (ct * 16 + l15) * 72 + 32 + q * 8), aa);
#pragma unroll
                    for (int i = 0; i < 4; ++i) { lw[ct][i] = -0.6065306597126334f * sigmoidf_(w0c[ct] + aw[i]); av[ct][i] = sigmoidf_(a0c[ct] + aa[i]); } } }
            WAVE_SYNC();
            float ssq[4] = {0.f, 0.f, 0.f, 0.f};
#pragma unroll
            for (int ct = 0; ct < 4; ++ct)
#pragma unroll
                for (int i = 0; i < 4; ++i) { const float kk = bf2f(R1[(q * 4 + i) * 72 + ct * 16 + l15]) * kkc[ct]; ssq[i] += kk * kk; }
            float inv[4];
#pragma unroll
            for (int i = 0; i < 4; ++i) { float s = ssq[i]; s += shx<1>(s); s += shx<2>(s); s += shx<4>(s); s += shx<8>(s); inv[i] = 1.0f / fmaxf(sqrtf(s), 1e-12f); }
            float bon[4] = {0.f, 0.f, 0.f, 0.f};
            bf16x8 Apk[4];
            float glv[4];
#pragma unroll
            for (int ct = 0; ct < 4; ++ct) {
                f32x4 lg; lg[0] = lw[ct][0]; lg[1] = lg[0] + lw[ct][1]; lg[2] = lg[1] + lw[ct][2]; lg[3] = lg[2] + lw[ct][3];
                const float tot = lg[3];
                float x1 = tot; { const float t1 = shup(x1, 16, lane); if (q >= 1) x1 += t1; }
                float x2 = x1;  { const float t2 = shup(x1, 32, lane); if (q >= 2) x2 += t2; }
                const float excl = x2 - tot;
                const float lgL = __int_as_float(__builtin_amdgcn_ds_bpermute((48 + l15) << 2, __float_as_int(x2)));
                f32x4 At, Bh, Kh, vv; const float eex = __expf(excl), egL = __expf(lgL); float egprev = eex;
#pragma unroll
                for (int i = 0; i < 4; ++i) { const int idx = (q * 4 + i) * 72 + ct * 16 + l15; const float lgt = excl + lg[i];
                    const float rs = bf2f(R0[idx]), ks = bf2f(R1[idx]), vs = bf2f(R2[idx]); const float a = av[ct][i];
                    const float kkn = ks * kkc[ct] * inv[i], kd = ks * (1.0f + (a - 1.0f) * kac[ct]), beta = -kkn * a;
                    bon[i] += rs * kd * rkc[ct];
                    const float eg = __expf(lgt), egm = (i == 0) ? eex : egprev, ig = __builtin_amdgcn_rcpf(eg), gl = egL * ig; egprev = eg;
                    At[i] = kkn * egm; R0[idx] = f2bf(At[i]); R3[idx] = f2bf(rs * eg); R1[idx] = f2bf(beta * ig); R2[idx] = f2bf(kd * ig);
                    Bh[i] = beta * gl; Kh[i] = kd * gl; vv[i] = vs; }
                Apk[ct] = pack_lo4(At);
                { u32x2 w; w.x = pk_bf16(Bh[0], Bh[1]); w.y = pk_bf16(Bh[2], Bh[3]); *(LAS u32x2*)(BKT + (ct * 16 + l15) * 32 + q * 4) = w;
                  w.x = pk_bf16(Kh[0], Kh[1]); w.y = pk_bf16(Kh[2], Kh[3]); *(LAS u32x2*)(BKT + (ct * 16 + l15) * 32 + 16 + q * 4) = w;
                  w.x = pk_bf16(vv[0], vv[1]); w.y = pk_bf16(vv[2], vv[3]); *(LAS u32x2*)(VF + (ct * 64 + lane) * 4) = w; }
                glv[ct] = egL;
            }
#pragma unroll
            for (int i = 0; i < 4; ++i) { float s = bon[i]; s += shx<1>(s); s += shx<2>(s); s += shx<4>(s); s += shx<8>(s);
                if (l15 == 0) { const int o = o0 + q * 4 + i; const int srow = jn * 64 + (d == 0 ? o : 63 - o); BON[((size_t)b * TB + srow) * 16 + h] = s; } }
            WAVE_SYNC();
            f32x4 Mab = (f32x4){0.f, 0.f, 0.f, 0.f}, MabT = Mab, Mak = Mab, Nrb = Mab, Nrk = Mab;
#pragma unroll
            for (int kq = 0; kq < 2; ++kq) { const bf16x8 fa = ldsA(R0 + l15 * 72 + kq * 32 + q * 8), fr = ldsA(R3 + l15 * 72 + kq * 32 + q * 8), fb = ldsA(R1 + l15 * 72 + kq * 32 + q * 8), fk = ldsA(R2 + l15 * 72 + kq * 32 + q * 8);
                Mab = MFMA16(fa, fb, Mab); MabT = MFMA16(fb, fa, MabT); Mak = MFMA16(fa, fk, Mak); Nrb = MFMA16(fr, fb, Nrb); Nrk = MFMA16(fr, fk, Nrk); }
#pragma unroll
            for (int i = 0; i < 4; ++i) { const int rr_ = q * 4 + i; if (!(l15 < rr_)) { Mab[i] = 0.f; Mak[i] = 0.f; } if (!(rr_ < l15)) MabT[i] = 0.f; if (!(l15 <= rr_)) { Nrb[i] = 0.f; Nrk[i] = 0.f; } }
            f32x4 TT;
            {   f32x4 eye;
#pragma unroll
                for (int i = 0; i < 4; ++i) eye[i] = (q * 4 + i == l15) ? 1.0f : 0.0f;
                const f32x4 M2 = mm16(MabT, Mab), N2 = mm16(Mab, MabT);
                const f32x4 M4 = mm16(N2, M2), N4 = mm16(M2, N2);
                const f32x4 N8 = mm16(M4, N4);
                const f32x4 W1 = mm16(M4 + eye, N8 + eye);
                const f32x4 W2 = mm16(M2 + eye, W1);
                TT = mm16(Mab + eye, W2); }
            WAVE_SYNC();
            {   const bf16x8 Tp = pack_lo4(TT);
                LAS bf16_t* AH = R0; LAS bf16_t* NN = (LAS bf16_t*)(wb + RWC_NN); LAS bf16_t* TMm = (LAS bf16_t*)(wb + RWC_TM);
#pragma unroll
                for (int ct = 0; ct < 4; ++ct) { f32x4 ah = (f32x4){0.f, 0.f, 0.f, 0.f}; ah = MFMA16(Tp, Apk[ct], ah);
#pragma unroll
                    for (int i = 0; i < 4; ++i) AH[(q * 4 + i) * 72 + ct * 16 + l15] = f2bf(ah[i]); }
                f32x4 tm = (f32x4){0.f, 0.f, 0.f, 0.f}; tm = MFMA16(Tp, pack_lo4(Mak), tm);
#pragma unroll
                for (int i = 0; i < 4; ++i) { const int t = q * 4 + i; NN[t * 32 + l15] = f2bf(Nrb[i]); NN[t * 32 + 16 + l15] = f2bf(Nrk[i]); TMm[t * 16 + l15] = f2bf(tm[i]); }
                if (q == 0) {
#pragma unroll
                    for (int ct = 0; ct < 4; ++ct) ((LAS float*)(wb + RWC_GL))[ct * 16 + l15] = glv[ct]; } }
        }
        __syncthreads();
        if (wave < 4) {
            for (int c = 0; c < 8; ++c) {
                const LAS unsigned char* sb = wreg0 + c * RWC_WREG;
                const LAS bf16_t* AH = (const LAS bf16_t*)(sb + RWC_R0); const LAS bf16_t* RT = (const LAS bf16_t*)(sb + RWC_R3); const LAS bf16_t* BKT = (const LAS bf16_t*)(sb + RWC_BK);
                const LAS bf16_t* VF = (const LAS bf16_t*)(sb + RWC_V); const LAS bf16_t* NN = (const LAS bf16_t*)(sb + RWC_NN); const LAS bf16_t* TMm = (const LAS bf16_t*)(sb + RWC_TM); const LAS float* GL = (const LAS float*)(sb + RWC_GL);
                const bf16x8 Sb0 = pack_8(Sacc[0], Sacc[1]), Sb1 = pack_8(Sacc[2], Sacc[3]);
                const u32x2 vw = *(const LAS u32x2*)(VF + (wave * 64 + lane) * 4);
                bf16x8 V0; { u32x4 w; w.x = 0u; w.y = 0u; w.z = vw.x; w.w = vw.y; __builtin_memcpy(&V0, &w, 16); }
                bf16x8 TMf; { const u32x2 tq = *(const LAS u32x2*)(TMm + l15 * 16 + q * 4); u32x4 w; w.x = 0u; w.y = 0u; w.z = tq.x; w.w = tq.y; __builtin_memcpy(&TMf, &w, 16); }
                f32x4 U = (f32x4){0.f, 0.f, 0.f, 0.f};
                U = MFMA16(lds_2x8(AH + l15 * 72 + q * 4, AH + l15 * 72 + 16 + q * 4), Sb0, U);
                U = MFMA16(lds_2x8(AH + l15 * 72 + 32 + q * 4, AH + l15 * 72 + 48 + q * 4), Sb1, U);
                U = MFMA16(TMf, V0, U);
                bf16x8 UV; { u32x4 w; w.x = pk_bf16(U[0], U[1]); w.y = pk_bf16(U[2], U[3]); w.z = vw.x; w.w = vw.y; __builtin_memcpy(&UV, &w, 16); }
                f32x4 Y = (f32x4){0.f, 0.f, 0.f, 0.f};
                Y = MFMA16(lds_2x8(RT + l15 * 72 + q * 4, RT + l15 * 72 + 16 + q * 4), Sb0, Y);
                Y = MFMA16(lds_2x8(RT + l15 * 72 + 32 + q * 4, RT + l15 * 72 + 48 + q * 4), Sb1, Y);
                Y = MFMA16(lds_2x8(NN + l15 * 32 + q * 4, NN + l15 * 32 + 16 + q * 4), UV, Y);
#pragma unroll
                for (int x = 0; x < 4; ++x) { const f32x4 gl = *(const LAS f32x4*)(GL + x * 16 + q * 4); Sacc[x] *= gl;
                    Sacc[x] = MFMA16(lds_2x8(BKT + (x * 16 + l15) * 32 + q * 4, BKT + (x * 16 + l15) * 32 + 16 + q * 4), UV, Sacc[x]); }
                const int ch = rnd * 8 + c, j64 = ch >> 2, jn = nat_chunk(d, j64), o0 = (ch & 3) * 16;
#pragma unroll
                for (int i = 0; i < 4; ++i) { const int o = o0 + q * 4 + i; const int srow = jn * 64 + (d == 0 ? o : 63 - o);
                    YO[((size_t)b * TB + srow) * 1024 + h * 64 + wave * 16 + l15] = f2bf(Y[i]); }
            }
        }
        __syncthreads();
    }
}

__device__ __forceinline__ void rw_finish_item(const Frame& F, int tid, int layer, int it) {
    const int lane = tid & 63, wave = __builtin_amdgcn_readfirstlane(tid >> 6), l15 = lane & 15, q = lane >> 4;
    constexpr int YP = 1032;
    LAS bf16_t* GA = (LAS bf16_t*)F.lds;
    LAS float* mean_ = (LAS float*)(GA + 32 * 136);
    LAS float* rstd_ = mean_ + 512, *bon_ = rstd_ + 512;
    LAS bf16_t* YS = (LAS bf16_t*)(bon_ + 512);
    LAS bf16_t* VS = YS + 32 * YP;
    const bf16_t* P = (const bf16_t*)(F.ws + WS_P);
    const bf16_t* YF = (const bf16_t*)(F.ws + WS_SC + SC_RWF); const bf16_t* YB = (const bf16_t*)(F.ws + WS_SC + SC_RWB); void* RWO = (void*)(F.ws + WS_SC + SC_RWO);
    const float* BON = (const float*)(F.ws + WS_BONUS); const bf16_t* GUPT = (const bf16_t*)(F.ws + WS_GUPT);
    const float* mu = F.in[I_RWMU] + layer * 3456;
    const int hf = it & 1, it2 = it >> 1;
    const int b = it2 / NCH, jn = it2 - b * NCH; const size_t rb = (size_t)b * TB + jn * 64 + hf * 32; const int sb = jn * 64 + hf * 32;
#pragma unroll
    for (int i = 0; i < 9; ++i) { const int id = tid + i * NTHR; if (id < 34 * 128) { const int r = id >> 7, pc = id & 127; long gr = (long)rb - 1 + r; gr = gr < 0 ? 0 : (gr > R - 1 ? R - 1 : gr);
        *(LAS u32x4*)(VS + r * YP + pc * 8) = *(const u32x4*)(P + (size_t)gr * PW + PC_RV + pc * 8); } }
    if (tid < 256) { const int t = tid >> 3, c0 = (tid & 7) * 16;
#pragma unroll
      for (int hh = 0; hh < 2; ++hh) { float m8[8], g8[8];
#pragma unroll
          for (int e = 0; e < 8; ++e) m8[e] = mu[3328 + c0 + hh * 8 + e];
          tshift8(P, rb + t, sb + t, PC_GD + c0 + hh * 8, m8, g8);
#pragma unroll
          for (int e = 0; e < 8; ++e) GA[t * 136 + c0 + hh * 8 + e] = f2bf(sigmoidf_(g8[e])); } }
    { const int p = tid, t = p >> 4, hd = p & 15; const size_t row = rb + t; float v[64]; float s = 0.f;
#pragma unroll
        for (int c8 = 0; c8 < 8; ++c8) { float a[8], bq[8]; unpack8(*(const u32x4*)(YF + row * 1024 + hd * 64 + c8 * 8), a); unpack8(*(const u32x4*)(YB + row * 1024 + hd * 64 + c8 * 8), bq);
#pragma unroll
            for (int e = 0; e < 8; ++e) { v[c8 * 8 + e] = a[e] + bq[e]; s += v[c8 * 8 + e]; } }
        const float mean = s * (1.0f / 64.0f); float qq = 0.f;
#pragma unroll
        for (int e = 0; e < 64; ++e) { const float dlt = v[e] - mean; qq += dlt * dlt; }
        mean_[t * 16 + hd] = mean; rstd_[t * 16 + hd] = rsqrtf(qq * (1.0f / 64.0f) + 64e-5f);
        bon_[t * 16 + hd] = BON[row * 16 + hd] + BON[((size_t)R + row) * 16 + hd];
#pragma unroll
        for (int c8 = 0; c8 < 8; ++c8) { u32x4 w; w.x = pk_bf16(v[c8 * 8], v[c8 * 8 + 1]); w.y = pk_bf16(v[c8 * 8 + 2], v[c8 * 8 + 3]); w.z = pk_bf16(v[c8 * 8 + 4], v[c8 * 8 + 5]); w.w = pk_bf16(v[c8 * 8 + 6], v[c8 * 8 + 7]);
            *(LAS u32x4*)(YS + t * YP + hd * 64 + c8 * 8) = w; } }
    __syncthreads();
    const float* ng = F.in[I_RWNG] + layer * 1024; const float* nb = F.in[I_RWNB] + layer * 1024;
    float fpv[2], fnv[2];
#pragma unroll
    for (int rt = 0; rt < 2; ++rt) { const int srow = sb + rt * 16 + l15; const bool hp = (srow != 0 && srow != CTXL), hn = (srow != CTXL - 1 && srow != TB - 1); fpv[rt] = hp ? 0.5f : 0.f; fnv[rt] = hn ? 0.5f : 0.f; }
    bf16x8 afr[4]; f32x4 muv, ngc, nbc;
#define RWF_LOAD(cc_, AFR, MUV, NGC, NBC) do { const int ct_ = wave * 8 + (cc_); const int c0_ = ct_ * 16 + q * 4; \
        _Pragma("unroll") for (int kq = 0; kq < 4; ++kq) AFR[kq] = *(const bf16x8*)(GUPT + (size_t)(ct_ * 16 + l15) * 128 + kq * 32 + q * 8); \
        MUV = *(const f32x4*)(mu + 2048 + c0_); NGC = *(const f32x4*)(ng + c0_); NBC = *(const f32x4*)(nb + c0_); } while (0)
    RWF_LOAD(0, afr, muv, ngc, nbc);
#pragma unroll
    for (int cc = 0; cc < 8; ++cc) { const int ct = wave * 8 + cc; const int c0 = ct * 16 + q * 4, hd = c0 >> 6;
        bf16x8 afr2[4]; f32x4 muv2, ngc2, nbc2;
        if (cc + 1 < 8) RWF_LOAD(cc + 1, afr2, muv2, ngc2, nbc2);
#pragma unroll
        for (int rt = 0; rt < 2; ++rt) { f32x4 acc = (f32x4){0.f, 0.f, 0.f, 0.f};
#pragma unroll
            for (int kq = 0; kq < 4; ++kq) acc = MFMA16(afr[kq], ldsA(GA + (rt * 16 + l15) * 136 + kq * 32 + q * 8), acc);
            const int t = rt * 16 + l15; const size_t row = rb + t;
            const float fp = fpv[rt], fn = fnv[rt]; const float mean = mean_[t * 16 + hd], rstd = rstd_[t * 16 + hd], bon = bon_[t * 16 + hd];
            const u32x2 wy = *(const LAS u32x2*)(YS + t * YP + c0), wz = *(const LAS u32x2*)(VS + (t + 1) * YP + c0), wp = *(const LAS u32x2*)(VS + t * YP + c0), wn = *(const LAS u32x2*)(VS + (t + 2) * YP + c0);
            float o4[4];
#pragma unroll
            for (int i = 0; i < 4; ++i) { const unsigned sf = 16u;
                const unsigned uy = (i < 2 ? wy.x : wy.y), uz = (i < 2 ? wz.x : wz.y), up = (i < 2 ? wp.x : wp.y), un = (i < 2 ? wn.x : wn.y);
                const float ys = (i & 1) ? __uint_as_float(uy & 0xffff0000u) : __uint_as_float(uy << sf);
                const float vz = (i & 1) ? __uint_as_float(uz & 0xffff0000u) : __uint_as_float(uz << sf), vp = (i & 1) ? __uint_as_float(up & 0xffff0000u) : __uint_as_float(up << sf), vn = (i & 1) ? __uint_as_float(un & 0xffff0000u) : __uint_as_float(un << sf);
                const float yn = (ys - mean) * rstd * ngc[i] + nbc[i];
                const float vsft = vz + muv[i] * (fp * vp + fn * vn - vz);
                o4[i] = (yn + bon * vsft) * acc[i]; }
            st_op4(RWO, row * 1024 + c0, o4[0], o4[1], o4[2], o4[3]); }
        if (cc + 1 < 8) {
#pragma unroll
            for (int kq = 0; kq < 4; ++kq) afr[kq] = afr2[kq];
            muv = muv2; ngc = ngc2; nbc = nbc2; }
    }
#undef RWF_LOAD
    __syncthreads();
}

__device__ __forceinline__ void phase_prep(const Frame& F, int layer) {
    const int tid = ltid();
    for (int it = F.bid; it < 64; it += F.G) s5_tables_item(F, tid, layer, it);
}
__device__ __forceinline__ void phase_gin(const Frame& F) {
    dense_gemm<0, false>(F, F.ws + WS_U, F.ws + WS_WIN, R, PW, 2048, F.ws + WS_P, nullptr, nullptr, PW);
}
__device__ __forceinline__ void phase_conv_s5a(const Frame& F, int layer) {
    const int tid = ltid(), lane = tid & 63;
    for (int it = F.bid; it < 528 + 144; it += F.G) { if (it < 528) conv_item(F, tid, layer, it); else s5a_wave_item(F, lane, (it - 528) * 8 + F.wave); }
}
__device__ __forceinline__ void phase_scan(const Frame& F, int layer) {
    const int tid = ltid();
    if (F.bid < 128) rwkvc_item(F, tid, layer, F.bid);
    else { if (F.bid < 192) { s5b_item(F, tid, layer, F.bid - 128); __syncthreads(); } mlstm_item(F, tid, layer, F.bid - 128); }
}
__device__ __forceinline__ void phase_fin(const Frame& F, int layer) {
    const int tid = ltid(), lane = tid & 63;
    for (int it = F.bid; it < 1056; it += F.G) rw_finish_item(F, tid, layer, it);
    for (int it = F.bid; it < 256; it += F.G) s5c_block_item(F, tid, it);
    ml_finish_rows(F, lane, layer);
}

#ifndef MK_ABL
#define MK_ABL 0
#endif
constexpr int NPH_LAYER = 19;
constexpr int NPH = 2 * NPH_LAYER;
__global__ void __launch_bounds__(NTHR, 2) mega_fwd(Args args) {
    extern __shared__ __attribute__((aligned(16))) unsigned char lds_raw[];
    Frame F; F.in = args.in; F.out = args.out; F.ws = args.ws; F.lds = (LAS unsigned char*)lds_raw;
    F.wave = __builtin_amdgcn_readfirstlane(threadIdx.x >> 6); F.G = gridDim.x; F.bid = blockIdx.x;
    volatile LAS unsigned* xbw = (volatile LAS unsigned*)(F.lds + LDS_BYTES - 16);
    if (threadIdx.x == 0) { xbw[0] = 0u; xbw[1] = 0u; xbw[2] = 0u; xbw[3] = 0u; }
    __syncthreads();
    const int lo = args.ph_lo, hi = args.ph_hi;
    const bool one_launch = (hi - lo) > 1;
    XcdBarrier bar; bar.bar = (unsigned*)(F.ws + WS_CTL) + CW_BAR; bar.x = 0; bar.st = xbw;
    if (one_launch) bar = xcd_barrier_post((unsigned*)(F.ws + WS_CTL) + CW_BAR, xbw);
#define IN(k) (lo <= (k) && (k) < hi)
#define SEAM(k) do { if (IN(k) && IN((k) + 1)) xcd_barrier(bar); } while (0)
#define TILE_SEAM() do { asm volatile("s_waitcnt vmcnt(0)" ::: "memory"); __syncthreads(); } while (0)
    bf16_t* const T1 = (bf16_t*)(F.ws + WS_T1); bf16_t* const T2 = (bf16_t*)(F.ws + WS_T2); bf16_t* const T1b = (bf16_t*)(F.ws + WS_SC + SC_RWF);     bf16_t* const Z = (bf16_t*)(F.ws + WS_Z); bf16_t* const MIX = (bf16_t*)(F.ws + WS_MIX);
    unsigned char* const Zop = F8 ? F.ws + WS_QK : F.ws + WS_Z;
    const unsigned char* const U = F.ws + WS_U; const unsigned char* const WG = F.ws + WS_WG; const unsigned char* const WML = F.ws + WS_WML;
    const unsigned char* const ML = F.ws + WS_SC + SC_ML; const unsigned char* const RWo = F.ws + WS_SC + SC_RWO; const unsigned char* const S5o = F.ws + WS_SC + SC_S5;
    for (int layer = 0; layer < 2; ++layer) {
        const int pb = layer * NPH_LAYER;
        const int rA = 0, rB = layer == 0 ? 32 : 0, rC = layer == 0 ? 64 : 0;
        if (IN(pb + 0)) { phase_prep(F, layer); if (layer == 0) phase_mods(F); phase_wprep(F, layer); }
        SEAM(pb + 0);
        if (IN(pb + 1)) { if (layer == 0) phase_ln1(F, layer); }
        if (layer == 0) SEAM(pb + 1);
        if (IN(pb + 2)) { phase_gin(F); }
        SEAM(pb + 2);
        if (IN(pb + 3)) { phase_conv_s5a(F, layer); }
        SEAM(pb + 3);
        if (IN(pb + 4)) { phase_scan(F, layer); }
        SEAM(pb + 4);
        if (IN(pb + 5)) { phase_fin(F, layer); }
        SEAM(pb + 5);
        if (IN(pb + 6)) { dense_gemm<0, false>(F, ML, WML, R, 2048, 1024, T1, nullptr, nullptr, 2048, layer == 1, rA); }
        TILE_SEAM();
        if (IN(pb + 8)) { dense_gemm<0, false>(F, RWo, WML + (size_t)1 * 2048 * 1024 * OPB, R, 2048, 1024, T1b, nullptr, nullptr, 2048, layer == 1, rB); }
        SEAM(pb + 8);
        if (IN(pb + 9)) { dense_gemm<6, false>(F, U, WG, R, 4096, 2048, Z, T1, T1b, 2048, layer == 1); }
        TILE_SEAM();
        if (IN(pb + 10)) { dense_gemm<5, false>(F, S5o, WML + (size_t)2 * 2048 * 1024 * OPB, R, 4096, 1024, T2, nullptr, nullptr, 2048, layer == 1); }
        SEAM(pb + 10);
        if (IN(pb + 12)) { dense_gemm<2, true>(F, U, WG + (size_t)4096 * 2048 * OPB, R, 2048, 2048, Zop, T2, Z, 2048, layer == 1, rC); }
        SEAM(pb + 12);
        if (IN(pb + 13)) { dense_gemm<0, false>(F, Zop, F.ws + WS_WOUT, R, 2048, 2048, MIX, nullptr, nullptr, 2048, layer == 1); }
        SEAM(pb + 13);
        if (IN(pb + 14)) { phase_post1_route(F, layer, true); }
        SEAM(pb + 14);
        if (IN(pb + 15)) { phase_gather(F, layer); }
        SEAM(pb + 15);
        if (IN(pb + 16)) { phase_moe_gemm(F, layer, 0); }
        SEAM(pb + 16);
        if (IN(pb + 17)) { phase_moe_gemm(F, layer, 1); }
        SEAM(pb + 17);
        if (IN(pb + 18)) { phase_post2_moe(F, layer, true); }
        SEAM(pb + 18);
    }
#undef IN
#undef SEAM
#undef TILE_SEAM
}

#ifndef MK_ONE_LAUNCH
#define MK_ONE_LAUNCH 1
#endif
extern "C" void kernel_launch(void* const* d_in, const int* in_sizes, int n_in, void* d_out, int out_size, void* d_ws, size_t ws_size, hipStream_t stream) {
    static int grid = 0;
    if (grid == 0) {
        if (n_in != N_IN || ws_size < WS_END) { fprintf(stderr, "kernel_launch: unexpected n_in %d / ws_size %zu (need %zu)\n", n_in, ws_size, (size_t)WS_END); grid = -1; return; }
        int dev = 0, cus = 0, per_cu = 0;
        if (hipGetDevice(&dev) != hipSuccess || hipDeviceGetAttribute(&cus, hipDeviceAttributeMultiprocessorCount, dev) != hipSuccess) { grid = -1; return; }
        if (hipFuncSetAttribute((const void*)mega_fwd, hipFuncAttributeMaxDynamicSharedMemorySize, LDS_BYTES) != hipSuccess) { fprintf(stderr, "kernel_launch: hipFuncSetAttribute failed\n"); grid = -1; return; }
        if (hipOccupancyMaxActiveBlocksPerMultiprocessor(&per_cu, (const void*)mega_fwd, NTHR, LDS_BYTES) != hipSuccess || per_cu < 1) { fprintf(stderr, "kernel_launch: occupancy query says %d\n", per_cu); }
        (void)hipGetLastError();
        grid = 256;
        if (cus != 256) fprintf(stderr, "kernel_launch: %d CUs, this kernel is laid out for 256\n", cus);
    }
    if (grid < 0) return;
    (void)hipMemsetAsync((char*)d_ws + WS_CTL, 0, CTL_BYTES, stream);
    Args a{};
    for (int i = 0; i < N_IN; ++i) a.in[i] = (const float*)d_in[i];
    a.out = (float*)d_out; a.ws = (unsigned char*)d_ws;
#if MK_ONE_LAUNCH
    a.ph_lo = 0; a.ph_hi = NPH;
    hipLaunchKernelGGL(mega_fwd, dim3(grid), dim3(NTHR), LDS_BYTES, stream, a);
#else
    for (int p = 0; p < NPH; ++p) { a.ph_lo = p; a.ph_hi = p + 1; hipLaunchKernelGGL(mega_fwd, dim3(grid), dim3(NTHR), LDS_BYTES, stream, a); }
#endif
}
```

```cpp
#include <hip/hip_runtime.h>
#include <stdint.h>
#include <stdio.h>

#define LAS __attribute__((address_space(3)))
typedef unsigned short bf16_t;
typedef short bf16x8 __attribute__((ext_vector_type(8)));
typedef float f32x4 __attribute__((ext_vector_type(4)));
typedef float f32x2 __attribute__((ext_vector_type(2)));
typedef unsigned u32x4 __attribute__((ext_vector_type(4)));
typedef unsigned u32x2 __attribute__((ext_vector_type(2)));

constexpr int D = 2048, NB = 4, SEQ = 8192, CTXL = 256, TB = SEQ + CTXL, R = NB * TB;
constexpr int NCH = TB / 64;
constexpr int PW = 8704;
constexpr int PC_Q = 0, PC_K = 1024, PC_V = 2048, PC_O = 3072, PC_IG = 4096, PC_FG = 4104, PC_RR = 4112, PC_RK = 5136, PC_RV = 6160,
              PC_WD = 7184, PC_AD = 7312, PC_GD = 7440, PC_S5 = 7568, PC_END = 8592;
constexpr int NTHR = 512, NWAVE = 8;
constexpr int LDS_BYTES = 163840;
constexpr float ALPHA = 1.4142135623730951f;
constexpr float LN_EPS = 1e-5f;

enum { I_X = 0, I_C, I_CTX, I_CCTX, I_ADAW, I_ADAB, I_WIN, I_MLCW, I_MLCB, I_MLIGB, I_MLFGB, I_MLNG, I_MLNB, I_MLPROJ, I_RWMU, I_RWW0, I_RWWUP, I_RWA0, I_RWAUP,
       I_RWGUP, I_RWKK, I_RWKA, I_RWRK, I_RWNG, I_RWNB, I_RWPROJ, I_S5LRE, I_S5LIM, I_S5LDT, I_S5BRE, I_S5BIM, I_S5CRE, I_S5CIM, I_S5D, I_S5WV, I_S5WG, I_WOUT,
       I_LN1G, I_LN1B, I_LN2G, I_LN2B, I_ROUTW, I_ROUTB, I_EWG, I_EWU, I_EWD, N_IN };

constexpr size_t al256(size_t x) { return (x + 255) & ~(size_t)255; }
constexpr size_t WS_CTL = 0, CTL_BYTES = 65536;
constexpr size_t WS_MODS = WS_CTL + CTL_BYTES;
constexpr size_t WS_ROUTE = al256(WS_MODS + 2 * 5 * 12288 * 4);
constexpr size_t WS_BONUS = al256(WS_ROUTE + (size_t)R * 8 * 4);
constexpr size_t WS_S5KC = al256(WS_BONUS + (size_t)2 * R * 16 * 4);
constexpr size_t WS_S5E = al256(WS_S5KC + (size_t)64 * 128 * 256 * 2);
constexpr size_t WS_S5F = al256(WS_S5E + (size_t)64 * 256 * 1024 * 2);
constexpr size_t WS_S5X = al256(WS_S5F + (size_t)64 * 1024 * 256 * 2);
constexpr size_t WS_GUPT = al256(WS_S5X + (size_t)64 * 528 * 256 * 4);
constexpr size_t WS_WIN = al256(WS_GUPT + (size_t)1024 * 128 * 2);
constexpr size_t WS_WG = al256(WS_WIN + (size_t)PW * D * 2);
constexpr size_t WS_WML = al256(WS_WG + (size_t)6144 * D * 2);
constexpr size_t WS_WOUT = al256(WS_WML + (size_t)4 * 2048 * 1024 * 2);
constexpr size_t WS_EGU = al256(WS_WOUT + (size_t)2048 * 2048 * 2);
constexpr size_t WS_EDN = al256(WS_EGU + (size_t)16 * 2048 * 2048 * 2);
constexpr size_t WS_P = al256(WS_EDN + (size_t)16 * 2048 * 1024 * 2);
constexpr size_t WS_U = al256(WS_P + (size_t)R * PW * 2);
constexpr size_t WS_QK = al256(WS_U + (size_t)R * D * 2);
constexpr size_t WS_SC = al256(WS_QK + (size_t)R * D * 2);
constexpr size_t SC_BYTES = (size_t)71680 * 2048 * 2;
constexpr size_t WS_XC = al256(WS_SC + SC_BYTES);
constexpr size_t WS_END = al256(WS_XC + (size_t)NB * CTXL * D * 4);
constexpr size_t WS_X1 = WS_P;
constexpr size_t WS_T1 = WS_P;
constexpr size_t WS_T2 = WS_P + (size_t)R * D * 2;
constexpr size_t WS_MIX = WS_P + (size_t)R * D * 4;
constexpr size_t WS_Z = WS_MIX + (size_t)R * D * 2;
static_assert(WS_Z + (size_t)R * D * 2 <= WS_U, "P-region aliases overflow");
static_assert(WS_END <= 1633652928ull, "workspace too large");

constexpr int CW_BAR = 0;
constexpr int CW_ECNT = 4096;

__device__ __forceinline__ float bf2f(bf16_t b) { return __uint_as_float(((unsigned)b) << 16); }
typedef __bf16 bf16x2_t __attribute__((ext_vector_type(2)));
__device__ __forceinline__ unsigned pk_bf16(float lo, float hi) { const f32x2 v = {lo, hi}; const bf16x2_t r = __builtin_convertvector(v, bf16x2_t); unsigned u; __builtin_memcpy(&u, &r, 4); return u; }
constexpr bool F8 = true;
constexpr int OPB = F8 ? 1 : 2;
constexpr float W8_SCALE = 64.0f;
typedef int v8i __attribute__((ext_vector_type(8)));
typedef int v4i __attribute__((ext_vector_type(4)));
__device__ __forceinline__ float clamp8(float x) { return fminf(fmaxf(x, -448.0f), 448.0f); }
__device__ __forceinline__ unsigned pk4_fp8(float a, float b, float c, float d) { int w = 0; w = __builtin_amdgcn_cvt_pk_fp8_f32(clamp8(a), clamp8(b), w, false); w = __builtin_amdgcn_cvt_pk_fp8_f32(clamp8(c), clamp8(d), w, true); return (unsigned)w; }
__device__ __forceinline__ bf16_t f2bf(float f) { return (bf16_t)(pk_bf16(f, 0.f) & 0xffffu); }
__device__ __forceinline__ float sigmoidf_(float x) { return __builtin_amdgcn_rcpf(1.0f + __expf(-x)); }
__device__ __forceinline__ float tanhf_(float x) { return 1.0f - 2.0f * __builtin_amdgcn_rcpf(1.0f + __expf(2.0f * x)); }
__device__ __forceinline__ void unpack8(const u32x4 p, float (&o)[8]) { const unsigned w[4] = {p.x, p.y, p.z, p.w};
#pragma unroll
    for (int e = 0; e < 4; ++e) { o[2 * e] = __uint_as_float(w[e] << 16); o[2 * e + 1] = __uint_as_float(w[e] & 0xffff0000u); } }
__device__ __forceinline__ void st_op4(void* base, size_t ei, float a, float b, float c, float d) {
    if (F8) *(unsigned*)((char*)base + ei) = pk4_fp8(a, b, c, d);
    else { u32x2 w; w.x = pk_bf16(a, b); w.y = pk_bf16(c, d); *(u32x2*)((char*)base + ei * 2) = w; } }
__device__ __forceinline__ void st_op8(void* base, size_t ei, const float (&v)[8]) {
    if (F8) { u32x2 w; w.x = pk4_fp8(v[0], v[1], v[2], v[3]); w.y = pk4_fp8(v[4], v[5], v[6], v[7]); *(u32x2*)((char*)base + ei) = w; }
    else { u32x4 w; w.x = pk_bf16(v[0], v[1]); w.y = pk_bf16(v[2], v[3]); w.z = pk_bf16(v[4], v[5]); w.w = pk_bf16(v[6], v[7]); *(u32x4*)((char*)base + ei * 2) = w; } }
__device__ __forceinline__ void st_op1(void* base, size_t ei, float a) {
    if (F8) ((unsigned char*)base)[ei] = (unsigned char)(pk4_fp8(a, 0.f, 0.f, 0.f) & 0xffu);
    else ((bf16_t*)base)[ei] = f2bf(a); }
__device__ __forceinline__ float siluf_(float x) { return x * sigmoidf_(x); }
template <int M> __device__ __forceinline__ float shx(float v) { return __int_as_float(__builtin_amdgcn_ds_swizzle(__float_as_int(v), 0x1f | (M << 10))); }
__device__ __forceinline__ float shx32(float v, int lane) { return __int_as_float(__builtin_amdgcn_ds_bpermute((lane ^ 32) << 2, __float_as_int(v))); }
__device__ __forceinline__ float shup(float v, int o, int lane) { return __int_as_float(__builtin_amdgcn_ds_bpermute((lane - o) << 2, __float_as_int(v))); }
__device__ __forceinline__ float rdlane(float v, int l) { return __int_as_float(__builtin_amdgcn_readlane(__float_as_int(v), l)); }
__device__ __forceinline__ float wave_sum(float v, int lane) {
    v += shx32(v, lane); v += shx<16>(v); v += shx<8>(v); v += shx<4>(v); v += shx<2>(v); v += shx<1>(v);
    return v;
}

#define XB_TMO      128
#define XB_XCNT(j)  (256  + 64 * (j))
#define XB_XSUB(j)  (1280 + 64 * (j))
#define XB_XGEN(j)  (2304 + 64 * (j))
#define XB_TOP      3328
#define XB_TOPGEN   3392
#define XCD_BAR_WORDS 3456
#define XB_SPIN_CAP (1u << 18)
__device__ __forceinline__ unsigned xb_ld(unsigned* p)              { return __hip_atomic_load(p, __ATOMIC_RELAXED, __HIP_MEMORY_SCOPE_AGENT); }
__device__ __forceinline__ unsigned xb_add(unsigned* p, unsigned v) { return __hip_atomic_fetch_add(p, v, __ATOMIC_RELAXED, __HIP_MEMORY_SCOPE_AGENT); }
__device__ __forceinline__ unsigned xb_xcc_id() { return (unsigned)__builtin_amdgcn_s_getreg((3 << 11) | 20) & 0xFu; }
#define XB_SPIN(cond, bar) do { unsigned _sp = 0; while (cond) { __builtin_amdgcn_s_sleep(1); \
    if ((++_sp & 255u) == 0u) { if (xb_ld(&(bar)[XB_TMO])) break; if (_sp > XB_SPIN_CAP) { atomicAdd(&(bar)[XB_TMO], 1u); break; } } } } while (0)
struct XcdBarrier { unsigned* bar; unsigned x; volatile LAS unsigned* st; };
__device__ __forceinline__ XcdBarrier xcd_barrier_post(unsigned* bar, volatile LAS unsigned* st) {
    XcdBarrier b; b.bar = bar; b.x = xb_xcc_id(); b.st = st;
    if (threadIdx.x == 0) (void)xb_add(&bar[XB_XCNT(b.x)], 1u);
    return b;
}
__device__ __forceinline__ void xcd_barrier_complete(unsigned* bar, unsigned x, unsigned& nloc, unsigned& nx) {
    const unsigned G = gridDim.x * gridDim.y * gridDim.z;
    unsigned sum, cnt, mine, sp = 0u;
    for (;;) {
        sum = 0u; cnt = 0u; mine = 0u;
#pragma unroll
        for (unsigned j = 0; j < 16; ++j) { const unsigned c = xb_ld(&bar[XB_XCNT(j)]); sum += c; cnt += (c > 0u) ? 1u : 0u; mine = (j == x) ? c : mine; }
        if (sum == G) break;
        __builtin_amdgcn_s_sleep(1);
        if ((++sp & 255u) == 0u) { if (xb_ld(&bar[XB_TMO])) break; if (sp > XB_SPIN_CAP) { atomicAdd(&bar[XB_TMO], 1u); break; } }
    }
    nloc = mine > 0u ? mine : 1u; nx = cnt > 0u ? cnt : 1u;
}
__device__ __forceinline__ void xcd_barrier(const XcdBarrier& b) {
    asm volatile("s_waitcnt vmcnt(0)" ::: "memory");
    __syncthreads();
    if (threadIdx.x == 0) {
        unsigned* bar = b.bar;
        __builtin_amdgcn_s_waitcnt(0);
        unsigned nloc = b.st[0], nx = b.st[1];
        if (nloc == 0u) { xcd_barrier_complete(bar, b.x, nloc, nx); b.st[0] = nloc; b.st[1] = nx; }
        const unsigned old = xb_add(&bar[XB_XSUB(b.x)], 1u);
        const unsigned gen = old / nloc;
        if (old + 1u == (gen + 1u) * nloc) {
            __builtin_amdgcn_fence(__ATOMIC_RELEASE, "agent");
            asm volatile("s_waitcnt vmcnt(0)" ::: "memory");
            const unsigned og = xb_add(&bar[XB_TOP], 1u);
            const unsigned tg = og / nx;
            if (og + 1u == (tg + 1u) * nx) xb_add(&bar[XB_TOPGEN], 1u);
            else XB_SPIN(xb_ld(&bar[XB_TOPGEN]) == tg, bar);
            __builtin_amdgcn_fence(__ATOMIC_ACQUIRE, "agent");
            xb_add(&bar[XB_XGEN(b.x)], 1u);
            asm volatile("s_waitcnt vmcnt(0)" ::: "memory");
        } else {
            XB_SPIN(xb_ld(&bar[XB_XGEN(b.x)]) == gen, bar);
            __builtin_amdgcn_fence(__ATOMIC_ACQUIRE, "agent");
            asm volatile("s_waitcnt vmcnt(0)" ::: "memory");
        }
    }
    __syncthreads();
}

struct Args { const float* in[N_IN]; float* out; unsigned char* ws; int ph_lo, ph_hi; };
struct Frame {
    const float* const* in; float* out; unsigned char* ws; LAS unsigned char* lds;
    int wave, G, bid;
};
__device__ __forceinline__ int ltid_(int wave) { int l; asm volatile("v_mbcnt_lo_u32_b32 %0, -1, 0\n\tv_mbcnt_hi_u32_b32 %0, -1, %0" : "=v"(l)); return wave * 64 + l; }
#define ltid() ltid_(F.wave)

__device__ __forceinline__ const float* xin_row(const Frame& F, int layer, int r) {
    const int b = r / TB, s = r - b * TB;
    if (s < CTXL) return (layer == 0 ? F.in[I_CTX] : (const float*)(F.ws + WS_XC)) + ((size_t)b * CTXL + s) * D;
    return (layer == 0 ? F.in[I_X] : (const float*)F.out) + ((size_t)b * SEQ + (s - CTXL)) * D;
}
__device__ __forceinline__ float* xout_row(const Frame& F, int r) {
    const int b = r / TB, s = r - b * TB;
    if (s < CTXL) return (float*)(F.ws + WS_XC) + ((size_t)b * CTXL + s) * D;
    return F.out + ((size_t)b * SEQ + (s - CTXL)) * D;
}

__device__ __forceinline__ void phase_mods(const Frame& F) {
    const int tid = ltid(), lane = tid & 63; (void)lane;
    LAS float* sc = (LAS float*)F.lds;
    LAS float* red = (LAS float*)(F.lds + 5 * 2048 * 4);
    float* mods = (float*)(F.ws + WS_MODS);
    for (int i = tid; i < 5 * 2048; i += NTHR) { const int r = i >> 11, k = i & 2047; const float v = r < 4 ? F.in[I_C][r * 2048 + k] : F.in[I_CCTX][k]; sc[i] = siluf_(v); }
    __syncthreads();
    for (int it = F.bid; it < 2 * 96; it += F.G) {
        const int l = it / 96, cg = it - l * 96, c4 = (tid & 31) * 4, ks = tid >> 5;
        const float* w = F.in[I_ADAW] + (size_t)l * 2048 * 12288 + cg * 128 + c4;
        f32x4 a0 = (f32x4){0.f, 0.f, 0.f, 0.f}, a1 = a0, a2 = a0, a3 = a0, a4 = a0;
#pragma unroll 8
        for (int k = ks; k < 2048; k += 16) { const f32x4 wv = *(const f32x4*)(w + (size_t)k * 12288); a0 += sc[k] * wv; a1 += sc[2048 + k] * wv; a2 += sc[4096 + k] * wv; a3 += sc[6144 + k] * wv; a4 += sc[8192 + k] * wv; }
        *(LAS f32x4*)(red + (ks * 5 + 0) * 128 + c4) = a0; *(LAS f32x4*)(red + (ks * 5 + 1) * 128 + c4) = a1; *(LAS f32x4*)(red + (ks * 5 + 2) * 128 + c4) = a2;
        *(LAS f32x4*)(red + (ks * 5 + 3) * 128 + c4) = a3; *(LAS f32x4*)(red + (ks * 5 + 4) * 128 + c4) = a4;
        __syncthreads();
        for (int i = tid; i < 5 * 128; i += NTHR) { const int r = i >> 7, cc = i & 127; float s = 0.f;
#pragma unroll
            for (int s16 = 0; s16 < 16; ++s16) s += red[(s16 * 5 + r) * 128 + cc];
            mods[((size_t)l * 5 + r) * 12288 + cg * 128 + cc] = s + F.in[I_ADAB][l * 12288 + cg * 128 + cc]; }
        __syncthreads();
    }
}

__device__ __forceinline__ void phase_ln1(const Frame& F, int layer) {
    const int tid = ltid(), lane = tid & 63; (void)lane;
    const float* mods = (const float*)(F.ws + WS_MODS) + (size_t)layer * 5 * 12288;
    bf16_t* U = (bf16_t*)(F.ws + WS_U);
    const int stride = F.G * NWAVE; f32x4 xq[8];
    { const float* x = xin_row(F, layer, F.bid * NWAVE + F.wave);
#pragma unroll
      for (int i = 0; i < 8; ++i) xq[i] = *(const f32x4*)(x + (i * 64 + lane) * 4); }
    for (int r = F.bid * NWAVE + F.wave; r < R; r += stride) {
        const int b = r / TB, s = r - b * TB; const float* md = mods + (size_t)(s < CTXL ? 4 : b) * 12288;
        f32x4 v[8]; float sum = 0.f;
#pragma unroll
        for (int i = 0; i < 8; ++i) { v[i] = xq[i]; sum += (v[i][0] + v[i][1]) + (v[i][2] + v[i][3]); }
        { const float* xn = xin_row(F, layer, r + stride < R ? r + stride : r);
#pragma unroll
          for (int i = 0; i < 8; ++i) xq[i] = *(const f32x4*)(xn + (i * 64 + lane) * 4); }
        const float mean = wave_sum(sum, lane) * (1.0f / D); float q = 0.f;
#pragma unroll
        for (int i = 0; i < 8; ++i) { v[i] -= mean; q += (v[i][0] * v[i][0] + v[i][1] * v[i][1]) + (v[i][2] * v[i][2] + v[i][3] * v[i][3]); }
        const float rstd = rsqrtf(wave_sum(q, lane) * (1.0f / D) + LN_EPS);
#pragma unroll
        for (int i = 0; i < 8; ++i) { const int e = (i * 64 + lane) * 4; const f32x4 sh = *(const f32x4*)(md + e), scl = *(const f32x4*)(md + 2048 + e);
            const f32x4 u = v[i] * rstd * (scl + 1.0f) + sh; st_op4(U, (size_t)r * D + e, u[0], u[1], u[2], u[3]); }
    }
}

namespace pg8 {
constexpr int BM = 256, BK = 64, HALF = 128, HTB = HALF * BK * 2, STAGE_BYTES = 8 * HTB, NXCD = 8, WGM = 8;
__host__ __device__ __forceinline__ int lds_byte(int r, int c) { const int st = (r >> 4) * 2 + (c >> 5), rr = r & 15, cc = c & 31, ob = rr * 64 + cc * 2; return st * 1024 + (ob ^ (((ob >> 9) & 1) << 5)); }
__host__ __device__ __forceinline__ void stage_rc(int b, int& Rr, int& C) { const int st = b / 1024, sb = b % 1024, swz = sb ^ (((sb >> 9) & 1) << 5); Rr = (st >> 1) * 16 + swz / 64; C = (st & 1) * 32 + (swz % 64) / 2; }
__host__ __device__ __forceinline__ int perm32(int rho) { const int n = rho >> 4, i = rho & 15; return 8 * (i >> 2) + 4 * n + (i & 3); }
struct Unit { int pm, pn; };
struct Gemm { const bf16_t* A; const bf16_t* Bt; int lda, ldb, K; };
struct StaticOrder {
    int nM, nN, nwg, G, c, skipctx;
    __device__ void init(int M, int N, int G_, int c_, int skipctx_ = 0) { nM = M / BM; nN = N / BM; nwg = nM * nN; G = G_; c = c_; skipctx = skipctx_; }
    __device__ bool next(int i, Unit& u) const {
        const long L = (long)i * G + c; if (L >= nwg) return false;
        int wgid = (int)L; { const int q = nwg / NXCD, r = nwg % NXCD, xcd = wgid % NXCD, off = wgid / NXCD; wgid = (xcd < r ? xcd * (q + 1) : r * (q + 1) + (xcd - r) * q) + off; }
        const int nig = WGM * nN, gid = wgid / nig, fm = gid * WGM, gsz = (nM - fm) < WGM ? (nM - fm) : WGM;
        u.pm = fm + ((wgid % nig) % gsz); u.pn = (wgid % nig) / gsz;
        if (skipctx) u.pm += (u.pm >> 5) + 1;
        return true;
    }
};
struct GroupedOrder {
    const LAS int* ts; int nN, G, c;
    __device__ bool next(int i, Unit& u) const {
        const int L = i * G + c; const int tot = __builtin_amdgcn_readfirstlane(ts[16]) * nN; if (L >= tot) return false;
        const int pm = L / nN, pl = L - pm * nN; int e = 0;
#pragma unroll 1
        for (int j = 1; j < 16; ++j) e += (pm >= ts[j]) ? 1 : 0;
        u.pm = __builtin_amdgcn_readfirstlane(pm); u.pn = __builtin_amdgcn_readfirstlane(e * nN + pl); return true;
    }
};
__device__ __forceinline__ unsigned cvt_pk_bf16(float lo, float hi) { return pk_bf16(lo, hi); }
__device__ __forceinline__ float fsig(float x) { return __builtin_amdgcn_rcpf(1.0f + __expf(-x)); }
constexpr float Y8_SCALE = 8.0f;
template <int MODE, bool O8> struct Epi {
    static constexpr bool PERM = true; static constexpr float ASC = F8 ? 1.0f / W8_SCALE : 1.0f;
    void* O; const bf16_t* X; const bf16_t* Zin; int ldc; int pn_mod;
    __device__ __forceinline__ void put8(size_t ei, const float (&h)[8]) const {
        if (O8) st_op8(O, ei, h);
        else { u32x4 w; w.x = cvt_pk_bf16(h[0], h[1]); w.y = cvt_pk_bf16(h[2], h[3]); w.z = cvt_pk_bf16(h[4], h[5]); w.w = cvt_pk_bf16(h[6], h[7]); *(u32x4*)((bf16_t*)O + ei) = w; } }
    __device__ __forceinline__ void operator()(const f32x4 (&acc)[2][2][4][2], const Unit& u, int wr, int wc, int fr, int fq) const {
        const int row0 = u.pm * BM + wr * 64 + fr; const int pnl = u.pn % pn_mod;
        if (MODE == 4 || MODE == 5 || MODE == 6) {
            const int col0 = pnl * HALF + wc * 32 + 8 * fq;
            u32x4 xw6[2][4], zw6[2][4];
            if (MODE == 6) {
#pragma unroll
                for (int ai = 0; ai < 2; ++ai)
#pragma unroll
                    for (int m = 0; m < 4; ++m) { const size_t ei = (size_t)(row0 + ai * HALF + m * 16) * ldc + col0; xw6[ai][m] = *(const u32x4*)(X + ei); zw6[ai][m] = *(const u32x4*)(Zin + ei); }
            }
#pragma unroll
            for (int ai = 0; ai < 2; ++ai)
#pragma unroll
                for (int m = 0; m < 4; ++m) { const size_t ei = (size_t)(row0 + ai * HALF + m * 16) * ldc + col0;
                    const f32x4 g0 = acc[ai][0][m][0], g1 = acc[ai][0][m][1], u0 = acc[ai][1][m][0], u1 = acc[ai][1][m][1]; float h[8];
                    float xa[8], xb[8]; if (MODE == 6) { unpack8(xw6[ai][m], xa); unpack8(zw6[ai][m], xb); }
#pragma unroll
                    for (int j = 0; j < 4; ++j) { const float ga = g0[j] * ASC, gb = g1[j] * ASC;
                        if (MODE == 4) { h[j] = ga * fsig(ga) * (u0[j] * ASC); h[4 + j] = gb * fsig(gb) * (u1[j] * ASC); }
                        else if (MODE == 5) { h[j] = ga * fsig(u0[j] * ASC); h[4 + j] = gb * fsig(u1[j] * ASC); }
                        else { h[j] = fsig(ga) * xa[j] + fsig(u0[j] * ASC) * xb[j]; h[4 + j] = fsig(gb) * xa[4 + j] + fsig(u1[j] * ASC) * xb[4 + j]; } }
                    put8(ei, h); }
        } else {
            const int col0 = pnl * BM + wc * 32 + 8 * fq;
#pragma unroll
            for (int ai = 0; ai < 2; ++ai)
#pragma unroll
              for (int mh = 0; mh < 2; ++mh) {
                u32x4 xw[2][2], zw[2][2];
                if (MODE == 1 || MODE == 2) {
#pragma unroll
                    for (int m2 = 0; m2 < 2; ++m2)
#pragma unroll
                        for (int bj = 0; bj < 2; ++bj) { const size_t ro = (size_t)(row0 + ai * HALF + (mh * 2 + m2) * 16) * ldc + col0 + bj * HALF;
                            xw[m2][bj] = *(const u32x4*)(X + ro); if (MODE == 2) zw[m2][bj] = *(const u32x4*)(Zin + ro); }
                }
#pragma unroll
                for (int m2 = 0; m2 < 2; ++m2) { const int m = mh * 2 + m2; const size_t ro = (size_t)(row0 + ai * HALF + m * 16) * ldc + col0;
#pragma unroll
                    for (int bj = 0; bj < 2; ++bj) { const f32x4 v0 = acc[ai][bj][m][0], v1 = acc[ai][bj][m][1]; float h[8];
#pragma unroll
                        for (int j = 0; j < 4; ++j) { h[j] = v0[j] * (MODE == 7 ? ASC * Y8_SCALE : ASC); h[4 + j] = v1[j] * (MODE == 7 ? ASC * Y8_SCALE : ASC); }
                        if (MODE == 1 || MODE == 2) { float x8[8]; unpack8(xw[m2][bj], x8);
#pragma unroll
                            for (int j = 0; j < 8; ++j) h[j] = fsig(h[j]) * x8[j];
                            if (MODE == 2) { float z8[8]; unpack8(zw[m2][bj], z8);
#pragma unroll
                                for (int j = 0; j < 8; ++j) h[j] += z8[j]; } }
                        put8(ro + bj * HALF, h); } }
              }
        }
    }
};

template <class EpiT, class Sched>
__device__ __forceinline__ void gemm_phase(LAS unsigned char* lds, const Gemm g, const Sched& S, const EpiT& E, int wave_id) {
    const int tid = ltid_(wave_id), wid = __builtin_amdgcn_readfirstlane(tid >> 6), lane = tid & 63, wr = wid >> 2, wc = wid & 3, fr = lane & 15, fq = lane >> 4;
    const int K = g.K, nt = K / BK;
    unsigned voffA[2], voffB[2];
#pragma unroll
    for (int i = 0; i < 2; ++i) { int Rr, C; stage_rc(tid * 16 + i * 8192, Rr, C); const int Rb = EpiT::PERM ? ((Rr & ~31) + perm32(Rr & 31)) : Rr;
        voffA[i] = (unsigned)(Rr * g.lda + C) * 2u; voffB[i] = (unsigned)(Rb * g.ldb + C) * 2u; }
    const size_t kstep = (size_t)(BK * 2);
    const size_t hstepA = (size_t)HALF * g.lda * 2, hstepB = (size_t)HALF * g.ldb * 2;
    const size_t tstepA = 2 * hstepA, tstepB = 2 * hstepB;
    const unsigned ldsw = (unsigned)wid * 1024u;
    const int aoff = lds_byte(wr * 64 + fr, fq * 8), boff = lds_byte(wc * 32 + fr, fq * 8);
#define PG8_SA(b, h) (((b) * 2 + (h)) * HTB)
#define PG8_SB(b, h) ((4 + (b) * 2 + (h)) * HTB)
#define PG8_STAGE(bufoff, gbase, voff) do { _Pragma("unroll") for (int _i = 0; _i < 2; ++_i) \
        __builtin_amdgcn_global_load_lds((const unsigned*)((const char*)(gbase) + (voff)[_i]), (LAS unsigned*)(lds + (bufoff) + ldsw + _i * 8192), 16, 0, 0); } while (0)
#define PG8_LD8(dst, addr) do { const v4i lo_ = *(const LAS v4i*)(addr), hi_ = *(const LAS v4i*)((addr) + 1024); dst = __builtin_shufflevector(lo_, hi_, 0, 1, 2, 3, 4, 5, 6, 7); } while (0)
#define PG8_LDA(dst, b, h) do { _Pragma("unroll") for (int m = 0; m < 4; ++m) PG8_LD8(dst[m], lds + PG8_SA(b, h) + aoff + m * 2048); } while (0)
#define PG8_LDB(dst, b, h) do { _Pragma("unroll") for (int n = 0; n < 2; ++n) PG8_LD8(dst[n], lds + PG8_SB(b, h) + boff + n * 2048); } while (0)
#define PG8_HALF(v, k) __builtin_bit_cast(bf16x8, __builtin_shufflevector(v, v, 4 * (k), 4 * (k) + 1, 4 * (k) + 2, 4 * (k) + 3))
#define PG8_MMA(ai, bj, At, Bt) do { __builtin_amdgcn_s_setprio(1); _Pragma("unroll") for (int m = 0; m < 4; ++m) _Pragma("unroll") for (int n = 0; n < 2; ++n) { \
        if (F8) asm volatile("v_mfma_f32_16x16x128_f8f6f4 %0, %1, %2, %0" : "+v"(acc[ai][bj][m][n]) : "v"(Bt[n]), "v"(At[m]));     \
        else { acc[ai][bj][m][n] = __builtin_amdgcn_mfma_f32_16x16x32_bf16(PG8_HALF(Bt[n], 0), PG8_HALF(At[m], 0), acc[ai][bj][m][n], 0, 0, 0); \
               acc[ai][bj][m][n] = __builtin_amdgcn_mfma_f32_16x16x32_bf16(PG8_HALF(Bt[n], 1), PG8_HALF(At[m], 1), acc[ai][bj][m][n], 0, 0, 0); } } \
        __builtin_amdgcn_s_setprio(0); } while (0)
#define PG8_WAIT_V(n) asm volatile("s_waitcnt vmcnt(" #n ")" ::: "memory")
#define PG8_WAIT_L(n) asm volatile("s_waitcnt lgkmcnt(" #n ")" ::: "memory")
#define PG8_BAR __builtin_amdgcn_s_barrier()
#define PG8_SCHED __builtin_amdgcn_sched_barrier(0)
    Unit cur, nxt; int ui = 0;
    if (!S.next(0, cur)) return;
    f32x4 acc[2][2][4][2];
#pragma unroll
    for (int a = 0; a < 2; ++a)
#pragma unroll
        for (int b = 0; b < 2; ++b)
#pragma unroll
            for (int m = 0; m < 4; ++m)
#pragma unroll
                for (int n = 0; n < 2; ++n) acc[a][b][m][n] = (f32x4){0.f, 0.f, 0.f, 0.f};
    v8i At[4], B0[2], B1[2];
    const char* cA = (const char*)g.A + (size_t)cur.pm * tstepA; const char* cB = (const char*)g.Bt + (size_t)cur.pn * tstepB;
    PG8_STAGE(PG8_SB(0, 0), cB, voffB); PG8_STAGE(PG8_SA(0, 0), cA, voffA); PG8_STAGE(PG8_SB(0, 1), cB + hstepB, voffB); PG8_STAGE(PG8_SA(0, 1), cA + hstepA, voffA);
    if (wr == 1) PG8_BAR;
    PG8_WAIT_V(4); PG8_BAR;
    PG8_STAGE(PG8_SB(1, 0), cB + kstep, voffB); PG8_STAGE(PG8_SA(1, 0), cA + kstep, voffA); PG8_STAGE(PG8_SB(1, 1), cB + hstepB + kstep, voffB);
    PG8_WAIT_V(6); PG8_BAR;
    for (;;) {
        const bool has_next = S.next(ui + 1, nxt);
        const char* nA = has_next ? (const char*)g.A + (size_t)nxt.pm * tstepA : cA; const char* nB = has_next ? (const char*)g.Bt + (size_t)nxt.pn * tstepB : cB;
        for (int t = 0; t < nt; t += 2) {
            const bool last = (t == nt - 2);
            const char* a1 = cA + (size_t)(t + 1) * kstep;
            const char* a2 = last ? nA : cA + (size_t)(t + 2) * kstep; const char* b2 = last ? nB : cB + (size_t)(t + 2) * kstep;
            const char* a3 = a2 + kstep; const char* b3 = b2 + kstep;
            PG8_LDB(B0, 0, 0); PG8_SCHED; PG8_LDA(At, 0, 0); PG8_STAGE(PG8_SA(1, 1), a1 + hstepA, voffA);
            PG8_WAIT_L(8); PG8_BAR; PG8_WAIT_L(0); PG8_MMA(0, 0, At, B0); PG8_BAR; PG8_SCHED;
            PG8_LDB(B1, 0, 1); PG8_STAGE(PG8_SB(0, 0), b2, voffB);
            PG8_BAR; PG8_WAIT_L(0); PG8_MMA(0, 1, At, B1); PG8_BAR;
            PG8_LDA(At, 0, 1); PG8_STAGE(PG8_SA(0, 0), a2, voffA);
            PG8_BAR; PG8_WAIT_L(0); PG8_MMA(1, 0, At, B0); PG8_BAR; PG8_SCHED;
            PG8_STAGE(PG8_SB(0, 1), b2 + hstepB, voffB);
            PG8_WAIT_V(6); PG8_BAR; PG8_MMA(1, 1, At, B1); PG8_BAR;
            PG8_LDB(B0, 1, 0); PG8_SCHED; PG8_LDA(At, 1, 0); PG8_STAGE(PG8_SA(0, 1), a2 + hstepA, voffA);
            PG8_WAIT_L(8); PG8_BAR; PG8_WAIT_L(0); PG8_MMA(0, 0, At, B0); PG8_BAR; PG8_SCHED;
            PG8_LDB(B1, 1, 1); PG8_STAGE(PG8_SB(1, 0), b3, voffB);
            PG8_BAR; PG8_WAIT_L(0); PG8_MMA(0, 1, At, B1); PG8_BAR;
            PG8_LDA(At, 1, 1); PG8_STAGE(PG8_SA(1, 0), a3, voffA);
            PG8_BAR; PG8_WAIT_L(0); PG8_MMA(1, 0, At, B0); PG8_BAR; PG8_SCHED;
            PG8_STAGE(PG8_SB(1, 1), b3 + hstepB, voffB);
            PG8_WAIT_V(6); PG8_BAR; PG8_MMA(1, 1, At, B1); PG8_BAR;
        }
        if (F8) { __builtin_amdgcn_sched_barrier(0); asm volatile("s_nop 15\n\ts_nop 15" ::: "memory"); __builtin_amdgcn_sched_barrier(0); }
        E(acc, cur, wr, wc, fr, fq);
        if (!has_next) break;
#pragma unroll
        for (int a = 0; a < 2; ++a)
#pragma unroll
            for (int b = 0; b < 2; ++b)
#pragma unroll
                for (int m = 0; m < 4; ++m)
#pragma unroll
                    for (int n = 0; n < 2; ++n) acc[a][b][m][n] = (f32x4){0.f, 0.f, 0.f, 0.f};
        cur = nxt; cA = nA; cB = nB; ++ui;
    }
    PG8_WAIT_V(0);
    if (wr == 0) PG8_BAR;
    PG8_BAR;
#undef PG8_SA
#undef PG8_SB
#undef PG8_STAGE
#undef PG8_LDA
#undef PG8_LD8
#undef PG8_HALF
#undef PG8_LDB
#undef PG8_MMA
#undef PG8_WAIT_V
#undef PG8_WAIT_L
#undef PG8_BAR
#undef PG8_SCHED
}
}

template <int MODE, bool O8>
__device__ __forceinline__ void dense_gemm(const Frame& F, const void* A, const void* Bt, int M, int N, int K, void* O, const bf16_t* X, const bf16_t* Zin, int ldc, int skipctx = 0, int rot = 0) {
    pg8::Gemm g{(const bf16_t*)A, (const bf16_t*)Bt, K * OPB / 2, K * OPB / 2, K * OPB / 2}; pg8::StaticOrder S; S.init(skipctx ? NB * SEQ : M, N, F.G, (F.bid + rot) % F.G, skipctx);
    pg8::Epi<MODE, O8> E{O, X, Zin, ldc, 1 << 30};
    pg8::gemm_phase<pg8::Epi<MODE, O8>, pg8::StaticOrder>(F.lds, g, S, E, F.wave);
}

struct TJob { const float* src; bf16_t* dst; size_t src_bstride; int src_pitch, K, Nvalid, Npad, dst_pitch, blk, blk_stride, row_off, nbatch, dst_brow; bool f8; };
constexpr int N_TJOBS = 13;
__device__ __forceinline__ TJob get_tjob(const Frame& F, int layer, int j) {
    TJob t; t.src_bstride = 0; t.blk = 1 << 30; t.blk_stride = 0; t.row_off = 0; t.nbatch = 1; t.dst_brow = 0; t.f8 = F8 && (j != 10);
    unsigned char* ws = F.ws;
    switch (j) {
    case 0: t.src = F.in[I_WIN] + (size_t)layer * 2048 * 14736; t.src_pitch = 14736; t.K = 2048; t.Nvalid = PC_END; t.Npad = PW; t.dst = (bf16_t*)(ws + WS_WIN); t.dst_pitch = 2048; break;
    case 1: t.src = F.in[I_WIN] + (size_t)layer * 2048 * 14736 + PC_END; t.src_pitch = 14736; t.K = 2048; t.Nvalid = 2048; t.Npad = 2048; t.dst = (bf16_t*)(ws + WS_WG); t.dst_pitch = 2048; t.blk = 128; t.blk_stride = 256; t.row_off = 0; break;
    case 11: t.src = F.in[I_WIN] + (size_t)layer * 2048 * 14736 + PC_END + 2048; t.src_pitch = 14736; t.K = 2048; t.Nvalid = 2048; t.Npad = 2048; t.dst = (bf16_t*)(ws + WS_WG); t.dst_pitch = 2048; t.blk = 128; t.blk_stride = 256; t.row_off = 128; break;
    case 12: t.src = F.in[I_WIN] + (size_t)layer * 2048 * 14736 + PC_END + 4096; t.src_pitch = 14736; t.K = 2048; t.Nvalid = 2048; t.Npad = 2048; t.dst = (bf16_t*)(ws + WS_WG + (size_t)4096 * 2048 * OPB); t.dst_pitch = 2048; break;
    case 2: t.src = F.in[I_MLPROJ] + (size_t)layer * 1024 * 2048; t.src_pitch = 2048; t.K = 1024; t.Nvalid = 2048; t.Npad = 2048; t.dst = (bf16_t*)(ws + WS_WML); t.dst_pitch = 1024; break;
    case 3: t.src = F.in[I_RWPROJ] + (size_t)layer * 1024 * 2048; t.src_pitch = 2048; t.K = 1024; t.Nvalid = 2048; t.Npad = 2048; t.dst = (bf16_t*)(ws + WS_WML + (size_t)1 * 2048 * 1024 * OPB); t.dst_pitch = 1024; break;
    case 4: t.src = F.in[I_S5WV] + (size_t)layer * 1024 * 2048; t.src_pitch = 2048; t.K = 1024; t.Nvalid = 2048; t.Npad = 2048; t.dst = (bf16_t*)(ws + WS_WML + (size_t)2 * 2048 * 1024 * OPB); t.dst_pitch = 1024; t.blk = 128; t.blk_stride = 256; t.row_off = 0; break;
    case 5: t.src = F.in[I_S5WG] + (size_t)layer * 1024 * 2048; t.src_pitch = 2048; t.K = 1024; t.Nvalid = 2048; t.Npad = 2048; t.dst = (bf16_t*)(ws + WS_WML + (size_t)2 * 2048 * 1024 * OPB); t.dst_pitch = 1024; t.blk = 128; t.blk_stride = 256; t.row_off = 128; break;
    case 6: t.src = F.in[I_WOUT] + (size_t)layer * 2048 * 2048; t.src_pitch = 2048; t.K = 2048; t.Nvalid = 2048; t.Npad = 2048; t.dst = (bf16_t*)(ws + WS_WOUT); t.dst_pitch = 2048; break;
    case 7: t.src = F.in[I_EWG] + (size_t)layer * 16 * 2048 * 1024; t.src_bstride = (size_t)2048 * 1024; t.src_pitch = 1024; t.K = 2048; t.Nvalid = 1024; t.Npad = 1024; t.dst = (bf16_t*)(ws + WS_EGU); t.dst_pitch = 2048;
            t.blk = 128; t.blk_stride = 256; t.row_off = 0; t.nbatch = 16; t.dst_brow = 2048; break;
    case 8: t.src = F.in[I_EWU] + (size_t)layer * 16 * 2048 * 1024; t.src_bstride = (size_t)2048 * 1024; t.src_pitch = 1024; t.K = 2048; t.Nvalid = 1024; t.Npad = 1024; t.dst = (bf16_t*)(ws + WS_EGU); t.dst_pitch = 2048;
            t.blk = 128; t.blk_stride = 256; t.row_off = 128; t.nbatch = 16; t.dst_brow = 2048; break;
    case 9: t.src = F.in[I_EWD] + (size_t)layer * 16 * 1024 * 2048; t.src_bstride = (size_t)1024 * 2048; t.src_pitch = 2048; t.K = 1024; t.Nvalid = 2048; t.Npad = 2048; t.dst = (bf16_t*)(ws + WS_EDN); t.dst_pitch = 1024;
            t.nbatch = 16; t.dst_brow = 2048; break;
    default: t.src = F.in[I_RWGUP] + (size_t)layer * 128 * 1024; t.src_pitch = 1024; t.K = 128; t.Nvalid = 1024; t.Npad = 1024; t.dst = (bf16_t*)(ws + WS_GUPT); t.dst_pitch = 128; break;
    }
    return t;
}
__device__ __forceinline__ int tjob_tiles(const TJob& t) { return t.nbatch * (t.Npad / 64) * (t.K / (t.f8 ? 128 : 64)); }
__device__ __forceinline__ void transpose_tile(LAS float* T, int lane, const TJob& t, int tile) {
    const int nkt = t.K / 64, nnt = t.Npad / 64;
    const int b = tile / (nnt * nkt), rem = tile - b * nnt * nkt, ktile = rem / nnt, ntile = rem - ktile * nnt;
    const int n0 = ntile * 64, k0 = ktile * 64;
    const float* src = t.src + (size_t)b * t.src_bstride;
    f32x4 v[16];
#pragma unroll
    for (int p = 0; p < 16; ++p) { const int kk = p * 4 + (lane >> 4), nn = (lane & 15) * 4;
        v[p] = (f32x4){0.f, 0.f, 0.f, 0.f};
        if (n0 + nn < t.Nvalid) v[p] = *(const f32x4*)(src + (size_t)(k0 + kk) * t.src_pitch + n0 + nn); }
#pragma unroll
    for (int p = 0; p < 16; ++p) { const int kk = p * 4 + (lane >> 4), nn = (lane & 15) * 4; T[kk * 65 + nn] = v[p][0]; T[kk * 65 + nn + 1] = v[p][1]; T[kk * 65 + nn + 2] = v[p][2]; T[kk * 65 + nn + 3] = v[p][3]; }
    asm volatile("s_waitcnt lgkmcnt(0)" ::: "memory"); __builtin_amdgcn_wave_barrier();
#pragma unroll
    for (int ps = 0; ps < 8; ++ps) { const int n = ps * 8 + (lane >> 3), kq = (lane & 7) * 8; float x[8];
#pragma unroll
        for (int j = 0; j < 8; ++j) x[j] = T[(kq + j) * 65 + n];
        const int ng = n0 + n; const int drow = b * t.dst_brow + (ng / t.blk) * t.blk_stride + (ng % t.blk) + t.row_off;
        if (t.f8) { u32x2 w; w.x = pk4_fp8(x[0] * W8_SCALE, x[1] * W8_SCALE, x[2] * W8_SCALE, x[3] * W8_SCALE); w.y = pk4_fp8(x[4] * W8_SCALE, x[5] * W8_SCALE, x[6] * W8_SCALE, x[7] * W8_SCALE);
            *(u32x2*)((char*)t.dst + (size_t)drow * t.dst_pitch + k0 + kq) = w; }
        else { u32x4 w; w.x = pk_bf16(x[0], x[1]); w.y = pk_bf16(x[2], x[3]); w.z = pk_bf16(x[4], x[5]); w.w = pk_bf16(x[6], x[7]);
            *(u32x4*)(t.dst + (size_t)drow * t.dst_pitch + k0 + kq) = w; } }
    asm volatile("s_waitcnt lgkmcnt(0)" ::: "memory"); __builtin_amdgcn_wave_barrier();
}
__device__ __forceinline__ void transpose_tile8(LAS unsigned* T8, int lane, const TJob& t, int tile) {
    const int nkt = t.K / 128, nnt = t.Npad / 64;
    const int b = tile / (nnt * nkt), rem = tile - b * nnt * nkt, ktile = rem / nnt, ntile = rem - ktile * nnt;
    const int n0 = ntile * 64, k0 = ktile * 128;
    const float* src = t.src + (size_t)b * t.src_bstride;
    const int nn = (lane & 15) * 4, kq = lane >> 4;
    f32x4 v[32];
#pragma unroll
    for (int p = 0; p < 32; ++p) { const int kk = (p >> 2) * 16 + kq * 4 + (p & 3);
        v[p] = (f32x4){0.f, 0.f, 0.f, 0.f};
        if (n0 + nn < t.Nvalid) v[p] = *(const f32x4*)(src + (size_t)(k0 + kk) * t.src_pitch + n0 + nn); }
#pragma unroll
    for (int g = 0; g < 8; ++g)
#pragma unroll
        for (int j = 0; j < 4; ++j)
            T8[(nn + j) * 36 + g * 4 + kq] = pk4_fp8(v[4 * g][j] * W8_SCALE, v[4 * g + 1][j] * W8_SCALE, v[4 * g + 2][j] * W8_SCALE, v[4 * g + 3][j] * W8_SCALE);
    asm volatile("s_waitcnt lgkmcnt(0)" ::: "memory"); __builtin_amdgcn_wave_barrier();
#pragma unroll
    for (int ps = 0; ps < 8; ++ps) { const int n = ps * 8 + (lane >> 3), pc = lane & 7;
        const u32x4 w = *(const LAS u32x4*)(T8 + n * 36 + pc * 4);
        const int ng = n0 + n; const int drow = b * t.dst_brow + (ng / t.blk) * t.blk_stride + (ng % t.blk) + t.row_off;
        *(u32x4*)((char*)t.dst + (size_t)drow * t.dst_pitch + k0 + pc * 16) = w; }
    asm volatile("s_waitcnt lgkmcnt(0)" ::: "memory"); __builtin_amdgcn_wave_barrier();
}
__device__ __forceinline__ void phase_wprep(const Frame& F, int layer) {
    const int tid = ltid(), lane = tid & 63; (void)lane;
    LAS float* T = (LAS float*)F.lds + F.wave * (64 * 65);
    const int gw = F.bid * NWAVE + F.wave, nw = F.G * NWAVE;
    int base = 0;
#pragma unroll
    for (int j = 0; j < N_TJOBS; ++j) {
        const TJob t = get_tjob(F, layer, j); const int nt = tjob_tiles(t);
        const int first = (gw - (base % nw) + nw) % nw;
        for (int tile = first; tile < nt; tile += nw) { if (t.f8) transpose_tile8((LAS unsigned*)T, lane, t, tile); else transpose_tile(T, lane, t, tile); }
        base += nt;
    }
    __syncthreads();
}

__device__ __forceinline__ void phase_post1_route(const Frame& F, int layer, bool use_mix) {
    const int tid = ltid(), lane = tid & 63; (void)lane;
    const float* mods = (const float*)(F.ws + WS_MODS) + (size_t)layer * 5 * 12288;
    const bf16_t* MIX = (const bf16_t*)(F.ws + WS_MIX);
    bf16_t* X1 = (bf16_t*)(F.ws + WS_X1);
    unsigned* route = (unsigned*)(F.ws + WS_ROUTE);
    unsigned* ecnt = (unsigned*)(F.ws + WS_CTL) + CW_ECNT + layer * 64;
    const float* g1 = F.in[I_LN1G] + layer * D; const float* b1 = F.in[I_LN1B] + layer * D;
    LAS float* RW = (LAS float*)F.lds;
    LAS unsigned* lcnt = (LAS unsigned*)(F.lds + 131072 + 256);
    if (tid < 32) lcnt[tid] = 0u;
    for (int i4 = tid; i4 < 2048 * 16 / 4; i4 += NTHR) { const int k = i4 >> 2, qd = i4 & 3; const int ii = k >> 8, ln = (k >> 2) & 63, c = k & 3;
        *(LAS f32x4*)(RW + ((((qd * 8 + ii) * 4 + c) * 64 + ln) * 4)) = *(const f32x4*)(F.in[I_ROUTW] + (size_t)k * 16 + qd * 4); }
    __syncthreads();
    const int stride = F.G * NWAVE;
    f32x4 xq[8]; u32x2 mq[8];
    const int nrows = layer == 1 ? NB * SEQ : R;
#define ROW_OF(qi) (layer == 1 ? (qi) + ((qi) >> 13) * CTXL + CTXL : (qi))
    { const int r = ROW_OF(F.bid * NWAVE + F.wave); const float* x = xin_row(F, layer, r);
#pragma unroll
      for (int i = 0; i < 8; ++i) { const int e = (i * 64 + lane) * 4; xq[i] = *(const f32x4*)(x + e); mq[i] = *(const u32x2*)(MIX + (size_t)r * D + e); } }
    for (int qi = F.bid * NWAVE + F.wave; qi < nrows; qi += stride) { const int r = ROW_OF(qi);
        const int b = r / TB, s = r - b * TB; const float* md = mods + (size_t)(s < CTXL ? 4 : b) * 12288;
        f32x4 v[8]; float sum = 0.f;
#pragma unroll
        for (int i = 0; i < 8; ++i) { const int e = (i * 64 + lane) * 4; v[i] = xq[i] * ALPHA;
            if (use_mix) { const u32x2 m = mq[i]; const f32x4 g = *(const f32x4*)(md + 2 * 2048 + e);
                v[i][0] += g[0] * __uint_as_float(m.x << 16); v[i][1] += g[1] * __uint_as_float(m.x & 0xffff0000u); v[i][2] += g[2] * __uint_as_float(m.y << 16); v[i][3] += g[3] * __uint_as_float(m.y & 0xffff0000u); }
            sum += (v[i][0] + v[i][1]) + (v[i][2] + v[i][3]); }
        { const int rn = ROW_OF(qi + stride < nrows ? qi + stride : qi); const float* xn = xin_row(F, layer, rn);
#pragma unroll
          for (int i = 0; i < 8; ++i) { const int e = (i * 64 + lane) * 4; xq[i] = *(const f32x4*)(xn + e); mq[i] = *(const u32x2*)(MIX + (size_t)rn * D + e); } }
        float mean = wave_sum(sum, lane) * (1.0f / D); float q = 0.f;
#pragma unroll
        for (int i = 0; i < 8; ++i) { v[i] -= mean; q += (v[i][0] * v[i][0] + v[i][1] * v[i][1]) + (v[i][2] * v[i][2] + v[i][3] * v[i][3]); }
        float rstd = rsqrtf(wave_sum(q, lane) * (1.0f / D) + LN_EPS);
        sum = 0.f;
#pragma unroll
        for (int i = 0; i < 8; ++i) { const int e = (i * 64 + lane) * 4; const f32x4 gg = *(const f32x4*)(g1 + e), bb = *(const f32x4*)(b1 + e);
            v[i] = v[i] * rstd * gg + bb; { u32x2 w; w.x = pk_bf16(v[i][0], v[i][1]); w.y = pk_bf16(v[i][2], v[i][3]); *(u32x2*)(X1 + (size_t)r * D + e) = w; } sum += (v[i][0] + v[i][1]) + (v[i][2] + v[i][3]); }
        mean = wave_sum(sum, lane) * (1.0f / D); q = 0.f;
#pragma unroll
        for (int i = 0; i < 8; ++i) { v[i] -= mean; q += (v[i][0] * v[i][0] + v[i][1] * v[i][1]) + (v[i][2] * v[i][2] + v[i][3] * v[i][3]); }
        rstd = rsqrtf(wave_sum(q, lane) * (1.0f / D) + LN_EPS);
        float lg[16];
#pragma unroll
        for (int e = 0; e < 16; ++e) lg[e] = 0.f;
#pragma unroll
        for (int i = 0; i < 8; ++i) { const int e0 = (i * 64 + lane) * 4; const f32x4 sh = *(const f32x4*)(md + 3 * 2048 + e0), scl = *(const f32x4*)(md + 4 * 2048 + e0);
            const f32x4 u = v[i] * rstd * (scl + 1.0f) + sh;
#pragma unroll
            for (int j = 0; j < 4; ++j) {
#pragma unroll
                for (int qd = 0; qd < 4; ++qd) { const f32x4 w = *(const LAS f32x4*)(RW + ((((qd * 8 + i) * 4 + j) * 64 + lane) * 4)); lg[qd * 4 + 0] += u[j] * w[0]; lg[qd * 4 + 1] += u[j] * w[1]; lg[qd * 4 + 2] += u[j] * w[2]; lg[qd * 4 + 3] += u[j] * w[3]; } }
            __builtin_amdgcn_sched_barrier(0); }
#pragma unroll
        for (int e = 0; e < 16; ++e) lg[e] = wave_sum(lg[e], lane);
        float aff[16], gsc[16];
#pragma unroll
        for (int e = 0; e < 16; ++e) { aff[e] = __builtin_amdgcn_rcpf(1.0f + __expf(-lg[e])); gsc[e] = aff[e] + F.in[I_ROUTB][e]; }
        int best = 0; float bestv = -1e30f;
#pragma unroll
        for (int gI = 0; gI < 4; ++gI) { float m1 = -1e30f, m2 = -1e30f;
#pragma unroll
            for (int j = 0; j < 4; ++j) { const float t = gsc[gI * 4 + j]; if (t > m1) { m2 = m1; m1 = t; } else if (t > m2) m2 = t; }
            const float sc = m1 + m2; if (sc > bestv) { bestv = sc; best = gI; } }
        int i0 = 0, i1 = 0; { float m1 = -1e30f, m2 = -1e30f;
#pragma unroll
            for (int gI = 0; gI < 4; ++gI) if (gI == best) {
#pragma unroll
                for (int j = 0; j < 4; ++j) { const float t = gsc[gI * 4 + j]; if (t > m1) { m2 = m1; i1 = i0; m1 = t; i0 = gI * 4 + j; } else if (t > m2) { m2 = t; i1 = gI * 4 + j; } } } }
        float a0 = 0.f, a1 = 0.f;
#pragma unroll
        for (int e = 0; e < 16; ++e) { a0 = (e == i0) ? aff[e] : a0; a1 = (e == i1) ? aff[e] : a1; }
        const float inv = 1.0f / (a0 + a1);
        if (lane == 0) {
            const unsigned s0 = __hip_atomic_fetch_add(lcnt + i0, 1u, __ATOMIC_RELAXED, __HIP_MEMORY_SCOPE_WORKGROUP), s1 = __hip_atomic_fetch_add(lcnt + i1, 1u, __ATOMIC_RELAXED, __HIP_MEMORY_SCOPE_WORKGROUP);
            u32x4 w0; w0.x = (unsigned)i0; w0.y = (unsigned)i1; w0.z = __float_as_uint(a0 * inv); w0.w = __float_as_uint(a1 * inv);
            *(u32x4*)(route + (size_t)r * 8) = w0; u32x2 w1; w1.x = s0; w1.y = s1; *(u32x2*)(route + (size_t)r * 8 + 4) = w1;
        }
    }
    __syncthreads();
    if (tid < 16) lcnt[16 + tid] = atomicAdd(ecnt + tid, lcnt[tid]);
    __syncthreads();
    for (int qi = F.bid * NWAVE + F.wave; qi < nrows; qi += stride) { const int r = ROW_OF(qi);
        if (lane == 0) { const u32x2 e01 = *(const u32x2*)(route + (size_t)r * 8); u32x2 sl = *(const u32x2*)(route + (size_t)r * 8 + 4);
            sl.x += lcnt[16 + e01.x]; sl.y += lcnt[16 + e01.y]; *(u32x2*)(route + (size_t)r * 8 + 4) = sl; } }
}
__device__ __forceinline__ void load_tile_starts(const Frame& F, int tid, int layer, LAS int* ts) {
    if (tid == 0) { const unsigned* ecnt = (const unsigned*)(F.ws + WS_CTL) + CW_ECNT + layer * 64; int a = 0;
        for (int e = 0; e < 16; ++e) { ts[e] = a; a += (int)((__hip_atomic_load(ecnt + e, __ATOMIC_RELAXED, __HIP_MEMORY_SCOPE_AGENT) + 255u) >> 8); } ts[16] = a; }
    __syncthreads();
}
__device__ __forceinline__ void phase_gather(const Frame& F, int layer) {
    const int tid = ltid(), lane = tid & 63; (void)lane;
    LAS int* ts = (LAS int*)(F.lds + LDS_BYTES - 512);
    const float* mods = (const float*)(F.ws + WS_MODS) + (size_t)layer * 5 * 12288;
    LAS float* ML = (LAS float*)F.lds;
    for (int i = tid; i < 5 * 2 * 512; i += NTHR) { const int mr = i >> 10, v = (i >> 9) & 1, c4 = i & 511; *(LAS f32x4*)(ML + (mr * 2 + v) * 2048 + c4 * 4) = *(const f32x4*)(mods + (size_t)mr * 12288 + (3 + v) * 2048 + c4 * 4); }
    load_tile_starts(F, tid, layer, ts);
    const bf16_t* X1 = (const bf16_t*)(F.ws + WS_X1);
    const unsigned* route = (const unsigned*)(F.ws + WS_ROUTE);
    bf16_t* UG = (bf16_t*)(F.ws + WS_SC);
    const int stride = F.G * NWAVE;
    u32x2 xw[8]; u32x4 rr; u32x2 sl;
    const int nrows = layer == 1 ? NB * SEQ : R;
    { const int r = ROW_OF(F.bid * NWAVE + F.wave);
#pragma unroll
      for (int i = 0; i < 8; ++i) xw[i] = *(const u32x2*)(X1 + (size_t)r * D + (i * 64 + lane) * 4);
      rr = *(const u32x4*)(route + (size_t)r * 8); sl = *(const u32x2*)(route + (size_t)r * 8 + 4); }
    for (int qi = F.bid * NWAVE + F.wave; qi < nrows; qi += stride) { const int r = ROW_OF(qi);
        const int b = r / TB, s = r - b * TB; const LAS float* md = ML + (s < CTXL ? 4 : b) * 4096;
        f32x4 v[8]; float sum = 0.f;
#pragma unroll
        for (int i = 0; i < 8; ++i) { const u32x2 w = xw[i]; v[i][0] = __uint_as_float(w.x << 16); v[i][1] = __uint_as_float(w.x & 0xffff0000u); v[i][2] = __uint_as_float(w.y << 16); v[i][3] = __uint_as_float(w.y & 0xffff0000u); sum += (v[i][0] + v[i][1]) + (v[i][2] + v[i][3]); }
        const u32x4 rc = rr; const u32x2 sc_ = sl;
        { const int rn = ROW_OF(qi + stride < nrows ? qi + stride : qi);
#pragma unroll
          for (int i = 0; i < 8; ++i) xw[i] = *(const u32x2*)(X1 + (size_t)rn * D + (i * 64 + lane) * 4);
          rr = *(const u32x4*)(route + (size_t)rn * 8); sl = *(const u32x2*)(route + (size_t)rn * 8 + 4); }
        const float mean = wave_sum(sum, lane) * (1.0f / D); float q = 0.f;
#pragma unroll
        for (int i = 0; i < 8; ++i) { v[i] -= mean; q += (v[i][0] * v[i][0] + v[i][1] * v[i][1]) + (v[i][2] * v[i][2] + v[i][3] * v[i][3]); }
        const float rstd = rsqrtf(wave_sum(q, lane) * (1.0f / D) + LN_EPS);
        const size_t row0 = (size_t)ts[rc.x] * 256 + sc_.x, row1 = (size_t)ts[rc.y] * 256 + sc_.y;
#pragma unroll
        for (int i = 0; i < 8; ++i) { const int e = (i * 64 + lane) * 4; const f32x4 sh = *(const LAS f32x4*)(md + e), scl = *(const LAS f32x4*)(md + 2048 + e);
            const f32x4 u = v[i] * rstd * (scl + 1.0f) + sh;
            st_op4(UG, row0 * D + e, u[0], u[1], u[2], u[3]); st_op4(UG, row1 * D + e, u[0], u[1], u[2], u[3]); }
    }
}
__device__ __forceinline__ void phase_moe_gemm(const Frame& F, int layer, int which) {
    const int tid = ltid(), lane = tid & 63; (void)lane;
    LAS int* ts = (LAS int*)(F.lds + pg8::STAGE_BYTES);
    load_tile_starts(F, tid, layer, ts);
    if (which == 0) {
        pg8::Gemm g{(const bf16_t*)(F.ws + WS_SC), (const bf16_t*)(F.ws + WS_EGU), 2048 * OPB / 2, 2048 * OPB / 2, 2048 * OPB / 2};
        pg8::GroupedOrder S{ts, 8, F.G, F.bid}; pg8::Epi<4, true> E{(void*)(F.ws + WS_U), nullptr, nullptr, 1024, 8};
        pg8::gemm_phase<pg8::Epi<4, true>, pg8::GroupedOrder>(F.lds, g, S, E, F.wave);
    } else {
        pg8::Gemm g{(const bf16_t*)(F.ws + WS_U), (const bf16_t*)(F.ws + WS_EDN), 1024 * OPB / 2, 1024 * OPB / 2, 1024 * OPB / 2};
        pg8::GroupedOrder S{ts, 8, F.G, F.bid}; pg8::Epi<7, true> E{(void*)(F.ws + WS_SC), nullptr, nullptr, 2048, 8};
        pg8::gemm_phase<pg8::Epi<7, true>, pg8::GroupedOrder>(F.lds, g, S, E, F.wave);
    }
}
__device__ __forceinline__ void phase_post2_moe(const Frame& F, int layer, bool use_ffn) {
    const int tid = ltid(), lane = tid & 63; (void)lane;
    LAS int* ts = (LAS int*)(F.lds + LDS_BYTES - 512);
    const float* mods = (const float*)(F.ws + WS_MODS) + (size_t)layer * 5 * 12288;
    LAS float* GL5 = (LAS float*)F.lds;
    LAS float* G2L = GL5 + 5 * 2048; LAS float* NXL = G2L + 2 * 2048;
    for (int i = tid; i < 5 * 512; i += NTHR) { const int mr = i >> 9, c4 = i & 511; *(LAS f32x4*)(GL5 + mr * 2048 + c4 * 4) = *(const f32x4*)(mods + (size_t)mr * 12288 + 5 * 2048 + c4 * 4); }
    for (int i = tid; i < 2 * 512; i += NTHR) { const int v = i >> 9, c4 = i & 511; *(LAS f32x4*)(G2L + v * 2048 + c4 * 4) = *(const f32x4*)((v == 0 ? F.in[I_LN2G] : F.in[I_LN2B]) + layer * D + c4 * 4); }
    if (layer == 0) for (int i = tid; i < 5 * 2 * 512; i += NTHR) { const int mr = i >> 10, v = (i >> 9) & 1, c4 = i & 511; *(LAS f32x4*)(NXL + (mr * 2 + v) * 2048 + c4 * 4) = *(const f32x4*)(mods + (size_t)5 * 12288 + (size_t)mr * 12288 + v * 2048 + c4 * 4); }
    load_tile_starts(F, tid, layer, ts);
    const bf16_t* X1 = (const bf16_t*)(F.ws + WS_X1);
    const unsigned* route = (const unsigned*)(F.ws + WS_ROUTE);
    const unsigned char* Y = F.ws + WS_SC;
    const float* g2 = F.in[I_LN2G] + layer * D; const float* b2 = F.in[I_LN2B] + layer * D;
    const int stride = F.G * NWAVE;
    u32x2 xw[8]; unsigned y0w[8], y1w[8]; u32x4 rrN; u32x2 slN; float w0c, w1c;
    const int nrows = layer == 1 ? NB * SEQ : R;
    { const int r = ROW_OF(F.bid * NWAVE + F.wave); const u32x4 rr = *(const u32x4*)(route + (size_t)r * 8); const u32x2 sl = *(const u32x2*)(route + (size_t)r * 8 + 4);
      const size_t row0 = (size_t)ts[rr.x] * 256 + sl.x, row1 = (size_t)ts[rr.y] * 256 + sl.y; w0c = __uint_as_float(rr.z); w1c = __uint_as_float(rr.w);
#pragma unroll
      for (int i = 0; i < 8; ++i) { const int e = (i * 64 + lane) * 4; xw[i] = *(const u32x2*)(X1 + (size_t)r * D + e); y0w[i] = *(const unsigned*)(Y + row0 * D + e); y1w[i] = *(const unsigned*)(Y + row1 * D + e); }
      const int q0 = F.bid * NWAVE + F.wave; const int rn = ROW_OF(q0 + stride < nrows ? q0 + stride : q0); rrN = *(const u32x4*)(route + (size_t)rn * 8); slN = *(const u32x2*)(route + (size_t)rn * 8 + 4); }
    for (int qi = F.bid * NWAVE + F.wave; qi < nrows; qi += stride) { const int r = ROW_OF(qi);
        const int b = r / TB, s = r - b * TB; const int mr = s < CTXL ? 4 : b;
        const float w0 = w0c * (1.0f / pg8::Y8_SCALE), w1 = w1c * (1.0f / pg8::Y8_SCALE);
        f32x4 v[8]; float sum = 0.f;
#pragma unroll
        for (int i = 0; i < 8; ++i) { const int e = (i * 64 + lane) * 4; { const u32x2 w = xw[i]; v[i][0] = __uint_as_float(w.x << 16); v[i][1] = __uint_as_float(w.x & 0xffff0000u); v[i][2] = __uint_as_float(w.y << 16); v[i][3] = __uint_as_float(w.y & 0xffff0000u); v[i] *= ALPHA; }
            if (use_ffn) { const f32x4 g = *(const LAS f32x4*)(GL5 + mr * 2048 + e);
                const auto a0 = __builtin_amdgcn_cvt_pk_f32_fp8((int)y0w[i], false), a1 = __builtin_amdgcn_cvt_pk_f32_fp8((int)y0w[i], true), b0 = __builtin_amdgcn_cvt_pk_f32_fp8((int)y1w[i], false), b1 = __builtin_amdgcn_cvt_pk_f32_fp8((int)y1w[i], true);
                v[i][0] += g[0] * (w0 * a0[0] + w1 * b0[0]); v[i][1] += g[1] * (w0 * a0[1] + w1 * b0[1]); v[i][2] += g[2] * (w0 * a1[0] + w1 * b1[0]); v[i][3] += g[3] * (w0 * a1[1] + w1 * b1[1]); }
            sum += (v[i][0] + v[i][1]) + (v[i][2] + v[i][3]); }
        {
            const int rn = ROW_OF(qi + stride < nrows ? qi + stride : qi); const int rn2 = ROW_OF(qi + 2 * stride < nrows ? qi + 2 * stride : qi);
            const size_t row0 = (size_t)ts[rrN.x] * 256 + slN.x, row1 = (size_t)ts[rrN.y] * 256 + slN.y; w0c = __uint_as_float(rrN.z); w1c = __uint_as_float(rrN.w);
#pragma unroll
            for (int i = 0; i < 8; ++i) { const int e = (i * 64 + lane) * 4; xw[i] = *(const u32x2*)(X1 + (size_t)rn * D + e); y0w[i] = *(const unsigned*)(Y + row0 * D + e); y1w[i] = *(const unsigned*)(Y + row1 * D + e); }
            rrN = *(const u32x4*)(route + (size_t)rn2 * 8); slN = *(const u32x2*)(route + (size_t)rn2 * 8 + 4); }
        const float mean = wave_sum(sum, lane) * (1.0f / D); float q = 0.f;
#pragma unroll
        for (int i = 0; i < 8; ++i) { v[i] -= mean; q += (v[i][0] * v[i][0] + v[i][1] * v[i][1]) + (v[i][2] * v[i][2] + v[i][3] * v[i][3]); }
        const float rstd = rsqrtf(wave_sum(q, lane) * (1.0f / D) + LN_EPS);
        float* o = xout_row(F, r); float sum2 = 0.f;
#pragma unroll
        for (int i = 0; i < 8; ++i) { const int e = (i * 64 + lane) * 4; const f32x4 gg = *(const LAS f32x4*)(G2L + e), bb = *(const LAS f32x4*)(G2L + 2048 + e);
            v[i] = v[i] * rstd * gg + bb; *(f32x4*)(o + e) = v[i]; sum2 += (v[i][0] + v[i][1]) + (v[i][2] + v[i][3]); }
        if (layer == 0) {
            const LAS float* mdn = NXL + mr * 4096; void* U = (void*)(F.ws + WS_U);
            const float mean2 = wave_sum(sum2, lane) * (1.0f / D); float q2 = 0.f;
#pragma unroll
            for (int i = 0; i < 8; ++i) { v[i] -= mean2; q2 += (v[i][0] * v[i][0] + v[i][1] * v[i][1]) + (v[i][2] * v[i][2] + v[i][3] * v[i][3]); }
            const float rstd2 = rsqrtf(wave_sum(q2, lane) * (1.0f / D) + LN_EPS);
#pragma unroll
            for (int i = 0; i < 8; ++i) { const int e = (i * 64 + lane) * 4; const f32x4 sh = *(const LAS f32x4*)(mdn + e), scl = *(const LAS f32x4*)(mdn + 2048 + e);
                const f32x4 u = v[i] * rstd2 * (scl + 1.0f) + sh; st_op4(U, (size_t)r * D + e, u[0], u[1], u[2], u[3]); }
        }
    }
}


__device__ __forceinline__ bf16x8 pack_8(const f32x4 a, const f32x4 b) { u32x4 w; w.x = pk_bf16(a[0], a[1]); w.y = pk_bf16(a[2], a[3]); w.z = pk_bf16(b[0], b[1]); w.w = pk_bf16(b[2], b[3]); bf16x8 r; __builtin_memcpy(&r, &w, 16); return r; }
__device__ __forceinline__ bf16x8 lds_2x8(const LAS bf16_t* p0, const LAS bf16_t* p1) { const u32x2 a = *(const LAS u32x2*)p0, b = *(const LAS u32x2*)p1; u32x4 w; w.x = a.x; w.y = a.y; w.z = b.x; w.w = b.y; bf16x8 r; __builtin_memcpy(&r, &w, 16); return r; }
__device__ __forceinline__ int nat_chunk(int d, int j) { return d == 0 ? j : (j < 4 ? 3 - j : 135 - j); }
__device__ __forceinline__ bf16x8 ldsA(const LAS bf16_t* p) { return *(const LAS bf16x8*)p; }
#define MFMA16(a, b, c) __builtin_amdgcn_mfma_f32_16x16x32_bf16((a), (b), (c), 0, 0, 0)
constexpr size_t SC_RWF = 0, SC_RWB = (size_t)R * 1024 * 2, SC_S5 = 2 * SC_RWB, SC_ML = SC_S5 + (size_t)R * 1024 * OPB, SC_RWO = F8 ? SC_ML + (size_t)R * 1024 * OPB : SC_RWF;
static_assert(SC_RWO + (size_t)R * 1024 * OPB <= SC_BYTES, "SC region overflow");

__device__ __forceinline__ void conv_item(const Frame& F, int tid, int layer, int it) {
    const bf16_t* P = (const bf16_t*)(F.ws + WS_P); bf16_t* QK = (bf16_t*)(F.ws + WS_QK);
    int b, rowbase[3], jmin, jmax; bool rv[3];
    if (it < 512) { b = it >> 7; const int i = it & 127; jmin = 0; jmax = 63;
        _Pragma("unroll") for (int a = 0; a < 3; ++a) { const int ii = i + a - 1; rv[a] = (ii >= 0 && ii < 128); rowbase[a] = b * TB + CTXL + ii * 64; } }
    else { const int q = it - 512; b = q >> 2; const int seg = q & 3; jmin = seg == 0 ? 0 : -1; jmax = seg == 3 ? 63 : 64;
        rv[0] = false; rv[2] = false; rv[1] = true; rowbase[0] = rowbase[2] = rowbase[1] = b * TB + seg * 64; }
    const int c0 = tid * 4;
    const float* cw = F.in[I_MLCW] + (size_t)layer * 9 * 2048; const float* cb = F.in[I_MLCB] + layer * 2048;
    f32x4 w[3][3];
#pragma unroll
    for (int a = 0; a < 3; ++a)
#pragma unroll
        for (int bb = 0; bb < 3; ++bb) w[a][bb] = *(const f32x4*)(cw + (a * 3 + bb) * 2048 + c0);
    const f32x4 bias = *(const f32x4*)(cb + c0);
    const float osc = c0 >= 1024 ? 0.0625f : 1.0f;
    f32x4 win[3][3];
#pragma unroll
    for (int a = 0; a < 3; ++a) { win[a][0] = (f32x4){0.f, 0.f, 0.f, 0.f}; win[a][1] = win[a][0]; win[a][2] = win[a][0]; }
    auto ldcol = [&](int a, int jj) -> f32x4 {
        const bool ok = rv[a] && jj >= jmin && jj <= jmax; const int rr = ok ? rowbase[a] + jj : rowbase[1];
        const u32x2 p = *(const u32x2*)(P + (size_t)rr * PW + c0); const float mk = ok ? 1.0f : 0.0f; f32x4 r;
        r[0] = mk * __uint_as_float(p.x << 16); r[1] = mk * __uint_as_float(p.x & 0xffff0000u); r[2] = mk * __uint_as_float(p.y << 16); r[3] = mk * __uint_as_float(p.y & 0xffff0000u);
        return r; };
#pragma unroll
    for (int a = 0; a < 3; ++a) { win[a][1] = ldcol(a, -1); win[a][2] = ldcol(a, 0); }
    for (int j0 = 0; j0 < 64; j0 += 8) {
        f32x4 nw[3][8];
#pragma unroll
        for (int u = 0; u < 8; ++u)
#pragma unroll
            for (int a = 0; a < 3; ++a) nw[a][u] = ldcol(a, j0 + u + 1);
#pragma unroll
        for (int u = 0; u < 8; ++u) {
            f32x4 acc = bias;
#pragma unroll
            for (int a = 0; a < 3; ++a) { win[a][0] = win[a][1]; win[a][1] = win[a][2]; win[a][2] = nw[a][u];
                acc += win[a][0] * w[a][0] + win[a][1] * w[a][1] + win[a][2] * w[a][2]; }
            u32x2 o; o.x = pk_bf16(siluf_(acc[0]) * osc, siluf_(acc[1]) * osc); o.y = pk_bf16(siluf_(acc[2]) * osc, siluf_(acc[3]) * osc);
            *(u32x2*)(QK + (size_t)(rowbase[1] + j0 + u) * 2048 + c0) = o;
        }
    }
}

__device__ __forceinline__ void fsincos(float a, float* s, float* c) { const float k = rintf(a * 0.15915494309189535f); const float r = fmaf(-k, 6.2831854820251465f, a) + k * 1.7484555e-7f; *s = __sinf(r); *c = __cosf(r); }
__device__ __forceinline__ void s5_tables_item(const Frame& F, int tid, int layer, int g) {
    LAS float* pwr = (LAS float*)F.lds;
    LAS float* pwi = pwr + 2 * 65 * 64;
    LAS float* bbr = pwi + 2 * 65 * 64;
    LAS float* bbi = bbr + 2 * 64 * 16;
    LAS float* ccr = bbi + 2 * 64 * 16;
    LAS float* cci = ccr + 2 * 16 * 64;
    LAS float* k0b = cci + 2 * 16 * 64;
    bf16_t* KC = (bf16_t*)(F.ws + WS_S5KC) + (size_t)g * 128 * 256;
    bf16_t* EC = (bf16_t*)(F.ws + WS_S5E) + (size_t)g * 256 * 1024;
    bf16_t* FC = (bf16_t*)(F.ws + WS_S5F) + (size_t)g * 1024 * 256;
    {
        const int dn = tid & 127, d = dn >> 6, n = dn & 63, tg = tid >> 7;
        const size_t li = (((size_t)layer * 2 + d) * 64 + g) * 64 + n;
        const float lre = F.in[I_S5LRE][li], lim = F.in[I_S5LIM][li], dt = expf(F.in[I_S5LDT][((size_t)layer * 2 + d) * 64 + g]);
        const float zr = lre * dt, zi = lim * dt;
        for (int tau = tg; tau <= 64; tau += 4) { const float mag = expf(zr * (float)tau); float sn, cs; fsincos(zi * (float)tau, &sn, &cs);
            pwr[(d * 65 + tau) * 64 + n] = mag * cs; pwi[(d * 65 + tau) * 64 + n] = mag * sn; }
        if (tg == 0) {
            const float mag = expf(zr); float sn, cs; fsincos(zi, &sn, &cs);
            const float nr = mag * cs - 1.0f, ni = mag * sn, den = 1.0f / (lre * lre + lim * lim);
            const float cr = (nr * lre + ni * lim) * den, ci = (ni * lre - nr * lim) * den;
            const float* br = F.in[I_S5BRE] + li * 16; const float* bi = F.in[I_S5BIM] + li * 16;
            for (int c = 0; c < 16; ++c) { bbr[(d * 64 + n) * 16 + c] = cr * br[c] - ci * bi[c]; bbi[(d * 64 + n) * 16 + c] = cr * bi[c] + ci * br[c]; }
        }
        for (int i = tid; i < 2 * 16 * 64; i += NTHR) { const int dd = i >> 10, rem = i & 1023;
            const size_t ci_ = (((size_t)layer * 2 + dd) * 64 + g) * 1024 + rem; ccr[i] = F.in[I_S5CRE][ci_]; cci[i] = F.in[I_S5CIM][ci_]; }
    }
    __syncthreads();
    {
        const int d = tid >> 8, co = (tid >> 4) & 15, ci = tid & 15;
        for (int half = 0; half < 2; ++half) {
            float acc[32];
#pragma unroll
            for (int t = 0; t < 32; ++t) acc[t] = 0.f;
            for (int n = 0; n < 64; ++n) {
                const float c_r = ccr[(d * 16 + co) * 64 + n], c_i = cci[(d * 16 + co) * 64 + n], b_r = bbr[(d * 64 + n) * 16 + ci], b_i = bbi[(d * 64 + n) * 16 + ci];
                const float gr = c_r * b_r - c_i * b_i, gi = c_r * b_i + c_i * b_r;
#pragma unroll
                for (int t = 0; t < 32; ++t) acc[t] += gr * pwr[(d * 65 + half * 32 + t) * 64 + n] - gi * pwi[(d * 65 + half * 32 + t) * 64 + n];
            }
            if (half == 0) {
                if (d == 1) k0b[tid & 255] = acc[0];
                __syncthreads();
                if (d == 0) acc[0] += k0b[tid & 255] + (co == ci ? F.in[I_S5D][layer * 1024 + g * 16 + co] : 0.f);
            }
#pragma unroll
            for (int t = 0; t < 32; ++t) { const int tau = half * 32 + t; if (d == 1 && tau == 0) continue; const int delta = d == 0 ? tau : -tau; KC[(size_t)(delta + 63) * 256 + co * 16 + ci] = f2bf(acc[t]); }
        }
        if (d == 1) KC[(size_t)127 * 256 + (tid & 255)] = 0;
    }
    for (int u = tid; u < 2 * 64 * 64 * 2; u += NTHR) {
        const int ch = u & 1, sp = (u >> 1) & 63, n = (u >> 7) & 63, d = u >> 13;
        const int tau = d == 0 ? 63 - sp : sp; const float pr = pwr[(d * 65 + tau) * 64 + n], pi = pwi[(d * 65 + tau) * 64 + n];
        float er[8], ei[8];
#pragma unroll
        for (int e = 0; e < 8; ++e) { const float b_r = bbr[(d * 64 + n) * 16 + ch * 8 + e], b_i = bbi[(d * 64 + n) * 16 + ch * 8 + e]; er[e] = pr * b_r - pi * b_i; ei[e] = pr * b_i + pi * b_r; }
        u32x4 wr_, wi_; wr_.x = pk_bf16(er[0], er[1]); wr_.y = pk_bf16(er[2], er[3]); wr_.z = pk_bf16(er[4], er[5]); wr_.w = pk_bf16(er[6], er[7]);
        wi_.x = pk_bf16(ei[0], ei[1]); wi_.y = pk_bf16(ei[2], ei[3]); wi_.z = pk_bf16(ei[4], ei[5]); wi_.w = pk_bf16(ei[6], ei[7]);
        *(u32x4*)(EC + (size_t)(d * 128 + n) * 1024 + sp * 16 + ch * 8) = wr_;
        *(u32x4*)(EC + (size_t)(d * 128 + 64 + n) * 1024 + sp * 16 + ch * 8) = wi_;
    }
    for (int u = tid; u < 1024 * 32; u += NTHR) {
        const int n8 = u & 7, part = (u >> 3) & 1, d = (u >> 4) & 1, co = (u >> 5) & 15, tp = u >> 9;
        const int tau = d == 0 ? tp + 1 : 64 - tp; float f[8];
#pragma unroll
        for (int e = 0; e < 8; ++e) { const int n = n8 * 8 + e; const float c_r = ccr[(d * 16 + co) * 64 + n], c_i = cci[(d * 16 + co) * 64 + n], pr = pwr[(d * 65 + tau) * 64 + n], pi = pwi[(d * 65 + tau) * 64 + n];
            f[e] = part == 0 ? (c_r * pr - c_i * pi) : -(c_r * pi + c_i * pr); }
        u32x4 w; w.x = pk_bf16(f[0], f[1]); w.y = pk_bf16(f[2], f[3]); w.z = pk_bf16(f[4], f[5]); w.w = pk_bf16(f[6], f[7]);
        *(u32x4*)(FC + (size_t)(tp * 16 + co) * 256 + d * 128 + part * 64 + n8 * 8) = w;
    }
    __syncthreads();
}

__device__ __forceinline__ void s5a_wave_item(const Frame& F, int lane, int wi) {
    const int rh = wi & 1, w2 = wi >> 1, g = w2 / 9, cq = w2 - g * 9, l15 = lane & 15, q = lane >> 4;
    const bf16_t* P = (const bf16_t*)(F.ws + WS_P); const bf16_t* EC = (const bf16_t*)(F.ws + WS_S5E) + (size_t)g * 256 * 1024 + (size_t)rh * 128 * 1024;
    float* XL = (float*)(F.ws + WS_S5X);
    const bf16_t* ub[4]; int colv[4];
#pragma unroll
    for (int c = 0; c < 4; ++c) { const int ct = (cq * 4 + c) < 33 ? cq * 4 + c : 32; const int col = ct * 16 + l15, b = col / NCH, jn = col - b * NCH; colv[c] = col;
        ub[c] = P + (size_t)(b * TB + jn * 64 + (q >> 1)) * PW + PC_S5 + g * 16 + (q & 1) * 8; }
    const unsigned eoff = (unsigned)(l15 * 1024 + q * 8) * 2u;
    f32x4 acc[4][8];
#pragma unroll
    for (int c = 0; c < 4; ++c)
#pragma unroll
        for (int x = 0; x < 8; ++x) acc[c][x] = (f32x4){0.f, 0.f, 0.f, 0.f};
    for (int ks = 0; ks < 32; ks += 2) {
        bf16x8 Bf[2][4], Af[2][8];
#pragma unroll
        for (int u = 0; u < 2; ++u) {
#pragma unroll
            for (int c = 0; c < 4; ++c) Bf[u][c] = *(const bf16x8*)(ub[c] + (size_t)((ks + u) * 2) * PW);
            unsigned eo = eoff; asm volatile("" : "+v"(eo));
#pragma unroll
            for (int x = 0; x < 8; ++x) Af[u][x] = *(const bf16x8*)((const char*)(EC + (size_t)(x * 16) * 1024 + (ks + u) * 32) + eo); }
#pragma unroll
        for (int u = 0; u < 2; ++u)
#pragma unroll
            for (int x = 0; x < 8; ++x)
#pragma unroll
                for (int c = 0; c < 4; ++c) acc[c][x] = MFMA16(Af[u][x], Bf[u][c], acc[c][x]);
    }
#pragma unroll
    for (int c = 0; c < 4; ++c) if (cq * 4 + c < 33) {
#pragma unroll
        for (int x = 0; x < 8; ++x) *(f32x4*)(XL + ((size_t)g * 528 + colv[c]) * 256 + rh * 128 + x * 16 + q * 4) = acc[c][x]; }
}

__device__ __forceinline__ void s5b_item(const Frame& F, int tid, int layer, int it) {
    const int idx = it * NTHR + tid, n = idx & 63, g = (idx >> 6) & 63, b = (idx >> 12) & 3, d = idx >> 14;
    const size_t li = (((size_t)layer * 2 + d) * 64 + g) * 64 + n;
    const float dt = expf(F.in[I_S5LDT][((size_t)layer * 2 + d) * 64 + g]);
    const float zr = F.in[I_S5LRE][li] * dt * 64.0f, zi = F.in[I_S5LIM][li] * dt * 64.0f;
    const float mag = expf(zr); float sn, cs; fsincos(zi, &sn, &cs); const float ar = mag * cs, ai = mag * sn;
    float* XL = (float*)(F.ws + WS_S5X);
    float cr = 0.f, ci = 0.f;
    for (int j0 = 0; j0 < NCH; j0 += 12) {
        float xr[12], xi[12];
#pragma unroll
        for (int u = 0; u < 12; ++u) { const int col = b * NCH + nat_chunk(d, j0 + u); const float* p = XL + ((size_t)g * 528 + col) * 256 + d * 128 + n; xr[u] = p[0]; xi[u] = p[64]; }
#pragma unroll
        for (int u = 0; u < 12; ++u) { const int col = b * NCH + nat_chunk(d, j0 + u); float* p = XL + ((size_t)g * 528 + col) * 256 + d * 128 + n;
            p[0] = cr; p[64] = ci; const float nr = ar * cr - ai * ci + xr[u], ni = ar * ci + ai * cr + xi[u]; cr = nr; ci = ni; }
    }
}

__device__ __forceinline__ float gelu_tanh(float x) { const float u = 0.7978845608028654f * (x + 0.044715f * x * x * x); const float e = __expf(2.0f * u); const float th = 1.0f - 2.0f / (e + 1.0f); return 0.5f * x * (1.0f + th); }
__device__ __forceinline__ void s5c_block_item(const Frame& F, int tid, int it) {
    const int g = it >> 2, part = it & 3, lane = tid & 63, l15 = lane & 15, q = lane >> 4;
    const int wave = __builtin_amdgcn_readfirstlane(tid >> 6);
    LAS bf16_t* KL = (LAS bf16_t*)F.lds;
    LAS bf16_t* UL = KL + 127 * 264;
    { const bf16_t* KC = (const bf16_t*)(F.ws + WS_S5KC) + (size_t)g * 128 * 256;
      for (int i = tid; i < 127 * 32; i += NTHR) { const int r = i >> 5, sgm = i & 31, co = sgm >> 1, hf = sgm & 1;
          *(LAS u32x4*)(KL + r * 264 + hf * 128 + co * 8) = *(const u32x4*)(KC + (size_t)r * 256 + sgm * 8); } }
    const bf16_t* P = (const bf16_t*)(F.ws + WS_P);
    const bf16_t* FC = (const bf16_t*)(F.ws + WS_S5F) + (size_t)g * 1024 * 256; const float* XC = (const float*)(F.ws + WS_S5X);
    void* OUT = (void*)(F.ws + WS_SC + SC_S5);
    const int c0 = part == 0 ? 0 : 9 + (part - 1) * 8, nct = part == 0 ? 9 : 8;
    for (int cp = 0; cp < (nct + 1) / 2; ++cp) {
        const int ctA = c0 + 2 * cp; const bool vB = (2 * cp + 1) < nct; const int ctB = vB ? ctA + 1 : ctA;
        __syncthreads();
        { const int grp = tid >> 8; const int ct = grp == 0 ? ctA : ctB;
#pragma unroll
          for (int i = 0; i < 8; ++i) { const int id = (tid & 255) + i * 256, s = id >> 5, rem = id & 31, cl = rem >> 1, hf = rem & 1;
              const int colg = ct * 16 + cl, bb = colg / NCH, jj = colg - bb * NCH;
              *(LAS u32x4*)(UL + grp * 16384 + s * 256 + hf * 128 + cl * 8) = *(const u32x4*)(P + (size_t)(bb * TB + jj * 64 + s) * PW + PC_S5 + g * 16 + hf * 8); } }
        __syncthreads();
        const int colA = ctA * 16 + l15, bA = colA / NCH, jA = colA - bA * NCH, colB = ctB * 16 + l15, bB = colB / NCH, jB = colB - bB * NCH;
        const LAS bf16_t* kcl = KL + (63 - (q >> 1)) * 264 + (q & 1) * 128 + l15 * 8;
        const LAS bf16_t* ul = UL + (q >> 1) * 256 + (q & 1) * 128 + l15 * 8;
        f32x4 acc[2][8];
#pragma unroll
        for (int c = 0; c < 2; ++c)
#pragma unroll
            for (int x = 0; x < 8; ++x) acc[c][x] = (f32x4){0.f, 0.f, 0.f, 0.f};
        for (int kb = 0; kb < 4; ++kb) {
#pragma unroll
            for (int i = 0; i < 8; ++i) { const int ks = kb * 8 + i; const bf16x8 b0 = ldsA(ul + ks * 512), b1 = ldsA(ul + 16384 + ks * 512);
#pragma unroll
                for (int x = 0; x < 8; ++x) { const bf16x8 af = ldsA(kcl + (wave * 8 + x - 2 * ks) * 264); acc[0][x] = MFMA16(af, b0, acc[0][x]); acc[1][x] = MFMA16(af, b1, acc[1][x]); }
                if (i & 1) __builtin_amdgcn_sched_barrier(0); }
        }
        {
            const unsigned foff = (unsigned)(l15 * 256 + q * 8) * 2u; const bf16_t* fu = FC + (size_t)(wave * 128) * 256;
            bf16x8 Af[8];
            { unsigned fo = foff; asm volatile("" : "+v"(fo));
#pragma unroll
              for (int x = 0; x < 8; ++x) Af[x] = *(const bf16x8*)((const char*)(fu + (size_t)(x * 16) * 256) + fo); }
            bf16x8 Xa[8], Xb[8];
#pragma unroll
            for (int ks = 0; ks < 8; ++ks) { const float* xp = XC + ((size_t)g * 528 + colA) * 256 + ks * 32 + q * 8; Xa[ks] = pack_8(*(const f32x4*)xp, *(const f32x4*)(xp + 4));
                const float* xq = XC + ((size_t)g * 528 + colB) * 256 + ks * 32 + q * 8; Xb[ks] = pack_8(*(const f32x4*)xq, *(const f32x4*)(xq + 4)); }
#pragma unroll
            for (int ks = 0; ks < 8; ++ks) { bf16x8 An[8]; unsigned fo = foff; asm volatile("" : "+v"(fo));
                if (ks + 1 < 8) {
#pragma unroll
                    for (int x = 0; x < 8; ++x) An[x] = *(const bf16x8*)((const char*)(fu + (size_t)(x * 16) * 256 + (ks + 1) * 32) + fo); }
#pragma unroll
                for (int x = 0; x < 8; ++x) { acc[0][x] = MFMA16(Af[x], Xa[ks], acc[0][x]); acc[1][x] = MFMA16(Af[x], Xb[ks], acc[1][x]); }
                if (ks + 1 < 8) {
#pragma unroll
                    for (int x = 0; x < 8; ++x) Af[x] = An[x]; }
                __builtin_amdgcn_sched_barrier(0); }
        }
#pragma unroll
        for (int x = 0; x < 8; ++x) { const int tp = wave * 8 + x;
            { const size_t row = (size_t)bA * TB + jA * 64 + tp; st_op4(OUT, row * 1024 + g * 16 + q * 4, gelu_tanh(acc[0][x][0]), gelu_tanh(acc[0][x][1]), gelu_tanh(acc[0][x][2]), gelu_tanh(acc[0][x][3])); }
            if (vB) { const size_t row = (size_t)bB * TB + jB * 64 + tp; st_op4(OUT, row * 1024 + g * 16 + q * 4, gelu_tanh(acc[1][x][0]), gelu_tanh(acc[1][x][1]), gelu_tanh(acc[1][x][2]), gelu_tanh(acc[1][x][3])); } }
    }
    __syncthreads();
}

__device__ __forceinline__ float logsigmoidf_(float x) { return fminf(x, 0.f) - __logf(1.0f + __expf(-fabsf(x))); }
__device__ __forceinline__ void mlstm_item(const Frame& F, int tid, int layer, int item) {
    const int vs = item & 3, h = (item >> 2) & 3, b = (item >> 4) & 3, d = item >> 6;
    const int lane = tid & 63, wave = __builtin_amdgcn_readfirstlane(tid >> 6), l15 = lane & 15, q = lane >> 4;
    const int y = wave & 3, p = wave >> 2;
    LAS bf16_t* Qs = (LAS bf16_t*)F.lds;
    LAS bf16_t* Ks = Qs + 64 * 264;
    LAS bf16_t* Kt = Ks + 64 * 264;
    LAS bf16_t* Vt = Kt + 256 * 72;
    LAS bf16_t* Vw = Vt + 64 * 72;
    LAS bf16_t* St = Vw + 64 * 72;
    LAS float* PX = (LAS float*)(St + 64 * 72);
    LAS float* fl = PX + 4 * 4 * 64 * 4;
    LAS float* gsc = fl;
    LAS float* rsum = fl + 384;
    LAS float* qn = fl + 512;
    LAS float* nvec = fl + 576;
    LAS float* wtsl = fl + 832;
    const bf16_t* P = (const bf16_t*)(F.ws + WS_P); const bf16_t* QK = (const bf16_t*)(F.ws + WS_QK);
    bf16_t* HO = (bf16_t*)(F.ws + WS_P);
    if (tid < 256) nvec[tid] = 0.f;
    f32x4 Cst[8];
#pragma unroll
    for (int x = 0; x < 8; ++x) Cst[x] = (f32x4){0.f, 0.f, 0.f, 0.f};
    float m_prev = 0.f;
    u32x4 pq[4], pk[4], pv; float pgi = 0.f, pgf = 0.f;
#define ML_LOAD(jj) do { const int rb_ = b * TB + nat_chunk(d, (jj)) * 64; int tl = tid; asm volatile("" : "+v"(tl));   \
        _Pragma("unroll") for (int i = 0; i < 4; ++i) { const int id = tl + i * NTHR; { const int t = id >> 5, seg = id & 31; const size_t row = (size_t)(rb_ + (d == 0 ? t : 63 - t)); pq[i] = *(const u32x4*)(QK + row * 2048 + h * 256 + seg * 8); } \
            { const int t = id & 63, seg = id >> 6; const size_t row = (size_t)(rb_ + (d == 0 ? t : 63 - t)); pk[i] = *(const u32x4*)(QK + row * 2048 + 1024 + h * 256 + seg * 8); } } \
        { const int t = tl & 63, seg = tl >> 6; const size_t row = (size_t)(rb_ + (d == 0 ? t : 63 - t)); pv = *(const u32x4*)(P + row * PW + PC_V + h * 256 + vs * 64 + seg * 8); } \
        if (wave == 7) { const size_t row = (size_t)(rb_ + (d == 0 ? lane : 63 - lane)); pgi = bf2f(P[row * PW + PC_IG + d * 4 + h]); pgf = bf2f(P[row * PW + PC_FG + d * 4 + h]); } } while (0)
#define ML_STAGE(jj) do { int tl = tid; asm volatile("" : "+v"(tl)); \
        _Pragma("unroll") for (int i = 0; i < 4; ++i) { const int id = tl + i * NTHR; { const int t = id >> 5, seg = id & 31; *(LAS u32x4*)(Qs + t * 264 + seg * 8) = pq[i]; } \
            { const int t = id & 63, seg = id >> 6; *(LAS u32x4*)(Ks + t * 264 + seg * 8) = pk[i]; const unsigned kw[4] = {pk[i].x, pk[i].y, pk[i].z, pk[i].w}; \
              _Pragma("unroll") for (int e = 0; e < 4; ++e) { Kt[(seg * 8 + 2 * e) * 72 + t] = (bf16_t)(kw[e] & 0xffffu); Kt[(seg * 8 + 2 * e + 1) * 72 + t] = (bf16_t)(kw[e] >> 16); } } } \
        { const int t = tl & 63, seg = tl >> 6; const unsigned vw_[4] = {pv.x, pv.y, pv.z, pv.w}; \
            _Pragma("unroll") for (int e = 0; e < 4; ++e) { Vt[(seg * 8 + 2 * e) * 72 + t] = (bf16_t)(vw_[e] & 0xffffu); Vt[(seg * 8 + 2 * e + 1) * 72 + t] = (bf16_t)(vw_[e] >> 16); } } \
        if (wave == 7) { const float igb = F.in[I_MLIGB][layer * 8 + d * 4 + h], fgb = F.in[I_MLFGB][layer * 8 + d * 4 + h];     \
            float bc = logsigmoidf_(pgf + fgb); \
            _Pragma("unroll") for (int o = 1; o < 64; o <<= 1) { const float t = shup(bc, o, lane); if (lane >= o) bc += t; } \
            const float g_ = (pgi + igb) - bc; float pm = g_; \
            _Pragma("unroll") for (int o = 1; o < 64; o <<= 1) { const float t = shup(pm, o, lane); if (lane >= o) pm = fmaxf(pm, t); } \
            LAS float* gs_ = gsc + ((jj) & 1) * 192; gs_[lane] = g_; gs_[64 + lane] = pm; gs_[128 + lane] = bc; } } while (0)
    ML_LOAD(0);
    __syncthreads();
    ML_STAGE(0);
    ML_LOAD(1);
    __syncthreads();
    for (int j = 0; j < NCH; ++j) {
        const int rb = b * TB + nat_chunk(d, j) * 64;
        const LAS float* gg = gsc + (j & 1) * 192; const LAS float* pmx = gg + 64; const LAS float* bcm = gg + 128;
        const float a63 = fmaxf(m_prev, pmx[63]), decay = __expf(m_prev - a63), m_new = bcm[63] + a63;
        { const int tr = wave >> 1; float rp[4] = {0.f, 0.f, 0.f, 0.f};
#pragma unroll
          for (int u = 0; u < 2; ++u) { const int tc = (wave & 1) * 2 + u; f32x4 acc = (f32x4){0.f, 0.f, 0.f, 0.f};
              if (tc <= tr) {
#pragma unroll
                  for (int ks = 0; ks < 8; ++ks) acc = MFMA16(ldsA(Qs + (tr * 16 + l15) * 264 + ks * 32 + q * 8), ldsA(Ks + (tc * 16 + l15) * 264 + ks * 32 + q * 8), acc);
              }
              const int s = tc * 16 + l15; const float gs = gg[s];
#pragma unroll
              for (int i = 0; i < 4; ++i) { const int jr = tr * 16 + q * 4 + i; const float v = (s <= jr) ? acc[i] * __expf(gs - fmaxf(pmx[jr], m_prev)) : 0.f; St[jr * 72 + s] = f2bf(v); rp[i] += v; } }
#pragma unroll
          for (int i = 0; i < 4; ++i) { float s_ = rp[i]; s_ += shx<1>(s_); s_ += shx<2>(s_); s_ += shx<4>(s_); s_ += shx<8>(s_); if (l15 == 0) rsum[(wave & 1) * 64 + tr * 16 + q * 4 + i] = s_; } }
#pragma unroll
        for (int i = 0; i < 8; ++i) { const int id = tid + i * NTHR, dv = id >> 6, s = id & 63; Vw[dv * 72 + s] = f2bf(bf2f(Vt[dv * 72 + s]) * __expf(gg[s] - a63)); }
        if (tid < 64) wtsl[tid] = __expf(gg[tid] - a63);
        { const int row = tid >> 3, part = tid & 7; float qv = 0.f;
#pragma unroll
          for (int e8 = 0; e8 < 4; ++e8) { float x8[8]; unpack8(*(const LAS u32x4*)(Qs + row * 264 + part * 32 + e8 * 8), x8); const f32x4 n0 = *(const LAS f32x4*)(nvec + part * 32 + e8 * 8), n1 = *(const LAS f32x4*)(nvec + part * 32 + e8 * 8 + 4);
              qv += (x8[0] * n0[0] + x8[1] * n0[1]) + (x8[2] * n0[2] + x8[3] * n0[3]) + (x8[4] * n1[0] + x8[5] * n1[1]) + (x8[6] * n1[2] + x8[7] * n1[3]); }
          qv += shx<1>(qv); qv += shx<2>(qv); qv += shx<4>(qv);
          if (part == 0) qn[row] = qv; }
        __syncthreads();
        f32x4 acc[4], PXs[4];
#pragma unroll
        for (int rt = 0; rt < 4; ++rt) PXs[rt] = (f32x4){0.f, 0.f, 0.f, 0.f};
        { bf16x8 Cb[4];
#pragma unroll
          for (int kk = 0; kk < 4; ++kk) Cb[kk] = pack_8(Cst[2 * kk], Cst[2 * kk + 1]);
#pragma unroll
          for (int rt = 0; rt < 4; ++rt) { acc[rt] = (f32x4){0.f, 0.f, 0.f, 0.f};
#pragma unroll
              for (int kk = 0; kk < 4; ++kk) { const LAS bf16_t* qp = Qs + (rt * 16 + l15) * 264 + (p * 8 + 2 * kk) * 16 + q * 4; acc[rt] = MFMA16(lds_2x8(qp, qp + 16), Cb[kk], acc[rt]); } } }
        if (p == 1) {
#pragma unroll
            for (int rt = 0; rt < 4; ++rt) *(LAS f32x4*)(PX + ((y * 4 + rt) * 64 + lane) * 4) = acc[rt];
        } else {
#pragma unroll
            for (int rt = 0; rt < 4; ++rt) { f32x4 a2 = (f32x4){0.f, 0.f, 0.f, 0.f};
#pragma unroll
                for (int ks = 0; ks < 2; ++ks) a2 = MFMA16(ldsA(St + (rt * 16 + l15) * 72 + ks * 32 + q * 8), ldsA(Vt + (y * 16 + l15) * 72 + ks * 32 + q * 8), a2);
                PXs[rt] = a2; }
        }
        { const bf16x8 vw0 = ldsA(Vw + (y * 16 + l15) * 72 + q * 8), vw1 = ldsA(Vw + (y * 16 + l15) * 72 + 32 + q * 8);
          bf16x8 wq0, wq1; { const f32x4 a0 = *(const LAS f32x4*)(wtsl + q * 8), a1 = *(const LAS f32x4*)(wtsl + q * 8 + 4), b0 = *(const LAS f32x4*)(wtsl + 32 + q * 8), b1 = *(const LAS f32x4*)(wtsl + 32 + q * 8 + 4);
              const f32x4 zz = (f32x4){0.f, 0.f, 0.f, 0.f}; wq0 = l15 == 0 ? pack_8(a0, a1) : pack_8(zz, zz); wq1 = l15 == 0 ? pack_8(b0, b1) : pack_8(zz, zz); }
#pragma unroll
          for (int x = 0; x < 8; ++x) { Cst[x] *= decay; const LAS bf16_t* kp = Kt + ((p * 8 + x) * 16 + l15) * 72 + q * 8; const bf16x8 k0 = ldsA(kp), k1 = ldsA(kp + 32);
              Cst[x] = MFMA16(k0, vw0, Cst[x]); Cst[x] = MFMA16(k1, vw1, Cst[x]);
              if (x == 2 * y || x == 2 * y + 1) { const int dkb = (p * 8 + x) * 16 + q * 4; f32x4 nn = (f32x4){0.f, 0.f, 0.f, 0.f};
                  if (l15 == 0) { nn = *(const LAS f32x4*)(nvec + dkb); nn *= decay; }
                  nn = MFMA16(k0, wq0, nn); nn = MFMA16(k1, wq1, nn);
                  if (l15 == 0) *(LAS f32x4*)(nvec + dkb) = nn; } } }
        __syncthreads();
        if (p == 0) {
#pragma unroll
            for (int rt = 0; rt < 4; ++rt) { const f32x4 px = *(const LAS f32x4*)(PX + ((y * 4 + rt) * 64 + lane) * 4);
#pragma unroll
                for (int i = 0; i < 4; ++i) { const int t = rt * 16 + q * 4 + i; const float a_ = fmaxf(pmx[t], m_prev), si = __expf(m_prev - a_);
                    const float hd = fmaxf(fabsf(rsum[t] + rsum[64 + t] + si * qn[t]), __expf(-(bcm[t] + a_)));
                    const float num = (acc[rt][i] + px[i]) * si + PXs[rt][i];
                    const size_t row = (size_t)(rb + (d == 0 ? t : 63 - t));
                    HO[row * PW + d * 1024 + h * 256 + vs * 64 + y * 16 + l15] = f2bf(num * __builtin_amdgcn_rcpf(hd)); } }
        }
        if (j + 1 < NCH) { ML_STAGE(j + 1); if (j + 2 < NCH) ML_LOAD(j + 2); }
        m_prev = m_new;
        __syncthreads();
    }
#undef ML_LOAD
#undef ML_STAGE
}

__device__ __forceinline__ void ml_finish_rows(const Frame& F, int lane, int layer) {
    const bf16_t* P = (const bf16_t*)(F.ws + WS_P); bf16_t* ML = (bf16_t*)(F.ws + WS_SC + SC_ML);
    const float* ng = F.in[I_MLNG] + layer * 1024; const float* nb = F.in[I_MLNB] + layer * 1024;
    const int c0 = lane * 16, stride = F.G * NWAVE;
    for (int r0 = F.bid * NWAVE + F.wave; r0 < R; r0 += 4 * stride) {
        u32x4 ha[4][2], hb[4][2], ho[4][2];
#pragma unroll
        for (int u = 0; u < 4; ++u) { const int r = r0 + u * stride < R ? r0 + u * stride : r0; const bf16_t* pr = P + (size_t)r * PW;
#pragma unroll
            for (int hh = 0; hh < 2; ++hh) { ha[u][hh] = *(const u32x4*)(pr + c0 + hh * 8); hb[u][hh] = *(const u32x4*)(pr + 1024 + c0 + hh * 8); ho[u][hh] = *(const u32x4*)(pr + PC_O + c0 + hh * 8); } }
#pragma unroll
        for (int u = 0; u < 4; ++u) { const int r = r0 + u * stride; if (r < R) {
            float v[16], o[16];
#pragma unroll
            for (int hh = 0; hh < 2; ++hh) { float a8[8], b8[8], o8[8]; unpack8(ha[u][hh], a8); unpack8(hb[u][hh], b8); unpack8(ho[u][hh], o8);
#pragma unroll
                for (int e2 = 0; e2 < 8; ++e2) { v[hh * 8 + e2] = a8[e2] + b8[e2]; o[hh * 8 + e2] = o8[e2]; } }
            float s = 0.f;
#pragma unroll
            for (int e2 = 0; e2 < 16; ++e2) s += v[e2];
            s += shx<1>(s); s += shx<2>(s); s += shx<4>(s); s += shx<8>(s);
            const float mean = s * (1.0f / 256.0f); float qq = 0.f;
#pragma unroll
            for (int e2 = 0; e2 < 16; ++e2) { v[e2] -= mean; qq += v[e2] * v[e2]; }
            qq += shx<1>(qq); qq += shx<2>(qq); qq += shx<4>(qq); qq += shx<8>(qq);
            const float rstd = rsqrtf(qq * (1.0f / 256.0f) + 1e-6f);
            float y8[8];
#pragma unroll
            for (int hh = 0; hh < 2; ++hh) {
#pragma unroll
                for (int e2 = 0; e2 < 8; ++e2) { const int ee = hh * 8 + e2; y8[e2] = (v[ee] * rstd * ng[c0 + ee] + nb[c0 + ee]) * sigmoidf_(o[ee]); }
                st_op8(ML, (size_t)r * 1024 + c0 + hh * 8, y8); } } }
    }
}


__device__ __forceinline__ void tshift8(const bf16_t* P, size_t row, int srow, int col, const float* mu, float (&o)[8]) {
    float z[8], zp[8], zn[8];
    const bool hp = (srow != 0 && srow != CTXL), hn = (srow != CTXL - 1 && srow != TB - 1);
    const u32x4 wz = *(const u32x4*)(P + row * PW + col), wp = *(const u32x4*)(P + (hp ? row - 1 : row) * PW + col), wn = *(const u32x4*)(P + (hn ? row + 1 : row) * PW + col);
    const f32x4 m0 = *(const f32x4*)mu, m1 = *(const f32x4*)(mu + 4);
    unpack8(wz, z); unpack8(wp, zp); unpack8(wn, zn);
    const float fp = hp ? 0.5f : 0.f, fn = hn ? 0.5f : 0.f;
#pragma unroll
    for (int e = 0; e < 8; ++e) { const float m = e < 4 ? m0[e & 3] : m1[e & 3]; o[e] = z[e] + m * (fp * zp[e] + fn * zn[e] - z[e]); }
}
__device__ __forceinline__ void rwkv_item(const Frame& F, int tid, int layer, int item) {
    const int h = item & 15, b = (item >> 4) & 3, d = item >> 6;
    const int lane = tid & 63, wave = __builtin_amdgcn_readfirstlane(tid >> 6), l15 = lane & 15, q = lane >> 4;
    LAS float* r_ = (LAS float*)F.lds;
    LAS float* w_ = r_ + 4096, *kd_ = w_ + 4096, *kk_ = kd_ + 4096, *bb_ = kk_ + 4096, *v_ = bb_ + 4096;
    LAS bf16_t* TW = (LAS bf16_t*)(v_ + 4096);
    LAS bf16_t* TA = TW + 64 * 72;
    LAS bf16_t* WU = TA + 64 * 72;
    LAS bf16_t* AU = WU + 64 * 72;
    LAS float* yout = (LAS float*)TW;
    const bf16_t* P = (const bf16_t*)(F.ws + WS_P);
    bf16_t* YO = (bf16_t*)(F.ws + WS_SC + (d == 0 ? SC_RWF : SC_RWB));
    float* BON = (float*)(F.ws + WS_BONUS) + (size_t)d * R * 16;
    const float* mu = F.in[I_RWMU] + layer * 3456;
    {
        const int rr = tid >> 3, c0 = (tid & 7) * 8;
        const float* wu = F.in[I_RWWUP] + (((size_t)layer * 2 + d) * 64 + rr) * 1024 + h * 64 + c0; const float* au = F.in[I_RWAUP] + (((size_t)layer * 2 + d) * 64 + rr) * 1024 + h * 64 + c0;
#pragma unroll
        for (int e = 0; e < 8; ++e) { WU[(c0 + e) * 72 + rr] = f2bf(wu[e]); AU[(c0 + e) * 72 + rr] = f2bf(au[e]); }
    }
    const int t_ = tid >> 3, c0 = (tid & 7) * 8;
    float mur[8], muk[8], muv[8], muw[8], mua[8], kkc[8], kac[8], rkc[8];
#pragma unroll
    for (int e = 0; e < 8; ++e) { mur[e] = mu[h * 64 + c0 + e]; muk[e] = mu[1024 + h * 64 + c0 + e]; muv[e] = mu[2048 + h * 64 + c0 + e]; muw[e] = mu[3072 + d * 64 + c0 + e]; mua[e] = mu[3200 + d * 64 + c0 + e];
        kkc[e] = F.in[I_RWKK][layer * 1024 + h * 64 + c0 + e]; kac[e] = F.in[I_RWKA][layer * 1024 + h * 64 + c0 + e]; rkc[e] = F.in[I_RWRK][layer * 1024 + h * 64 + c0 + e]; }
    float S[8];
#pragma unroll
    for (int e = 0; e < 8; ++e) S[e] = 0.f;
    const int vrow = tid >> 3, cg = tid & 7;
    __syncthreads();
    for (int j = 0; j < NCH; ++j) {
        const int jn = nat_chunk(d, j); const int srow = jn * 64 + (d == 0 ? t_ : 63 - t_); const size_t row = (size_t)b * TB + srow;
        float rs[8], ks[8], vs[8], tmp[8];
        tshift8(P, row, srow, PC_RR + h * 64 + c0, mur, rs); tshift8(P, row, srow, PC_RK + h * 64 + c0, muk, ks); tshift8(P, row, srow, PC_RV + h * 64 + c0, muv, vs);
        tshift8(P, row, srow, PC_WD + d * 64 + c0, muw, tmp);
#pragma unroll
        for (int e = 0; e < 8; ++e) TW[t_ * 72 + c0 + e] = f2bf(tanhf_(tmp[e]));
        tshift8(P, row, srow, PC_AD + d * 64 + c0, mua, tmp);
#pragma unroll
        for (int e = 0; e < 8; ++e) TA[t_ * 72 + c0 + e] = f2bf(tmp[e]);
        float kkv[8], ss = 0.f;
#pragma unroll
        for (int e = 0; e < 8; ++e) { r_[t_ * 64 + c0 + e] = rs[e]; v_[t_ * 64 + c0 + e] = vs[e]; kkv[e] = ks[e] * kkc[e]; ss += kkv[e] * kkv[e]; }
        ss += shx<1>(ss); ss += shx<2>(ss); ss += shx<4>(ss);
        const float inv = 1.0f / fmaxf(sqrtf(ss), 1e-12f);
        __syncthreads();
        {
            const int tr = wave >> 1;
#pragma unroll
            for (int u = 0; u < 2; ++u) { const int tc = (wave & 1) * 2 + u; f32x4 aw = (f32x4){0.f, 0.f, 0.f, 0.f}, aa = aw;
#pragma unroll
                for (int kq = 0; kq < 2; ++kq) { aw = MFMA16(ldsA(TW + (tr * 16 + l15) * 72 + kq * 32 + q * 8), ldsA(WU + (tc * 16 + l15) * 72 + kq * 32 + q * 8), aw);
                    aa = MFMA16(ldsA(TA + (tr * 16 + l15) * 72 + kq * 32 + q * 8), ldsA(AU + (tc * 16 + l15) * 72 + kq * 32 + q * 8), aa); }
                const int c = tc * 16 + l15; const float w0 = F.in[I_RWW0][((size_t)layer * 2 + d) * 1024 + h * 64 + c], a0 = F.in[I_RWA0][((size_t)layer * 2 + d) * 1024 + h * 64 + c];
#pragma unroll
                for (int i = 0; i < 4; ++i) { const int t = tr * 16 + q * 4 + i; w_[t * 64 + c] = __expf(-0.6065306597126334f * sigmoidf_(w0 + aw[i])); bb_[t * 64 + c] = sigmoidf_(a0 + aa[i]); } }
        }
        __syncthreads();
        { float bon = 0.f;
#pragma unroll
          for (int e = 0; e < 8; ++e) { const float a = bb_[t_ * 64 + c0 + e]; const float kdv = ks[e] * (1.0f + (a - 1.0f) * kac[e]); const float kkn = kkv[e] * inv;
              kd_[t_ * 64 + c0 + e] = kdv; kk_[t_ * 64 + c0 + e] = kkn; bb_[t_ * 64 + c0 + e] = kkn * a; bon += rs[e] * kdv * rkc[e]; }
          bon += shx<1>(bon); bon += shx<2>(bon); bon += shx<4>(bon);
          if ((tid & 7) == 0) BON[row * 16 + h] = bon; }
        __syncthreads();
        for (int t = 0; t < 64; ++t) {
            const LAS f32x4* pk = (const LAS f32x4*)(kk_ + t * 64 + cg * 8); const LAS f32x4* pw = (const LAS f32x4*)(w_ + t * 64 + cg * 8);
            const LAS f32x4* pb = (const LAS f32x4*)(bb_ + t * 64 + cg * 8); const LAS f32x4* pd = (const LAS f32x4*)(kd_ + t * 64 + cg * 8); const LAS f32x4* pr = (const LAS f32x4*)(r_ + t * 64 + cg * 8);
            const f32x4 k0 = pk[0], k1 = pk[1], w0 = pw[0], w1 = pw[1], b0 = pb[0], b1 = pb[1], d0 = pd[0], d1 = pd[1], r0 = pr[0], r1 = pr[1];
            const float vv = v_[t * 64 + vrow];
            float skk = (S[0] * k0[0] + S[1] * k0[1]) + (S[2] * k0[2] + S[3] * k0[3]) + (S[4] * k1[0] + S[5] * k1[1]) + (S[6] * k1[2] + S[7] * k1[3]);
            skk += shx<1>(skk); skk += shx<2>(skk); skk += shx<4>(skk);
#pragma unroll
            for (int e = 0; e < 4; ++e) { S[e] = S[e] * w0[e] - skk * b0[e] + vv * d0[e]; S[4 + e] = S[4 + e] * w1[e] - skk * b1[e] + vv * d1[e]; }
            float y = (S[0] * r0[0] + S[1] * r0[1]) + (S[2] * r0[2] + S[3] * r0[3]) + (S[4] * r1[0] + S[5] * r1[1]) + (S[6] * r1[2] + S[7] * r1[3]);
            y += shx<1>(y); y += shx<2>(y); y += shx<4>(y);
            if (cg == 0) yout[t * 64 + vrow] = y;
        }
        __syncthreads();
        { float yv[8];
#pragma unroll
          for (int e = 0; e < 8; ++e) yv[e] = yout[t_ * 64 + c0 + e];
          u32x4 w; w.x = pk_bf16(yv[0], yv[1]); w.y = pk_bf16(yv[2], yv[3]); w.z = pk_bf16(yv[4], yv[5]); w.w = pk_bf16(yv[6], yv[7]);
          *(u32x4*)(YO + row * 1024 + h * 64 + c0) = w; }
        __syncthreads();
    }
}

#define MFMAF32(a, b, c) __builtin_amdgcn_mfma_f32_16x16x4f32((a), (b), (c), 0, 0, 0)
__device__ __forceinline__ f32x4 mm16(const f32x4 P, const f32x4 Y) {
    f32x4 acc = (f32x4){0.f, 0.f, 0.f, 0.f};
#pragma unroll
    for (int i = 0; i < 4; ++i) acc = MFMAF32(P[i], Y[i], acc);
    return acc;
}
__device__ __forceinline__ bf16x8 pack_lo4(const f32x4 x) { u32x4 w; w.x = pk_bf16(x[0], x[1]); w.y = pk_bf16(x[2], x[3]); w.z = 0u; w.w = 0u; bf16x8 r; __builtin_memcpy(&r, &w, 16); return r; }
__device__ __forceinline__ bf16x8 pack_hi4(const f32x4 x) { u32x4 w; w.x = 0u; w.y = 0u; w.z = pk_bf16(x[0], x[1]); w.w = pk_bf16(x[2], x[3]); bf16x8 r; __builtin_memcpy(&r, &w, 16); return r; }
#define WAVE_SYNC() do { asm volatile("s_waitcnt lgkmcnt(0)" ::: "memory"); __builtin_amdgcn_wave_barrier(); } while (0)
constexpr int RWC_WREG = 15360;
constexpr int RWC_R0 = 0, RWC_R1 = 2304, RWC_R2 = 4608, RWC_R3 = 6912, RWC_BK = 9216, RWC_V = 13312, RWC_NN = RWC_R1, RWC_TM = RWC_R1 + 1024, RWC_GL = RWC_R1 + 1536;
__device__ __forceinline__ void rwkvc_item(const Frame& F, int tid, int layer, int item) {
    const int h = item & 15, b = (item >> 4) & 3, d = item >> 6;
    const int lane = tid & 63, wave = __builtin_amdgcn_readfirstlane(tid >> 6), l15 = lane & 15, q = lane >> 4;
    LAS bf16_t* WU = (LAS bf16_t*)F.lds;
    LAS bf16_t* AU = WU + 64 * 72;
    LAS unsigned char* wreg0 = F.lds + 2 * 64 * 72 * 2;
    LAS unsigned char* wb = wreg0 + wave * RWC_WREG;
    LAS float* MUL = (LAS float*)(wreg0 + 8 * RWC_WREG);
    const bf16_t* P = (const bf16_t*)(F.ws + WS_P);
    bf16_t* YO = (bf16_t*)(F.ws + WS_SC + (d == 0 ? SC_RWF : SC_RWB));
    float* BON = (float*)(F.ws + WS_BONUS) + (size_t)d * R * 16;
    const float* mu = F.in[I_RWMU] + layer * 3456;
    if (tid < 320) { const int a = tid >> 6, c = tid & 63; const int off = a == 0 ? h * 64 : a == 1 ? 1024 + h * 64 : a == 2 ? 2048 + h * 64 : a == 3 ? 3072 + d * 64 : 3200 + d * 64; MUL[tid] = mu[off + c]; }
    {   const int rr = tid >> 3, c0 = (tid & 7) * 8;
        const float* wu = F.in[I_RWWUP] + (((size_t)layer * 2 + d) * 64 + rr) * 1024 + h * 64 + c0; const float* au = F.in[I_RWAUP] + (((size_t)layer * 2 + d) * 64 + rr) * 1024 + h * 64 + c0;
#pragma unroll
        for (int e = 0; e < 8; ++e) { WU[(c0 + e) * 72 + rr] = f2bf(wu[e]); AU[(c0 + e) * 72 + rr] = f2bf(au[e]); } }
    float kkc[4], kac[4], rkc[4], w0c[4], a0c[4];
#pragma unroll
    for (int ct = 0; ct < 4; ++ct) { const int c = h * 64 + ct * 16 + l15; kkc[ct] = F.in[I_RWKK][layer * 1024 + c]; kac[ct] = F.in[I_RWKA][layer * 1024 + c]; rkc[ct] = F.in[I_RWRK][layer * 1024 + c];
        w0c[ct] = F.in[I_RWW0][((size_t)layer * 2 + d) * 1024 + c]; a0c[ct] = F.in[I_RWA0][((size_t)layer * 2 + d) * 1024 + c]; }
    f32x4 Sacc[4];
#pragma unroll
    for (int x = 0; x < 4; ++x) Sacc[x] = (f32x4){0.f, 0.f, 0.f, 0.f};
    __syncthreads();
    for (int rnd = 0; rnd < NCH * 4 / 8; ++rnd) {
        {
            const int ch = rnd * 8 + wave, j64 = ch >> 2, jn = nat_chunk(d, j64), o0 = (ch & 3) * 16;
            LAS bf16_t* R0 = (LAS bf16_t*)(wb + RWC_R0); LAS bf16_t* R1 = (LAS bf16_t*)(wb + RWC_R1); LAS bf16_t* R2 = (LAS bf16_t*)(wb + RWC_R2); LAS bf16_t* R3 = (LAS bf16_t*)(wb + RWC_R3);
            LAS bf16_t* TAp = (LAS bf16_t*)(wb + RWC_BK); LAS bf16_t* BKT = (LAS bf16_t*)(wb + RWC_BK); LAS bf16_t* VF = (LAS bf16_t*)(wb + RWC_V);
            {
                const int t = lane >> 2, cq = (lane & 3) * 16; const int o = o0 + t; const int srow = jn * 64 + (d == 0 ? o : 63 - o); const size_t row = (size_t)b * TB + srow;
                const bool hp = (srow != 0 && srow != CTXL), hn = (srow != CTXL - 1 && srow != TB - 1); const float fp = hp ? 0.5f : 0.f, fn = hn ? 0.5f : 0.f;
                const bf16_t* pz = P + row * PW; const bf16_t* pp = P + (hp ? row - 1 : row) * PW; const bf16_t* pn = P + (hn ? row + 1 : row) * PW;
                const int colA[5] = {PC_RR + h * 64, PC_RK + h * 64, PC_RV + h * 64, PC_WD + d * 64, PC_AD + d * 64};
                u32x4 wz[5][2], wp[5][2], wn[5][2];
#pragma unroll
                for (int a = 0; a < 5; ++a)
#pragma unroll
                    for (int hh = 0; hh < 2; ++hh) { const int c = colA[a] + cq + hh * 8; wz[a][hh] = *(const u32x4*)(pz + c); wp[a][hh] = *(const u32x4*)(pp + c); wn[a][hh] = *(const u32x4*)(pn + c); }
                LAS bf16_t* dst[5] = {R0, R1, R2, R3, TAp};
#pragma unroll
                for (int a = 0; a < 5; ++a)
#pragma unroll
                    for (int hh = 0; hh < 2; ++hh) { const int cc = cq + hh * 8; float z[8], zp[8], zn[8], x8[8];
                        unpack8(wz[a][hh], z); unpack8(wp[a][hh], zp); unpack8(wn[a][hh], zn);
                        const f32x4 m0 = *(const LAS f32x4*)(MUL + a * 64 + cc), m1 = *(const LAS f32x4*)(MUL + a * 64 + cc + 4);
#pragma unroll
                        for (int e = 0; e < 8; ++e) { const float m = e < 4 ? m0[e & 3] : m1[e & 3]; x8[e] = z[e] + m * (fp * zp[e] + fn * zn[e] - z[e]); if (a == 3) x8[e] = tanhf_(x8[e]); }
                        u32x4 w; w.x = pk_bf16(x8[0], x8[1]); w.y = pk_bf16(x8[2], x8[3]); w.z = pk_bf16(x8[4], x8[5]); w.w = pk_bf16(x8[6], x8[7]); *(LAS u32x4*)(dst[a] + t * 72 + cc) = w; }
            }
            WAVE_SYNC();
            f32x4 lw[4], av[4];
            {   const bf16x8 tw0 = ldsA(R3 + l15 * 72 + q * 8), tw1 = ldsA(R3 + l15 * 72 + 32 + q * 8), ta0 = ldsA(TAp + l15 * 72 + q * 8), ta1 = ldsA(TAp + l15 * 72 + 32 + q * 8);
#pragma unroll
                for (int ct = 0; ct < 4; ++ct) { f32x4 aw = (f32x4){0.f, 0.f, 0.f, 0.f}, aa = aw;
                    aw = MFMA16(tw0, ldsA(WU + (ct * 16 + l15) * 72 + q * 8), aw); aw = MFMA16(tw1, ldsA(WU + (ct * 16 + l15) * 72 + 32 + q * 8), aw);
                    aa = MFMA16(ta0, ldsA(AU + (ct * 16 + l15) * 72 + q * 8), aa); aa = MFMA16(ta1, ldsA(AU + (ct * 16 + l15) * 72 + 32 + q * 8), aa);
#pragma unroll
                    for (int i = 0; i < 4; ++i) { lw[ct][i] = -0.6065306597126334f * sigmoidf_(w0c[ct] + aw[i]); av[ct][i] = sigmoidf_(a0c[ct] + aa[i]); } } }
            WAVE_SYNC();
            float ssq[4] = {0.f, 0.f, 0.f, 0.f};
#pragma unroll
            for (int ct = 0; ct < 4; ++ct)
#pragma unroll
                for (int i = 0; i < 4; ++i) { const float kk = bf2f(R1[(q * 4 + i) * 72 + ct * 16 + l15]) * kkc[ct]; ssq[i] += kk * kk; }
            float inv[4];
#pragma unroll
            for (int i = 0; i < 4; ++i) { float s = ssq[i]; s += shx<1>(s); s += shx<2>(s); s += shx<4>(s); s += shx<8>(s); inv[i] = 1.0f / fmaxf(sqrtf(s), 1e-12f); }
            float bon[4] = {0.f, 0.f, 0.f, 0.f};
            bf16x8 Apk[4];
            float glv[4];
#pragma unroll
            for (int ct = 0; ct < 4; ++ct) {
                f32x4 lg; lg[0] = lw[ct][0]; lg[1] = lg[0] + lw[ct][1]; lg[2] = lg[1] + lw[ct][2]; lg[3] = lg[2] + lw[ct][3];
                const float tot = lg[3];
                float x1 = tot; { const float t1 = shup(x1, 16, lane); if (q >= 1) x1 += t1; }
                float x2 = x1;  { const float t2 = shup(x1, 32, lane); if (q >= 2) x2 += t2; }
                const float excl = x2 - tot;
                const float lgL = __int_as_float(__builtin_amdgcn_ds_bpermute((48 + l15) << 2, __float_as_int(x2)));
                f32x4 At, Bh, Kh, vv; const float eex = __expf(excl), egL = __expf(lgL); float egprev = eex;
#pragma unroll
                for (int i = 0; i < 4; ++i) { const int idx = (q * 4 + i) * 72 + ct * 16 + l15; const float lgt = excl + lg[i];
                    const float rs = bf2f(R0[idx]), ks = bf2f(R1[idx]), vs = bf2f(R2[idx]); const float a = av[ct][i];
                    const float kkn = ks * kkc[ct] * inv[i], kd = ks * (1.0f + (a - 1.0f) * kac[ct]), beta = -kkn * a;
                    bon[i] += rs * kd * rkc[ct];
                    const float eg = __expf(lgt), egm = (i == 0) ? eex : egprev, ig = __builtin_amdgcn_rcpf(eg), gl = egL * ig; egprev = eg;
                    At[i] = kkn * egm; R0[idx] = f2bf(At[i]); R3[idx] = f2bf(rs * eg); R1[idx] = f2bf(beta * ig); R2[idx] = f2bf(kd * ig);
                    Bh[i] = beta * gl; Kh[i] = kd * gl; vv[i] = vs; }
                Apk[ct] = pack_lo4(At);
                { u32x2 w; w.x = pk_bf16(Bh[0], Bh[1]); w.y = pk_bf16(Bh[2], Bh[3]); *(LAS u32x2*)(BKT + (ct * 16 + l15) * 32 + q * 4) = w;
                  w.x = pk_bf16(Kh[0], Kh[1]); w.y = pk_bf16(Kh[2], Kh[3]); *(LAS u32x2*)(BKT + (ct * 16 + l15) * 32 + 16 + q * 4) = w;
                  w.x = pk_bf16(vv[0], vv[1]); w.y = pk_bf16(vv[2], vv[3]); *(LAS u32x2*)(VF + (ct * 64 + lane) * 4) = w; }
                glv[ct] = egL;
            }
#pragma unroll
            for (int i = 0; i < 4; ++i) { float s = bon[i]; s += shx<1>(s); s += shx<2>(s); s += shx<4>(s); s += shx<8>(s);
                if (l15 == 0) { const int o = o0 + q * 4 + i; const int srow = jn * 64 + (d == 0 ? o : 63 - o); BON[((size_t)b * TB + srow) * 16 + h] = s; } }
            WAVE_SYNC();
            f32x4 Mab = (f32x4){0.f, 0.f, 0.f, 0.f}, MabT = Mab, Mak = Mab, Nrb = Mab, Nrk = Mab;
#pragma unroll
            for (int kq = 0; kq < 2; ++kq) { const bf16x8 fa = ldsA(R0 + l15 * 72 + kq * 32 + q * 8), fr = ldsA(R3 + l15 * 72 + kq * 32 + q * 8), fb = ldsA(R1 + l15 * 72 + kq * 32 + q * 8), fk = ldsA(R2 + l15 * 72 + kq * 32 + q * 8);
                Mab = MFMA16(fa, fb, Mab); MabT = MFMA16(fb, fa, MabT); Mak = MFMA16(fa, fk, Mak); Nrb = MFMA16(fr, fb, Nrb); Nrk = MFMA16(fr, fk, Nrk); }
#pragma unroll
            for (int i = 0; i < 4; ++i) { const int rr_ = q * 4 + i; if (!(l15 < rr_)) { Mab[i] = 0.f; Mak[i] = 0.f; } if (!(rr_ < l15)) MabT[i] = 0.f; if (!(l15 <= rr_)) { Nrb[i] = 0.f; Nrk[i] = 0.f; } }
            f32x4 TT;
            {   f32x4 eye;
#pragma unroll
                for (int i = 0; i < 4; ++i) eye[i] = (q * 4 + i == l15) ? 1.0f : 0.0f;
                const f32x4 M2 = mm16(MabT, Mab), N2 = mm16(Mab, MabT);
                const f32x4 M4 = mm16(N2, M2), N4 = mm16(M2, N2);
                const f32x4 N8 = mm16(M4, N4);
                const f32x4 W1 = mm16(M4 + eye, N8 + eye);
                const f32x4 W2 = mm16(M2 + eye, W1);
                TT = mm16(Mab + eye, W2); }
            WAVE_SYNC();
            {   const bf16x8 Tp = pack_lo4(TT);
                LAS bf16_t* AH = R0; LAS bf16_t* NN = (LAS bf16_t*)(wb + RWC_NN); LAS bf16_t* TMm = (LAS bf16_t*)(wb + RWC_TM);
#pragma unroll
                for (int ct = 0; ct < 4; ++ct) { f32x4 ah = (f32x4){0.f, 0.f, 0.f, 0.f}; ah = MFMA16(Tp, Apk[ct], ah);
#pragma unroll
                    for (int i = 0; i < 4; ++i) AH[(q * 4 + i) * 72 + ct * 16 + l15] = f2bf(ah[i]); }
                f32x4 tm = (f32x4){0.f, 0.f, 0.f, 0.f}; tm = MFMA16(Tp, pack_lo4(Mak), tm);
#pragma unroll
                for (int i = 0; i < 4; ++i) { const int t = q * 4 + i; NN[t * 32 + l15] = f2bf(Nrb[i]); NN[t * 32 + 16 + l15] = f2bf(Nrk[i]); TMm[t * 16 + l15] = f2bf(tm[i]); }
                if (q == 0) {
#pragma unroll
                    for (int ct = 0; ct < 4; ++ct) ((LAS float*)(wb + RWC_GL))[ct * 16 + l15] = glv[ct]; } }
        }
        __syncthreads();
        if (wave < 4) {
            for (int c = 0; c < 8; ++c) {
                const LAS unsigned char* sb = wreg0 + c * RWC_WREG;
                const LAS bf16_t* AH = (const LAS bf16_t*)(sb + RWC_R0); const LAS bf16_t* RT = (const LAS bf16_t*)(sb + RWC_R3); const LAS bf16_t* BKT = (const LAS bf16_t*)(sb + RWC_BK);
                const LAS bf16_t* VF = (const LAS bf16_t*)(sb + RWC_V); const LAS bf16_t* NN = (const LAS bf16_t*)(sb + RWC_NN); const LAS bf16_t* TMm = (const LAS bf16_t*)(sb + RWC_TM); const LAS float* GL = (const LAS float*)(sb + RWC_GL);
                const bf16x8 Sb0 = pack_8(Sacc[0], Sacc[1]), Sb1 = pack_8(Sacc[2], Sacc[3]);
                const u32x2 vw = *(const LAS u32x2*)(VF + (wave * 64 + lane) * 4);
                bf16x8 V0; { u32x4 w; w.x = 0u; w.y = 0u; w.z = vw.x; w.w = vw.y; __builtin_memcpy(&V0, &w, 16); }
                bf16x8 TMf; { const u32x2 tq = *(const LAS u32x2*)(TMm + l15 * 16 + q * 4); u32x4 w; w.x = 0u; w.y = 0u; w.z = tq.x; w.w = tq.y; __builtin_memcpy(&TMf, &w, 16); }
                f32x4 U = (f32x4){0.f, 0.f, 0.f, 0.f};
                U = MFMA16(lds_2x8(AH + l15 * 72 + q * 4, AH + l15 * 72 + 16 + q * 4), Sb0, U);
                U = MFMA16(lds_2x8(AH + l15 * 72 + 32 + q * 4, AH + l15 * 72 + 48 + q * 4), Sb1, U);
                U = MFMA16(TMf, V0, U);
                bf16x8 UV; { u32x4 w; w.x = pk_bf16(U[0], U[1]); w.y = pk_bf16(U[2], U[3]); w.z = vw.x; w.w = vw.y; __builtin_memcpy(&UV, &w, 16); }
                f32x4 Y = (f32x4){0.f, 0.f, 0.f, 0.f};
                Y = MFMA16(lds_2x8(RT + l15 * 72 + q * 4, RT + l15 * 72 + 16 + q * 4), Sb0, Y);
                Y = MFMA16(lds_2x8(RT + l15 * 72 + 32 + q * 4, RT + l15 * 72 + 48 + q * 4), Sb1, Y);
                Y = MFMA16(lds_2x8(NN + l15 * 32 + q * 4, NN + l15 * 32 + 16 + q * 4), UV, Y);
#pragma unroll
                for (int x = 0; x < 4; ++x) { const f32x4 gl = *(const LAS f32x4*)(GL + x * 16 + q * 4); Sacc[x] *= gl;
                    Sacc[x] = MFMA16(lds_2x8(BKT + (x * 16 + l15) * 32 + q * 4, BKT + (x * 16 + l15) * 32 + 16 + q * 4), UV, Sacc[x]); }
                const int ch = rnd * 8 + c, j64 = ch >> 2, jn = nat_chunk(d, j64), o0 = (ch & 3) * 16;
#pragma unroll
                for (int i = 0; i < 4; ++i) { const int o = o0 + q * 4 + i; const int srow = jn * 64 + (d == 0 ? o : 63 - o);
                    YO[((size_t)b * TB + srow) * 1024 + h * 64 + wave * 16 + l15] = f2bf(Y[i]); }
            }
        }
        __syncthreads();
    }
}

__device__ __forceinline__ void rw_finish_item(const Frame& F, int tid, int layer, int it) {
    const int lane = tid & 63, wave = __builtin_amdgcn_readfirstlane(tid >> 6), l15 = lane & 15, q = lane >> 4;
    constexpr int YP = 1032;
    LAS bf16_t* GA = (LAS bf16_t*)F.lds;
    LAS float* mean_ = (LAS float*)(GA + 32 * 136);
    LAS float* rstd_ = mean_ + 512, *bon_ = rstd_ + 512;
    LAS bf16_t* YS = (LAS bf16_t*)(bon_ + 512);
    LAS bf16_t* VS = YS + 32 * YP;
    const bf16_t* P = (const bf16_t*)(F.ws + WS_P);
    const bf16_t* YF = (const bf16_t*)(F.ws + WS_SC + SC_RWF); const bf16_t* YB = (const bf16_t*)(F.ws + WS_SC + SC_RWB); void* RWO = (void*)(F.ws + WS_SC + SC_RWO);
    const float* BON = (const float*)(F.ws + WS_BONUS); const bf16_t* GUPT = (const bf16_t*)(F.ws + WS_GUPT);
    const float* mu = F.in[I_RWMU] + layer * 3456;
    const int hf = it & 1, it2 = it >> 1;
    const int b = it2 / NCH, jn = it2 - b * NCH; const size_t rb = (size_t)b * TB + jn * 64 + hf * 32; const int sb = jn * 64 + hf * 32;
#pragma unroll
    for (int i = 0; i < 9; ++i) { const int id = tid + i * NTHR; if (id < 34 * 128) { const int r = id >> 7, pc = id & 127; long gr = (long)rb - 1 + r; gr = gr < 0 ? 0 : (gr > R - 1 ? R - 1 : gr);
        *(LAS u32x4*)(VS + r * YP + pc * 8) = *(const u32x4*)(P + (size_t)gr * PW + PC_RV + pc * 8); } }
    if (tid < 256) { const int t = tid >> 3, c0 = (tid & 7) * 16;
#pragma unroll
      for (int hh = 0; hh < 2; ++hh) { float m8[8], g8[8];
#pragma unroll
          for (int e = 0; e < 8; ++e) m8[e] = mu[3328 + c0 + hh * 8 + e];
          tshift8(P, rb + t, sb + t, PC_GD + c0 + hh * 8, m8, g8);
#pragma unroll
          for (int e = 0; e < 8; ++e) GA[t * 136 + c0 + hh * 8 + e] = f2bf(sigmoidf_(g8[e])); } }
    { const int p = tid, t = p >> 4, hd = p & 15; const size_t row = rb + t; float v[64]; float s = 0.f;
#pragma unroll
        for (int c8 = 0; c8 < 8; ++c8) { float a[8], bq[8]; unpack8(*(const u32x4*)(YF + row * 1024 + hd * 64 + c8 * 8), a); unpack8(*(const u32x4*)(YB + row * 1024 + hd * 64 + c8 * 8), bq);
#pragma unroll
            for (int e = 0; e < 8; ++e) { v[c8 * 8 + e] = a[e] + bq[e]; s += v[c8 * 8 + e]; } }
        const float mean = s * (1.0f / 64.0f); float qq = 0.f;
#pragma unroll
        for (int e = 0; e < 64; ++e) { const float dlt = v[e] - mean; qq += dlt * dlt; }
        mean_[t * 16 + hd] = mean; rstd_[t * 16 + hd] = rsqrtf(qq * (1.0f / 64.0f) + 64e-5f);
        bon_[t * 16 + hd] = BON[row * 16 + hd] + BON[((size_t)R + row) * 16 + hd];
#pragma unroll
        for (int c8 = 0; c8 < 8; ++c8) { u32x4 w; w.x = pk_bf16(v[c8 * 8], v[c8 * 8 + 1]); w.y = pk_bf16(v[c8 * 8 + 2], v[c8 * 8 + 3]); w.z = pk_bf16(v[c8 * 8 + 4], v[c8 * 8 + 5]); w.w = pk_bf16(v[c8 * 8 + 6], v[c8 * 8 + 7]);
            *(LAS u32x4*)(YS + t * YP + hd * 64 + c8 * 8) = w; } }
    __syncthreads();
    const float* ng = F.in[I_RWNG] + layer * 1024; const float* nb = F.in[I_RWNB] + layer * 1024;
    float fpv[2], fnv[2];
#pragma unroll
    for (int rt = 0; rt < 2; ++rt) { const int srow = sb + rt * 16 + l15; const bool hp = (srow != 0 && srow != CTXL), hn = (srow != CTXL - 1 && srow != TB - 1); fpv[rt] = hp ? 0.5f : 0.f; fnv[rt] = hn ? 0.5f : 0.f; }
    bf16x8 afr[4]; f32x4 muv, ngc, nbc;
#define RWF_LOAD(cc_, AFR, MUV, NGC, NBC) do { const int ct_ = wave * 8 + (cc_); const int c0_ = ct_ * 16 + q * 4; \
        _Pragma("unroll") for (int kq = 0; kq < 4; ++kq) AFR[kq] = *(const bf16x8*)(GUPT + (size_t)(ct_ * 16 + l15) * 128 + kq * 32 + q * 8); \
        MUV = *(const f32x4*)(mu + 2048 + c0_); NGC = *(const f32x4*)(ng + c0_); NBC = *(const f32x4*)(nb + c0_); } while (0)
    RWF_LOAD(0, afr, muv, ngc, nbc);
#pragma unroll
    for (int cc = 0; cc < 8; ++cc) { const int ct = wave * 8 + cc; const int c0 = ct * 16 + q * 4, hd = c0 >> 6;
        bf16x8 afr2[4]; f32x4 muv2, ngc2, nbc2;
        if (cc + 1 < 8) RWF_LOAD(cc + 1, afr2, muv2, ngc2, nbc2);
#pragma unroll
        for (int rt = 0; rt < 2; ++rt) { f32x4 acc = (f32x4){0.f, 0.f, 0.f, 0.f};
#pragma unroll
            for (int kq = 0; kq < 4; ++kq) acc = MFMA16(afr[kq], ldsA(GA + (rt * 16 + l15) * 136 + kq * 32 + q * 8), acc);
            const int t = rt * 16 + l15; const size_t row = rb + t;
            const float fp = fpv[rt], fn = fnv[rt]; const float mean = mean_[t * 16 + hd], rstd = rstd_[t * 16 + hd], bon = bon_[t * 16 + hd];
            const u32x2 wy = *(const LAS u32x2*)(YS + t * YP + c0), wz = *(const LAS u32x2*)(VS + (t + 1) * YP + c0), wp = *(const LAS u32x2*)(VS + t * YP + c0), wn = *(const LAS u32x2*)(VS + (t + 2) * YP + c0);
            float o4[4];
#pragma unroll
            for (int i = 0; i < 4; ++i) { const unsigned sf = 16u;
                const unsigned uy = (i < 2 ? wy.x : wy.y), uz = (i < 2 ? wz.x : wz.y), up = (i < 2 ? wp.x : wp.y), un = (i < 2 ? wn.x : wn.y);
                const float ys = (i & 1) ? __uint_as_float(uy & 0xffff0000u) : __uint_as_float(uy << sf);
                const float vz = (i & 1) ? __uint_as_float(uz & 0xffff0000u) : __uint_as_float(uz << sf), vp = (i & 1) ? __uint_as_float(up & 0xffff0000u) : __uint_as_float(up << sf), vn = (i & 1) ? __uint_as_float(un & 0xffff0000u) : __uint_as_float(un << sf);
                const float yn = (ys - mean) * rstd * ngc[i] + nbc[i];
                const float vsft = vz + muv[i] * (fp * vp + fn * vn - vz);
                o4[i] = (yn + bon * vsft) * acc[i]; }
            st_op4(RWO, row * 1024 + c0, o4[0], o4[1], o4[2], o4[3]); }
        if (cc + 1 < 8) {
#pragma unroll
            for (int kq = 0; kq < 4; ++kq) afr[kq] = afr2[kq];
            muv = muv2; ngc = ngc2; nbc = nbc2; }
    }
#undef RWF_LOAD
    __syncthreads();
}

__device__ __forceinline__ void phase_prep(const Frame& F, int layer) {
    const int tid = ltid();
    for (int it = F.bid; it < 64; it += F.G) s5_tables_item(F, tid, layer, it);
}
__device__ __forceinline__ void phase_gin(const Frame& F) {
    dense_gemm<0, false>(F, F.ws + WS_U, F.ws + WS_WIN, R, PW, 2048, F.ws + WS_P, nullptr, nullptr, PW);
}
__device__ __forceinline__ void phase_conv_s5a(const Frame& F, int layer) {
    const int tid = ltid(), lane = tid & 63;
    for (int it = F.bid; it < 528 + 144; it += F.G) { if (it < 528) conv_item(F, tid, layer, it); else s5a_wave_item(F, lane, (it - 528) * 8 + F.wave); }
}
__device__ __forceinline__ void phase_scan(const Frame& F, int layer) {
    const int tid = ltid();
    if (F.bid < 128) rwkvc_item(F, tid, layer, F.bid);
    else { if (F.bid < 192) { s5b_item(F, tid, layer, F.bid - 128); __syncthreads(); } mlstm_item(F, tid, layer, F.bid - 128); }
}
__device__ __forceinline__ void phase_fin(const Frame& F, int layer) {
    const int tid = ltid(), lane = tid & 63;
    for (int it = F.bid; it < 1056; it += F.G) rw_finish_item(F, tid, layer, it);
    for (int it = F.bid; it < 256; it += F.G) s5c_block_item(F, tid, it);
    ml_finish_rows(F, lane, layer);
}

#ifndef MK_ABL
#define MK_ABL 0
#endif
constexpr int NPH_LAYER = 19;
constexpr int NPH = 2 * NPH_LAYER;
__global__ void __launch_bounds__(NTHR, 2) mega_fwd(Args args) {
    extern __shared__ __attribute__((aligned(16))) unsigned char lds_raw[];
    Frame F; F.in = args.in; F.out = args.out; F.ws = args.ws; F.lds = (LAS unsigned char*)lds_raw;
    F.wave = __builtin_amdgcn_readfirstlane(threadIdx.x >> 6); F.G = gridDim.x; F.bid = blockIdx.x;
    volatile LAS unsigned* xbw = (volatile LAS unsigned*)(F.lds + LDS_BYTES - 16);
    if (threadIdx.x == 0) { xbw[0] = 0u; xbw[1] = 0u; xbw[2] = 0u; xbw[3] = 0u; }
    __syncthreads();
    const int lo = args.ph_lo, hi = args.ph_hi;
    const bool one_launch = (hi - lo) > 1;
    XcdBarrier bar; bar.bar = (unsigned*)(F.ws + WS_CTL) + CW_BAR; bar.x = 0; bar.st = xbw;
    if (one_launch) bar = xcd_barrier_post((unsigned*)(F.ws + WS_CTL) + CW_BAR, xbw);
#define IN(k) (lo <= (k) && (k) < hi)
#define SEAM(k) do { if (IN(k) && IN((k) + 1)) xcd_barrier(bar); } while (0)
#define TILE_SEAM() do { asm volatile("s_waitcnt vmcnt(0)" ::: "memory"); __syncthreads(); } while (0)
    bf16_t* const T1 = (bf16_t*)(F.ws + WS_T1); bf16_t* const T2 = (bf16_t*)(F.ws + WS_T2); bf16_t* const T1b = (bf16_t*)(F.ws + WS_SC + SC_RWF);     bf16_t* const Z = (bf16_t*)(F.ws + WS_Z); bf16_t* const MIX = (bf16_t*)(F.ws + WS_MIX);
    unsigned char* const Zop = F8 ? F.ws + WS_QK : F.ws + WS_Z;
    const unsigned char* const U = F.ws + WS_U; const unsigned char* const WG = F.ws + WS_WG; const unsigned char* const WML = F.ws + WS_WML;
    const unsigned char* const ML = F.ws + WS_SC + SC_ML; const unsigned char* const RWo = F.ws + WS_SC + SC_RWO; const unsigned char* const S5o = F.ws + WS_SC + SC_S5;
    for (int layer = 0; layer < 2; ++layer) {
        const int pb = layer * NPH_LAYER;
        const int rA = 0, rB = layer == 0 ? 32 : 0, rC = layer == 0 ? 64 : 0;
        if (IN(pb + 0)) { phase_prep(F, layer); if (layer == 0) phase_mods(F); phase_wprep(F, layer); }
        SEAM(pb + 0);
        if (IN(pb + 1)) { if (layer == 0) phase_ln1(F, layer); }
        if (layer == 0) SEAM(pb + 1);
        if (IN(pb + 2)) { phase_gin(F); }
        SEAM(pb + 2);
        if (IN(pb + 3)) { phase_conv_s5a(F, layer); }
        SEAM(pb + 3);
        if (IN(pb + 4)) { phase_scan(F, layer); }
        SEAM(pb + 4);
        if (IN(pb + 5)) { phase_fin(F, layer); }
        SEAM(pb + 5);
        if (IN(pb + 6)) { dense_gemm<0, false>(F, ML, WML, R, 2048, 1024, T1, nullptr, nullptr, 2048, layer == 1, rA); }
        TILE_SEAM();
        if (IN(pb + 8)) { dense_gemm<0, false>(F, RWo, WML + (size_t)1 * 2048 * 1024 * OPB, R, 2048, 1024, T1b, nullptr, nullptr, 2048, layer == 1, rB); }
        SEAM(pb + 8);
        if (IN(pb + 9)) { dense_gemm<6, false>(F, U, WG, R, 4096, 2048, Z, T1, T1b, 2048, layer == 1); }
        TILE_SEAM();
        if (IN(pb + 10)) { dense_gemm<5, false>(F, S5o, WML + (size_t)2 * 2048 * 1024 * OPB, R, 4096, 1024, T2, nullptr, nullptr, 2048, layer == 1); }
        SEAM(pb + 10);
        if (IN(pb + 12)) { dense_gemm<2, true>(F, U, WG + (size_t)4096 * 2048 * OPB, R, 2048, 2048, Zop, T2, Z, 2048, layer == 1, rC); }
        SEAM(pb + 12);
        if (IN(pb + 13)) { dense_gemm<0, false>(F, Zop, F.ws + WS_WOUT, R, 2048, 2048, MIX, nullptr, nullptr, 2048, layer == 1); }
        SEAM(pb + 13);
        if (IN(pb + 14)) { phase_post1_route(F, layer, true); }
        SEAM(pb + 14);
        if (IN(pb + 15)) { phase_gather(F, layer); }
        SEAM(pb + 15);
        if (IN(pb + 16)) { phase_moe_gemm(F, layer, 0); }
        SEAM(pb + 16);
        if (IN(pb + 17)) { phase_moe_gemm(F, layer, 1); }
        SEAM(pb + 17);
        if (IN(pb + 18)) { phase_post2_moe(F, layer, true); }
        SEAM(pb + 18);
    }
#undef IN
#undef SEAM
#undef TILE_SEAM
}

#ifndef MK_ONE_LAUNCH
#define MK_ONE_LAUNCH 1
#endif
extern "C" void kernel_launch(void* const* d_in, const int* in_sizes, int n_in, void* d_out, int out_size, void* d_ws, size_t ws_size, hipStream_t stream) {
    static int grid = 0;
    if (grid == 0) {
        if (n_in != N_IN || ws_size < WS_END) { fprintf(stderr, "kernel_launch: unexpected n_in %d / ws_size %zu (need %zu)\n", n_in, ws_size, (size_t)WS_END); grid = -1; return; }
        int dev = 0, cus = 0, per_cu = 0;
        if (hipGetDevice(&dev) != hipSuccess || hipDeviceGetAttribute(&cus, hipDeviceAttributeMultiprocessorCount, dev) != hipSuccess) { grid = -1; return; }
        if (hipFuncSetAttribute((const void*)mega_fwd, hipFuncAttributeMaxDynamicSharedMemorySize, LDS_BYTES) != hipSuccess) { fprintf(stderr, "kernel_launch: hipFuncSetAttribute failed\n"); grid = -1; return; }
        if (hipOccupancyMaxActiveBlocksPerMultiprocessor(&per_cu, (const void*)mega_fwd, NTHR, LDS_BYTES) != hipSuccess || per_cu < 1) { fprintf(stderr, "kernel_launch: occupancy query says %d\n", per_cu); }
        (void)hipGetLastError();
        grid = 256;
        if (cus != 256) fprintf(stderr, "kernel_launch: %d CUs, this kernel is laid out for 256\n", cus);
    }
    if (grid < 0) return;
    (void)hipMemsetAsync((char*)d_ws + WS_CTL, 0, CTL_BYTES, stream);
    Args a{};
    for (int i = 0; i < N_IN; ++i) a.in[i] = (const float*)d_in[i];
    a.out = (float*)d_out; a.ws = (unsigned char*)d_ws;
#if MK_ONE_LAUNCH
    a.ph_lo = 0; a.ph_hi = NPH;
    hipLaunchKernelGGL(mega_fwd, dim3(grid), dim3(NTHR), LDS_BYTES, stream, a);
#else
    for (int p = 0; p < NPH; ++p) { a.ph_lo = p; a.ph_hi = p + 1; hipLaunchKernelGGL(mega_fwd, dim3(grid), dim3(NTHR), LDS_BYTES, stream, a); }
#endif
}
```

```cpp
#include <hip/hip_runtime.h>
#include <stdint.h>
#include <stdio.h>

#define LAS __attribute__((address_space(3)))
typedef unsigned short bf16_t;
typedef short bf16x8 __attribute__((ext_vector_type(8)));
typedef float f32x4 __attribute__((ext_vector_type(4)));
typedef float f32x2 __attribute__((ext_vector_type(2)));
typedef unsigned u32x4 __attribute__((ext_vector_type(4)));
typedef unsigned u32x2 __attribute__((ext_vector_type(2)));

constexpr int D = 2048, NB = 4, SEQ = 8192, CTXL = 256, TB = SEQ + CTXL, R = NB * TB;
constexpr int NCH = TB / 64;
constexpr int PW = 8704;
constexpr int PC_Q = 0, PC_K = 1024, PC_V = 2048, PC_O = 3072, PC_IG = 4096, PC_FG = 4104, PC_RR = 4112, PC_RK = 5136, PC_RV = 6160,
              PC_WD = 7184, PC_AD = 7312, PC_GD = 7440, PC_S5 = 7568, PC_END = 8592;
constexpr int NTHR = 512, NWAVE = 8;
constexpr int LDS_BYTES = 163840;
constexpr float ALPHA = 1.4142135623730951f;
constexpr float LN_EPS = 1e-5f;

enum { I_X = 0, I_C, I_CTX, I_CCTX, I_ADAW, I_ADAB, I_WIN, I_MLCW, I_MLCB, I_MLIGB, I_MLFGB, I_MLNG, I_MLNB, I_MLPROJ, I_RWMU, I_RWW0, I_RWWUP, I_RWA0, I_RWAUP,
       I_RWGUP, I_RWKK, I_RWKA, I_RWRK, I_RWNG, I_RWNB, I_RWPROJ, I_S5LRE, I_S5LIM, I_S5LDT, I_S5BRE, I_S5BIM, I_S5CRE, I_S5CIM, I_S5D, I_S5WV, I_S5WG, I_WOUT,
       I_LN1G, I_LN1B, I_LN2G, I_LN2B, I_ROUTW, I_ROUTB, I_EWG, I_EWU, I_EWD, N_IN };

constexpr size_t al256(size_t x) { return (x + 255) & ~(size_t)255; }
constexpr size_t WS_CTL = 0, CTL_BYTES = 65536;
constexpr size_t WS_MODS = WS_CTL + CTL_BYTES;
constexpr size_t WS_ROUTE = al256(WS_MODS + 2 * 5 * 12288 * 4);
constexpr size_t WS_BONUS = al256(WS_ROUTE + (size_t)R * 8 * 4);
constexpr size_t WS_S5KC = al256(WS_BONUS + (size_t)2 * R * 16 * 4);
constexpr size_t WS_S5E = al256(WS_S5KC + (size_t)64 * 128 * 256 * 2);
constexpr size_t WS_S5F = al256(WS_S5E + (size_t)64 * 256 * 1024 * 2);
constexpr size_t WS_S5X = al256(WS_S5F + (size_t)64 * 1024 * 256 * 2);
constexpr size_t WS_GUPT = al256(WS_S5X + (size_t)64 * 528 * 256 * 4);
constexpr size_t WS_WIN = al256(WS_GUPT + (size_t)1024 * 128 * 2);
constexpr size_t WS_WG = al256(WS_WIN + (size_t)PW * D * 2);
constexpr size_t WS_WML = al256(WS_WG + (size_t)6144 * D * 2);
constexpr size_t WS_WOUT = al256(WS_WML + (size_t)4 * 2048 * 1024 * 2);
constexpr size_t WS_EGU = al256(WS_WOUT + (size_t)2048 * 2048 * 2);
constexpr size_t WS_EDN = al256(WS_EGU + (size_t)16 * 2048 * 2048 * 2);
constexpr size_t WS_P = al256(WS_EDN + (size_t)16 * 2048 * 1024 * 2);
constexpr size_t WS_U = al256(WS_P + (size_t)R * PW * 2);
constexpr size_t WS_QK = al256(WS_U + (size_t)R * D * 2);
constexpr size_t WS_SC = al256(WS_QK + (size_t)R * D * 2);
constexpr size_t SC_BYTES = (size_t)71680 * 2048 * 2;
constexpr size_t WS_XC = al256(WS_SC + SC_BYTES);
constexpr size_t WS_END = al256(WS_XC + (size_t)NB * CTXL * D * 4);
constexpr size_t WS_X1 = WS_P;
constexpr size_t WS_T1 = WS_P;
constexpr size_t WS_T2 = WS_P + (size_t)R * D * 2;
constexpr size_t WS_MIX = WS_P + (size_t)R * D * 4;
constexpr size_t WS_Z = WS_MIX + (size_t)R * D * 2;
static_assert(WS_Z + (size_t)R * D * 2 <= WS_U, "P-region aliases overflow");
static_assert(WS_END <= 1633652928ull, "workspace too large");

constexpr int CW_BAR = 0;
constexpr int CW_ECNT = 4096;

__device__ __forceinline__ float bf2f(bf16_t b) { return __uint_as_float(((unsigned)b) << 16); }
typedef __bf16 bf16x2_t __attribute__((ext_vector_type(2)));
__device__ __forceinline__ unsigned pk_bf16(float lo, float hi) { const f32x2 v = {lo, hi}; const bf16x2_t r = __builtin_convertvector(v, bf16x2_t); unsigned u; __builtin_memcpy(&u, &r, 4); return u; }
constexpr bool F8 = true;
constexpr int OPB = F8 ? 1 : 2;
constexpr float W8_SCALE = 64.0f;
typedef int v8i __attribute__((ext_vector_type(8)));
typedef int v4i __attribute__((ext_vector_type(4)));
__device__ __forceinline__ float clamp8(float x) { return fminf(fmaxf(x, -448.0f), 448.0f); }
__device__ __forceinline__ unsigned pk4_fp8(float a, float b, float c, float d) { int w = 0; w = __builtin_amdgcn_cvt_pk_fp8_f32(clamp8(a), clamp8(b), w, false); w = __builtin_amdgcn_cvt_pk_fp8_f32(clamp8(c), clamp8(d), w, true); return (unsigned)w; }
__device__ __forceinline__ bf16_t f2bf(float f) { return (bf16_t)(pk_bf16(f, 0.f) & 0xffffu); }
__device__ __forceinline__ float sigmoidf_(float x) { return __builtin_amdgcn_rcpf(1.0f + __expf(-x)); }
__device__ __forceinline__ float tanhf_(float x) { return 1.0f - 2.0f * __builtin_amdgcn_rcpf(1.0f + __expf(2.0f * x)); }
__device__ __forceinline__ void unpack8(const u32x4 p, float (&o)[8]) { const unsigned w[4] = {p.x, p.y, p.z, p.w};
#pragma unroll
    for (int e = 0; e < 4; ++e) { o[2 * e] = __uint_as_float(w[e] << 16); o[2 * e + 1] = __uint_as_float(w[e] & 0xffff0000u); } }
__device__ __forceinline__ void st_op4(void* base, size_t ei, float a, float b, float c, float d) {
    if (F8) *(unsigned*)((char*)base + ei) = pk4_fp8(a, b, c, d);
    else { u32x2 w; w.x = pk_bf16(a, b); w.y = pk_bf16(c, d); *(u32x2*)((char*)base + ei * 2) = w; } }
__device__ __forceinline__ void st_op8(void* base, size_t ei, const float (&v)[8]) {
    if (F8) { u32x2 w; w.x = pk4_fp8(v[0], v[1], v[2], v[3]); w.y = pk4_fp8(v[4], v[5], v[6], v[7]); *(u32x2*)((char*)base + ei) = w; }
    else { u32x4 w; w.x = pk_bf16(v[0], v[1]); w.y = pk_bf16(v[2], v[3]); w.z = pk_bf16(v[4], v[5]); w.w = pk_bf16(v[6], v[7]); *(u32x4*)((char*)base + ei * 2) = w; } }
__device__ __forceinline__ void st_op1(void* base, size_t ei, float a) {
    if (F8) ((unsigned char*)base)[ei] = (unsigned char)(pk4_fp8(a, 0.f, 0.f, 0.f) & 0xffu);
    else ((bf16_t*)base)[ei] = f2bf(a); }
__device__ __forceinline__ float siluf_(float x) { return x * sigmoidf_(x); }
template <int M> __device__ __forceinline__ float shx(float v) { return __int_as_float(__builtin_amdgcn_ds_swizzle(__float_as_int(v), 0x1f | (M << 10))); }
__device__ __forceinline__ float shx32(float v, int lane) { return __int_as_float(__builtin_amdgcn_ds_bpermute((lane ^ 32) << 2, __float_as_int(v))); }
__device__ __forceinline__ float shup(float v, int o, int lane) { return __int_as_float(__builtin_amdgcn_ds_bpermute((lane - o) << 2, __float_as_int(v))); }
__device__ __forceinline__ float rdlane(float v, int l) { return __int_as_float(__builtin_amdgcn_readlane(__float_as_int(v), l)); }
__device__ __forceinline__ float wave_sum(float v, int lane) {
    v += shx32(v, lane); v += shx<16>(v); v += shx<8>(v); v += shx<4>(v); v += shx<2>(v); v += shx<1>(v);
    return v;
}

#define XB_TMO      128
#define XB_XCNT(j)  (256  + 64 * (j))
#define XB_XSUB(j)  (1280 + 64 * (j))
#define XB_XGEN(j)  (2304 + 64 * (j))
#define XB_TOP      3328
#define XB_TOPGEN   3392
#define XCD_BAR_WORDS 3456
#define XB_SPIN_CAP (1u << 18)
__device__ __forceinline__ unsigned xb_ld(unsigned* p)              { return __hip_atomic_load(p, __ATOMIC_RELAXED, __HIP_MEMORY_SCOPE_AGENT); }
__device__ __forceinline__ unsigned xb_add(unsigned* p, unsigned v) { return __hip_atomic_fetch_add(p, v, __ATOMIC_RELAXED, __HIP_MEMORY_SCOPE_AGENT); }
__device__ __forceinline__ unsigned xb_xcc_id() { return (unsigned)__builtin_amdgcn_s_getreg((3 << 11) | 20) & 0xFu; }
#define XB_SPIN(cond, bar) do { unsigned _sp = 0; while (cond) { __builtin_amdgcn_s_sleep(1); \
    if ((++_sp & 255u) == 0u) { if (xb_ld(&(bar)[XB_TMO])) break; if (_sp > XB_SPIN_CAP) { atomicAdd(&(bar)[XB_TMO], 1u); break; } } } } while (0)
struct XcdBarrier { unsigned* bar; unsigned x; volatile LAS unsigned* st; };
__device__ __forceinline__ XcdBarrier xcd_barrier_post(unsigned* bar, volatile LAS unsigned* st) {
    XcdBarrier b; b.bar = bar; b.x = xb_xcc_id(); b.st = st;
    if (threadIdx.x == 0) (void)xb_add(&bar[XB_XCNT(b.x)], 1u);
    return b;
}
__device__ __forceinline__ void xcd_barrier_complete(unsigned* bar, unsigned x, unsigned& nloc, unsigned& nx) {
    const unsigned G = gridDim.x * gridDim.y * gridDim.z;
    unsigned sum, cnt, mine, sp = 0u;
    for (;;) {
        sum = 0u; cnt = 0u; mine = 0u;
#pragma unroll
        for (unsigned j = 0; j < 16; ++j) { const unsigned c = xb_ld(&bar[XB_XCNT(j)]); sum += c; cnt += (c > 0u) ? 1u : 0u; mine = (j == x) ? c : mine; }
        if (sum == G) break;
        __builtin_amdgcn_s_sleep(1);
        if ((++sp & 255u) == 0u) { if (xb_ld(&bar[XB_TMO])) break; if (sp > XB_SPIN_CAP) { atomicAdd(&bar[XB_TMO], 1u); break; } }
    }
    nloc = mine > 0u ? mine : 1u; nx = cnt > 0u ? cnt : 1u;
}
__device__ __forceinline__ void xcd_barrier(const XcdBarrier& b) {
    asm volatile("s_waitcnt vmcnt(0)" ::: "memory");
    __syncthreads();
    if (threadIdx.x == 0) {
        unsigned* bar = b.bar;
        __builtin_amdgcn_s_waitcnt(0);
        unsigned nloc = b.st[0], nx = b.st[1];
        if (nloc == 0u) { xcd_barrier_complete(bar, b.x, nloc, nx); b.st[0] = nloc; b.st[1] = nx; }
        const unsigned old = xb_add(&bar[XB_XSUB(b.x)], 1u);
        const unsigned gen = old / nloc;
        if (old + 1u == (gen + 1u) * nloc) {
            __builtin_amdgcn_fence(__ATOMIC_RELEASE, "agent");
            asm volatile("s_waitcnt vmcnt(0)" ::: "memory");
            const unsigned og = xb_add(&bar[XB_TOP], 1u);
            const unsigned tg = og / nx;
            if (og + 1u == (tg + 1u) * nx) xb_add(&bar[XB_TOPGEN], 1u);
            else XB_SPIN(xb_ld(&bar[XB_TOPGEN]) == tg, bar);
            __builtin_amdgcn_fence(__ATOMIC_ACQUIRE, "agent");
            xb_add(&bar[XB_XGEN(b.x)], 1u);
            asm volatile("s_waitcnt vmcnt(0)" ::: "memory");
        } else {
            XB_SPIN(xb_ld(&bar[XB_XGEN(b.x)]) == gen, bar);
            __builtin_amdgcn_fence(__ATOMIC_ACQUIRE, "agent");
            asm volatile("s_waitcnt vmcnt(0)" ::: "memory");
        }
    }
    __syncthreads();
}

struct Args { const float* in[N_IN]; float* out; unsigned char* ws; int ph_lo, ph_hi; };
struct Frame {
    const float* const* in; float* out; unsigned char* ws; LAS unsigned char* lds;
    int wave, G, bid;
};
__device__ __forceinline__ int ltid_(int wave) { int l; asm volatile("v_mbcnt_lo_u32_b32 %0, -1, 0\n\tv_mbcnt_hi_u32_b32 %0, -1, %0" : "=v"(l)); return wave * 64 + l; }
#define ltid() ltid_(F.wave)

__device__ __forceinline__ const float* xin_row(const Frame& F, int layer, int r) {
    const int b = r / TB, s = r - b * TB;
    if (s < CTXL) return (layer == 0 ? F.in[I_CTX] : (const float*)(F.ws + WS_XC)) + ((size_t)b * CTXL + s) * D;
    return (layer == 0 ? F.in[I_X] : (const float*)F.out) + ((size_t)b * SEQ + (s - CTXL)) * D;
}
__device__ __forceinline__ float* xout_row(const Frame& F, int r) {
    const int b = r / TB, s = r - b * TB;
    if (s < CTXL) return (float*)(F.ws + WS_XC) + ((size_t)b * CTXL + s) * D;
    return F.out + ((size_t)b * SEQ + (s - CTXL)) * D;
}

__device__ __forceinline__ void phase_mods(const Frame& F) {
    const int tid = ltid(), lane = tid & 63; (void)lane;
    LAS float* sc = (LAS float*)F.lds;
    LAS float* red = (LAS float*)(F.lds + 5 * 2048 * 4);
    float* mods = (float*)(F.ws + WS_MODS);
    for (int i = tid; i < 5 * 2048; i += NTHR) { const int r = i >> 11, k = i & 2047; const float v = r < 4 ? F.in[I_C][r * 2048 + k] : F.in[I_CCTX][k]; sc[i] = siluf_(v); }
    __syncthreads();
    for (int it = F.bid; it < 2 * 96; it += F.G) {
        const int l = it / 96, cg = it - l * 96, c4 = (tid & 31) * 4, ks = tid >> 5;
        const float* w = F.in[I_ADAW] + (size_t)l * 2048 * 12288 + cg * 128 + c4;
        f32x4 a0 = (f32x4){0.f, 0.f, 0.f, 0.f}, a1 = a0, a2 = a0, a3 = a0, a4 = a0;
#pragma unroll 8
        for (int k = ks; k < 2048; k += 16) { const f32x4 wv = *(const f32x4*)(w + (size_t)k * 12288); a0 += sc[k] * wv; a1 += sc[2048 + k] * wv; a2 += sc[4096 + k] * wv; a3 += sc[6144 + k] * wv; a4 += sc[8192 + k] * wv; }
        *(LAS f32x4*)(red + (ks * 5 + 0) * 128 + c4) = a0; *(LAS f32x4*)(red + (ks * 5 + 1) * 128 + c4) = a1; *(LAS f32x4*)(red + (ks * 5 + 2) * 128 + c4) = a2;
        *(LAS f32x4*)(red + (ks * 5 + 3) * 128 + c4) = a3; *(LAS f32x4*)(red + (ks * 5 + 4) * 128 + c4) = a4;
        __syncthreads();
        for (int i = tid; i < 5 * 128; i += NTHR) { const int r = i >> 7, cc = i & 127; float s = 0.f;
#pragma unroll
            for (int s16 = 0; s16 < 16; ++s16) s += red[(s16 * 5 + r) * 128 + cc];
            mods[((size_t)l * 5 + r) * 12288 + cg * 128 + cc] = s + F.in[I_ADAB][l * 12288 + cg * 128 + cc]; }
        __syncthreads();
    }
}

__device__ __forceinline__ void phase_ln1(const Frame& F, int layer) {
    const int tid = ltid(), lane = tid & 63; (void)lane;
    const float* mods = (const float*)(F.ws + WS_MODS) + (size_t)layer * 5 * 12288;
    bf16_t* U = (bf16_t*)(F.ws + WS_U);
    const int stride = F.G * NWAVE; f32x4 xq[8];
    { const float* x = xin_row(F, layer, F.bid * NWAVE + F.wave);
#pragma unroll
      for (int i = 0; i < 8; ++i) xq[i] = *(const f32x4*)(x + (i * 64 + lane) * 4); }
    for (int r = F.bid * NWAVE + F.wave; r < R; r += stride) {
        const int b = r / TB, s = r - b * TB; const float* md = mods + (size_t)(s < CTXL ? 4 : b) * 12288;
        f32x4 v[8]; float sum = 0.f;
#pragma unroll
        for (int i = 0; i < 8; ++i) { v[i] = xq[i]; sum += (v[i][0] + v[i][1]) + (v[i][2] + v[i][3]); }
        { const float* xn = xin_row(F, layer, r + stride < R ? r + stride : r);
#pragma unroll
          for (int i = 0; i < 8; ++i) xq[i] = *(const f32x4*)(xn + (i * 64 + lane) * 4); }
        const float mean = wave_sum(sum, lane) * (1.0f / D); float q = 0.f;
#pragma unroll
        for (int i = 0; i < 8; ++i) { v[i] -= mean; q += (v[i][0] * v[i][0] + v[i][1] * v[i][1]) + (v[i][2] * v[i][2] + v[i][3] * v[i][3]); }
        const float rstd = rsqrtf(wave_sum(q, lane) * (1.0f / D) + LN_EPS);
#pragma unroll
        for (int i = 0; i < 8; ++i) { const int e = (i * 64 + lane) * 4; const f32x4 sh = *(const f32x4*)(md + e), scl = *(const f32x4*)(md + 2048 + e);
            const f32x4 u = v[i] * rstd * (scl + 1.0f) + sh; st_op4(U, (size_t)r * D + e, u[0], u[1], u[2], u[3]); }
    }
}

namespace pg8 {
constexpr int BM = 256, BK = 64, HALF = 128, HTB = HALF * BK * 2, STAGE_BYTES = 8 * HTB, NXCD = 8, WGM = 8;
__host__ __device__ __forceinline__ int lds_byte(int r, int c) { const int st = (r >> 4) * 2 + (c >> 5), rr = r & 15, cc = c & 31, ob = rr * 64 + cc * 2; return st * 1024 + (ob ^ (((ob >> 9) & 1) << 5)); }
__host__ __device__ __forceinline__ void stage_rc(int b, int& Rr, int& C) { const int st = b / 1024, sb = b % 1024, swz = sb ^ (((sb >> 9) & 1) << 5); Rr = (st >> 1) * 16 + swz / 64; C = (st & 1) * 32 + (swz % 64) / 2; }
__host__ __device__ __forceinline__ int perm32(int rho) { const int n = rho >> 4, i = rho & 15; return 8 * (i >> 2) + 4 * n + (i & 3); }
struct Unit { int pm, pn; };
struct Gemm { const bf16_t* A; const bf16_t* Bt; int lda, ldb, K; };
struct StaticOrder {
    int nM, nN, nwg, G, c, skipctx;
    __device__ void init(int M, int N, int G_, int c_, int skipctx_ = 0) { nM = M / BM; nN = N / BM; nwg = nM * nN; G = G_; c = c_; skipctx = skipctx_; }
    __device__ bool next(int i, Unit& u) const {
        const long L = (long)i * G + c; if (L >= nwg) return false;
        int wgid = (int)L; { const int q = nwg / NXCD, r = nwg % NXCD, xcd = wgid % NXCD, off = wgid / NXCD; wgid = (xcd < r ? xcd * (q + 1) : r * (q + 1) + (xcd - r) * q) + off; }
        const int nig = WGM * nN, gid = wgid / nig, fm = gid * WGM, gsz = (nM - fm) < WGM ? (nM - fm) : WGM;
        u.pm = fm + ((wgid % nig) % gsz); u.pn = (wgid % nig) / gsz;
        if (skipctx) u.pm += (u.pm >> 5) + 1;
        return true;
    }
};
struct GroupedOrder {
    const LAS int* ts; int nN, G, c;
    __device__ bool next(int i, Unit& u) const {
        const int L = i * G + c; const int tot = __builtin_amdgcn_readfirstlane(ts[16]) * nN; if (L >= tot) return false;
        const int pm = L / nN, pl = L - pm * nN; int e = 0;
#pragma unroll 1
        for (int j = 1; j < 16; ++j) e += (pm >= ts[j]) ? 1 : 0;
        u.pm = __builtin_amdgcn_readfirstlane(pm); u.pn = __builtin_amdgcn_readfirstlane(e * nN + pl); return true;
    }
};
__device__ __forceinline__ unsigned cvt_pk_bf16(float lo, float hi) { return pk_bf16(lo, hi); }
__device__ __forceinline__ float fsig(float x) { return __builtin_amdgcn_rcpf(1.0f + __expf(-x)); }
constexpr float Y8_SCALE = 8.0f;
template <int MODE, bool O8> struct Epi {
    static constexpr bool PERM = true; static constexpr float ASC = F8 ? 1.0f / W8_SCALE : 1.0f;
    void* O; const bf16_t* X; const bf16_t* Zin; int ldc; int pn_mod;
    __device__ __forceinline__ void put8(size_t ei, const float (&h)[8]) const {
        if (O8) st_op8(O, ei, h);
        else { u32x4 w; w.x = cvt_pk_bf16(h[0], h[1]); w.y = cvt_pk_bf16(h[2], h[3]); w.z = cvt_pk_bf16(h[4], h[5]); w.w = cvt_pk_bf16(h[6], h[7]); *(u32x4*)((bf16_t*)O + ei) = w; } }
    __device__ __forceinline__ void operator()(const f32x4 (&acc)[2][2][4][2], const Unit& u, int wr, int wc, int fr, int fq) const {
        const int row0 = u.pm * BM + wr * 64 + fr; const int pnl = u.pn % pn_mod;
        if (MODE == 4 || MODE == 5 || MODE == 6) {
            const int col0 = pnl * HALF + wc * 32 + 8 * fq;
            u32x4 xw6[2][4], zw6[2][4];
            if (MODE == 6) {
#pragma unroll
                for (int ai = 0; ai < 2; ++ai)
#pragma unroll
                    for (int m = 0; m < 4; ++m) { const size_t ei = (size_t)(row0 + ai * HALF + m * 16) * ldc + col0; xw6[ai][m] = *(const u32x4*)(X + ei); zw6[ai][m] = *(const u32x4*)(Zin + ei); }
            }
#pragma unroll
            for (int ai = 0; ai < 2; ++ai)
#pragma unroll
                for (int m = 0; m < 4; ++m) { const size_t ei = (size_t)(row0 + ai * HALF + m * 16) * ldc + col0;
                    const f32x4 g0 = acc[ai][0][m][0], g1 = acc[ai][0][m][1], u0 = acc[ai][1][m][0], u1 = acc[ai][1][m][1]; float h[8];
                    float xa[8], xb[8]; if (MODE == 6) { unpack8(xw6[ai][m], xa); unpack8(zw6[ai][m], xb); }
#pragma unroll
                    for (int j = 0; j < 4; ++j) { const float ga = g0[j] * ASC, gb = g1[j] * ASC;
                        if (MODE == 4) { h[j] = ga * fsig(ga) * (u0[j] * ASC); h[4 + j] = gb * fsig(gb) * (u1[j] * ASC); }
                        else if (MODE == 5) { h[j] = ga * fsig(u0[j] * ASC); h[4 + j] = gb * fsig(u1[j] * ASC); }
                        else { h[j] = fsig(ga) * xa[j] + fsig(u0[j] * ASC) * xb[j]; h[4 + j] = fsig(gb) * xa[4 + j] + fsig(u1[j] * ASC) * xb[4 + j]; } }
                    put8(ei, h); }
        } else {
            const int col0 = pnl * BM + wc * 32 + 8 * fq;
#pragma unroll
            for (int ai = 0; ai < 2; ++ai)
#pragma unroll
              for (int mh = 0; mh < 2; ++mh) {
                u32x4 xw[2][2], zw[2][2];
                if (MODE == 1 || MODE == 2) {
#pragma unroll
                    for (int m2 = 0; m2 < 2; ++m2)
#pragma unroll
                        for (int bj = 0; bj < 2; ++bj) { const size_t ro = (size_t)(row0 + ai * HALF + (mh * 2 + m2) * 16) * ldc + col0 + bj * HALF;
                            xw[m2][bj] = *(const u32x4*)(X + ro); if (MODE == 2) zw[m2][bj] = *(const u32x4*)(Zin + ro); }
                }
#pragma unroll
                for (int m2 = 0; m2 < 2; ++m2) { const int m = mh * 2 + m2; const size_t ro = (size_t)(row0 + ai * HALF + m * 16) * ldc + col0;
#pragma unroll
                    for (int bj = 0; bj < 2; ++bj) { const f32x4 v0 = acc[ai][bj][m][0], v1 = acc[ai][bj][m][1]; float h[8];
#pragma unroll
                        for (int j = 0; j < 4; ++j) { h[j] = v0[j] * (MODE == 7 ? ASC * Y8_SCALE : ASC); h[4 + j] = v1[j] * (MODE == 7 ? ASC * Y8_SCALE : ASC); }
                        if (MODE == 1 || MODE == 2) { float x8[8]; unpack8(xw[m2][bj], x8);
#pragma unroll
                            for (int j = 0; j < 8; ++j) h[j] = fsig(h[j]) * x8[j];
                            if (MODE == 2) { float z8[8]; unpack8(zw[m2][bj], z8);
#pragma unroll
                                for (int j = 0; j < 8; ++j) h[j] += z8[j]; } }
                        put8(ro + bj * HALF, h); } }
              }
        }
    }
};

template <class EpiT, class Sched>
__device__ __forceinline__ void gemm_phase(LAS unsigned char* lds, const Gemm g, const Sched& S, const EpiT& E, int wave_id) {
    const int tid = ltid_(wave_id), wid = __builtin_amdgcn_readfirstlane(tid >> 6), lane = tid & 63, wr = wid >> 2, wc = wid & 3, fr = lane & 15, fq = lane >> 4;
    const int K = g.K, nt = K / BK;
    unsigned voffA[2], voffB[2];
#pragma unroll
    for (int i = 0; i < 2; ++i) { int Rr, C; stage_rc(tid * 16 + i * 8192, Rr, C); const int Rb = EpiT::PERM ? ((Rr & ~31) + perm32(Rr & 31)) : Rr;
        voffA[i] = (unsigned)(Rr * g.lda + C) * 2u; voffB[i] = (unsigned)(Rb * g.ldb + C) * 2u; }
    const size_t kstep = (size_t)(BK * 2);
    const size_t hstepA = (size_t)HALF * g.lda * 2, hstepB = (size_t)HALF * g.ldb * 2;
    const size_t tstepA = 2 * hstepA, tstepB = 2 * hstepB;
    const unsigned ldsw = (unsigned)wid * 1024u;
    const int aoff = lds_byte(wr * 64 + fr, fq * 8), boff = lds_byte(wc * 32 + fr, fq * 8);
#define PG8_SA(b, h) (((b) * 2 + (h)) * HTB)
#define PG8_SB(b, h) ((4 + (b) * 2 + (h)) * HTB)
#define PG8_STAGE(bufoff, gbase, voff) do { _Pragma("unroll") for (int _i = 0; _i < 2; ++_i) \
        __builtin_amdgcn_global_load_lds((const unsigned*)((const char*)(gbase) + (voff)[_i]), (LAS unsigned*)(lds + (bufoff) + ldsw + _i * 8192), 16, 0, 0); } while (0)
#define PG8_LD8(dst, addr) do { const v4i lo_ = *(const LAS v4i*)(addr), hi_ = *(const LAS v4i*)((addr) + 1024); dst = __builtin_shufflevector(lo_, hi_, 0, 1, 2, 3, 4, 5, 6, 7); } while (0)
#define PG8_LDA(dst, b, h) do { _Pragma("unroll") for (int m = 0; m < 4; ++m) PG8_LD8(dst[m], lds + PG8_SA(b, h) + aoff + m * 2048); } while (0)
#define PG8_LDB(dst, b, h) do { _Pragma("unroll") for (int n = 0; n < 2; ++n) PG8_LD8(dst[n], lds + PG8_SB(b, h) + boff + n * 2048); } while (0)
#define PG8_HALF(v, k) __builtin_bit_cast(bf16x8, __builtin_shufflevector(v, v, 4 * (k), 4 * (k) + 1, 4 * (k) + 2, 4 * (k) + 3))
#define PG8_MMA(ai, bj, At, Bt) do { __builtin_amdgcn_s_setprio(1); _Pragma("unroll") for (int m = 0; m < 4; ++m) _Pragma("unroll") for (int n = 0; n < 2; ++n) { \
        if (F8) asm volatile("v_mfma_f32_16x16x128_f8f6f4 %0, %1, %2, %0" : "+v"(acc[ai][bj][m][n]) : "v"(Bt[n]), "v"(At[m]));     \
        else { acc[ai][bj][m][n] = __builtin_amdgcn_mfma_f32_16x16x32_bf16(PG8_HALF(Bt[n], 0), PG8_HALF(At[m], 0), acc[ai][bj][m][n], 0, 0, 0); \
               acc[ai][bj][m][n] = __builtin_amdgcn_mfma_f32_16x16x32_bf16(PG8_HALF(Bt[n], 1), PG8_HALF(At[m], 1), acc[ai][bj][m][n], 0, 0, 0); } } \
        __builtin_amdgcn_s_setprio(0); } while (0)
#define PG8_WAIT_V(n) asm volatile("s_waitcnt vmcnt(" #n ")" ::: "memory")
#define PG8_WAIT_L(n) asm volatile("s_waitcnt lgkmcnt(" #n ")" ::: "memory")
#define PG8_BAR __builtin_amdgcn_s_barrier()
#define PG8_SCHED __builtin_amdgcn_sched_barrier(0)
    Unit cur, nxt; int ui = 0;
    if (!S.next(0, cur)) return;
    f32x4 acc[2][2][4][2];
#pragma unroll
    for (int a = 0; a < 2; ++a)
#pragma unroll
        for (int b = 0; b < 2; ++b)
#pragma unroll
            for (int m = 0; m < 4; ++m)
#pragma unroll
                for (int n = 0; n < 2; ++n) acc[a][b][m][n] = (f32x4){0.f, 0.f, 0.f, 0.f};
    v8i At[4], B0[2], B1[2];
    const char* cA = (const char*)g.A + (size_t)cur.pm * tstepA; const char* cB = (const char*)g.Bt + (size_t)cur.pn * tstepB;
    PG8_STAGE(PG8_SB(0, 0), cB, voffB); PG8_STAGE(PG8_SA(0, 0), cA, voffA); PG8_STAGE(PG8_SB(0, 1), cB + hstepB, voffB); PG8_STAGE(PG8_SA(0, 1), cA + hstepA, voffA);
    if (wr == 1) PG8_BAR;
    PG8_WAIT_V(4); PG8_BAR;
    PG8_STAGE(PG8_SB(1, 0), cB + kstep, voffB); PG8_STAGE(PG8_SA(1, 0), cA + kstep, voffA); PG8_STAGE(PG8_SB(1, 1), cB + hstepB + kstep, voffB);
    PG8_WAIT_V(6); PG8_BAR;
    for (;;) {
        const bool has_next = S.next(ui + 1, nxt);
        const char* nA = has_next ? (const char*)g.A + (size_t)nxt.pm * tstepA : cA; const char* nB = has_next ? (const char*)g.Bt + (size_t)nxt.pn * tstepB : cB;
        for (int t = 0; t < nt; t += 2) {
            const bool last = (t == nt - 2);
            const char* a1 = cA + (size_t)(t + 1) * kstep;
            const char* a2 = last ? nA : cA + (size_t)(t + 2) * kstep; const char* b2 = last ? nB : cB + (size_t)(t + 2) * kstep;
            const char* a3 = a2 + kstep; const char* b3 = b2 + kstep;
            PG8_LDB(B0, 0, 0); PG8_SCHED; PG8_LDA(At, 0, 0); PG8_STAGE(PG8_SA(1, 1), a1 + hstepA, voffA);
            PG8_WAIT_L(8); PG8_BAR; PG8_WAIT_L(0); PG8_MMA(0, 0, At, B0); PG8_BAR; PG8_SCHED;
            PG8_LDB(B1, 0, 1); PG8_STAGE(PG8_SB(0, 0), b2, voffB);
            PG8_BAR; PG8_WAIT_L(0); PG8_MMA(0, 1, At, B1); PG8_BAR;
            PG8_LDA(At, 0, 1); PG8_STAGE(PG8_SA(0, 0), a2, voffA);
            PG8_BAR; PG8_WAIT_L(0); PG8_MMA(1, 0, At, B0); PG8_BAR; PG8_SCHED;
            PG8_STAGE(PG8_SB(0, 1), b2 + hstepB, voffB);
            PG8_WAIT_V(6); PG8_BAR; PG8_MMA(1, 1, At, B1); PG8_BAR;
            PG8_LDB(B0, 1, 0); PG8_SCHED; PG8_LDA(At, 1, 0); PG8_STAGE(PG8_SA(0, 1), a2 + hstepA, voffA);
            PG8_WAIT_L(8); PG8_BAR; PG8_WAIT_L(0); PG8_MMA(0, 0, At, B0); PG8_BAR; PG8_SCHED;
            PG8_LDB(B1, 1, 1); PG8_STAGE(PG8_SB(1, 0), b3, voffB);
            PG8_BAR; PG8_WAIT_L(0); PG8_MMA(0, 1, At, B1); PG8_BAR;
            PG8_LDA(At, 1, 1); PG8_STAGE(PG8_SA(1, 0), a3, voffA);
            PG8_BAR; PG8_WAIT_L(0); PG8_MMA(1, 0, At, B0); PG8_BAR; PG8_SCHED;
            PG8_STAGE(PG8_SB(1, 1), b3 + hstepB, voffB);
            PG8_WAIT_V(6); PG8_BAR; PG8_MMA(1, 1, At, B1); PG8_BAR;
        }
        if (F8) { __builtin_amdgcn_sched_barrier(0); asm volatile("s_nop 15\n\ts_nop 15" ::: "memory"); __builtin_amdgcn_sched_barrier(0); }
        E(acc, cur, wr, wc, fr, fq);
        if (!has_next) break;
#pragma unroll
        for (int a = 0; a < 2; ++a)
#pragma unroll
            for (int b = 0; b < 2; ++b)
#pragma unroll
                for (int m = 0; m < 4; ++m)
#pragma unroll
                    for (int n = 0; n < 2; ++n) acc[a][b][m][n] = (f32x4){0.f, 0.f, 0.f, 0.f};
        cur = nxt; cA = nA; cB = nB; ++ui;
    }
    PG8_WAIT_V(0);
    if (wr == 0) PG8_BAR;
    PG8_BAR;
#undef PG8_SA
#undef PG8_SB
#undef PG8_STAGE
#undef PG8_LDA
#undef PG8_LD8
#undef PG8_HALF
#undef PG8_LDB
#undef PG8_MMA
#undef PG8_WAIT_V
#undef PG8_WAIT_L
#undef PG8_BAR
#undef PG8_SCHED
}
}

template <int MODE, bool O8>
__device__ __forceinline__ void dense_gemm(const Frame& F, const void* A, const void* Bt, int M, int N, int K, void* O, const bf16_t* X, const bf16_t* Zin, int ldc, int skipctx = 0, int rot = 0) {
    pg8::Gemm g{(const bf16_t*)A, (const bf16_t*)Bt, K * OPB / 2, K * OPB / 2, K * OPB / 2}; pg8::StaticOrder S; S.init(skipctx ? NB * SEQ : M, N, F.G, (F.bid + rot) % F.G, skipctx);
    pg8::Epi<MODE, O8> E{O, X, Zin, ldc, 1 << 30};
    pg8::gemm_phase<pg8::Epi<MODE, O8>, pg8::StaticOrder>(F.lds, g, S, E, F.wave);
}

struct TJob { const float* src; bf16_t* dst; size_t src_bstride; int src_pitch, K, Nvalid, Npad, dst_pitch, blk, blk_stride, row_off, nbatch, dst_brow; bool f8; };
constexpr int N_TJOBS = 13;
__device__ __forceinline__ TJob get_tjob(const Frame& F, int layer, int j) {
    TJob t; t.src_bstride = 0; t.blk = 1 << 30; t.blk_stride = 0; t.row_off = 0; t.nbatch = 1; t.dst_brow = 0; t.f8 = F8 && (j != 10);
    unsigned char* ws = F.ws;
    switch (j) {
    case 0: t.src = F.in[I_WIN] + (size_t)layer * 2048 * 14736; t.src_pitch = 14736; t.K = 2048; t.Nvalid = PC_END; t.Npad = PW; t.dst = (bf16_t*)(ws + WS_WIN); t.dst_pitch = 2048; break;
    case 1: t.src = F.in[I_WIN] + (size_t)layer * 2048 * 14736 + PC_END; t.src_pitch = 14736; t.K = 2048; t.Nvalid = 2048; t.Npad = 2048; t.dst = (bf16_t*)(ws + WS_WG); t.dst_pitch = 2048; t.blk = 128; t.blk_stride = 256; t.row_off = 0; break;
    case 11: t.src = F.in[I_WIN] + (size_t)layer * 2048 * 14736 + PC_END + 2048; t.src_pitch = 14736; t.K = 2048; t.Nvalid = 2048; t.Npad = 2048; t.dst = (bf16_t*)(ws + WS_WG); t.dst_pitch = 2048; t.blk = 128; t.blk_stride = 256; t.row_off = 128; break;
    case 12: t.src = F.in[I_WIN] + (size_t)layer * 2048 * 14736 + PC_END + 4096; t.src_pitch = 14736; t.K = 2048; t.Nvalid = 2048; t.Npad = 2048; t.dst = (bf16_t*)(ws + WS_WG + (size_t)4096 * 2048 * OPB); t.dst_pitch = 2048; break;
    case 2: t.src = F.in[I_MLPROJ] + (size_t)layer * 1024 * 2048; t.src_pitch = 2048; t.K = 1024; t.Nvalid = 2048; t.Npad = 2048; t.dst = (bf16_t*)(ws + WS_WML); t.dst_pitch = 1024; break;
    case 3: t.src = F.in[I_RWPROJ] + (size_t)layer * 1024 * 2048; t.src_pitch = 2048; t.K = 1024; t.Nvalid = 2048; t.Npad = 2048; t.dst = (bf16_t*)(ws + WS_WML + (size_t)1 * 2048 * 1024 * OPB); t.dst_pitch = 1024; break;
    case 4: t.src = F.in[I_S5WV] + (size_t)layer * 1024 * 2048; t.src_pitch = 2048; t.K = 1024; t.Nvalid = 2048; t.Npad = 2048; t.dst = (bf16_t*)(ws + WS_WML + (size_t)2 * 2048 * 1024 * OPB); t.dst_pitch = 1024; t.blk = 128; t.blk_stride = 256; t.row_off = 0; break;
    case 5: t.src = F.in[I_S5WG] + (size_t)layer * 1024 * 2048; t.src_pitch = 2048; t.K = 1024; t.Nvalid = 2048; t.Npad = 2048; t.dst = (bf16_t*)(ws + WS_WML + (size_t)2 * 2048 * 1024 * OPB); t.dst_pitch = 1024; t.blk = 128; t.blk_stride = 256; t.row_off = 128; break;
    case 6: t.src = F.in[I_WOUT] + (size_t)layer * 2048 * 2048; t.src_pitch = 2048; t.K = 2048; t.Nvalid = 2048; t.Npad = 2048; t.dst = (bf16_t*)(ws + WS_WOUT); t.dst_pitch = 2048; break;
    case 7: t.src = F.in[I_EWG] + (size_t)layer * 16 * 2048 * 1024; t.src_bstride = (size_t)2048 * 1024; t.src_pitch = 1024; t.K = 2048; t.Nvalid = 1024; t.Npad = 1024; t.dst = (bf16_t*)(ws + WS_EGU); t.dst_pitch = 2048;
            t.blk = 128; t.blk_stride = 256; t.row_off = 0; t.nbatch = 16; t.dst_brow = 2048; break;
    case 8: t.src = F.in[I_EWU] + (size_t)layer * 16 * 2048 * 1024; t.src_bstride = (size_t)2048 * 1024; t.src_pitch = 1024; t.K = 2048; t.Nvalid = 1024; t.Npad = 1024; t.dst = (bf16_t*)(ws + WS_EGU); t.dst_pitch = 2048;
            t.blk = 128; t.blk_stride = 256; t.row_off = 128; t.nbatch = 16; t.dst_brow = 2048; break;
    case 9: t.src = F.in[I_EWD] + (size_t)layer * 16 * 1024 * 2048; t.src_bstride = (size_t)1024 * 2048; t.src_pitch = 2048; t.K = 1024; t.Nvalid = 2048; t.Npad = 2048; t.dst = (bf16_t*)(ws + WS_EDN); t.dst_pitch = 1024;
            t.nbatch = 16; t.dst_brow = 2048; break;
    default: t.src = F.in[I_RWGUP] + (size_t)layer * 128 * 1024; t.src_pitch = 1024; t.K = 128; t.Nvalid = 1024; t.Npad = 1024; t.dst = (bf16_t*)(ws + WS_GUPT); t.dst_pitch = 128; break;
    }
    return t;
}
__device__ __forceinline__ int tjob_tiles(const TJob& t) { return t.nbatch * (t.Npad / 64) * (t.K / (t.f8 ? 128 : 64)); }
__device__ __forceinline__ void transpose_tile(LAS float* T, int lane, const TJob& t, int tile) {
    const int nkt = t.K / 64, nnt = t.Npad / 64;
    const int b = tile / (nnt * nkt), rem = tile - b * nnt * nkt, ktile = rem / nnt, ntile = rem - ktile * nnt;
    const int n0 = ntile * 64, k0 = ktile * 64;
    const float* src = t.src + (size_t)b * t.src_bstride;
    f32x4 v[16];
#pragma unroll
    for (int p = 0; p < 16; ++p) { const int kk = p * 4 + (lane >> 4), nn = (lane & 15) * 4;
        v[p] = (f32x4){0.f, 0.f, 0.f, 0.f};
        if (n0 + nn < t.Nvalid) v[p] = *(const f32x4*)(src + (size_t)(k0 + kk) * t.src_pitch + n0 + nn); }
#pragma unroll
    for (int p = 0; p < 16; ++p) { const int kk = p * 4 + (lane >> 4), nn = (lane & 15) * 4; T[kk * 65 + nn] = v[p][0]; T[kk * 65 + nn + 1] = v[p][1]; T[kk * 65 + nn + 2] = v[p][2]; T[kk * 65 + nn + 3] = v[p][3]; }
    asm volatile("s_waitcnt lgkmcnt(0)" ::: "memory"); __builtin_amdgcn_wave_barrier();
#pragma unroll
    for (int ps = 0; ps < 8; ++ps) { const int n = ps * 8 + (lane >> 3), kq = (lane & 7) * 8; float x[8];
#pragma unroll
        for (int j = 0; j < 8; ++j) x[j] = T[(kq + j) * 65 + n];
        const int ng = n0 + n; const int drow = b * t.dst_brow + (ng / t.blk) * t.blk_stride + (ng % t.blk) + t.row_off;
        if (t.f8) { u32x2 w; w.x = pk4_fp8(x[0] * W8_SCALE, x[1] * W8_SCALE, x[2] * W8_SCALE, x[3] * W8_SCALE); w.y = pk4_fp8(x[4] * W8_SCALE, x[5] * W8_SCALE, x[6] * W8_SCALE, x[7] * W8_SCALE);
            *(u32x2*)((char*)t.dst + (size_t)drow * t.dst_pitch + k0 + kq) = w; }
        else { u32x4 w; w.x = pk_bf16(x[0], x[1]); w.y = pk_bf16(x[2], x[3]); w.z = pk_bf16(x[4], x[5]); w.w = pk_bf16(x[6], x[7]);
            *(u32x4*)(t.dst + (size_t)drow * t.dst_pitch + k0 + kq) = w; } }
    asm volatile("s_waitcnt lgkmcnt(0)" ::: "memory"); __builtin_amdgcn_wave_barrier();
}
__device__ __forceinline__ void transpose_tile8(LAS unsigned* T8, int lane, const TJob& t, int tile) {
    const int nkt = t.K / 128, nnt = t.Npad / 64;
    const int b = tile / (nnt * nkt), rem = tile - b * nnt * nkt, ktile = rem / nnt, ntile = rem - ktile * nnt;
    const int n0 = ntile * 64, k0 = ktile * 128;
    const float* src = t.src + (size_t)b * t.src_bstride;
    const int nn = (lane & 15) * 4, kq = lane >> 4;
    f32x4 v[32];
#pragma unroll
    for (int p = 0; p < 32; ++p) { const int kk = (p >> 2) * 16 + kq * 4 + (p & 3);
        v[p] = (f32x4){0.f, 0.f, 0.f, 0.f};
        if (n0 + nn < t.Nvalid) v[p] = *(const f32x4*)(src + (size_t)(k0 + kk) * t.src_pitch + n0 + nn); }
#pragma unroll
    for (int g = 0; g < 8; ++g)
#pragma unroll
        for (int j = 0; j < 4; ++j)
            T8[(nn + j) * 36 + g * 4 + kq] = pk4_fp8(v[4 * g][j] * W8_SCALE, v[4 * g + 1][j] * W8_SCALE, v[4 * g + 2][j] * W8_SCALE, v[4 * g + 3][j] * W8_SCALE);
    asm volatile("s_waitcnt lgkmcnt(0)" ::: "memory"); __builtin_amdgcn_wave_barrier();
#pragma unroll
    for (int ps = 0; ps < 8; ++ps) { const int n = ps * 8 + (lane >> 3), pc = lane & 7;
        const u32x4 w = *(const LAS u32x4*)(T8 + n * 36 + pc * 4);
        const int ng = n0 + n; const int drow = b * t.dst_brow + (ng / t.blk) * t.blk_stride + (ng % t.blk) + t.row_off;
        *(u32x4*)((char*)t.dst + (size_t)drow * t.dst_pitch + k0 + pc * 16) = w; }
    asm volatile("s_waitcnt lgkmcnt(0)" ::: "memory"); __builtin_amdgcn_wave_barrier();
}
__device__ __forceinline__ void phase_wprep(const Frame& F, int layer) {
    const int tid = ltid(), lane = tid & 63; (void)lane;
    LAS float* T = (LAS float*)F.lds + F.wave * (64 * 65);
    const int gw = F.bid * NWAVE + F.wave, nw = F.G * NWAVE;
    int base = 0;
#pragma unroll
    for (int j = 0; j < N_TJOBS; ++j) {
        const TJob t = get_tjob(F, layer, j); const int nt = tjob_tiles(t);
        const int first = (gw - (base % nw) + nw) % nw;
        for (int tile = first; tile < nt; tile += nw) { if (t.f8) transpose_tile8((LAS unsigned*)T, lane, t, tile); else transpose_tile(T, lane, t, tile); }
        base += nt;
    }
    __syncthreads();
}

__device__ __forceinline__ void phase_post1_route(const Frame& F, int layer, bool use_mix) {
    const int tid = ltid(), lane = tid & 63; (void)lane;
    const float* mods = (const float*)(F.ws + WS_MODS) + (size_t)layer * 5 * 12288;
    const unsigned char* MIX = F.ws + WS_MIX;
    bf16_t* X1 = (bf16_t*)(F.ws + WS_X1);
    unsigned* route = (unsigned*)(F.ws + WS_ROUTE);
    unsigned* ecnt = (unsigned*)(F.ws + WS_CTL) + CW_ECNT + layer * 64;
    const float* g1 = F.in[I_LN1G] + layer * D; const float* b1 = F.in[I_LN1B] + layer * D;
    LAS float* RW = (LAS float*)F.lds;
    LAS unsigned* lcnt = (LAS unsigned*)(F.lds + 131072 + 256);
    if (tid < 32) lcnt[tid] = 0u;
    for (int i4 = tid; i4 < 2048 * 16 / 4; i4 += NTHR) { const int k = i4 >> 2, qd = i4 & 3; const int ii = k >> 8, ln = (k >> 2) & 63, c = k & 3;
        *(LAS f32x4*)(RW + ((((qd * 8 + ii) * 4 + c) * 64 + ln) * 4)) = *(const f32x4*)(F.in[I_ROUTW] + (size_t)k * 16 + qd * 4); }
    __syncthreads();
    const int stride = F.G * NWAVE;
    f32x4 xq[8]; unsigned mq[8];
    const int nrows = layer == 1 ? NB * SEQ : R;
#define ROW_OF(qi) (layer == 1 ? (qi) + ((qi) >> 13) * CTXL + CTXL : (qi))
    { const int r = ROW_OF(F.bid * NWAVE + F.wave); const float* x = xin_row(F, layer, r);
#pragma unroll
      for (int i = 0; i < 8; ++i) { const int e = (i * 64 + lane) * 4; xq[i] = *(const f32x4*)(x + e); mq[i] = *(const unsigned*)(MIX + (size_t)r * D + e); } }
    for (int qi = F.bid * NWAVE + F.wave; qi < nrows; qi += stride) { const int r = ROW_OF(qi);
        const int b = r / TB, s = r - b * TB; const float* md = mods + (size_t)(s < CTXL ? 4 : b) * 12288;
        f32x4 v[8]; float sum = 0.f;
#pragma unroll
        for (int i = 0; i < 8; ++i) { const int e = (i * 64 + lane) * 4; v[i] = xq[i] * ALPHA;
            if (use_mix) { const f32x4 g = *(const f32x4*)(md + 2 * 2048 + e) * (1.0f / pg8::Y8_SCALE); const auto m0 = __builtin_amdgcn_cvt_pk_f32_fp8((int)mq[i], false), m1 = __builtin_amdgcn_cvt_pk_f32_fp8((int)mq[i], true);
                v[i][0] += g[0] * m0[0]; v[i][1] += g[1] * m0[1]; v[i][2] += g[2] * m1[0]; v[i][3] += g[3] * m1[1]; }
            sum += (v[i][0] + v[i][1]) + (v[i][2] + v[i][3]); }
        { const int rn = ROW_OF(qi + stride < nrows ? qi + stride : qi); const float* xn = xin_row(F, layer, rn);
#pragma unroll
          for (int i = 0; i < 8; ++i) { const int e = (i * 64 + lane) * 4; xq[i] = *(const f32x4*)(xn + e); mq[i] = *(const unsigned*)(MIX + (size_t)rn * D + e); } }
        float mean = wave_sum(sum, lane) * (1.0f / D); float q = 0.f;
#pragma unroll
        for (int i = 0; i < 8; ++i) { v[i] -= mean; q += (v[i][0] * v[i][0] + v[i][1] * v[i][1]) + (v[i][2] * v[i][2] + v[i][3] * v[i][3]); }
        float rstd = rsqrtf(wave_sum(q, lane) * (1.0f / D) + LN_EPS);
        sum = 0.f;
#pragma unroll
        for (int i = 0; i < 8; ++i) { const int e = (i * 64 + lane) * 4; const f32x4 gg = *(const f32x4*)(g1 + e), bb = *(const f32x4*)(b1 + e);
            v[i] = v[i] * rstd * gg + bb; { u32x2 w; w.x = pk_bf16(v[i][0], v[i][1]); w.y = pk_bf16(v[i][2], v[i][3]); *(u32x2*)(X1 + (size_t)r * D + e) = w; } sum += (v[i][0] + v[i][1]) + (v[i][2] + v[i][3]); }
        mean = wave_sum(sum, lane) * (1.0f / D); q = 0.f;
#pragma unroll
        for (int i = 0; i < 8; ++i) { v[i] -= mean; q += (v[i][0] * v[i][0] + v[i][1] * v[i][1]) + (v[i][2] * v[i][2] + v[i][3] * v[i][3]); }
        rstd = rsqrtf(wave_sum(q, lane) * (1.0f / D) + LN_EPS);
        float lg[16];
#pragma unroll
        for (int e = 0; e < 16; ++e) lg[e] = 0.f;
#pragma unroll
        for (int i = 0; i < 8; ++i) { const int e0 = (i * 64 + lane) * 4; const f32x4 sh = *(const f32x4*)(md + 3 * 2048 + e0), scl = *(const f32x4*)(md + 4 * 2048 + e0);
            const f32x4 u = v[i] * rstd * (scl + 1.0f) + sh;
#pragma unroll
            for (int j = 0; j < 4; ++j) {
#pragma unroll
                for (int qd = 0; qd < 4; ++qd) { const f32x4 w = *(const LAS f32x4*)(RW + ((((qd * 8 + i) * 4 + j) * 64 + lane) * 4)); lg[qd * 4 + 0] += u[j] * w[0]; lg[qd * 4 + 1] += u[j] * w[1]; lg[qd * 4 + 2] += u[j] * w[2]; lg[qd * 4 + 3] += u[j] * w[3]; } }
            __builtin_amdgcn_sched_barrier(0); }
#pragma unroll
        for (int e = 0; e < 16; ++e) lg[e] = wave_sum(lg[e], lane);
        float aff[16], gsc[16];
#pragma unroll
        for (int e = 0; e < 16; ++e) { aff[e] = __builtin_amdgcn_rcpf(1.0f + __expf(-lg[e])); gsc[e] = aff[e] + F.in[I_ROUTB][e]; }
        int best = 0; float bestv = -1e30f;
#pragma unroll
        for (int gI = 0; gI < 4; ++gI) { float m1 = -1e30f, m2 = -1e30f;
#pragma unroll
            for (int j = 0; j < 4; ++j) { const float t = gsc[gI * 4 + j]; if (t > m1) { m2 = m1; m1 = t; } else if (t > m2) m2 = t; }
            const float sc = m1 + m2; if (sc > bestv) { bestv = sc; best = gI; } }
        int i0 = 0, i1 = 0; { float m1 = -1e30f, m2 = -1e30f;
#pragma unroll
            for (int gI = 0; gI < 4; ++gI) if (gI == best) {
#pragma unroll
                for (int j = 0; j < 4; ++j) { const float t = gsc[gI * 4 + j]; if (t > m1) { m2 = m1; i1 = i0; m1 = t; i0 = gI * 4 + j; } else if (t > m2) { m2 = t; i1 = gI * 4 + j; } } } }
        float a0 = 0.f, a1 = 0.f;
#pragma unroll
        for (int e = 0; e < 16; ++e) { a0 = (e == i0) ? aff[e] : a0; a1 = (e == i1) ? aff[e] : a1; }
        const float inv = 1.0f / (a0 + a1);
        if (lane == 0) {
            const unsigned s0 = __hip_atomic_fetch_add(lcnt + i0, 1u, __ATOMIC_RELAXED, __HIP_MEMORY_SCOPE_WORKGROUP), s1 = __hip_atomic_fetch_add(lcnt + i1, 1u, __ATOMIC_RELAXED, __HIP_MEMORY_SCOPE_WORKGROUP);
            u32x4 w0; w0.x = (unsigned)i0; w0.y = (unsigned)i1; w0.z = __float_as_uint(a0 * inv); w0.w = __float_as_uint(a1 * inv);
            *(u32x4*)(route + (size_t)r * 8) = w0; u32x2 w1; w1.x = s0; w1.y = s1; *(u32x2*)(route + (size_t)r * 8 + 4) = w1;
        }
    }
    __syncthreads();
    if (tid < 16) lcnt[16 + tid] = atomicAdd(ecnt + tid, lcnt[tid]);
    __syncthreads();
    for (int qi = F.bid * NWAVE + F.wave; qi < nrows; qi += stride) { const int r = ROW_OF(qi);
        if (lane == 0) { const u32x2 e01 = *(const u32x2*)(route + (size_t)r * 8); u32x2 sl = *(const u32x2*)(route + (size_t)r * 8 + 4);
            sl.x += lcnt[16 + e01.x]; sl.y += lcnt[16 + e01.y]; *(u32x2*)(route + (size_t)r * 8 + 4) = sl; } }
}
__device__ __forceinline__ void load_tile_starts(const Frame& F, int tid, int layer, LAS int* ts) {
    if (tid == 0) { const unsigned* ecnt = (const unsigned*)(F.ws + WS_CTL) + CW_ECNT + layer * 64; int a = 0;
        for (int e = 0; e < 16; ++e) { ts[e] = a; a += (int)((__hip_atomic_load(ecnt + e, __ATOMIC_RELAXED, __HIP_MEMORY_SCOPE_AGENT) + 255u) >> 8); } ts[16] = a; }
    __syncthreads();
}
__device__ __forceinline__ void phase_gather(const Frame& F, int layer) {
    const int tid = ltid(), lane = tid & 63; (void)lane;
    LAS int* ts = (LAS int*)(F.lds + LDS_BYTES - 512);
    const float* mods = (const float*)(F.ws + WS_MODS) + (size_t)layer * 5 * 12288;
    LAS float* ML = (LAS float*)F.lds;
    for (int i = tid; i < 5 * 2 * 512; i += NTHR) { const int mr = i >> 10, v = (i >> 9) & 1, c4 = i & 511; *(LAS f32x4*)(ML + (mr * 2 + v) * 2048 + c4 * 4) = *(const f32x4*)(mods + (size_t)mr * 12288 + (3 + v) * 2048 + c4 * 4); }
    load_tile_starts(F, tid, layer, ts);
    const bf16_t* X1 = (const bf16_t*)(F.ws + WS_X1);
    const unsigned* route = (const unsigned*)(F.ws + WS_ROUTE);
    bf16_t* UG = (bf16_t*)(F.ws + WS_SC);
    const int stride = F.G * NWAVE;
    u32x2 xw[8]; u32x4 rr; u32x2 sl;
    const int nrows = layer == 1 ? NB * SEQ : R;
    { const int r = ROW_OF(F.bid * NWAVE + F.wave);
#pragma unroll
      for (int i = 0; i < 8; ++i) xw[i] = *(const u32x2*)(X1 + (size_t)r * D + (i * 64 + lane) * 4);
      rr = *(const u32x4*)(route + (size_t)r * 8); sl = *(const u32x2*)(route + (size_t)r * 8 + 4); }
    for (int qi = F.bid * NWAVE + F.wave; qi < nrows; qi += stride) { const int r = ROW_OF(qi);
        const int b = r / TB, s = r - b * TB; const LAS float* md = ML + (s < CTXL ? 4 : b) * 4096;
        f32x4 v[8]; float sum = 0.f;
#pragma unroll
        for (int i = 0; i < 8; ++i) { const u32x2 w = xw[i]; v[i][0] = __uint_as_float(w.x << 16); v[i][1] = __uint_as_float(w.x & 0xffff0000u); v[i][2] = __uint_as_float(w.y << 16); v[i][3] = __uint_as_float(w.y & 0xffff0000u); sum += (v[i][0] + v[i][1]) + (v[i][2] + v[i][3]); }
        const u32x4 rc = rr; const u32x2 sc_ = sl;
        { const int rn = ROW_OF(qi + stride < nrows ? qi + stride : qi);
#pragma unroll
          for (int i = 0; i < 8; ++i) xw[i] = *(const u32x2*)(X1 + (size_t)rn * D + (i * 64 + lane) * 4);
          rr = *(const u32x4*)(route + (size_t)rn * 8); sl = *(const u32x2*)(route + (size_t)rn * 8 + 4); }
        const float mean = wave_sum(sum, lane) * (1.0f / D); float q = 0.f;
#pragma unroll
        for (int i = 0; i < 8; ++i) { v[i] -= mean; q += (v[i][0] * v[i][0] + v[i][1] * v[i][1]) + (v[i][2] * v[i][2] + v[i][3] * v[i][3]); }
        const float rstd = rsqrtf(wave_sum(q, lane) * (1.0f / D) + LN_EPS);
        const size_t row0 = (size_t)ts[rc.x] * 256 + sc_.x, row1 = (size_t)ts[rc.y] * 256 + sc_.y;
#pragma unroll
        for (int i = 0; i < 8; ++i) { const int e = (i * 64 + lane) * 4; const f32x4 sh = *(const LAS f32x4*)(md + e), scl = *(const LAS f32x4*)(md + 2048 + e);
            const f32x4 u = v[i] * rstd * (scl + 1.0f) + sh;
            st_op4(UG, row0 * D + e, u[0], u[1], u[2], u[3]); st_op4(UG, row1 * D + e, u[0], u[1], u[2], u[3]); }
    }
}
__device__ __forceinline__ void phase_moe_gemm(const Frame& F, int layer, int which) {
    const int tid = ltid(), lane = tid & 63; (void)lane;
    LAS int* ts = (LAS int*)(F.lds + pg8::STAGE_BYTES);
    load_tile_starts(F, tid, layer, ts);
    if (which == 0) {
        pg8::Gemm g{(const bf16_t*)(F.ws + WS_SC), (const bf16_t*)(F.ws + WS_EGU), 2048 * OPB / 2, 2048 * OPB / 2, 2048 * OPB / 2};
        pg8::GroupedOrder S{ts, 8, F.G, F.bid}; pg8::Epi<4, true> E{(void*)(F.ws + WS_U), nullptr, nullptr, 1024, 8};
        pg8::gemm_phase<pg8::Epi<4, true>, pg8::GroupedOrder>(F.lds, g, S, E, F.wave);
    } else {
        pg8::Gemm g{(const bf16_t*)(F.ws + WS_U), (const bf16_t*)(F.ws + WS_EDN), 1024 * OPB / 2, 1024 * OPB / 2, 1024 * OPB / 2};
        pg8::GroupedOrder S{ts, 8, F.G, F.bid}; pg8::Epi<7, true> E{(void*)(F.ws + WS_SC), nullptr, nullptr, 2048, 8};
        pg8::gemm_phase<pg8::Epi<7, true>, pg8::GroupedOrder>(F.lds, g, S, E, F.wave);
    }
}
__device__ __forceinline__ void phase_post2_moe(const Frame& F, int layer, bool use_ffn) {
    const int tid = ltid(), lane = tid & 63; (void)lane;
    LAS int* ts = (LAS int*)(F.lds + LDS_BYTES - 512);
    const float* mods = (const float*)(F.ws + WS_MODS) + (size_t)layer * 5 * 12288;
    LAS float* GL5 = (LAS float*)F.lds;
    LAS float* G2L = GL5 + 5 * 2048; LAS float* NXL = G2L + 2 * 2048;
    for (int i = tid; i < 5 * 512; i += NTHR) { const int mr = i >> 9, c4 = i & 511; *(LAS f32x4*)(GL5 + mr * 2048 + c4 * 4) = *(const f32x4*)(mods + (size_t)mr * 12288 + 5 * 2048 + c4 * 4); }
    for (int i = tid; i < 2 * 512; i += NTHR) { const int v = i >> 9, c4 = i & 511; *(LAS f32x4*)(G2L + v * 2048 + c4 * 4) = *(const f32x4*)((v == 0 ? F.in[I_LN2G] : F.in[I_LN2B]) + layer * D + c4 * 4); }
    if (layer == 0) for (int i = tid; i < 5 * 2 * 512; i += NTHR) { const int mr = i >> 10, v = (i >> 9) & 1, c4 = i & 511; *(LAS f32x4*)(NXL + (mr * 2 + v) * 2048 + c4 * 4) = *(const f32x4*)(mods + (size_t)5 * 12288 + (size_t)mr * 12288 + v * 2048 + c4 * 4); }
    load_tile_starts(F, tid, layer, ts);
    const bf16_t* X1 = (const bf16_t*)(F.ws + WS_X1);
    const unsigned* route = (const unsigned*)(F.ws + WS_ROUTE);
    const unsigned char* Y = F.ws + WS_SC;
    const float* g2 = F.in[I_LN2G] + layer * D; const float* b2 = F.in[I_LN2B] + layer * D;
    const int stride = F.G * NWAVE;
    u32x2 xw[8]; unsigned y0w[8], y1w[8]; u32x4 rrN; u32x2 slN; float w0c, w1c;
    const int nrows = layer == 1 ? NB * SEQ : R;
    { const int r = ROW_OF(F.bid * NWAVE + F.wave); const u32x4 rr = *(const u32x4*)(route + (size_t)r * 8); const u32x2 sl = *(const u32x2*)(route + (size_t)r * 8 + 4);
      const size_t row0 = (size_t)ts[rr.x] * 256 + sl.x, row1 = (size_t)ts[rr.y] * 256 + sl.y; w0c = __uint_as_float(rr.z); w1c = __uint_as_float(rr.w);
#pragma unroll
      for (int i = 0; i < 8; ++i) { const int e = (i * 64 + lane) * 4; xw[i] = *(const u32x2*)(X1 + (size_t)r * D + e); y0w[i] = *(const unsigned*)(Y + row0 * D + e); y1w[i] = *(const unsigned*)(Y + row1 * D + e); }
      const int q0 = F.bid * NWAVE + F.wave; const int rn = ROW_OF(q0 + stride < nrows ? q0 + stride : q0); rrN = *(const u32x4*)(route + (size_t)rn * 8); slN = *(const u32x2*)(route + (size_t)rn * 8 + 4); }
    for (int qi = F.bid * NWAVE + F.wave; qi < nrows; qi += stride) { const int r = ROW_OF(qi);
        const int b = r / TB, s = r - b * TB; const int mr = s < CTXL ? 4 : b;
        const float w0 = w0c * (1.0f / pg8::Y8_SCALE), w1 = w1c * (1.0f / pg8::Y8_SCALE);
        f32x4 v[8]; float sum = 0.f;
#pragma unroll
        for (int i = 0; i < 8; ++i) { const int e = (i * 64 + lane) * 4; { const u32x2 w = xw[i]; v[i][0] = __uint_as_float(w.x << 16); v[i][1] = __uint_as_float(w.x & 0xffff0000u); v[i][2] = __uint_as_float(w.y << 16); v[i][3] = __uint_as_float(w.y & 0xffff0000u); v[i] *= ALPHA; }
            if (use_ffn) { const f32x4 g = *(const LAS f32x4*)(GL5 + mr * 2048 + e);
                const auto a0 = __builtin_amdgcn_cvt_pk_f32_fp8((int)y0w[i], false), a1 = __builtin_amdgcn_cvt_pk_f32_fp8((int)y0w[i], true), b0 = __builtin_amdgcn_cvt_pk_f32_fp8((int)y1w[i], false), b1 = __builtin_amdgcn_cvt_pk_f32_fp8((int)y1w[i], true);
                v[i][0] += g[0] * (w0 * a0[0] + w1 * b0[0]); v[i][1] += g[1] * (w0 * a0[1] + w1 * b0[1]); v[i][2] += g[2] * (w0 * a1[0] + w1 * b1[0]); v[i][3] += g[3] * (w0 * a1[1] + w1 * b1[1]); }
            sum += (v[i][0] + v[i][1]) + (v[i][2] + v[i][3]); }
        {
            const int rn = ROW_OF(qi + stride < nrows ? qi + stride : qi); const int rn2 = ROW_OF(qi + 2 * stride < nrows ? qi + 2 * stride : qi);
            const size_t row0 = (size_t)ts[rrN.x] * 256 + slN.x, row1 = (size_t)ts[rrN.y] * 256 + slN.y; w0c = __uint_as_float(rrN.z); w1c = __uint_as_float(rrN.w);
#pragma unroll
            for (int i = 0; i < 8; ++i) { const int e = (i * 64 + lane) * 4; xw[i] = *(const u32x2*)(X1 + (size_t)rn * D + e); y0w[i] = *(const unsigned*)(Y + row0 * D + e); y1w[i] = *(const unsigned*)(Y + row1 * D + e); }
            rrN = *(const u32x4*)(route + (size_t)rn2 * 8); slN = *(const u32x2*)(route + (size_t)rn2 * 8 + 4); }
        const float mean = wave_sum(sum, lane) * (1.0f / D); float q = 0.f;
#pragma unroll
        for (int i = 0; i < 8; ++i) { v[i] -= mean; q += (v[i][0] * v[i][0] + v[i][1] * v[i][1]) + (v[i][2] * v[i][2] + v[i][3] * v[i][3]); }
        const float rstd = rsqrtf(wave_sum(q, lane) * (1.0f / D) + LN_EPS);
        float* o = xout_row(F, r); float sum2 = 0.f;
#pragma unroll
        for (int i = 0; i < 8; ++i) { const int e = (i * 64 + lane) * 4; const f32x4 gg = *(const LAS f32x4*)(G2L + e), bb = *(const LAS f32x4*)(G2L + 2048 + e);
            v[i] = v[i] * rstd * gg + bb; *(f32x4*)(o + e) = v[i]; sum2 += (v[i][0] + v[i][1]) + (v[i][2] + v[i][3]); }
        if (layer == 0) {
            const LAS float* mdn = NXL + mr * 4096; void* U = (void*)(F.ws + WS_U);
            const float mean2 = wave_sum(sum2, lane) * (1.0f / D); float q2 = 0.f;
#pragma unroll
            for (int i = 0; i < 8; ++i) { v[i] -= mean2; q2 += (v[i][0] * v[i][0] + v[i][1] * v[i][1]) + (v[i][2] * v[i][2] + v[i][3] * v[i][3]); }
            const float rstd2 = rsqrtf(wave_sum(q2, lane) * (1.0f / D) + LN_EPS);
#pragma unroll
            for (int i = 0; i < 8; ++i) { const int e = (i * 64 + lane) * 4; const f32x4 sh = *(const LAS f32x4*)(mdn + e), scl = *(const LAS f32x4*)(mdn + 2048 + e);
                const f32x4 u = v[i] * rstd2 * (scl + 1.0f) + sh; st_op4(U, (size_t)r * D + e, u[0], u[1], u[2], u[3]); }
        }
    }
}


__device__ __forceinline__ bf16x8 pack_8(const f32x4 a, const f32x4 b) { u32x4 w; w.x = pk_bf16(a[0], a[1]); w.y = pk_bf16(a[2], a[3]); w.z = pk_bf16(b[0], b[1]); w.w = pk_bf16(b[2], b[3]); bf16x8 r; __builtin_memcpy(&r, &w, 16); return r; }
__device__ __forceinline__ bf16x8 lds_2x8(const LAS bf16_t* p0, const LAS bf16_t* p1) { const u32x2 a = *(const LAS u32x2*)p0, b = *(const LAS u32x2*)p1; u32x4 w; w.x = a.x; w.y = a.y; w.z = b.x; w.w = b.y; bf16x8 r; __builtin_memcpy(&r, &w, 16); return r; }
__device__ __forceinline__ int nat_chunk(int d, int j) { return d == 0 ? j : (j < 4 ? 3 - j : 135 - j); }
__device__ __forceinline__ bf16x8 ldsA(const LAS bf16_t* p) { return *(const LAS bf16x8*)p; }
#define MFMA16(a, b, c) __builtin_amdgcn_mfma_f32_16x16x32_bf16((a), (b), (c), 0, 0, 0)
constexpr size_t SC_RWF = 0, SC_RWB = (size_t)R * 1024 * 2, SC_S5 = 2 * SC_RWB, SC_ML = SC_S5 + (size_t)R * 1024 * OPB, SC_RWO = F8 ? SC_ML + (size_t)R * 1024 * OPB : SC_RWF;
static_assert(SC_RWO + (size_t)R * 1024 * OPB <= SC_BYTES, "SC region overflow");

__device__ __forceinline__ void conv_item(const Frame& F, int tid, int layer, int it) {
    const bf16_t* P = (const bf16_t*)(F.ws + WS_P); bf16_t* QK = (bf16_t*)(F.ws + WS_QK);
    int b, rowbase[3], jmin, jmax; bool rv[3];
    if (it < 512) { b = it >> 7; const int i = it & 127; jmin = 0; jmax = 63;
        _Pragma("unroll") for (int a = 0; a < 3; ++a) { const int ii = i + a - 1; rv[a] = (ii >= 0 && ii < 128); rowbase[a] = b * TB + CTXL + ii * 64; } }
    else { const int q = it - 512; b = q >> 2; const int seg = q & 3; jmin = seg == 0 ? 0 : -1; jmax = seg == 3 ? 63 : 64;
        rv[0] = false; rv[2] = false; rv[1] = true; rowbase[0] = rowbase[2] = rowbase[1] = b * TB + seg * 64; }
    const int c0 = tid * 4;
    const float* cw = F.in[I_MLCW] + (size_t)layer * 9 * 2048; const float* cb = F.in[I_MLCB] + layer * 2048;
    f32x4 w[3][3];
#pragma unroll
    for (int a = 0; a < 3; ++a)
#pragma unroll
        for (int bb = 0; bb < 3; ++bb) w[a][bb] = *(const f32x4*)(cw + (a * 3 + bb) * 2048 + c0);
    const f32x4 bias = *(const f32x4*)(cb + c0);
    const float osc = c0 >= 1024 ? 0.0625f : 1.0f;
    f32x4 win[3][3];
#pragma unroll
    for (int a = 0; a < 3; ++a) { win[a][0] = (f32x4){0.f, 0.f, 0.f, 0.f}; win[a][1] = win[a][0]; win[a][2] = win[a][0]; }
    auto ldcol = [&](int a, int jj) -> f32x4 {
        const bool ok = rv[a] && jj >= jmin && jj <= jmax; const int rr = ok ? rowbase[a] + jj : rowbase[1];
        const u32x2 p = *(const u32x2*)(P + (size_t)rr * PW + c0); const float mk = ok ? 1.0f : 0.0f; f32x4 r;
        r[0] = mk * __uint_as_float(p.x << 16); r[1] = mk * __uint_as_float(p.x & 0xffff0000u); r[2] = mk * __uint_as_float(p.y << 16); r[3] = mk * __uint_as_float(p.y & 0xffff0000u);
        return r; };
#pragma unroll
    for (int a = 0; a < 3; ++a) { win[a][1] = ldcol(a, -1); win[a][2] = ldcol(a, 0); }
    for (int j0 = 0; j0 < 64; j0 += 8) {
        f32x4 nw[3][8];
#pragma unroll
        for (int u = 0; u < 8; ++u)
#pragma unroll
            for (int a = 0; a < 3; ++a) nw[a][u] = ldcol(a, j0 + u + 1);
#pragma unroll
        for (int u = 0; u < 8; ++u) {
            f32x4 acc = bias;
#pragma unroll
            for (int a = 0; a < 3; ++a) { win[a][0] = win[a][1]; win[a][1] = win[a][2]; win[a][2] = nw[a][u];
                acc += win[a][0] * w[a][0] + win[a][1] * w[a][1] + win[a][2] * w[a][2]; }
            u32x2 o; o.x = pk_bf16(siluf_(acc[0]) * osc, siluf_(acc[1]) * osc); o.y = pk_bf16(siluf_(acc[2]) * osc, siluf_(acc[3]) * osc);
            *(u32x2*)(QK + (size_t)(rowbase[1] + j0 + u) * 2048 + c0) = o;
        }
    }
}

__device__ __forceinline__ void fsincos(float a, float* s, float* c) { const float k = rintf(a * 0.15915494309189535f); const float r = fmaf(-k, 6.2831854820251465f, a) + k * 1.7484555e-7f; *s = __sinf(r); *c = __cosf(r); }
__device__ __forceinline__ void s5_tables_item(const Frame& F, int tid, int layer, int g) {
    LAS float* pwr = (LAS float*)F.lds;
    LAS float* pwi = pwr + 2 * 65 * 64;
    LAS float* bbr = pwi + 2 * 65 * 64;
    LAS float* bbi = bbr + 2 * 64 * 16;
    LAS float* ccr = bbi + 2 * 64 * 16;
    LAS float* cci = ccr + 2 * 16 * 64;
    LAS float* k0b = cci + 2 * 16 * 64;
    bf16_t* KC = (bf16_t*)(F.ws + WS_S5KC) + (size_t)g * 128 * 256;
    bf16_t* EC = (bf16_t*)(F.ws + WS_S5E) + (size_t)g * 256 * 1024;
    bf16_t* FC = (bf16_t*)(F.ws + WS_S5F) + (size_t)g * 1024 * 256;
    {
        const int dn = tid & 127, d = dn >> 6, n = dn & 63, tg = tid >> 7;
        const size_t li = (((size_t)layer * 2 + d) * 64 + g) * 64 + n;
        const float lre = F.in[I_S5LRE][li], lim = F.in[I_S5LIM][li], dt = expf(F.in[I_S5LDT][((size_t)layer * 2 + d) * 64 + g]);
        const float zr = lre * dt, zi = lim * dt;
        for (int tau = tg; tau <= 64; tau += 4) { const float mag = expf(zr * (float)tau); float sn, cs; fsincos(zi * (float)tau, &sn, &cs);
            pwr[(d * 65 + tau) * 64 + n] = mag * cs; pwi[(d * 65 + tau) * 64 + n] = mag * sn; }
        if (tg == 0) {
            const float mag = expf(zr); float sn, cs; fsincos(zi, &sn, &cs);
            const float nr = mag * cs - 1.0f, ni = mag * sn, den = 1.0f / (lre * lre + lim * lim);
            const float cr = (nr * lre + ni * lim) * den, ci = (ni * lre - nr * lim) * den;
            const float* br = F.in[I_S5BRE] + li * 16; const float* bi = F.in[I_S5BIM] + li * 16;
            for (int c = 0; c < 16; ++c) { bbr[(d * 64 + n) * 16 + c] = cr * br[c] - ci * bi[c]; bbi[(d * 64 + n) * 16 + c] = cr * bi[c] + ci * br[c]; }
        }
        for (int i = tid; i < 2 * 16 * 64; i += NTHR) { const int dd = i >> 10, rem = i & 1023;
            const size_t ci_ = (((size_t)layer * 2 + dd) * 64 + g) * 1024 + rem; ccr[i] = F.in[I_S5CRE][ci_]; cci[i] = F.in[I_S5CIM][ci_]; }
    }
    __syncthreads();
    {
        const int d = tid >> 8, co = (tid >> 4) & 15, ci = tid & 15;
        for (int half = 0; half < 2; ++half) {
            float acc[32];
#pragma unroll
            for (int t = 0; t < 32; ++t) acc[t] = 0.f;
            for (int n = 0; n < 64; ++n) {
                const float c_r = ccr[(d * 16 + co) * 64 + n], c_i = cci[(d * 16 + co) * 64 + n], b_r = bbr[(d * 64 + n) * 16 + ci], b_i = bbi[(d * 64 + n) * 16 + ci];
                const float gr = c_r * b_r - c_i * b_i, gi = c_r * b_i + c_i * b_r;
#pragma unroll
                for (int t = 0; t < 32; ++t) acc[t] += gr * pwr[(d * 65 + half * 32 + t) * 64 + n] - gi * pwi[(d * 65 + half * 32 + t) * 64 + n];
            }
            if (half == 0) {
                if (d == 1) k0b[tid & 255] = acc[0];
                __syncthreads();
                if (d == 0) acc[0] += k0b[tid & 255] + (co == ci ? F.in[I_S5D][layer * 1024 + g * 16 + co] : 0.f);
            }
#pragma unroll
            for (int t = 0; t < 32; ++t) { const int tau = half * 32 + t; if (d == 1 && tau == 0) continue; const int delta = d == 0 ? tau : -tau; KC[(size_t)(delta + 63) * 256 + co * 16 + ci] = f2bf(acc[t]); }
        }
        if (d == 1) KC[(size_t)127 * 256 + (tid & 255)] = 0;
    }
    for (int u = tid; u < 2 * 64 * 64 * 2; u += NTHR) {
        const int ch = u & 1, sp = (u >> 1) & 63, n = (u >> 7) & 63, d = u >> 13;
        const int tau = d == 0 ? 63 - sp : sp; const float pr = pwr[(d * 65 + tau) * 64 + n], pi = pwi[(d * 65 + tau) * 64 + n];
        float er[8], ei[8];
#pragma unroll
        for (int e = 0; e < 8; ++e) { const float b_r = bbr[(d * 64 + n) * 16 + ch * 8 + e], b_i = bbi[(d * 64 + n) * 16 + ch * 8 + e]; er[e] = pr * b_r - pi * b_i; ei[e] = pr * b_i + pi * b_r; }
        u32x4 wr_, wi_; wr_.x = pk_bf16(er[0], er[1]); wr_.y = pk_bf16(er[2], er[3]); wr_.z = pk_bf16(er[4], er[5]); wr_.w = pk_bf16(er[6], er[7]);
        wi_.x = pk_bf16(ei[0], ei[1]); wi_.y = pk_bf16(ei[2], ei[3]); wi_.z = pk_bf16(ei[4], ei[5]); wi_.w = pk_bf16(ei[6], ei[7]);
        *(u32x4*)(EC + (size_t)(d * 128 + n) * 1024 + sp * 16 + ch * 8) = wr_;
        *(u32x4*)(EC + (size_t)(d * 128 + 64 + n) * 1024 + sp * 16 + ch * 8) = wi_;
    }
    for (int u = tid; u < 1024 * 32; u += NTHR) {
        const int n8 = u & 7, part = (u >> 3) & 1, d = (u >> 4) & 1, co = (u >> 5) & 15, tp = u >> 9;
        const int tau = d == 0 ? tp + 1 : 64 - tp; float f[8];
#pragma unroll
        for (int e = 0; e < 8; ++e) { const int n = n8 * 8 + e; const float c_r = ccr[(d * 16 + co) * 64 + n], c_i = cci[(d * 16 + co) * 64 + n], pr = pwr[(d * 65 + tau) * 64 + n], pi = pwi[(d * 65 + tau) * 64 + n];
            f[e] = part == 0 ? (c_r * pr - c_i * pi) : -(c_r * pi + c_i * pr); }
        u32x4 w; w.x = pk_bf16(f[0], f[1]); w.y = pk_bf16(f[2], f[3]); w.z = pk_bf16(f[4], f[5]); w.w = pk_bf16(f[6], f[7]);
        *(u32x4*)(FC + (size_t)(tp * 16 + co) * 256 + d * 128 + part * 64 + n8 * 8) = w;
    }
    __syncthreads();
}

__device__ __forceinline__ void s5a_wave_item(const Frame& F, int lane, int wi) {
    const int rh = wi & 1, w2 = wi >> 1, g = w2 / 9, cq = w2 - g * 9, l15 = lane & 15, q = lane >> 4;
    const bf16_t* P = (const bf16_t*)(F.ws + WS_P); const bf16_t* EC = (const bf16_t*)(F.ws + WS_S5E) + (size_t)g * 256 * 1024 + (size_t)rh * 128 * 1024;
    float* XL = (float*)(F.ws + WS_S5X);
    const bf16_t* ub[4]; int colv[4];
#pragma unroll
    for (int c = 0; c < 4; ++c) { const int ct = (cq * 4 + c) < 33 ? cq * 4 + c : 32; const int col = ct * 16 + l15, b = col / NCH, jn = col - b * NCH; colv[c] = col;
        ub[c] = P + (size_t)(b * TB + jn * 64 + (q >> 1)) * PW + PC_S5 + g * 16 + (q & 1) * 8; }
    const unsigned eoff = (unsigned)(l15 * 1024 + q * 8) * 2u;
    f32x4 acc[4][8];
#pragma unroll
    for (int c = 0; c < 4; ++c)
#pragma unroll
        for (int x = 0; x < 8; ++x) acc[c][x] = (f32x4){0.f, 0.f, 0.f, 0.f};
    for (int ks = 0; ks < 32; ks += 2) {
        bf16x8 Bf[2][4], Af[2][8];
#pragma unroll
        for (int u = 0; u < 2; ++u) {
#pragma unroll
            for (int c = 0; c < 4; ++c) Bf[u][c] = *(const bf16x8*)(ub[c] + (size_t)((ks + u) * 2) * PW);
            unsigned eo = eoff; asm volatile("" : "+v"(eo));
#pragma unroll
            for (int x = 0; x < 8; ++x) Af[u][x] = *(const bf16x8*)((const char*)(EC + (size_t)(x * 16) * 1024 + (ks + u) * 32) + eo); }
#pragma unroll
        for (int u = 0; u < 2; ++u)
#pragma unroll
            for (int x = 0; x < 8; ++x)
#pragma unroll
                for (int c = 0; c < 4; ++c) acc[c][x] = MFMA16(Af[u][x], Bf[u][c], acc[c][x]);
    }
#pragma unroll
    for (int c = 0; c < 4; ++c) if (cq * 4 + c < 33) {
#pragma unroll
        for (int x = 0; x < 8; ++x) *(f32x4*)(XL + ((size_t)g * 528 + colv[c]) * 256 + rh * 128 + x * 16 + q * 4) = acc[c][x]; }
}

__device__ __forceinline__ void s5b_item(const Frame& F, int tid, int layer, int it) {
    const int idx = it * NTHR + tid, n = idx & 63, g = (idx >> 6) & 63, b = (idx >> 12) & 3, d = idx >> 14;
    const size_t li = (((size_t)layer * 2 + d) * 64 + g) * 64 + n;
    const float dt = expf(F.in[I_S5LDT][((size_t)layer * 2 + d) * 64 + g]);
    const float zr = F.in[I_S5LRE][li] * dt * 64.0f, zi = F.in[I_S5LIM][li] * dt * 64.0f;
    const float mag = expf(zr); float sn, cs; fsincos(zi, &sn, &cs); const float ar = mag * cs, ai = mag * sn;
    float* XL = (float*)(F.ws + WS_S5X);
    float cr = 0.f, ci = 0.f;
    for (int j0 = 0; j0 < NCH; j0 += 12) {
        float xr[12], xi[12];
#pragma unroll
        for (int u = 0; u < 12; ++u) { const int col = b * NCH + nat_chunk(d, j0 + u); const float* p = XL + ((size_t)g * 528 + col) * 256 + d * 128 + n; xr[u] = p[0]; xi[u] = p[64]; }
#pragma unroll
        for (int u = 0; u < 12; ++u) { const int col = b * NCH + nat_chunk(d, j0 + u); float* p = XL + ((size_t)g * 528 + col) * 256 + d * 128 + n;
            p[0] = cr; p[64] = ci; const float nr = ar * cr - ai * ci + xr[u], ni = ar * ci + ai * cr + xi[u]; cr = nr; ci = ni; }
    }
}

__device__ __forceinline__ float gelu_tanh(float x) { const float u = 0.7978845608028654f * (x + 0.044715f * x * x * x); const float e = __expf(2.0f * u); const float th = 1.0f - 2.0f / (e + 1.0f); return 0.5f * x * (1.0f + th); }
__device__ __forceinline__ void s5c_block_item(const Frame& F, int tid, int it) {
    const int g = it >> 2, part = it & 3, lane = tid & 63, l15 = lane & 15, q = lane >> 4;
    const int wave = __builtin_amdgcn_readfirstlane(tid >> 6);
    LAS bf16_t* KL = (LAS bf16_t*)F.lds;
    LAS bf16_t* UL = KL + 127 * 264;
    { const bf16_t* KC = (const bf16_t*)(F.ws + WS_S5KC) + (size_t)g * 128 * 256;
      for (int i = tid; i < 127 * 32; i += NTHR) { const int r = i >> 5, sgm = i & 31, co = sgm >> 1, hf = sgm & 1;
          *(LAS u32x4*)(KL + r * 264 + hf * 128 + co * 8) = *(const u32x4*)(KC + (size_t)r * 256 + sgm * 8); } }
    const bf16_t* P = (const bf16_t*)(F.ws + WS_P);
    const bf16_t* FC = (const bf16_t*)(F.ws + WS_S5F) + (size_t)g * 1024 * 256; const float* XC = (const float*)(F.ws + WS_S5X);
    void* OUT = (void*)(F.ws + WS_SC + SC_S5);
    const int c0 = part == 0 ? 0 : 9 + (part - 1) * 8, nct = part == 0 ? 9 : 8;
    for (int cp = 0; cp < (nct + 1) / 2; ++cp) {
        const int ctA = c0 + 2 * cp; const bool vB = (2 * cp + 1) < nct; const int ctB = vB ? ctA + 1 : ctA;
        __syncthreads();
        { const int grp = tid >> 8; const int ct = grp == 0 ? ctA : ctB;
#pragma unroll
          for (int i = 0; i < 8; ++i) { const int id = (tid & 255) + i * 256, s = id >> 5, rem = id & 31, cl = rem >> 1, hf = rem & 1;
              const int colg = ct * 16 + cl, bb = colg / NCH, jj = colg - bb * NCH;
              *(LAS u32x4*)(UL + grp * 16384 + s * 256 + hf * 128 + cl * 8) = *(const u32x4*)(P + (size_t)(bb * TB + jj * 64 + s) * PW + PC_S5 + g * 16 + hf * 8); } }
        __syncthreads();
        const int colA = ctA * 16 + l15, bA = colA / NCH, jA = colA - bA * NCH, colB = ctB * 16 + l15, bB = colB / NCH, jB = colB - bB * NCH;
        const LAS bf16_t* kcl = KL + (63 - (q >> 1)) * 264 + (q & 1) * 128 + l15 * 8;
        const LAS bf16_t* ul = UL + (q >> 1) * 256 + (q & 1) * 128 + l15 * 8;
        f32x4 acc[2][8];
#pragma unroll
        for (int c = 0; c < 2; ++c)
#pragma unroll
            for (int x = 0; x < 8; ++x) acc[c][x] = (f32x4){0.f, 0.f, 0.f, 0.f};
        for (int kb = 0; kb < 4; ++kb) {
#pragma unroll
            for (int i = 0; i < 8; ++i) { const int ks = kb * 8 + i; const bf16x8 b0 = ldsA(ul + ks * 512), b1 = ldsA(ul + 16384 + ks * 512);
#pragma unroll
                for (int x = 0; x < 8; ++x) { const bf16x8 af = ldsA(kcl + (wave * 8 + x - 2 * ks) * 264); acc[0][x] = MFMA16(af, b0, acc[0][x]); acc[1][x] = MFMA16(af, b1, acc[1][x]); }
                if (i & 1) __builtin_amdgcn_sched_barrier(0); }
        }
        {
            const unsigned foff = (unsigned)(l15 * 256 + q * 8) * 2u; const bf16_t* fu = FC + (size_t)(wave * 128) * 256;
            bf16x8 Af[8];
            { unsigned fo = foff; asm volatile("" : "+v"(fo));
#pragma unroll
              for (int x = 0; x < 8; ++x) Af[x] = *(const bf16x8*)((const char*)(fu + (size_t)(x * 16) * 256) + fo); }
            bf16x8 Xa[8], Xb[8];
#pragma unroll
            for (int ks = 0; ks < 8; ++ks) { const float* xp = XC + ((size_t)g * 528 + colA) * 256 + ks * 32 + q * 8; Xa[ks] = pack_8(*(const f32x4*)xp, *(const f32x4*)(xp + 4));
                const float* xq = XC + ((size_t)g * 528 + colB) * 256 + ks * 32 + q * 8; Xb[ks] = pack_8(*(const f32x4*)xq, *(const f32x4*)(xq + 4)); }
#pragma unroll
            for (int ks = 0; ks < 8; ++ks) { bf16x8 An[8]; unsigned fo = foff; asm volatile("" : "+v"(fo));
                if (ks + 1 < 8) {
#pragma unroll
                    for (int x = 0; x < 8; ++x) An[x] = *(const bf16x8*)((const char*)(fu + (size_t)(x * 16) * 256 + (ks + 1) * 32) + fo); }
#pragma unroll
                for (int x = 0; x < 8; ++x) { acc[0][x] = MFMA16(Af[x], Xa[ks], acc[0][x]); acc[1][x] = MFMA16(Af[x], Xb[ks], acc[1][x]); }
                if (ks + 1 < 8) {
#pragma unroll
                    for (int x = 0; x < 8; ++x) Af[x] = An[x]; }
                __builtin_amdgcn_sched_barrier(0); }
        }
#pragma unroll
        for (int x = 0; x < 8; ++x) { const int tp = wave * 8 + x;
            { const size_t row = (size_t)bA * TB + jA * 64 + tp; st_op4(OUT, row * 1024 + g * 16 + q * 4, gelu_tanh(acc[0][x][0]), gelu_tanh(acc[0][x][1]), gelu_tanh(acc[0][x][2]), gelu_tanh(acc[0][x][3])); }
            if (vB) { const size_t row = (size_t)bB * TB + jB * 64 + tp; st_op4(OUT, row * 1024 + g * 16 + q * 4, gelu_tanh(acc[1][x][0]), gelu_tanh(acc[1][x][1]), gelu_tanh(acc[1][x][2]), gelu_tanh(acc[1][x][3])); } }
    }
    __syncthreads();
}

__device__ __forceinline__ float logsigmoidf_(float x) { return fminf(x, 0.f) - __logf(1.0f + __expf(-fabsf(x))); }
__device__ __forceinline__ void mlstm_item(const Frame& F, int tid, int layer, int item) {
    const int vs = item & 3, h = (item >> 2) & 3, b = (item >> 4) & 3, d = item >> 6;
    const int lane = tid & 63, wave = __builtin_amdgcn_readfirstlane(tid >> 6), l15 = lane & 15, q = lane >> 4;
    const int y = wave & 3, p = wave >> 2;
    LAS bf16_t* Qs = (LAS bf16_t*)F.lds;
    LAS bf16_t* Ks = Qs + 64 * 264;
    LAS bf16_t* Kt = Ks + 64 * 264;
    LAS bf16_t* Vt = Kt + 256 * 72;
    LAS bf16_t* Vw = Vt + 64 * 72;
    LAS bf16_t* St = Vw + 64 * 72;
    LAS float* PX = (LAS float*)(St + 64 * 72);
    LAS float* fl = PX + 4 * 4 * 64 * 4;
    LAS float* gsc = fl;
    LAS float* rsum = fl + 384;
    LAS float* qn = fl + 512;
    LAS float* nvec = fl + 576;
    LAS float* wtsl = fl + 832;
    const bf16_t* P = (const bf16_t*)(F.ws + WS_P); const bf16_t* QK = (const bf16_t*)(F.ws + WS_QK);
    bf16_t* HO = (bf16_t*)(F.ws + WS_P);
    if (tid < 256) nvec[tid] = 0.f;
    f32x4 Cst[8];
#pragma unroll
    for (int x = 0; x < 8; ++x) Cst[x] = (f32x4){0.f, 0.f, 0.f, 0.f};
    float m_prev = 0.f;
    u32x4 pq[4], pk[4], pv; float pgi = 0.f, pgf = 0.f;
#define ML_LOAD(jj) do { const int rb_ = b * TB + nat_chunk(d, (jj)) * 64; int tl = tid; asm volatile("" : "+v"(tl));   \
        _Pragma("unroll") for (int i = 0; i < 4; ++i) { const int id = tl + i * NTHR; { const int t = id >> 5, seg = id & 31; const size_t row = (size_t)(rb_ + (d == 0 ? t : 63 - t)); pq[i] = *(const u32x4*)(QK + row * 2048 + h * 256 + seg * 8); } \
            { const int t = id & 63, seg = id >> 6; const size_t row = (size_t)(rb_ + (d == 0 ? t : 63 - t)); pk[i] = *(const u32x4*)(QK + row * 2048 + 1024 + h * 256 + seg * 8); } } \
        { const int t = tl & 63, seg = tl >> 6; const size_t row = (size_t)(rb_ + (d == 0 ? t : 63 - t)); pv = *(const u32x4*)(P + row * PW + PC_V + h * 256 + vs * 64 + seg * 8); } \
        if (wave == 7) { const size_t row = (size_t)(rb_ + (d == 0 ? lane : 63 - lane)); pgi = bf2f(P[row * PW + PC_IG + d * 4 + h]); pgf = bf2f(P[row * PW + PC_FG + d * 4 + h]); } } while (0)
#define ML_STAGE(jj) do { int tl = tid; asm volatile("" : "+v"(tl)); \
        _Pragma("unroll") for (int i = 0; i < 4; ++i) { const int id = tl + i * NTHR; { const int t = id >> 5, seg = id & 31; *(LAS u32x4*)(Qs + t * 264 + seg * 8) = pq[i]; } \
            { const int t = id & 63, seg = id >> 6; *(LAS u32x4*)(Ks + t * 264 + seg * 8) = pk[i]; const unsigned kw[4] = {pk[i].x, pk[i].y, pk[i].z, pk[i].w}; \
              _Pragma("unroll") for (int e = 0; e < 4; ++e) { Kt[(seg * 8 + 2 * e) * 72 + t] = (bf16_t)(kw[e] & 0xffffu); Kt[(seg * 8 + 2 * e + 1) * 72 + t] = (bf16_t)(kw[e] >> 16); } } } \
        { const int t = tl & 63, seg = tl >> 6; const unsigned vw_[4] = {pv.x, pv.y, pv.z, pv.w}; \
            _Pragma("unroll") for (int e = 0; e < 4; ++e) { Vt[(seg * 8 + 2 * e) * 72 + t] = (bf16_t)(vw_[e] & 0xffffu); Vt[(seg * 8 + 2 * e + 1) * 72 + t] = (bf16_t)(vw_[e] >> 16); } } \
        if (wave == 7) { const float igb = F.in[I_MLIGB][layer * 8 + d * 4 + h], fgb = F.in[I_MLFGB][layer * 8 + d * 4 + h];     \
            float bc = logsigmoidf_(pgf + fgb); \
            _Pragma("unroll") for (int o = 1; o < 64; o <<= 1) { const float t = shup(bc, o, lane); if (lane >= o) bc += t; } \
            const float g_ = (pgi + igb) - bc; float pm = g_; \
            _Pragma("unroll") for (int o = 1; o < 64; o <<= 1) { const float t = shup(pm, o, lane); if (lane >= o) pm = fmaxf(pm, t); } \
            LAS float* gs_ = gsc + ((jj) & 1) * 192; gs_[lane] = g_; gs_[64 + lane] = pm; gs_[128 + lane] = bc; } } while (0)
    ML_LOAD(0);
    __syncthreads();
    ML_STAGE(0);
    ML_LOAD(1);
    __syncthreads();
    for (int j = 0; j < NCH; ++j) {
        const int rb = b * TB + nat_chunk(d, j) * 64;
        const LAS float* gg = gsc + (j & 1) * 192; const LAS float* pmx = gg + 64; const LAS float* bcm = gg + 128;
        const float a63 = fmaxf(m_prev, pmx[63]), decay = __expf(m_prev - a63), m_new = bcm[63] + a63;
        { const int tr = wave >> 1; float rp[4] = {0.f, 0.f, 0.f, 0.f};
#pragma unroll
          for (int u = 0; u < 2; ++u) { const int tc = (wave & 1) * 2 + u; f32x4 acc = (f32x4){0.f, 0.f, 0.f, 0.f};
              if (tc <= tr) {
#pragma unroll
                  for (int ks = 0; ks < 8; ++ks) acc = MFMA16(ldsA(Qs + (tr * 16 + l15) * 264 + ks * 32 + q * 8), ldsA(Ks + (tc * 16 + l15) * 264 + ks * 32 + q * 8), acc);
              }
              const int s = tc * 16 + l15; const float gs = gg[s];
#pragma unroll
              for (int i = 0; i < 4; ++i) { const int jr = tr * 16 + q * 4 + i; const float v = (s <= jr) ? acc[i] * __expf(gs - fmaxf(pmx[jr], m_prev)) : 0.f; St[jr * 72 + s] = f2bf(v); rp[i] += v; } }
#pragma unroll
          for (int i = 0; i < 4; ++i) { float s_ = rp[i]; s_ += shx<1>(s_); s_ += shx<2>(s_); s_ += shx<4>(s_); s_ += shx<8>(s_); if (l15 == 0) rsum[(wave & 1) * 64 + tr * 16 + q * 4 + i] = s_; } }
#pragma unroll
        for (int i = 0; i < 8; ++i) { const int id = tid + i * NTHR, dv = id >> 6, s = id & 63; Vw[dv * 72 + s] = f2bf(bf2f(Vt[dv * 72 + s]) * __expf(gg[s] - a63)); }
        if (tid < 64) wtsl[tid] = __expf(gg[tid] - a63);
        { const int row = tid >> 3, part = tid & 7; float qv = 0.f;
#pragma unroll
          for (int e8 = 0; e8 < 4; ++e8) { float x8[8]; unpack8(*(const LAS u32x4*)(Qs + row * 264 + part * 32 + e8 * 8), x8); const f32x4 n0 = *(const LAS f32x4*)(nvec + part * 32 + e8 * 8), n1 = *(const LAS f32x4*)(nvec + part * 32 + e8 * 8 + 4);
              qv += (x8[0] * n0[0] + x8[1] * n0[1]) + (x8[2] * n0[2] + x8[3] * n0[3]) + (x8[4] * n1[0] + x8[5] * n1[1]) + (x8[6] * n1[2] + x8[7] * n1[3]); }
          qv += shx<1>(qv); qv += shx<2>(qv); qv += shx<4>(qv);
          if (part == 0) qn[row] = qv; }
        __syncthreads();
        f32x4 acc[4], PXs[4];
#pragma unroll
        for (int rt = 0; rt < 4; ++rt) PXs[rt] = (f32x4){0.f, 0.f, 0.f, 0.f};
        { bf16x8 Cb[4];
#pragma unroll
          for (int kk = 0; kk < 4; ++kk) Cb[kk] = pack_8(Cst[2 * kk], Cst[2 * kk + 1]);
#pragma unroll
          for (int rt = 0; rt < 4; ++rt) { acc[rt] = (f32x4){0.f, 0.f, 0.f, 0.f};
#pragma unroll
              for (int kk = 0; kk < 4; ++kk) { const LAS bf16_t* qp = Qs + (rt * 16 + l15) * 264 + (p * 8 + 2 * kk) * 16 + q * 4; acc[rt] = MFMA16(lds_2x8(qp, qp + 16), Cb[kk], acc[rt]); } } }
        if (p == 1) {
#pragma unroll
            for (int rt = 0; rt < 4; ++rt) *(LAS f32x4*)(PX + ((y * 4 + rt) * 64 + lane) * 4) = acc[rt];
        } else {
#pragma unroll
            for (int rt = 0; rt < 4; ++rt) { f32x4 a2 = (f32x4){0.f, 0.f, 0.f, 0.f};
#pragma unroll
                for (int ks = 0; ks < 2; ++ks) a2 = MFMA16(ldsA(St + (rt * 16 + l15) * 72 + ks * 32 + q * 8), ldsA(Vt + (y * 16 + l15) * 72 + ks * 32 + q * 8), a2);
                PXs[rt] = a2; }
        }
        { const bf16x8 vw0 = ldsA(Vw + (y * 16 + l15) * 72 + q * 8), vw1 = ldsA(Vw + (y * 16 + l15) * 72 + 32 + q * 8);
          bf16x8 wq0, wq1; { const f32x4 a0 = *(const LAS f32x4*)(wtsl + q * 8), a1 = *(const LAS f32x4*)(wtsl + q * 8 + 4), b0 = *(const LAS f32x4*)(wtsl + 32 + q * 8), b1 = *(const LAS f32x4*)(wtsl + 32 + q * 8 + 4);
              const f32x4 zz = (f32x4){0.f, 0.f, 0.f, 0.f}; wq0 = l15 == 0 ? pack_8(a0, a1) : pack_8(zz, zz); wq1 = l15 == 0 ? pack_8(b0, b1) : pack_8(zz, zz); }
#pragma unroll
          for (int x = 0; x < 8; ++x) { Cst[x] *= decay; const LAS bf16_t* kp = Kt + ((p * 8 + x) * 16 + l15) * 72 + q * 8; const bf16x8 k0 = ldsA(kp), k1 = ldsA(kp + 32);
              Cst[x] = MFMA16(k0, vw0, Cst[x]); Cst[x] = MFMA16(k1, vw1, Cst[x]);
              if (x == 2 * y || x == 2 * y + 1) { const int dkb = (p * 8 + x) * 16 + q * 4; f32x4 nn = (f32x4){0.f, 0.f, 0.f, 0.f};
                  if (l15 == 0) { nn = *(const LAS f32x4*)(nvec + dkb); nn *= decay; }
                  nn = MFMA16(k0, wq0, nn); nn = MFMA16(k1, wq1, nn);
                  if (l15 == 0) *(LAS f32x4*)(nvec + dkb) = nn; } } }
        __syncthreads();
        if (p == 0) {
#pragma unroll
            for (int rt = 0; rt < 4; ++rt) { const f32x4 px = *(const LAS f32x4*)(PX + ((y * 4 + rt) * 64 + lane) * 4);
#pragma unroll
                for (int i = 0; i < 4; ++i) { const int t = rt * 16 + q * 4 + i; const float a_ = fmaxf(pmx[t], m_prev), si = __expf(m_prev - a_);
                    const float hd = fmaxf(fabsf(rsum[t] + rsum[64 + t] + si * qn[t]), __expf(-(bcm[t] + a_)));
                    const float num = (acc[rt][i] + px[i]) * si + PXs[rt][i];
                    const size_t row = (size_t)(rb + (d == 0 ? t : 63 - t));
                    HO[row * PW + d * 1024 + h * 256 + vs * 64 + y * 16 + l15] = f2bf(num * __builtin_amdgcn_rcpf(hd)); } }
        }
        if (j + 1 < NCH) { ML_STAGE(j + 1); if (j + 2 < NCH) ML_LOAD(j + 2); }
        m_prev = m_new;
        __syncthreads();
    }
#undef ML_LOAD
#undef ML_STAGE
}

__device__ __forceinline__ void ml_finish_rows(const Frame& F, int lane, int layer) {
    const bf16_t* P = (const bf16_t*)(F.ws + WS_P); bf16_t* ML = (bf16_t*)(F.ws + WS_SC + SC_ML);
    const float* ng = F.in[I_MLNG] + layer * 1024; const float* nb = F.in[I_MLNB] + layer * 1024;
    const int c0 = lane * 16, stride = F.G * NWAVE;
    for (int r0 = F.bid * NWAVE + F.wave; r0 < R; r0 += 4 * stride) {
        u32x4 ha[4][2], hb[4][2], ho[4][2];
#pragma unroll
        for (int u = 0; u < 4; ++u) { const int r = r0 + u * stride < R ? r0 + u * stride : r0; const bf16_t* pr = P + (size_t)r * PW;
#pragma unroll
            for (int hh = 0; hh < 2; ++hh) { ha[u][hh] = *(const u32x4*)(pr + c0 + hh * 8); hb[u][hh] = *(const u32x4*)(pr + 1024 + c0 + hh * 8); ho[u][hh] = *(const u32x4*)(pr + PC_O + c0 + hh * 8); } }
#pragma unroll
        for (int u = 0; u < 4; ++u) { const int r = r0 + u * stride; if (r < R) {
            float v[16], o[16];
#pragma unroll
            for (int hh = 0; hh < 2; ++hh) { float a8[8], b8[8], o8[8]; unpack8(ha[u][hh], a8); unpack8(hb[u][hh], b8); unpack8(ho[u][hh], o8);
#pragma unroll
                for (int e2 = 0; e2 < 8; ++e2) { v[hh * 8 + e2] = a8[e2] + b8[e2]; o[hh * 8 + e2] = o8[e2]; } }
            float s = 0.f;
#pragma unroll
            for (int e2 = 0; e2 < 16; ++e2) s += v[e2];
            s += shx<1>(s); s += shx<2>(s); s += shx<4>(s); s += shx<8>(s);
            const float mean = s * (1.0f / 256.0f); float qq = 0.f;
#pragma unroll
            for (int e2 = 0; e2 < 16; ++e2) { v[e2] -= mean; qq += v[e2] * v[e2]; }
            qq += shx<1>(qq); qq += shx<2>(qq); qq += shx<4>(qq); qq += shx<8>(qq);
            const float rstd = rsqrtf(qq * (1.0f / 256.0f) + 1e-6f);
            float y8[8];
#pragma unroll
            for (int hh = 0; hh < 2; ++hh) {
#pragma unroll
                for (int e2 = 0; e2 < 8; ++e2) { const int ee = hh * 8 + e2; y8[e2] = (v[ee] * rstd * ng[c0 + ee] + nb[c0 + ee]) * sigmoidf_(o[ee]); }
                st_op8(ML, (size_t)r * 1024 + c0 + hh * 8, y8); } } }
    }
}


__device__ __forceinline__ void tshift8(const bf16_t* P, size_t row, int srow, int col, const float* mu, float (&o)[8]) {
    float z[8], zp[8], zn[8];
    const bool hp = (srow != 0 && srow != CTXL), hn = (srow != CTXL - 1 && srow != TB - 1);
    const u32x4 wz = *(const u32x4*)(P + row * PW + col), wp = *(const u32x4*)(P + (hp ? row - 1 : row) * PW + col), wn = *(const u32x4*)(P + (hn ? row + 1 : row) * PW + col);
    const f32x4 m0 = *(const f32x4*)mu, m1 = *(const f32x4*)(mu + 4);
    unpack8(wz, z); unpack8(wp, zp); unpack8(wn, zn);
    const float fp = hp ? 0.5f : 0.f, fn = hn ? 0.5f : 0.f;
#pragma unroll
    for (int e = 0; e < 8; ++e) { const float m = e < 4 ? m0[e & 3] : m1[e & 3]; o[e] = z[e] + m * (fp * zp[e] + fn * zn[e] - z[e]); }
}
__device__ __forceinline__ void rwkv_item(const Frame& F, int tid, int layer, int item) {
    const int h = item & 15, b = (item >> 4) & 3, d = item >> 6;
    const int lane = tid & 63, wave = __builtin_amdgcn_readfirstlane(tid >> 6), l15 = lane & 15, q = lane >> 4;
    LAS float* r_ = (LAS float*)F.lds;
    LAS float* w_ = r_ + 4096, *kd_ = w_ + 4096, *kk_ = kd_ + 4096, *bb_ = kk_ + 4096, *v_ = bb_ + 4096;
    LAS bf16_t* TW = (LAS bf16_t*)(v_ + 4096);
    LAS bf16_t* TA = TW + 64 * 72;
    LAS bf16_t* WU = TA + 64 * 72;
    LAS bf16_t* AU = WU + 64 * 72;
    LAS float* yout = (LAS float*)TW;
    const bf16_t* P = (const bf16_t*)(F.ws + WS_P);
    bf16_t* YO = (bf16_t*)(F.ws + WS_SC + (d == 0 ? SC_RWF : SC_RWB));
    float* BON = (float*)(F.ws + WS_BONUS) + (size_t)d * R * 16;
    const float* mu = F.in[I_RWMU] + layer * 3456;
    {
        const int rr = tid >> 3, c0 = (tid & 7) * 8;
        const float* wu = F.in[I_RWWUP] + (((size_t)layer * 2 + d) * 64 + rr) * 1024 + h * 64 + c0; const float* au = F.in[I_RWAUP] + (((size_t)layer * 2 + d) * 64 + rr) * 1024 + h * 64 + c0;
#pragma unroll
        for (int e = 0; e < 8; ++e) { WU[(c0 + e) * 72 + rr] = f2bf(wu[e]); AU[(c0 + e) * 72 + rr] = f2bf(au[e]); }
    }
    const int t_ = tid >> 3, c0 = (tid & 7) * 8;
    float mur[8], muk[8], muv[8], muw[8], mua[8], kkc[8], kac[8], rkc[8];
#pragma unroll
    for (int e = 0; e < 8; ++e) { mur[e] = mu[h * 64 + c0 + e]; muk[e] = mu[1024 + h * 64 + c0 + e]; muv[e] = mu[2048 + h * 64 + c0 + e]; muw[e] = mu[3072 + d * 64 + c0 + e]; mua[e] = mu[3200 + d * 64 + c0 + e];
        kkc[e] = F.in[I_RWKK][layer * 1024 + h * 64 + c0 + e]; kac[e] = F.in[I_RWKA][layer * 1024 + h * 64 + c0 + e]; rkc[e] = F.in[I_RWRK][layer * 1024 + h * 64 + c0 + e]; }
    float S[8];
#pragma unroll
    for (int e = 0; e < 8; ++e) S[e] = 0.f;
    const int vrow = tid >> 3, cg = tid & 7;
    __syncthreads();
    for (int j = 0; j < NCH; ++j) {
        const int jn = nat_chunk(d, j); const int srow = jn * 64 + (d == 0 ? t_ : 63 - t_); const size_t row = (size_t)b * TB + srow;
        float rs[8], ks[8], vs[8], tmp[8];
        tshift8(P, row, srow, PC_RR + h * 64 + c0, mur, rs); tshift8(P, row, srow, PC_RK + h * 64 + c0, muk, ks); tshift8(P, row, srow, PC_RV + h * 64 + c0, muv, vs);
        tshift8(P, row, srow, PC_WD + d * 64 + c0, muw, tmp);
#pragma unroll
        for (int e = 0; e < 8; ++e) TW[t_ * 72 + c0 + e] = f2bf(tanhf_(tmp[e]));
        tshift8(P, row, srow, PC_AD + d * 64 + c0, mua, tmp);
#pragma unroll
        for (int e = 0; e < 8; ++e) TA[t_ * 72 + c0 + e] = f2bf(tmp[e]);
        float kkv[8], ss = 0.f;
#pragma unroll
        for (int e = 0; e < 8; ++e) { r_[t_ * 64 + c0 + e] = rs[e]; v_[t_ * 64 + c0 + e] = vs[e]; kkv[e] = ks[e] * kkc[e]; ss += kkv[e] * kkv[e]; }
        ss += shx<1>(ss); ss += shx<2>(ss); ss += shx<4>(ss);
        const float inv = 1.0f / fmaxf(sqrtf(ss), 1e-12f);
        __syncthreads();
        {
            const int tr = wave >> 1;
#pragma unroll
            for (int u = 0; u < 2; ++u) { const int tc = (wave & 1) * 2 + u; f32x4 aw = (f32x4){0.f, 0.f, 0.f, 0.f}, aa = aw;
#pragma unroll
                for (int kq = 0; kq < 2; ++kq) { aw = MFMA16(ldsA(TW + (tr * 16 + l15) * 72 + kq * 32 + q * 8), ldsA(WU + (tc * 16 + l15) * 72 + kq * 32 + q * 8), aw);
                    aa = MFMA16(ldsA(TA + (tr * 16 + l15) * 72 + kq * 32 + q * 8), ldsA(AU + (tc * 16 + l15) * 72 + kq * 32 + q * 8), aa); }
                const int c = tc * 16 + l15; const float w0 = F.in[I_RWW0][((size_t)layer * 2 + d) * 1024 + h * 64 + c], a0 = F.in[I_RWA0][((size_t)layer * 2 + d) * 1024 + h * 64 + c];
#pragma unroll
                for (int i = 0; i < 4; ++i) { const int t = tr * 16 + q * 4 + i; w_[t * 64 + c] = __expf(-0.6065306597126334f * sigmoidf_(w0 + aw[i])); bb_[t * 64 + c] = sigmoidf_(a0 + aa[i]); } }
        }
        __syncthreads();
        { float bon = 0.f;
#pragma unroll
          for (int e = 0; e < 8; ++e) { const float a = bb_[t_ * 64 + c0 + e]; const float kdv = ks[e] * (1.0f + (a - 1.0f) * kac[e]); const float kkn = kkv[e] * inv;
              kd_[t_ * 64 + c0 + e] = kdv; kk_[t_ * 64 + c0 + e] = kkn; bb_[t_ * 64 + c0 + e] = kkn * a; bon += rs[e] * kdv * rkc[e]; }
          bon += shx<1>(bon); bon += shx<2>(bon); bon += shx<4>(bon);
          if ((tid & 7) == 0) BON[row * 16 + h] = bon; }
        __syncthreads();
        for (int t = 0; t < 64; ++t) {
            const LAS f32x4* pk = (const LAS f32x4*)(kk_ + t * 64 + cg * 8); const LAS f32x4* pw = (const LAS f32x4*)(w_ + t * 64 + cg * 8);
            const LAS f32x4* pb = (const LAS f32x4*)(bb_ + t * 64 + cg * 8); const LAS f32x4* pd = (const LAS f32x4*)(kd_ + t * 64 + cg * 8); const LAS f32x4* pr = (const LAS f32x4*)(r_ + t * 64 + cg * 8);
            const f32x4 k0 = pk[0], k1 = pk[1], w0 = pw[0], w1 = pw[1], b0 = pb[0], b1 = pb[1], d0 = pd[0], d1 = pd[1], r0 = pr[0], r1 = pr[1];
            const float vv = v_[t * 64 + vrow];
            float skk = (S[0] * k0[0] + S[1] * k0[1]) + (S[2] * k0[2] + S[3] * k0[3]) + (S[4] * k1[0] + S[5] * k1[1]) + (S[6] * k1[2] + S[7] * k1[3]);
            skk += shx<1>(skk); skk += shx<2>(skk); skk += shx<4>(skk);
#pragma unroll
            for (int e = 0; e < 4; ++e) { S[e] = S[e] * w0[e] - skk * b0[e] + vv * d0[e]; S[4 + e] = S[4 + e] * w1[e] - skk * b1[e] + vv * d1[e]; }
            float y = (S[0] * r0[0] + S[1] * r0[1]) + (S[2] * r0[2] + S[3] * r0[3]) + (S[4] * r1[0] + S[5] * r1[1]) + (S[6] * r1[2] + S[7] * r1[3]);
            y += shx<1>(y); y += shx<2>(y); y += shx<4>(y);
            if (cg == 0) yout[t * 64 + vrow] = y;
        }
        __syncthreads();
        { float yv[8];
#pragma unroll
          for (int e = 0; e < 8; ++e) yv[e] = yout[t_ * 64 + c0 + e];
          u32x4 w; w.x = pk_bf16(yv[0], yv[1]); w.y = pk_bf16(yv[2], yv[3]); w.z = pk_bf16(yv[4], yv[5]); w.w = pk_bf16(yv[6], yv[7]);
          *(u32x4*)(YO + row * 1024 + h * 64 + c0) = w; }
        __syncthreads();
    }
}

#define MFMAF32(a, b, c) __builtin_amdgcn_mfma_f32_16x16x4f32((a), (b), (c), 0, 0, 0)
__device__ __forceinline__ f32x4 mm16(const f32x4 P, const f32x4 Y) {
    f32x4 acc = (f32x4){0.f, 0.f, 0.f, 0.f};
#pragma unroll
    for (int i = 0; i < 4; ++i) acc = MFMAF32(P[i], Y[i], acc);
    return acc;
}
__device__ __forceinline__ bf16x8 pack_lo4(const f32x4 x) { u32x4 w; w.x = pk_bf16(x[0], x[1]); w.y = pk_bf16(x[2], x[3]); w.z = 0u; w.w = 0u; bf16x8 r; __builtin_memcpy(&r, &w, 16); return r; }
__device__ __forceinline__ bf16x8 pack_hi4(const f32x4 x) { u32x4 w; w.x = 0u; w.y = 0u; w.z = pk_bf16(x[0], x[1]); w.w = pk_bf16(x[2], x[3]); bf16x8 r; __builtin_memcpy(&r, &w, 16); return r; }
#define WAVE_SYNC() do { asm volatile("s_waitcnt lgkmcnt(0)" ::: "memory"); __builtin_amdgcn_wave_barrier(); } while (0)
constexpr int RWC_WREG = 15360;
constexpr int RWC_R0 = 0, RWC_R1 = 2304, RWC_R2 = 4608, RWC_R3 = 6912, RWC_BK = 9216, RWC_V = 13312, RWC_NN = RWC_R1, RWC_TM = RWC_R1 + 1024, RWC_GL = RWC_R1 + 1536;
__device__ __forceinline__ void rwkvc_item(const Frame& F, int tid, int layer, int item) {
    const int h = item & 15, b = (item >> 4) & 3, d = item >> 6;
    const int lane = tid & 63, wave = __builtin_amdgcn_readfirstlane(tid >> 6), l15 = lane & 15, q = lane >> 4;
    LAS bf16_t* WU = (LAS bf16_t*)F.lds;
    LAS bf16_t* AU = WU + 64 * 72;
    LAS unsigned char* wreg0 = F.lds + 2 * 64 * 72 * 2;
    LAS unsigned char* wb = wreg0 + wave * RWC_WREG;
    LAS float* MUL = (LAS float*)(wreg0 + 8 * RWC_WREG);
    const bf16_t* P = (const bf16_t*)(F.ws + WS_P);
    bf16_t* YO = (bf16_t*)(F.ws + WS_SC + (d == 0 ? SC_RWF : SC_RWB));
    float* BON = (float*)(F.ws + WS_BONUS) + (size_t)d * R * 16;
    const float* mu = F.in[I_RWMU] + layer * 3456;
    if (tid < 320) { const int a = tid >> 6, c = tid & 63; const int off = a == 0 ? h * 64 : a == 1 ? 1024 + h * 64 : a == 2 ? 2048 + h * 64 : a == 3 ? 3072 + d * 64 : 3200 + d * 64; MUL[tid] = mu[off + c]; }
    {   const int rr = tid >> 3, c0 = (tid & 7) * 8;
        const float* wu = F.in[I_RWWUP] + (((size_t)layer * 2 + d) * 64 + rr) * 1024 + h * 64 + c0; const float* au = F.in[I_RWAUP] + (((size_t)layer * 2 + d) * 64 + rr) * 1024 + h * 64 + c0;
#pragma unroll
        for (int e = 0; e < 8; ++e) { WU[(c0 + e) * 72 + rr] = f2bf(wu[e]); AU[(c0 + e) * 72 + rr] = f2bf(au[e]); } }
    float kkc[4], kac[4], rkc[4], w0c[4], a0c[4];
#pragma unroll
    for (int ct = 0; ct < 4; ++ct) { const int c = h * 64 + ct * 16 + l15; kkc[ct] = F.in[I_RWKK][layer * 1024 + c]; kac[ct] = F.in[I_RWKA][layer * 1024 + c]; rkc[ct] = F.in[I_RWRK][layer * 1024 + c];
        w0c[ct] = F.in[I_RWW0][((size_t)layer * 2 + d) * 1024 + c]; a0c[ct] = F.in[I_RWA0][((size_t)layer * 2 + d) * 1024 + c]; }
    f32x4 Sacc[4];
#pragma unroll
    for (int x = 0; x < 4; ++x) Sacc[x] = (f32x4){0.f, 0.f, 0.f, 0.f};
    __syncthreads();
    for (int rnd = 0; rnd < NCH * 4 / 8; ++rnd) {
        {
            const int ch = rnd * 8 + wave, j64 = ch >> 2, jn = nat_chunk(d, j64), o0 = (ch & 3) * 16;
            LAS bf16_t* R0 = (LAS bf16_t*)(wb + RWC_R0); LAS bf16_t* R1 = (LAS bf16_t*)(wb + RWC_R1); LAS bf16_t* R2 = (LAS bf16_t*)(wb + RWC_R2); LAS bf16_t* R3 = (LAS bf16_t*)(wb + RWC_R3);
            LAS bf16_t* TAp = (LAS bf16_t*)(wb + RWC_BK); LAS bf16_t* BKT = (LAS bf16_t*)(wb + RWC_BK); LAS bf16_t* VF = (LAS bf16_t*)(wb + RWC_V);
            {
                const int t = lane >> 2, cq = (lane & 3) * 16; const int o = o0 + t; const int srow = jn * 64 + (d == 0 ? o : 63 - o); const size_t row = (size_t)b * TB + srow;
                const bool hp = (srow != 0 && srow != CTXL), hn = (srow != CTXL - 1 && srow != TB - 1); const float fp = hp ? 0.5f : 0.f, fn = hn ? 0.5f : 0.f;
                const bf16_t* pz = P + row * PW; const bf16_t* pp = P + (hp ? row - 1 : row) * PW; const bf16_t* pn = P + (hn ? row + 1 : row) * PW;
                const int colA[5] = {PC_RR + h * 64, PC_RK + h * 64, PC_RV + h * 64, PC_WD + d * 64, PC_AD + d * 64};
                u32x4 wz[5][2], wp[5][2], wn[5][2];
#pragma unroll
                for (int a = 0; a < 5; ++a)
#pragma unroll
                    for (int hh = 0; hh < 2; ++hh) { const int c = colA[a] + cq + hh * 8; wz[a][hh] = *(const u32x4*)(pz + c); wp[a][hh] = *(const u32x4*)(pp + c); wn[a][hh] = *(const u32x4*)(pn + c); }
                LAS bf16_t* dst[5] = {R0, R1, R2, R3, TAp};
#pragma unroll
                for (int a = 0; a < 5; ++a)
#pragma unroll
                    for (int hh = 0; hh < 2; ++hh) { const int cc = cq + hh * 8; float z[8], zp[8], zn[8], x8[8];
                        unpack8(wz[a][hh], z); unpack8(wp[a][hh], zp); unpack8(wn[a][hh], zn);
                        const f32x4 m0 = *(const LAS f32x4*)(MUL + a * 64 + cc), m1 = *(const LAS f32x4*)(MUL + a * 64 + cc + 4);
#pragma unroll
                        for (int e = 0; e < 8; ++e) { const float m = e < 4 ? m0[e & 3] : m1[e & 3]; x8[e] = z[e] + m * (fp * zp[e] + fn * zn[e] - z[e]); if (a == 3) x8[e] = tanhf_(x8[e]); }
                        u32x4 w; w.x = pk_bf16(x8[0], x8[1]); w.y = pk_bf16(x8[2], x8[3]); w.z = pk_bf16(x8[4], x8[5]); w.w = pk_bf16(x8[6], x8[7]); *(LAS u32x4*)(dst[a] + t * 72 + cc) = w; }
            }
            WAVE_SYNC();
            f32x4 lw[4], av[4];
            {   const bf16x8 tw0 = ldsA(R3 + l15 * 72 + q * 8), tw1 = ldsA(R3 + l15 * 72 + 32 + q * 8), ta0 = ldsA(TAp + l15 * 72 + q * 8), ta1 = ldsA(TAp + l15 * 72 + 32 + q * 8);
#pragma unroll
                for (int ct = 0; ct < 4; ++ct) { f32x4 aw = (f32x4){0.f, 0.f, 0.f, 0.f}, aa = aw;
                    aw = MFMA16(tw0, ldsA(WU + (ct * 16 + l15) * 72 + q * 8), aw); aw = MFMA16(tw1, ldsA(WU + (ct * 16 + l15) * 72 + 32 + q * 8), aw);
                    aa = MFMA16(ta0, ldsA(AU + (ct * 16 + l15) * 72 + q * 8), aa); aa = MFMA16(ta1, ldsA(AU + (ct * 16 + l15) * 72 + 32 + q * 8), aa);
#pragma unroll
                    for (int i = 0; i < 4; ++i) { lw[ct][i] = -0.6065306597126334f * sigmoidf_(w0c[ct] + aw[i]); av[ct][i] = sigmoidf_(a0c[ct] + aa[i]); } } }
            WAVE_SYNC();
            float ssq[4] = {0.f, 0.f, 0.f, 0.f};
#pragma unroll
            for (int ct = 0; ct < 4; ++ct)
#pragma unroll
                for (int i = 0; i < 4; ++i) { const float kk = bf2f(R1[(q * 4 + i) * 72 + ct * 16 + l15]) * kkc[ct]; ssq[i] += kk * kk; }
            float inv[4];
#pragma unroll
            for (int i = 0; i < 4; ++i) { float s = ssq[i]; s += shx<1>(s); s += shx<2>(s); s += shx<4>(s); s += shx<8>(s); inv[i] = 1.0f / fmaxf(sqrtf(s), 1e-12f); }
            float bon[4] = {0.f, 0.f, 0.f, 0.f};
            bf16x8 Apk[4];
            float glv[4];
#pragma unroll
            for (int ct = 0; ct < 4; ++ct) {
                f32x4 lg; lg[0] = lw[ct][0]; lg[1] = lg[0] + lw[ct][1]; lg[2] = lg[1] + lw[ct][2]; lg[3] = lg[2] + lw[ct][3];
                const float tot = lg[3];
                float x1 = tot; { const float t1 = shup(x1, 16, lane); if (q >= 1) x1 += t1; }
                float x2 = x1;  { const float t2 = shup(x1, 32, lane); if (q >= 2) x2 += t2; }
                const float excl = x2 - tot;
                const float lgL = __int_as_float(__builtin_amdgcn_ds_bpermute((48 + l15) << 2, __float_as_int(x2)));
                f32x4 At, Bh, Kh, vv; const float eex = __expf(excl), egL = __expf(lgL); float egprev = eex;
#pragma unroll
                for (int i = 0; i < 4; ++i) { const int idx = (q * 4 + i) * 72 + ct * 16 + l15; const float lgt = excl + lg[i];
                    const float rs = bf2f(R0[idx]), ks = bf2f(R1[idx]), vs = bf2f(R2[idx]); const float a = av[ct][i];
                    const float kkn = ks * kkc[ct] * inv[i], kd = ks * (1.0f + (a - 1.0f) * kac[ct]), beta = -kkn * a;
                    bon[i] += rs * kd * rkc[ct];
                    const float eg = __expf(lgt), egm = (i == 0) ? eex : egprev, ig = __builtin_amdgcn_rcpf(eg), gl = egL * ig; egprev = eg;
                    At[i] = kkn * egm; R0[idx] = f2bf(At[i]); R3[idx] = f2bf(rs * eg); R1[idx] = f2bf(beta * ig); R2[idx] = f2bf(kd * ig);
                    Bh[i] = beta * gl; Kh[i] = kd * gl; vv[i] = vs; }
                Apk[ct] = pack_lo4(At);
                { u32x2 w; w.x = pk_bf16(Bh[0], Bh[1]); w.y = pk_bf16(Bh[2], Bh[3]); *(LAS u32x2*)(BKT + (ct * 16 + l15) * 32 + q * 4) = w;
                  w.x = pk_bf16(Kh[0], Kh[1]); w.y = pk_bf16(Kh[2], Kh[3]); *(LAS u32x2*)(BKT + (ct * 16 + l15) * 32 + 16 + q * 4) = w;
                  w.x = pk_bf16(vv[0], vv[1]); w.y = pk_bf16(vv[2], vv[3]); *(LAS u32x2*)(VF + (ct * 64 + lane) * 4) = w; }
                glv[ct] = egL;
            }
#pragma unroll
            for (int i = 0; i < 4; ++i) { float s = bon[i]; s += shx<1>(s); s += shx<2>(s); s += shx<4>(s); s += shx<8>(s);
                if (l15 == 0) { const int o = o0 + q * 4 + i; const int srow = jn * 64 + (d == 0 ? o : 63 - o); BON[((size_t)b * TB + srow) * 16 + h] = s; } }
            WAVE_SYNC();
            f32x4 Mab = (f32x4){0.f, 0.f, 0.f, 0.f}, MabT = Mab, Mak = Mab, Nrb = Mab, Nrk = Mab;
#pragma unroll
            for (int kq = 0; kq < 2; ++kq) { const bf16x8 fa = ldsA(R0 + l15 * 72 + kq * 32 + q * 8), fr = ldsA(R3 + l15 * 72 + kq * 32 + q * 8), fb = ldsA(R1 + l15 * 72 + kq * 32 + q * 8), fk = ldsA(R2 + l15 * 72 + kq * 32 + q * 8);
                Mab = MFMA16(fa, fb, Mab); MabT = MFMA16(fb, fa, MabT); Mak = MFMA16(fa, fk, Mak); Nrb = MFMA16(fr, fb, Nrb); Nrk = MFMA16(fr, fk, Nrk); }
#pragma unroll
            for (int i = 0; i < 4; ++i) { const int rr_ = q * 4 + i; if (!(l15 < rr_)) { Mab[i] = 0.f; Mak[i] = 0.f; } if (!(rr_ < l15)) MabT[i] = 0.f; if (!(l15 <= rr_)) { Nrb[i] = 0.f; Nrk[i] = 0.f; } }
            f32x4 TT;
            {   f32x4 eye;
#pragma unroll
                for (int i = 0; i < 4; ++i) eye[i] = (q * 4 + i == l15) ? 1.0f : 0.0f;
                const f32x4 M2 = mm16(MabT, Mab), N2 = mm16(Mab, MabT);
                const f32x4 M4 = mm16(N2, M2), N4 = mm16(M2, N2);
                const f32x4 N8 = mm16(M4, N4);
                const f32x4 W1 = mm16(M4 + eye, N8 + eye);
                const f32x4 W2 = mm16(M2 + eye, W1);
                TT = mm16(Mab + eye, W2); }
            WAVE_SYNC();
            {   const bf16x8 Tp = pack_lo4(TT);
                LAS bf16_t* AH = R0; LAS bf16_t* NN = (LAS bf16_t*)(wb + RWC_NN); LAS bf16_t* TMm = (LAS bf16_t*)(wb + RWC_TM);
#pragma unroll
                for (int ct = 0; ct < 4; ++ct) { f32x4 ah = (f32x4){0.f, 0.f, 0.f, 0.f}; ah = MFMA16(Tp, Apk[ct], ah);
#pragma unroll
                    for (int i = 0; i < 4; ++i) AH[(q * 4 + i) * 72 + ct * 16 + l15] = f2bf(ah[i]); }
                f32x4 tm = (f32x4){0.f, 0.f, 0.f, 0.f}; tm = MFMA16(Tp, pack_lo4(Mak), tm);
#pragma unroll
                for (int i = 0; i < 4; ++i) { const int t = q * 4 + i; NN[t * 32 + l15] = f2bf(Nrb[i]); NN[t * 32 + 16 + l15] = f2bf(Nrk[i]); TMm[t * 16 + l15] = f2bf(tm[i]); }
                if (q == 0) {
#pragma unroll
                    for (int ct = 0; ct < 4; ++ct) ((LAS float*)(wb + RWC_GL))[ct * 16 + l15] = glv[ct]; } }
        }
        __syncthreads();
        if (wave < 4) {
            for (int c = 0; c < 8; ++c) {
                const LAS unsigned char* sb = wreg0 + c * RWC_WREG;
                const LAS bf16_t* AH = (const LAS bf16_t*)(sb + RWC_R0); const LAS bf16_t* RT = (const LAS bf16_t*)(sb + RWC_R3); const LAS bf16_t* BKT = (const LAS bf16_t*)(sb + RWC_BK);
                const LAS bf16_t* VF = (const LAS bf16_t*)(sb + RWC_V); const LAS bf16_t* NN = (const LAS bf16_t*)(sb + RWC_NN); const LAS bf16_t* TMm = (const LAS bf16_t*)(sb + RWC_TM); const LAS float* GL = (const LAS float*)(sb + RWC_GL);
                const bf16x8 Sb0 = pack_8(Sacc[0], Sacc[1]), Sb1 = pack_8(Sacc[2], Sacc[3]);
                const u32x2 vw = *(const LAS u32x2*)(VF + (wave * 64 + lane) * 4);
                bf16x8 V0; { u32x4 w; w.x = 0u; w.y = 0u; w.z = vw.x; w.w = vw.y; __builtin_memcpy(&V0, &w, 16); }
                bf16x8 TMf; { const u32x2 tq = *(const LAS u32x2*)(TMm + l15 * 16 + q * 4); u32x4 w; w.x = 0u; w.y = 0u; w.z = tq.x; w.w = tq.y; __builtin_memcpy(&TMf, &w, 16); }
                f32x4 U = (f32x4){0.f, 0.f, 0.f, 0.f};
                U = MFMA16(lds_2x8(AH + l15 * 72 + q * 4, AH + l15 * 72 + 16 + q * 4), Sb0, U);
                U = MFMA16(lds_2x8(AH + l15 * 72 + 32 + q * 4, AH + l15 * 72 + 48 + q * 4), Sb1, U);
                U = MFMA16(TMf, V0, U);
                bf16x8 UV; { u32x4 w; w.x = pk_bf16(U[0], U[1]); w.y = pk_bf16(U[2], U[3]); w.z = vw.x; w.w = vw.y; __builtin_memcpy(&UV, &w, 16); }
                f32x4 Y = (f32x4){0.f, 0.f, 0.f, 0.f};
                Y = MFMA16(lds_2x8(RT + l15 * 72 + q * 4, RT + l15 * 72 + 16 + q * 4), Sb0, Y);
                Y = MFMA16(lds_2x8(RT + l15 * 72 + 32 + q * 4, RT + l15 * 72 + 48 + q * 4), Sb1, Y);
                Y = MFMA16(lds_2x8(NN + l15 * 32 + q * 4, NN + l15 * 32 + 16 + q * 4), UV, Y);
#pragma unroll
                for (int x = 0; x < 4; ++x) { const f32x4 gl = *(const LAS f32x4*)(GL + x * 16 + q * 4); Sacc[x] *= gl;
                    Sacc[x] = MFMA16(lds_2x8(BKT + (x * 16 + l15) * 32 + q * 4, BKT + (x * 16 + l15) * 32 + 16 + q * 4), UV, Sacc[x]); }
                const int ch = rnd * 8 + c, j64 = ch >> 2, jn = nat_chunk(d, j64), o0 = (ch & 3) * 16;
#pragma unroll
                for (int i = 0; i < 4; ++i) { const int o = o0 + q * 4 + i; const int srow = jn * 64 + (d == 0 ? o : 63 - o);
                    YO[((size_t)b * TB + srow) * 1024 + h * 64 + wave * 16 + l15] = f2bf(Y[i]); }
            }
        }
        __syncthreads();
    }
}

__device__ __forceinline__ void rw_finish_item(const Frame& F, int tid, int layer, int it) {
    const int lane = tid & 63, wave = __builtin_amdgcn_readfirstlane(tid >> 6), l15 = lane & 15, q = lane >> 4;
    constexpr int YP = 1032;
    LAS bf16_t* GA = (LAS bf16_t*)F.lds;
    LAS float* mean_ = (LAS float*)(GA + 32 * 136);
    LAS float* rstd_ = mean_ + 512, *bon_ = rstd_ + 512;
    LAS bf16_t* YS = (LAS bf16_t*)(bon_ + 512);
    LAS bf16_t* VS = YS + 32 * YP;
    const bf16_t* P = (const bf16_t*)(F.ws + WS_P);
    const bf16_t* YF = (const bf16_t*)(F.ws + WS_SC + SC_RWF); const bf16_t* YB = (const bf16_t*)(F.ws + WS_SC + SC_RWB); void* RWO = (void*)(F.ws + WS_SC + SC_RWO);
    const float* BON = (const float*)(F.ws + WS_BONUS); const bf16_t* GUPT = (const bf16_t*)(F.ws + WS_GUPT);
    const float* mu = F.in[I_RWMU] + layer * 3456;
    const int hf = it & 1, it2 = it >> 1;
    const int b = it2 / NCH, jn = it2 - b * NCH; const size_t rb = (size_t)b * TB + jn * 64 + hf * 32; const int sb = jn * 64 + hf * 32;
#pragma unroll
    for (int i = 0; i < 9; ++i) { const int id = tid + i * NTHR; if (id < 34 * 128) { const int r = id >> 7, pc = id & 127; long gr = (long)rb - 1 + r; gr = gr < 0 ? 0 : (gr > R - 1 ? R - 1 : gr);
        *(LAS u32x4*)(VS + r * YP + pc * 8) = *(const u32x4*)(P + (size_t)gr * PW + PC_RV + pc * 8); } }
    if (tid < 256) { const int t = tid >> 3, c0 = (tid & 7) * 16;
#pragma unroll
      for (int hh = 0; hh < 2; ++hh) { float m8[8], g8[8];
#pragma unroll
          for (int e = 0; e < 8; ++e) m8[e] = mu[3328 + c0 + hh * 8 + e];
          tshift8(P, rb + t, sb + t, PC_GD + c0 + hh * 8, m8, g8);
#pragma unroll
          for (int e = 0; e < 8; ++e) GA[t * 136 + c0 + hh * 8 + e] = f2bf(sigmoidf_(g8[e])); } }
    { const int p = tid, t = p >> 4, hd = p & 15; const size_t row = rb + t; float v[64]; float s = 0.f;
#pragma unroll
        for (int c8 = 0; c8 < 8; ++c8) { float a[8], bq[8]; unpack8(*(const u32x4*)(YF + row * 1024 + hd * 64 + c8 * 8), a); unpack8(*(const u32x4*)(YB + row * 1024 + hd * 64 + c8 * 8), bq);
#pragma unroll
            for (int e = 0; e < 8; ++e) { v[c8 * 8 + e] = a[e] + bq[e]; s += v[c8 * 8 + e]; } }
        const float mean = s * (1.0f / 64.0f); float qq = 0.f;
#pragma unroll
        for (int e = 0; e < 64; ++e) { const float dlt = v[e] - mean; qq += dlt * dlt; }
        mean_[t * 16 + hd] = mean; rstd_[t * 16 + hd] = rsqrtf(qq * (1.0f / 64.0f) + 64e-5f);
        bon_[t * 16 + hd] = BON[row * 16 + hd] + BON[((size_t)R + row) * 16 + hd];
#pragma unroll
        for (int c8 = 0; c8 < 8; ++c8) { u32x4 w; w.x = pk_bf16(v[c8 * 8], v[c8 * 8 + 1]); w.y = pk_bf16(v[c8 * 8 + 2], v[c8 * 8 + 3]); w.z = pk_bf16(v[c8 * 8 + 4], v[c8 * 8 + 5]); w.w = pk_bf16(v[c8 * 8 + 6], v[c8 * 8 + 7]);
            *(LAS u32x4*)(YS + t * YP + hd * 64 + c8 * 8) = w; } }
    __syncthreads();
    const float* ng = F.in[I_RWNG] + layer * 1024; const float* nb = F.in[I_RWNB] + layer * 1024;
    float fpv[2], fnv[2];
#pragma unroll
    for (int rt = 0; rt < 2; ++rt) { const int srow = sb + rt * 16 + l15; const bool hp = (srow != 0 && srow != CTXL), hn = (srow != CTXL - 1 && srow != TB - 1); fpv[rt] = hp ? 0.5f : 0.f; fnv[rt] = hn ? 0.5f : 0.f; }
    bf16x8 afr[4]; f32x4 muv, ngc, nbc;
#define RWF_LOAD(cc_, AFR, MUV, NGC, NBC) do { const int ct_ = wave * 8 + (cc_); const int c0_ = ct_ * 16 + q * 4; \
        _Pragma("unroll") for (int kq = 0; kq < 4; ++kq) AFR[kq] = *(const bf16x8*)(GUPT + (size_t)(ct_ * 16 + l15) * 128 + kq * 32 + q * 8); \
        MUV = *(const f32x4*)(mu + 2048 + c0_); NGC = *(const f32x4*)(ng + c0_); NBC = *(const f32x4*)(nb + c0_); } while (0)
    RWF_LOAD(0, afr, muv, ngc, nbc);
#pragma unroll
    for (int cc = 0; cc < 8; ++cc) { const int ct = wave * 8 + cc; const int c0 = ct * 16 + q * 4, hd = c0 >> 6;
        bf16x8 afr2[4]; f32x4 muv2, ngc2, nbc2;
        if (cc + 1 < 8) RWF_LOAD(cc + 1, afr2, muv2, ngc2, nbc2);
#pragma unroll
        for (int rt = 0; rt < 2; ++rt) { f32x4 acc = (f32x4){0.f, 0.f, 0.f, 0.f};
#pragma unroll
            for (int kq = 0; kq < 4; ++kq) acc = MFMA16(afr[kq], ldsA(GA + (rt * 16 + l15) * 136 + kq * 32 + q * 8), acc);
            const int t = rt * 16 + l15; const size_t row = rb + t;
            const float fp = fpv[rt], fn = fnv[rt]; const float mean = mean_[t * 16 + hd], rstd = rstd_[t * 16 + hd], bon = bon_[t * 16 + hd];
            const u32x2 wy = *(const LAS u32x2*)(YS + t * YP + c0), wz = *(const LAS u32x2*)(VS + (t + 1) * YP + c0), wp = *(const LAS u32x2*)(VS + t * YP + c0), wn = *(const LAS u32x2*)(VS + (t + 2) * YP + c0);
            float o4[4];
#pragma unroll
            for (int i = 0; i < 4; ++i) { const unsigned sf = 16u;
                const unsigned uy = (i < 2 ? wy.x : wy.y), uz = (i < 2 ? wz.x : wz.y), up = (i < 2 ? wp.x : wp.y), un = (i < 2 ? wn.x : wn.y);
                const float ys = (i & 1) ? __uint_as_float(uy & 0xffff0000u) : __uint_as_float(uy << sf);
                const float vz = (i & 1) ? __uint_as_float(uz & 0xffff0000u) : __uint_as_float(uz << sf), vp = (i & 1) ? __uint_as_float(up & 0xffff0000u) : __uint_as_float(up << sf), vn = (i & 1) ? __uint_as_float(un & 0xffff0000u) : __uint_as_float(un << sf);
                const float yn = (ys - mean) * rstd * ngc[i] + nbc[i];
                const float vsft = vz + muv[i] * (fp * vp + fn * vn - vz);
                o4[i] = (yn + bon * vsft) * acc[i]; }
            st_op4(RWO, row * 1024 + c0, o4[0], o4[1], o4[2], o4[3]); }
        if (cc + 1 < 8) {
#pragma unroll
            for (int kq = 0; kq < 4; ++kq) afr[kq] = afr2[kq];
            muv = muv2; ngc = ngc2; nbc = nbc2; }
    }
#undef RWF_LOAD
    __syncthreads();
}

__device__ __forceinline__ void phase_prep(const Frame& F, int layer) {
    const int tid = ltid();
    for (int it = F.bid; it < 64; it += F.G) s5_tables_item(F, tid, layer, it);
}
__device__ __forceinline__ void phase_gin(const Frame& F) {
    dense_gemm<0, false>(F, F.ws + WS_U, F.ws + WS_WIN, R, PW, 2048, F.ws + WS_P, nullptr, nullptr, PW);
}
__device__ __forceinline__ void phase_conv_s5a(const Frame& F, int layer) {
    const int tid = ltid(), lane = tid & 63;
    for (int it = F.bid; it < 528 + 144; it += F.G) { if (it < 528) conv_item(F, tid, layer, it); else s5a_wave_item(F, lane, (it - 528) * 8 + F.wave); }
}
__device__ __forceinline__ void phase_scan(const Frame& F, int layer) {
    const int tid = ltid();
    if (F.bid < 128) rwkvc_item(F, tid, layer, F.bid);
    else { if (F.bid < 192) { s5b_item(F, tid, layer, F.bid - 128); __syncthreads(); } mlstm_item(F, tid, layer, F.bid - 128); }
}
__device__ __forceinline__ void phase_fin(const Frame& F, int layer) {
    const int tid = ltid(), lane = tid & 63;
    for (int it = F.bid; it < 1056; it += F.G) rw_finish_item(F, tid, layer, it);
    for (int it = F.bid; it < 256; it += F.G) s5c_block_item(F, tid, it);
    ml_finish_rows(F, lane, layer);
}

#ifndef MK_ABL
#define MK_ABL 0
#endif
constexpr int NPH_LAYER = 19;
constexpr int NPH = 2 * NPH_LAYER;
__global__ void __launch_bounds__(NTHR, 2) mega_fwd(Args args) {
    extern __shared__ __attribute__((aligned(16))) unsigned char lds_raw[];
    Frame F; F.in = args.in; F.out = args.out; F.ws = args.ws; F.lds = (LAS unsigned char*)lds_raw;
    F.wave = __builtin_amdgcn_readfirstlane(threadIdx.x >> 6); F.G = gridDim.x; F.bid = blockIdx.x;
    volatile LAS unsigned* xbw = (volatile LAS unsigned*)(F.lds + LDS_BYTES - 16);
    if (threadIdx.x == 0) { xbw[0] = 0u; xbw[1] = 0u; xbw[2] = 0u; xbw[3] = 0u; }
    __syncthreads();
    const int lo = args.ph_lo, hi = args.ph_hi;
    const bool one_launch = (hi - lo) > 1;
    XcdBarrier bar; bar.bar = (unsigned*)(F.ws + WS_CTL) + CW_BAR; bar.x = 0; bar.st = xbw;
    if (one_launch) bar = xcd_barrier_post((unsigned*)(F.ws + WS_CTL) + CW_BAR, xbw);
#define IN(k) (lo <= (k) && (k) < hi)
#define SEAM(k) do { if (IN(k) && IN((k) + 1)) xcd_barrier(bar); } while (0)
#define TILE_SEAM() do { asm volatile("s_waitcnt vmcnt(0)" ::: "memory"); __syncthreads(); } while (0)
    bf16_t* const T1 = (bf16_t*)(F.ws + WS_T1); bf16_t* const T2 = (bf16_t*)(F.ws + WS_T2); bf16_t* const T1b = (bf16_t*)(F.ws + WS_SC + SC_RWF);     bf16_t* const Z = (bf16_t*)(F.ws + WS_Z); bf16_t* const MIX = (bf16_t*)(F.ws + WS_MIX);
    unsigned char* const Zop = F8 ? F.ws + WS_QK : F.ws + WS_Z;
    const unsigned char* const U = F.ws + WS_U; const unsigned char* const WG = F.ws + WS_WG; const unsigned char* const WML = F.ws + WS_WML;
    const unsigned char* const ML = F.ws + WS_SC + SC_ML; const unsigned char* const RWo = F.ws + WS_SC + SC_RWO; const unsigned char* const S5o = F.ws + WS_SC + SC_S5;
    for (int layer = 0; layer < 2; ++layer) {
        const int pb = layer * NPH_LAYER;
        const int rA = 0, rB = layer == 0 ? 32 : 0, rC = layer == 0 ? 64 : 0;
        if (IN(pb + 0)) { phase_prep(F, layer); if (layer == 0) phase_mods(F); phase_wprep(F, layer); }
        SEAM(pb + 0);
        if (IN(pb + 1)) { if (layer == 0) phase_ln1(F, layer); }
        if (layer == 0) SEAM(pb + 1);
        if (IN(pb + 2)) { phase_gin(F); }
        SEAM(pb + 2);
        if (IN(pb + 3)) { phase_conv_s5a(F, layer); }
        SEAM(pb + 3);
        if (IN(pb + 4)) { phase_scan(F, layer); }
        SEAM(pb + 4);
        if (IN(pb + 5)) { phase_fin(F, layer); }
        SEAM(pb + 5);
        if (IN(pb + 6)) { dense_gemm<0, false>(F, ML, WML, R, 2048, 1024, T1, nullptr, nullptr, 2048, layer == 1, rA); }
        TILE_SEAM();
        if (IN(pb + 8)) { dense_gemm<0, false>(F, RWo, WML + (size_t)1 * 2048 * 1024 * OPB, R, 2048, 1024, T1b, nullptr, nullptr, 2048, layer == 1, rB); }
        SEAM(pb + 8);
        if (IN(pb + 9)) { dense_gemm<6, false>(F, U, WG, R, 4096, 2048, Z, T1, T1b, 2048, layer == 1); }
        TILE_SEAM();
        if (IN(pb + 10)) { dense_gemm<5, false>(F, S5o, WML + (size_t)2 * 2048 * 1024 * OPB, R, 4096, 1024, T2, nullptr, nullptr, 2048, layer == 1); }
        SEAM(pb + 10);
        if (IN(pb + 12)) { dense_gemm<2, true>(F, U, WG + (size_t)4096 * 2048 * OPB, R, 2048, 2048, Zop, T2, Z, 2048, layer == 1, rC); }
        SEAM(pb + 12);
        if (IN(pb + 13)) { dense_gemm<7, true>(F, Zop, F.ws + WS_WOUT, R, 2048, 2048, MIX, nullptr, nullptr, 2048, layer == 1); }
        SEAM(pb + 13);
        if (IN(pb + 14)) { phase_post1_route(F, layer, true); }
        SEAM(pb + 14);
        if (IN(pb + 15)) { phase_gather(F, layer); }
        SEAM(pb + 15);
        if (IN(pb + 16)) { phase_moe_gemm(F, layer, 0); }
        SEAM(pb + 16);
        if (IN(pb + 17)) { phase_moe_gemm(F, layer, 1); }
        SEAM(pb + 17);
        if (IN(pb + 18)) { phase_post2_moe(F, layer, true); }
        SEAM(pb + 18);
    }
#undef IN
#undef SEAM
#undef TILE_SEAM
}

#ifndef MK_ONE_LAUNCH
#define MK_ONE_LAUNCH 1
#endif
extern "C" void kernel_launch(void* const* d_in, const int* in_sizes, int n_in, void* d_out, int out_size, void* d_ws, size_t ws_size, hipStream_t stream) {
    static int grid = 0;
    if (grid == 0) {
        if (n_in != N_IN || ws_size < WS_END) { fprintf(stderr, "kernel_launch: unexpected n_in %d / ws_size %zu (need %zu)\n", n_in, ws_size, (size_t)WS_END); grid = -1; return; }
        int dev = 0, cus = 0, per_cu = 0;
        if (hipGetDevice(&dev) != hipSuccess || hipDeviceGetAttribute(&cus, hipDeviceAttributeMultiprocessorCount, dev) != hipSuccess) { grid = -1; return; }
        if (hipFuncSetAttribute((const void*)mega_fwd, hipFuncAttributeMaxDynamicSharedMemorySize, LDS_BYTES) != hipSuccess) { fprintf(stderr, "kernel_launch: hipFuncSetAttribute failed\n"); grid = -1; return; }
        if (hipOccupancyMaxActiveBlocksPerMultiprocessor(&per_cu, (const void*)mega_fwd, NTHR, LDS_BYTES) != hipSuccess || per_cu < 1) { fprintf(stderr, "kernel_launch: occupancy query says %d\n", per_cu); }
        (void)hipGetLastError();
        grid = 256;
        if (cus != 256) fprintf(stderr, "kernel_launch: %d CUs, this kernel is laid out for 256\n", cus);
    }
    if (grid < 0) return;
    (void)hipMemsetAsync((char*)d_ws + WS_CTL, 0, CTL_BYTES, stream);
    Args a{};
    for (int i = 0; i < N_IN; ++i) a.in[i] = (const float*)d_in[i];
    a.out = (float*)d_out; a.ws = (unsigned char*)d_ws;
#if MK_ONE_LAUNCH
    a.ph_lo = 0; a.ph_hi = NPH;
    hipLaunchKernelGGL(mega_fwd, dim3(grid), dim3(NTHR), LDS_BYTES, stream, a);
#else
    for (int p = 0; p < NPH; ++p) { a.ph_lo = p; a.ph_hi = p + 1; hipLaunchKernelGGL(mega_fwd, dim3(grid), dim3(NTHR), LDS_BYTES, stream, a); }
#endif
}
```
